# Optimizing an MI355X kernel written in HIP

```python
import jax, jax.numpy as jnp
from jax import lax
import numpy as np

D_MODEL = 1024
BATCH = 8
SEQ = 4096
DEPTH = 4

EPS = 1e-6
BLOCK = 128
HEAD_DIM = 128
N_HEADS_A = 4
N_HEADS_B = 4
N_IDX_HEADS = 8
IDX_DIM = 64
TOPK_MAX = 256
N_HEADS_C = 4
QK_NOPE_DIM = 128
QK_ROPE_DIM = 64
V_DIM_C = 128
Q_LORA = 384
KV_LORA = 256
ROPE_THETA = 10000.0
SSM_D_INNER = 1024
SSM_HEAD_DIM = 64
SSM_HEADS = SSM_D_INNER // SSM_HEAD_DIM
SSM_GROUPS = 4
SSM_STATE = 128
CONV_WIDTH = 4
SSM_CHUNK = 128
CONV_DIM = SSM_D_INNER + 2 * SSM_GROUPS * SSM_STATE
D_FF = 4 * D_MODEL

N_EVEN = (DEPTH + 1) // 2
N_ODD = DEPTH // 2

EVEN_COLS = (N_HEADS_A * HEAD_DIM, HEAD_DIM, HEAD_DIM,
             N_IDX_HEADS * IDX_DIM, IDX_DIM, N_IDX_HEADS,
             N_HEADS_B * HEAD_DIM, N_HEADS_B * HEAD_DIM, N_HEADS_B * HEAD_DIM, N_HEADS_B)
ODD_COLS = (Q_LORA, KV_LORA, QK_ROPE_DIM,
            SSM_D_INNER, CONV_DIM, SSM_HEADS)
W_IN_EVEN = sum(EVEN_COLS)
W_IN_ODD = sum(ODD_COLS)
W_OUT_EVEN = N_HEADS_A * HEAD_DIM + N_HEADS_B * HEAD_DIM
W_OUT_ODD = N_HEADS_C * V_DIM_C + SSM_D_INNER

kernel_name = 'hybrid_dsa_fox_mla_mamba2_trunk'


def split_cols(t, sizes):
    out, off = [], 0
    for n in sizes:
        out.append(t[..., off:off + n])
        off += n
    return out


def rms_norm(x, g):
    x32 = x.astype(jnp.float32)
    y = x32 * lax.rsqrt(jnp.mean(x32 * x32, axis=-1, keepdims=True) + EPS)
    return (y * g.astype(jnp.float32)).astype(x.dtype)


def rope(x, positions):
    half = QK_ROPE_DIM // 2
    inv_freq = ROPE_THETA ** (-jnp.arange(half, dtype=jnp.float32) / half)
    ang = positions.astype(jnp.float32)[..., None] * inv_freq
    cos, sin = jnp.cos(ang)[:, :, None, :], jnp.sin(ang)[:, :, None, :]
    x32 = x.astype(jnp.float32)
    x1, x2 = x32[..., :half], x32[..., half:]
    return jnp.concatenate([x1 * cos - x2 * sin, x2 * cos + x1 * sin], axis=-1).astype(x.dtype)


def to_blocks(t, nb):
    return t.reshape(t.shape[0], nb, BLOCK, *t.shape[2:]).swapaxes(0, 1)


def causal_softmax_attention(q, k, v, log_decay=None):
    B, S, H, Dq = q.shape
    nb = S // BLOCK
    scale = Dq ** -0.5
    kpos = jnp.arange(S)
    ck = None if log_decay is None else log_decay.transpose(0, 2, 1)

    def block(args):
        qi, start = args
        logits = jnp.einsum('bqhd,bkhd->bhqk', qi, k).astype(jnp.float32) * scale
        if ck is not None:
            ci = lax.dynamic_slice_in_dim(ck, start, BLOCK, axis=2)
            logits = logits + ci[..., None] - ck[:, :, None, :]
        qpos = start + jnp.arange(BLOCK)
        mask = kpos[None, :] <= qpos[:, None]
        logits = jnp.where(mask, logits, -jnp.inf)
        p = jax.nn.softmax(logits, axis=-1).astype(v.dtype)
        return jnp.einsum('bhqk,bkhd->bqhd', p, v)

    out = lax.map(block, (to_blocks(q, nb), jnp.arange(nb) * BLOCK))
    return out.swapaxes(0, 1).reshape(B, S, H, v.shape[-1])


def dsa_attention(q, k, v, q_idx, k_idx, w_idx, topk):
    B, S, H, D = q.shape
    nb = S // BLOCK
    scale = D ** -0.5
    kpos = jnp.arange(S)
    gather = jax.vmap(lambda t, i: t[i])

    def block(args):
        qi, qii, wi, start = args
        s_h = jnp.einsum('bqjd,bkd->bjqk', qii, k_idx).astype(jnp.float32)
        score = jnp.einsum('bqj,bjqk->bqk', wi.astype(jnp.float32), jax.nn.relu(s_h))
        qpos = start + jnp.arange(BLOCK)
        admissible = kpos[None, :] <= qpos[:, None]
        score = jnp.where(admissible[None], score, -jnp.inf)
        _, idx = lax.top_k(score, topk)
        valid = idx <= qpos[None, :, None]
        k_sel = gather(k, idx)
        v_sel = gather(v, idx)
        logits = jnp.einsum('bqhd,bqkd->bhqk', qi, k_sel).astype(jnp.float32) * scale
        logits = jnp.where(valid[:, None], logits, -jnp.inf)
        p = jax.nn.softmax(logits, axis=-1).astype(v.dtype)
        return jnp.einsum('bhqk,bqkd->bqhd', p, v_sel)

    xs = (to_blocks(q, nb), to_blocks(q_idx, nb), to_blocks(w_idx, nb), jnp.arange(nb) * BLOCK)
    out = lax.map(block, xs)
    return out.swapaxes(0, 1).reshape(B, S, H, D)


def causal_depthwise_conv(x, w, b):
    C = x.shape[-1]
    xp = jnp.pad(x, ((0, 0), (CONV_WIDTH - 1, 0), (0, 0)))
    y = lax.conv_general_dilated(xp, w[:, None, :].astype(x.dtype), window_strides=(1,), padding='VALID',
                                 dimension_numbers=('NWC', 'WIO', 'NWC'), feature_group_count=C)
    return y + b.astype(x.dtype)


def ssd_chunked(x, dt, A, Bm, Cm):
    Bsz, S, H, P = x.shape
    G, N = Bm.shape[2], Bm.shape[3]
    R = H // G
    Q = SSM_CHUNK
    nc = S // Q
    xd = (x.astype(jnp.float32) * dt[..., None]).reshape(Bsz, nc, Q, G, R, P)
    a = (dt * A).reshape(Bsz, nc, Q, G, R)
    Bc = Bm.astype(jnp.float32).reshape(Bsz, nc, Q, G, N)
    Cc = Cm.astype(jnp.float32).reshape(Bsz, nc, Q, G, N)
    a_cum = jnp.cumsum(a, axis=2)
    acT = jnp.moveaxis(a_cum, 2, -1)
    causal = jnp.tril(jnp.ones((Q, Q), dtype=bool))
    Lmat = jnp.exp(jnp.where(causal, acT[..., :, None] - acT[..., None, :], -jnp.inf))
    CB = jnp.einsum('bclgn,bcsgn->bcgls', Cc, Bc)
    y_diag = jnp.einsum('bcgrls,bcsgrp->bclgrp', CB[:, :, :, None] * Lmat, xd)
    decay_to_end = jnp.exp(a_cum[:, :, -1:] - a_cum)
    states = jnp.einsum('bclgn,bclgrp->bcgrpn', Bc, xd * decay_to_end[..., None])
    chunk_decay = jnp.exp(a_cum[:, :, -1])

    def step(h, inp):
        st, dec = inp
        return h * dec[..., None, None] + st, h

    h0 = jnp.zeros((Bsz, G, R, P, N), jnp.float32)
    _, h_start = lax.scan(step, h0, (jnp.moveaxis(states, 1, 0), jnp.moveaxis(chunk_decay, 1, 0)))
    h_start = jnp.moveaxis(h_start, 0, 1)
    y_off = jnp.einsum('bclgn,bcgrpn->bclgrp', Cc, h_start) * jnp.exp(a_cum)[..., None]
    return (y_diag + y_off).reshape(Bsz, S, H, P)


def even_mixer(h, w_in, b_f, qn_a, kn_a, qn_b, kn_b, w_out):
    B, S, _ = h.shape
    topk = min(TOPK_MAX, S // 4)
    qa, ka, va, qi, ki, wi, qb, kb, vb, fb = split_cols(h @ w_in, EVEN_COLS)
    qa = rms_norm(qa.reshape(B, S, N_HEADS_A, HEAD_DIM), qn_a)
    ka = rms_norm(ka, kn_a)
    qi = qi.reshape(B, S, N_IDX_HEADS, IDX_DIM)
    oa = dsa_attention(qa, ka, va, qi, ki, wi, topk)
    qb = rms_norm(qb.reshape(B, S, N_HEADS_B, HEAD_DIM), qn_b)
    kb = rms_norm(kb.reshape(B, S, N_HEADS_B, HEAD_DIM), kn_b)
    vb = vb.reshape(B, S, N_HEADS_B, HEAD_DIM)
    log_f = jax.nn.log_sigmoid((fb + b_f).astype(jnp.float32))
    ob = causal_softmax_attention(qb, kb, vb, jnp.cumsum(log_f, axis=1))
    o = jnp.concatenate([oa.reshape(B, S, -1), ob.reshape(B, S, -1)], axis=-1)
    return o @ w_out


def odd_mixer(h, positions, w_in, cq_norm, ckv_norm, w_uq, w_ukv, qn_c, kn_c,
              conv_w, conv_b, dt_bias, a_log, d_skip, gate_norm, w_out):
    B, S, _ = h.shape
    cq, ckv, kr, z, xbc, dt = split_cols(h @ w_in, ODD_COLS)
    q = (rms_norm(cq, cq_norm) @ w_uq).reshape(B, S, N_HEADS_C, QK_NOPE_DIM + QK_ROPE_DIM)
    kv = (rms_norm(ckv, ckv_norm) @ w_ukv).reshape(B, S, N_HEADS_C, QK_NOPE_DIM + V_DIM_C)
    k_nope, v = kv[..., :QK_NOPE_DIM], kv[..., QK_NOPE_DIM:]
    k = jnp.concatenate([k_nope, jnp.broadcast_to(kr[:, :, None, :], (B, S, N_HEADS_C, QK_ROPE_DIM))], axis=-1)
    q = rms_norm(q, qn_c)
    k = rms_norm(k, kn_c)
    q = jnp.concatenate([q[..., :QK_NOPE_DIM], rope(q[..., QK_NOPE_DIM:], positions)], axis=-1)
    k = jnp.concatenate([k[..., :QK_NOPE_DIM], rope(k[..., QK_NOPE_DIM:], positions)], axis=-1)
    oc = causal_softmax_attention(q, k, v)
    xbc = jax.nn.silu(causal_depthwise_conv(xbc, conv_w, conv_b))
    xs, Bm, Cm = split_cols(xbc, (SSM_D_INNER, SSM_GROUPS * SSM_STATE, SSM_GROUPS * SSM_STATE))
    xs = xs.reshape(B, S, SSM_HEADS, SSM_HEAD_DIM)
    Bm = Bm.reshape(B, S, SSM_GROUPS, SSM_STATE)
    Cm = Cm.reshape(B, S, SSM_GROUPS, SSM_STATE)
    dt = jax.nn.softplus((dt + dt_bias).astype(jnp.float32))
    A = -jnp.exp(a_log.astype(jnp.float32))
    y = ssd_chunked(xs, dt, A, Bm, Cm) + d_skip.astype(jnp.float32)[:, None] * xs.astype(jnp.float32)
    y = y.reshape(B, S, SSM_D_INNER) * jax.nn.silu(z.astype(jnp.float32))
    y = rms_norm(y.reshape(B, S, SSM_GROUPS, -1), gate_norm.reshape(SSM_GROUPS, -1))
    y = y.reshape(B, S, SSM_D_INNER).astype(h.dtype)
    o = jnp.concatenate([oc.reshape(B, S, -1), y], axis=-1)
    return o @ w_out


def squared_relu_mlp(h, w1, w2):
    return jnp.square(jax.nn.relu(h @ w1)) @ w2


def setup_inputs(seed: int = 0) -> dict:
    key = jax.random.key(seed)
    ks = jax.random.split(key, 32)
    f32 = jnp.float32

    def nrm(k, shape, scale):
        return jax.random.normal(k, shape, f32) * scale

    def gain(k, shape):
        return 1.0 + 0.02 * jax.random.normal(k, shape, f32)

    dt_init = jnp.exp(jax.random.uniform(ks[20], (N_ODD, SSM_HEADS), f32, np.log(1e-3), np.log(1e-1)))
    return {
        'x': nrm(ks[0], (BATCH, SEQ, D_MODEL), 1.0),
        'positions': jnp.tile(jnp.arange(SEQ, dtype=jnp.int32)[None, :], (BATCH, 1)),
        'ev_norm': gain(ks[1], (N_EVEN, D_MODEL)),
        'ev_w_in': nrm(ks[2], (N_EVEN, D_MODEL, W_IN_EVEN), D_MODEL ** -0.5),
        'ev_b_f': jax.random.uniform(ks[3], (N_EVEN, N_HEADS_B), f32, 1.0, 4.0),
        'ev_qn_a': gain(ks[4], (N_EVEN, HEAD_DIM)),
        'ev_kn_a': gain(ks[5], (N_EVEN, HEAD_DIM)),
        'ev_qn_b': gain(ks[6], (N_EVEN, HEAD_DIM)),
        'ev_kn_b': gain(ks[7], (N_EVEN, HEAD_DIM)),
        'ev_w_out': nrm(ks[8], (N_EVEN, W_OUT_EVEN, D_MODEL), W_OUT_EVEN ** -0.5),
        'od_norm': gain(ks[9], (N_ODD, D_MODEL)),
        'od_w_in': nrm(ks[10], (N_ODD, D_MODEL, W_IN_ODD), D_MODEL ** -0.5),
        'od_cq_norm': gain(ks[11], (N_ODD, Q_LORA)),
        'od_ckv_norm': gain(ks[12], (N_ODD, KV_LORA)),
        'od_w_uq': nrm(ks[13], (N_ODD, Q_LORA, N_HEADS_C * (QK_NOPE_DIM + QK_ROPE_DIM)), Q_LORA ** -0.5),
        'od_w_ukv': nrm(ks[14], (N_ODD, KV_LORA, N_HEADS_C * (QK_NOPE_DIM + V_DIM_C)), KV_LORA ** -0.5),
        'od_qn_c': gain(ks[15], (N_ODD, QK_NOPE_DIM + QK_ROPE_DIM)),
        'od_kn_c': gain(ks[16], (N_ODD, QK_NOPE_DIM + QK_ROPE_DIM)),
        'od_conv_w': nrm(ks[17], (N_ODD, CONV_WIDTH, CONV_DIM), CONV_WIDTH ** -0.5),
        'od_conv_b': nrm(ks[18], (N_ODD, CONV_DIM), 0.02),
        'od_dt_bias': dt_init + jnp.log(-jnp.expm1(-dt_init)),
        'od_a_log': jnp.log(jax.random.uniform(ks[21], (N_ODD, SSM_HEADS), f32, 1.0, 16.0)),
        'od_d_skip': 1.0 + 0.1 * jax.random.normal(ks[22], (N_ODD, SSM_HEADS), f32),
        'od_gate_norm': gain(ks[23], (N_ODD, SSM_D_INNER)),
        'od_w_out': nrm(ks[24], (N_ODD, W_OUT_ODD, D_MODEL), W_OUT_ODD ** -0.5),
        'mlp_norm': gain(ks[25], (DEPTH, D_MODEL)),
        'mlp_w1': nrm(ks[26], (DEPTH, D_MODEL, D_FF), D_MODEL ** -0.5),
        'mlp_w2': nrm(ks[27], (DEPTH, D_FF, D_MODEL), D_FF ** -0.5),
    }


def reference(x, positions, ev_norm, ev_w_in, ev_b_f, ev_qn_a, ev_kn_a, ev_qn_b, ev_kn_b, ev_w_out,
              od_norm, od_w_in, od_cq_norm, od_ckv_norm, od_w_uq, od_w_ukv, od_qn_c, od_kn_c,
              od_conv_w, od_conv_b, od_dt_bias, od_a_log, od_d_skip, od_gate_norm, od_w_out,
              mlp_norm, mlp_w1, mlp_w2):
    for layer in range(DEPTH):
        i = layer // 2
        if layer % 2 == 0:
            x = x + even_mixer(rms_norm(x, ev_norm[i]), ev_w_in[i], ev_b_f[i], ev_qn_a[i], ev_kn_a[i],
                               ev_qn_b[i], ev_kn_b[i], ev_w_out[i])
        else:
            x = x + odd_mixer(rms_norm(x, od_norm[i]), positions, od_w_in[i], od_cq_norm[i], od_ckv_norm[i],
                              od_w_uq[i], od_w_ukv[i], od_qn_c[i], od_kn_c[i], od_conv_w[i], od_conv_b[i],
                              od_dt_bias[i], od_a_log[i], od_d_skip[i], od_gate_norm[i], od_w_out[i])
        x = x + squared_relu_mlp(rms_norm(x, mlp_norm[layer]), mlp_w1[layer], mlp_w2[layer])
    return x
```

```cpp
#include <hip/hip_runtime.h>
#include <hip/hip_bf16.h>
#include <cstdio>
#include <cstdint>
#include <cmath>

constexpr int BATCH = 8, SEQ = 4096, DM = 1024, MTOK = BATCH * SEQ, DFF = 4096;
constexpr int N_E_IN = 3072, N_O_IN = 3840;
constexpr int K_O_OUT = 1536;
constexpr float EPS = 1e-6f;
constexpr float LOG2E = 1.4426950408889634f;
constexpr float QSCALE128 = 0.08838834764831845f * LOG2E;
constexpr float QSCALE192 = 0.07216878364870323f * LOG2E;

constexpr size_t MiB = 1u << 20;
constexpr size_t WS_CTL = 0, CTL_ZERO_BYTES = 1 * MiB;
constexpr size_t WS_SSP = 1 * MiB;
constexpr size_t WS_CUMB = WS_SSP + 512 * 1024;
constexpr size_t WS_MISC32 = 2 * MiB;
constexpr size_t WS_GSS = 4 * MiB;
constexpr size_t WS_SSY = 5 * MiB;
constexpr size_t WS_ROPE = 9 * MiB;
constexpr size_t WS_BM = 17 * MiB;
constexpr size_t WS_W = 33 * MiB;
constexpr size_t WS_XB = 85 * MiB;
constexpr size_t WS_R = 149 * MiB;
constexpr size_t WS_END = 501 * MiB;
constexpr size_t WE_IN = 0, WE_OUT = 6 * MiB, WE_1 = 8 * MiB, WE_2 = 16 * MiB;
constexpr size_t WO_IN = 24 * MiB, WO_UQ = 24 * MiB + 7680 * 1024, WO_UKV = WO_UQ + 768 * 1024, WO_OUT = WO_UKV + 512 * 1024, WO_1 = 36 * MiB, WO_2 = 44 * MiB;
static_assert(WO_OUT + 3 * MiB <= WO_1, "weights map");
constexpr size_t R_EP = 0, R_AOE = 192 * MiB;
constexpr size_t R_C1 = 0, R_AO = 48 * MiB, R_XBC = 144 * MiB, R_KK = 272 * MiB, R_VV = 320 * MiB;
constexpr size_t R_H = 0;
constexpr int CW_TMO = 0;
constexpr int CW_BAR = 4096;
constexpr int CW_QUEUE = 16384;

constexpr int RING_BYTES = 131072;
constexpr int LDS_STAT = 139264;
constexpr int LDS_CAND = 147456;
constexpr int LDS_MISC = 155136;
constexpr int LDS_BYTES = 155648;


__device__ __forceinline__ int olane() { int l; asm volatile("v_mbcnt_lo_u32_b32 %0, -1, 0\n\tv_mbcnt_hi_u32_b32 %0, -1, %0" : "=v"(l)); return l; }
__device__ __forceinline__ int otid(int wave_s) { return (wave_s << 6) | olane(); }
template <int M> __device__ __forceinline__ float xor_f(float v) {
    if constexpr (M == 32) { auto rr = __builtin_amdgcn_permlane32_swap(__float_as_uint(v), __float_as_uint(v), false, false); return __uint_as_float(rr[0] == __float_as_uint(v) ? rr[1] : rr[0]); }
    else return __int_as_float(__builtin_amdgcn_ds_swizzle(__float_as_int(v), (M << 10) | 0x1f));
}
__device__ __forceinline__ float up_f(float v, int o) { const int l = olane(); const int s = (l - o) < 0 ? l : (l - o); return __int_as_float(__builtin_amdgcn_ds_bpermute(s << 2, __float_as_int(v))); }
__device__ __forceinline__ int down_i(int v, int o) { const int l = olane(); const int s = (l + o) > 63 ? l : (l + o); return __builtin_amdgcn_ds_bpermute(s << 2, v); }
__device__ __forceinline__ float wsum_f(float v) { v += xor_f<1>(v); v += xor_f<2>(v); v += xor_f<4>(v); v += xor_f<8>(v); v += xor_f<16>(v); v += xor_f<32>(v); return v; }
__device__ __forceinline__ float wmin_f(float v) { v = fminf(v, xor_f<1>(v)); v = fminf(v, xor_f<2>(v)); v = fminf(v, xor_f<4>(v)); v = fminf(v, xor_f<8>(v)); v = fminf(v, xor_f<16>(v)); v = fminf(v, xor_f<32>(v)); return v; }
__device__ __forceinline__ float wmax_f(float v) { v = fmaxf(v, xor_f<1>(v)); v = fmaxf(v, xor_f<2>(v)); v = fmaxf(v, xor_f<4>(v)); v = fmaxf(v, xor_f<8>(v)); v = fmaxf(v, xor_f<16>(v)); v = fmaxf(v, xor_f<32>(v)); return v; }
namespace pg8 {
#define PG8_LAS __attribute__((address_space(3)))
typedef unsigned short bf16_t;
typedef short bf16x8 __attribute__((ext_vector_type(8)));
typedef float f32x4 __attribute__((ext_vector_type(4)));
typedef unsigned u32x4 __attribute__((ext_vector_type(4)));
constexpr int BM = 256, BK = 64, HALF = 128, HTB = HALF * BK * 2  , STAGE_BYTES = 8 * HTB, NXCD = 8, WGM = 8;

__host__ __device__ __forceinline__ int lds_byte(int r, int c) { const int st = (r >> 4) * 2 + (c >> 5), rr = r & 15, cc = c & 31, ob = rr * 64 + cc * 2; return st * 1024 + (ob ^ (((ob >> 9) & 1) << 5)); }
__host__ __device__ __forceinline__ void stage_rc(int b, int& R, int& C) { const int st = b / 1024, sb = b % 1024, swz = sb ^ (((sb >> 9) & 1) << 5); R = (st >> 1) * 16 + swz / 64; C = (st & 1) * 32 + (swz % 64) / 2; }
__host__ __device__ __forceinline__ int perm32(int rho) { const int n = rho >> 4, i = rho & 15; return 8 * (i >> 2) + 4 * n + (i & 3); }

struct Unit { int pm, pn; };
struct Gemm { const bf16_t* A; const bf16_t* Bt; int M, N, K, lda; };

struct StaticOrder {
    int nM, nN, nwg, G, c;
    __host__ __device__ void init(int M, int N, int G_, int c_) { nM = M / BM; nN = N / BM; nwg = nM * nN; G = G_; c = c_; }
    __host__ __device__ bool next(int i, Unit& u) const {
        const long L = (long)i * G + c; if (L >= nwg) return false;
        int wgid = (int)L; { const int q = nwg / NXCD, r = nwg % NXCD, xcd = wgid % NXCD, off = wgid / NXCD; wgid = (xcd < r ? xcd * (q + 1) : r * (q + 1) + (xcd - r) * q) + off; }
        const int nig = WGM * nN, gid = wgid / nig, fm = gid * WGM, gsz = (nM - fm) < WGM ? (nM - fm) : WGM;
        u.pm = fm + ((wgid % nig) % gsz); u.pn = (wgid % nig) / gsz; return true;
    }
    __device__ __forceinline__ void a_ready(const Unit&) const {}
    __device__ __forceinline__ void done(const Unit&) const {}
};


__device__ __forceinline__ unsigned cvt_pk_bf16(float lo, float hi) { unsigned r; asm volatile("v_cvt_pk_bf16_f32 %0, %1, %2" : "=v"(r) : "v"(lo), "v"(hi)); return r; }
typedef unsigned u32x2 __attribute__((ext_vector_type(2)));
#define EPI_BAR() do { asm volatile("s_waitcnt lgkmcnt(0)" ::: "memory"); __builtin_amdgcn_s_barrier(); asm volatile("" ::: "memory"); } while (0)
__device__ __forceinline__ float sq4(const f32x4 x) { return (x[0] * x[0] + x[1] * x[1]) + (x[2] * x[2] + x[3] * x[3]); }
__device__ __forceinline__ float red_fq(float q) { q += xor_f<16>(q); q += xor_f<32>(q); return q; }
__device__ __forceinline__ u32x4 pack8(const f32x4 a, const f32x4 b) { u32x4 w; w.x = cvt_pk_bf16(a[0], a[1]); w.y = cvt_pk_bf16(a[2], a[3]); w.z = cvt_pk_bf16(b[0], b[1]); w.w = cvt_pk_bf16(b[2], b[3]); return w; }
__device__ __forceinline__ float row_rs(const float* ssp, int row) { const float ss = (ssp[row] + ssp[MTOK + row]) + (ssp[2 * MTOK + row] + ssp[3 * MTOK + row]); return rsqrtf(ss * (1.0f / 1024.0f) + EPS); }
__device__ __forceinline__ float log_sigmoidf(float x) { return fminf(x, 0.f) - __logf(1.0f + __expf(-fabsf(x))); }
__device__ __forceinline__ float softplusf(float x) { return fmaxf(x, 0.f) + __logf(1.0f + __expf(-fabsf(x))); }

struct EpiEvenIn {
    static constexpr bool PERM = true, AFTER_DRAIN = false;
    bf16_t* EP; const float* ssp; float* misc32; const float* qn_a; const float* kn_a; const float* qn_b; const float* kn_b; const float* b_f; PG8_LAS float* st;
    __device__ __forceinline__ void operator()(f32x4 (&acc)[2][2][4][2], const Unit& u, int wr, int wc, int fr, int fq) const {
        const int tid_ = ((wr * 4 + wc) << 6) | (fq << 4) | fr;
        const int pn = u.pn;
        const float* g0 = nullptr; const float* g1 = nullptr; float s0 = 1.f, s1 = 1.f;
        if (pn <= 1) { g0 = qn_a; g1 = qn_a; s0 = QSCALE128; s1 = QSCALE128; }
        else if (pn == 2) { g0 = kn_a; }
        else if (pn == 6 || pn == 7) { g0 = qn_b; g1 = qn_b; s0 = QSCALE128; s1 = QSCALE128; }
        else if (pn == 8 || pn == 9) { g0 = kn_b; g1 = kn_b; }
        int rl0 = wr * 64 + fr; asm volatile("" : "+v"(rl0)); const int row0 = u.pm * BM + rl0;
        { const int tid = tid_; if (tid < 256) { st[2048 + tid] = row_rs(ssp, u.pm * BM + tid);
            const float* g = (tid >> 7) ? g1 : g0; st[2304 + tid] = g ? g[tid & 127] * ((tid >> 7) ? s1 : s0) : 1.f; } }
        EPI_BAR();
#pragma unroll
        for (int ai = 0; ai < 2; ++ai)
#pragma unroll
            for (int m = 0; m < 4; ++m) { const int rl = ai * HALF + rl0 + m * 16; const float rs = st[2048 + rl];
#pragma unroll
                for (int bj = 0; bj < 2; ++bj) { acc[ai][bj][m][0] *= rs; acc[ai][bj][m][1] *= rs;
                    if (g0 != nullptr) { const float q = red_fq(sq4(acc[ai][bj][m][0]) + sq4(acc[ai][bj][m][1])); if (fq == 0) st[(rl * 2 + bj) * 4 + wc] = q; } } }
        if (g0 != nullptr) EPI_BAR();
#pragma unroll
        for (int ai = 0; ai < 2; ++ai)
#pragma unroll
            for (int m = 0; m < 4; ++m) { const int rl = ai * HALF + rl0 + m * 16; bf16_t* rowp = EP + (size_t)(u.pm * BM + rl) * N_E_IN + pn * BM + wc * 32 + fq * 8;
#pragma unroll
                for (int bj = 0; bj < 2; ++bj) { float f = 1.f;
                    if ((bj ? g1 : g0) != nullptr) { const f32x4 p = *(const PG8_LAS f32x4*)(st + (rl * 2 + bj) * 4); f = rsqrtf(((p[0] + p[1]) + (p[2] + p[3])) * (1.0f / 128.0f) + EPS); }
                    const PG8_LAS float* gp = st + 2304 + bj * HALF + wc * 32 + fq * 8;
                    const f32x4 v0 = acc[ai][bj][m][0] * *(const PG8_LAS f32x4*)gp * f, v1 = acc[ai][bj][m][1] * *(const PG8_LAS f32x4*)(gp + 4) * f;
                    *(u32x4*)(rowp + bj * HALF) = pack8(v0, v1); }
                asm volatile("" ::: "memory"); }
        if (pn == 5 && wc == 2 && fq < 2) {
#pragma unroll
            for (int ai = 0; ai < 2; ++ai)
#pragma unroll
                for (int m = 0; m < 4; ++m) { float* mp = misc32 + (size_t)(row0 + ai * HALF + m * 16) * 16;
                    if (fq == 0) { *(f32x4*)(mp) = acc[ai][0][m][0]; *(f32x4*)(mp + 4) = acc[ai][0][m][1]; }
                    else { const f32x4 v = acc[ai][0][m][0], bf = *(const f32x4*)b_f; f32x4 lf;
#pragma unroll
                        for (int j = 0; j < 4; ++j) lf[j] = log_sigmoidf(v[j] + bf[j]);
                        *(f32x4*)(mp + 8) = lf; } }
        }
    }
};

struct EpiResid {
    static constexpr bool PERM = false, AFTER_DRAIN = false;
    const float* resid; float* xout; bf16_t* xb; float* ssp; PG8_LAS float* st;
    __device__ __forceinline__ void operator()(f32x4 (&acc)[2][2][4][2], const Unit& u, int wr, int wc, int fr, int fq) const {
        const int tid_ = ((wr * 4 + wc) << 6) | (fq << 4) | fr;
        int rl0 = wr * 64 + fr; asm volatile("" : "+v"(rl0));
#pragma unroll
        for (int ai = 0; ai < 2; ++ai)
#pragma unroll
            for (int m = 0; m < 4; ++m) { const int rl = ai * HALF + rl0 + m * 16; const size_t off = (size_t)(u.pm * BM + rl) * DM + u.pn * BM + wc * 32 + fq * 4; float q = 0.f;
#pragma unroll
                for (int bj = 0; bj < 2; ++bj)
#pragma unroll
                    for (int n = 0; n < 2; ++n) { const size_t o2 = off + bj * HALF + n * 16; const f32x4 v = *(const f32x4*)(resid + o2) + acc[ai][bj][m][n];
                        *(f32x4*)(xout + o2) = v; u32x2 w; w.x = cvt_pk_bf16(v[0], v[1]); w.y = cvt_pk_bf16(v[2], v[3]); *(u32x2*)(xb + o2) = w; q += sq4(v); }
                q = red_fq(q); if (fq == 0) st[rl * 4 + wc] = q;
                asm volatile("" ::: "memory"); }
        EPI_BAR();
        const int tid = tid_;
        if (tid < 256) { const f32x4 p = *(const PG8_LAS f32x4*)(st + tid * 4); ssp[(size_t)u.pn * MTOK + u.pm * BM + tid] = (p[0] + p[1]) + (p[2] + p[3]); }
    }
};

struct EpiMlpUp {
    static constexpr bool PERM = true, AFTER_DRAIN = false;
    bf16_t* H; const float* ssp;
    __device__ __forceinline__ void operator()(f32x4 (&acc)[2][2][4][2], const Unit& u, int wr, int wc, int fr, int fq) const {
        int row0 = u.pm * BM + wr * 64 + fr; asm volatile("" : "+v"(row0));
#pragma unroll
        for (int ai = 0; ai < 2; ++ai)
#pragma unroll
            for (int m = 0; m < 4; ++m) { const int row = row0 + ai * HALF + m * 16; const float rs = row_rs(ssp, row); bf16_t* rowp = H + (size_t)row * DFF + u.pn * BM + wc * 32 + fq * 8;
#pragma unroll
                for (int bj = 0; bj < 2; ++bj) { f32x4 v0 = acc[ai][bj][m][0] * rs, v1 = acc[ai][bj][m][1] * rs;
#pragma unroll
                    for (int j = 0; j < 4; ++j) { const float a = fmaxf(v0[j], 0.f), b = fmaxf(v1[j], 0.f); v0[j] = a * a; v1[j] = b * b; }
                    *(u32x4*)(rowp + bj * HALF) = pack8(v0, v1); } }
    }
};

struct EpiOddIn {
    static constexpr bool PERM = true, AFTER_DRAIN = false;
    bf16_t* C1; bf16_t* AO; bf16_t* XBC; const float* ssp; float* gss; float* dt32; const float* dt_bias; PG8_LAS float* st;
    __device__ __forceinline__ void operator()(f32x4 (&acc)[2][2][4][2], const Unit& u, int wr, int wc, int fr, int fq) const {
        const int tid_ = ((wr * 4 + wc) << 6) | (fq << 4) | fr;
        const int pn = u.pn; int rl0 = wr * 64 + fr; asm volatile("" : "+v"(rl0)); const int row0 = u.pm * BM + rl0;
        bf16_t* dst; int ld;
        if (pn < 3) { dst = C1 + pn * BM; ld = 768; } else if (pn < 7) { dst = AO + 512 + (pn - 3) * BM; ld = K_O_OUT; } else { dst = XBC + (pn - 7) * BM; ld = 2048; }
        { const int tid = tid_; if (tid < 256) st[2048 + tid] = row_rs(ssp, u.pm * BM + tid); }
        EPI_BAR();
#pragma unroll
        for (int ai = 0; ai < 2; ++ai)
#pragma unroll
            for (int m = 0; m < 4; ++m) { const int rl = ai * HALF + rl0 + m * 16; const float rs = st[2048 + rl]; bf16_t* rowp = dst + (size_t)(u.pm * BM + rl) * ld + wc * 32 + fq * 8;
#pragma unroll
                for (int bj = 0; bj < 2; ++bj) { acc[ai][bj][m][0] *= rs; acc[ai][bj][m][1] *= rs; *(u32x4*)(rowp + bj * HALF) = pack8(acc[ai][bj][m][0], acc[ai][bj][m][1]); }
                asm volatile("" ::: "memory"); }
        if (pn < 3) {
#pragma unroll
            for (int ai = 0; ai < 2; ++ai)
#pragma unroll
                for (int m = 0; m < 4; ++m)
#pragma unroll
                    for (int bj = 0; bj < 2; ++bj) { float q = sq4(acc[ai][bj][m][0]) + sq4(acc[ai][bj][m][1]);
                        if (pn == 2 && bj == 1 && wc >= 2) q = 0.f;
                        q = red_fq(q); if (fq == 0) st[((ai * HALF + rl0 + m * 16) * 2 + bj) * 4 + wc] = q; }
            EPI_BAR();
            const int tid = tid_;
            if (tid < 256) {
#pragma unroll
                for (int bj = 0; bj < 2; ++bj) { const f32x4 p = *(const PG8_LAS f32x4*)(st + (tid * 2 + bj) * 4); gss[(size_t)(u.pm * BM + tid) * 8 + 2 * pn + bj] = (p[0] + p[1]) + (p[2] + p[3]); } }
            if (pn == 2 && wc == 2 && fq < 2) {
                const f32x4 b0 = *(const f32x4*)(dt_bias + fq * 8), b1 = *(const f32x4*)(dt_bias + fq * 8 + 4);
#pragma unroll
                for (int ai = 0; ai < 2; ++ai)
#pragma unroll
                    for (int m = 0; m < 4; ++m) { float* mp = dt32 + (size_t)(row0 + ai * HALF + m * 16) * 16 + fq * 8; f32x4 d0, d1;
#pragma unroll
                        for (int j = 0; j < 4; ++j) { d0[j] = softplusf(acc[ai][1][m][0][j] + b0[j]); d1[j] = softplusf(acc[ai][1][m][1][j] + b1[j]); }
                        *(f32x4*)mp = d0; *(f32x4*)(mp + 4) = d1; }
            }
        }
    }
};

struct EpiUq {
    static constexpr bool PERM = true, AFTER_DRAIN = false;
    bf16_t* Q; const float* gss; const float* qn_c; const float* rope; PG8_LAS float* st;
    __device__ __forceinline__ void operator()(f32x4 (&acc)[2][2][4][2], const Unit& u, int wr, int wc, int fr, int fq) const {
        const int tid_ = ((wr * 4 + wc) << 6) | (fq << 4) | fr;
        const int h = u.pn; int rl0 = wr * 64 + fr; asm volatile("" : "+v"(rl0));
        { const int tid = tid_; if (tid < 256) { const float* gp = gss + (size_t)(u.pm * BM + tid) * 8; st[2048 + tid] = rsqrtf(((gp[0] + gp[1]) + gp[2]) * (1.0f / 384.0f) + EPS);
            float gg = 0.f; if (tid < 128) gg = qn_c[tid]; else if (tid < 192) { const int jj = tid - 128; gg = qn_c[128 + ((jj & 1) ? 32 : 0) + (jj >> 1)]; }
            st[2304 + tid] = gg * QSCALE192; } }
        EPI_BAR();
#pragma unroll
        for (int ai = 0; ai < 2; ++ai)
#pragma unroll
            for (int m = 0; m < 4; ++m) { const int rl = ai * HALF + rl0 + m * 16; const float rc = st[2048 + rl]; float q = 0.f;
#pragma unroll
                for (int bj = 0; bj < 2; ++bj) { acc[ai][bj][m][0] *= rc; acc[ai][bj][m][1] *= rc; q += sq4(acc[ai][bj][m][0]) + sq4(acc[ai][bj][m][1]); }
                q = red_fq(q); if (fq == 0) st[rl * 4 + wc] = q; }
        EPI_BAR();
        const int i0 = (wc & 1) * 16 + fq * 4;
#pragma unroll
        for (int ai = 0; ai < 2; ++ai)
#pragma unroll
            for (int m = 0; m < 4; ++m) { const int rl = ai * HALF + rl0 + m * 16; const int row = u.pm * BM + rl;
                const f32x4 p = *(const PG8_LAS f32x4*)(st + rl * 4); const float f = rsqrtf(((p[0] + p[1]) + (p[2] + p[3])) * (1.0f / 192.0f) + EPS);
                bf16_t* rowp = Q + (size_t)row * 768 + h * 192; const PG8_LAS float* gp = st + 2304 + wc * 32 + fq * 8;
                *(u32x4*)(rowp + wc * 32 + fq * 8) = pack8(acc[ai][0][m][0] * *(const PG8_LAS f32x4*)gp * f, acc[ai][0][m][1] * *(const PG8_LAS f32x4*)(gp + 4) * f);
                if (wc < 2) { const float* rp = rope + ((size_t)row * 32 + i0) * 2; const f32x4 cs0 = *(const f32x4*)rp, cs1 = *(const f32x4*)(rp + 4);
                    const f32x4 a = acc[ai][1][m][0] * *(const PG8_LAS f32x4*)(gp + HALF) * f, b = acc[ai][1][m][1] * *(const PG8_LAS f32x4*)(gp + HALF + 4) * f;
                    f32x4 o0, o1;
                    o0[0] = a[0] * cs0[0] - a[1] * cs0[1]; o0[1] = a[1] * cs0[0] + a[0] * cs0[1]; o0[2] = a[2] * cs0[2] - a[3] * cs0[3]; o0[3] = a[3] * cs0[2] + a[2] * cs0[3];
                    o1[0] = b[0] * cs1[0] - b[1] * cs1[1]; o1[1] = b[1] * cs1[0] + b[0] * cs1[1]; o1[2] = b[2] * cs1[2] - b[3] * cs1[3]; o1[3] = b[3] * cs1[2] + b[2] * cs1[3];
                    *(u32x4*)(rowp + 128 + wc * 32 + fq * 8) = pack8(o0, o1); }
                asm volatile("" ::: "memory"); }
    }
};

struct EpiUkv {
    static constexpr bool PERM = true, AFTER_DRAIN = false;
    bf16_t* KK; bf16_t* VV; const bf16_t* C1; const float* gss; const float* kn_c; const float* rope; PG8_LAS float* st;
    __device__ __forceinline__ void operator()(f32x4 (&acc)[2][2][4][2], const Unit& u, int wr, int wc, int fr, int fq) const {
        const int tid_ = ((wr * 4 + wc) << 6) | (fq << 4) | fr;
        const int h = u.pn; int rl0 = wr * 64 + fr; asm volatile("" : "+v"(rl0)); const int tid = tid_;
        if (tid < 256) { const float* gp = gss + (size_t)(u.pm * BM + tid) * 8; st[2048 + tid] = rsqrtf((gp[3] + gp[4]) * (1.0f / 256.0f) + EPS);
            float gg = 0.f; if (tid < 128) gg = kn_c[tid]; else if (tid < 192) { const int jj = tid - 128; gg = kn_c[128 + ((jj & 1) ? 32 : 0) + (jj >> 1)]; }
            st[2304 + tid] = gg; }
        EPI_BAR();
#pragma unroll
        for (int ai = 0; ai < 2; ++ai)
#pragma unroll
            for (int m = 0; m < 4; ++m) { const int rl = ai * HALF + rl0 + m * 16; const int row = u.pm * BM + rl; const float rc = st[2048 + rl];
#pragma unroll
                for (int bj = 0; bj < 2; ++bj) { acc[ai][bj][m][0] *= rc; acc[ai][bj][m][1] *= rc; }
                *(u32x4*)(VV + (size_t)row * 512 + h * 128 + wc * 32 + fq * 8) = pack8(acc[ai][1][m][0], acc[ai][1][m][1]);
                const float q = red_fq(sq4(acc[ai][0][m][0]) + sq4(acc[ai][0][m][1])); if (fq == 0) st[rl * 4 + wc] = q;
                asm volatile("" ::: "memory"); }
        EPI_BAR();
        if (tid < 256) { const f32x4 p = *(const PG8_LAS f32x4*)(st + tid * 4); const float ss = ((p[0] + p[1]) + (p[2] + p[3])) + gss[(size_t)(u.pm * BM + tid) * 8 + 5];
            st[2048 + tid] = rsqrtf(ss * (1.0f / 192.0f) + EPS); }
        EPI_BAR();
#pragma unroll
        for (int ai = 0; ai < 2; ++ai)
#pragma unroll
            for (int m = 0; m < 4; ++m) { const int rl = ai * HALF + rl0 + m * 16; const float f = st[2048 + rl]; const PG8_LAS float* gp = st + 2304 + wc * 32 + fq * 8;
                *(u32x4*)(KK + (size_t)(u.pm * BM + rl) * 768 + h * 192 + wc * 32 + fq * 8) = pack8(acc[ai][0][m][0] * *(const PG8_LAS f32x4*)gp * f, acc[ai][0][m][1] * *(const PG8_LAS f32x4*)(gp + 4) * f);
                asm volatile("" ::: "memory"); }
        { const int rl = tid >> 1, ib = (tid & 1) * 16; const int row = u.pm * BM + rl; const float f = st[2048 + rl];
          const bf16_t* src = C1 + (size_t)row * 768 + 640 + ib * 2; bf16_t* dstp = KK + (size_t)row * 768 + h * 192 + 128 + ib * 2; const float* rp = rope + ((size_t)row * 32 + ib) * 2;
          const PG8_LAS float* gq = st + 2304 + 128 + ib * 2;
#pragma unroll
          for (int c = 0; c < 4; ++c) { const u32x4 raw = *(const u32x4*)(src + c * 8); const f32x4 g0 = *(const PG8_LAS f32x4*)(gq + c * 8), g1 = *(const PG8_LAS f32x4*)(gq + c * 8 + 4);
              const f32x4 cA = *(const f32x4*)(rp + c * 8), cB = *(const f32x4*)(rp + c * 8 + 4);
              f32x4 xa, xb;
              xa[0] = __uint_as_float(raw[0] << 16) * g0[0] * f; xa[1] = __uint_as_float(raw[0] & 0xffff0000u) * g0[1] * f; xa[2] = __uint_as_float(raw[1] << 16) * g0[2] * f; xa[3] = __uint_as_float(raw[1] & 0xffff0000u) * g0[3] * f;
              xb[0] = __uint_as_float(raw[2] << 16) * g1[0] * f; xb[1] = __uint_as_float(raw[2] & 0xffff0000u) * g1[1] * f; xb[2] = __uint_as_float(raw[3] << 16) * g1[2] * f; xb[3] = __uint_as_float(raw[3] & 0xffff0000u) * g1[3] * f;
              f32x4 o0, o1;
              o0[0] = xa[0] * cA[0] - xa[1] * cA[1]; o0[1] = xa[1] * cA[0] + xa[0] * cA[1]; o0[2] = xa[2] * cA[2] - xa[3] * cA[3]; o0[3] = xa[3] * cA[2] + xa[2] * cA[3];
              o1[0] = xb[0] * cB[0] - xb[1] * cB[1]; o1[1] = xb[1] * cB[0] + xb[0] * cB[1]; o1[2] = xb[2] * cB[2] - xb[3] * cB[3]; o1[3] = xb[3] * cB[2] + xb[2] * cB[3];
              *(u32x4*)(dstp + c * 8) = pack8(o0, o1); } }
    }
};
template <class Epi, class Sched, bool ALIGN_EPI = false, bool SP2 = false>
__device__ __forceinline__ void gemm_phase(PG8_LAS unsigned char* lds, const Gemm g, const Sched& S, const Epi& E, const int tid_in) {
    int tid = tid_in; asm volatile("" : "+v"(tid)); const int wid = __builtin_amdgcn_readfirstlane(tid >> 6), lane = tid & 63, wr = wid >> 2, wc = wid & 3, fr = lane & 15, fq = lane >> 4;
    const int K = g.K, nt = K / BK;
    unsigned voffA[2], voffB[2];
#pragma unroll
    for (int i = 0; i < 2; ++i) { int R, C; stage_rc(tid * 16 + i * 8192, R, C); const int Rb = Epi::PERM ? ((R & ~31) + perm32(R & 31)) : R;
        voffA[i] = (unsigned)(R * g.lda + C) * 2u; voffB[i] = (unsigned)(Rb * K + C) * 2u; }
    const size_t kstep = (size_t)(BK * 2);
    const size_t hstepA = (size_t)HALF * g.lda * 2, hstepB = (size_t)HALF * K * 2;
    const size_t tstepA = 2 * hstepA, tstepB = 2 * hstepB;
    const unsigned ldsw = (unsigned)wid * 1024u;
    const int aoff = lds_byte(wr * 64 + fr, fq * 8), boff = lds_byte(wc * 32 + fr, fq * 8);
#define PG8_SA(b, h) (((b) * 2 + (h)) * HTB)
#define PG8_SB(b, h) ((4 + (b) * 2 + (h)) * HTB)
#define PG8_STAGE(bufoff, gbase, voff) do { _Pragma("unroll") for (int _i = 0; _i < 2; ++_i) \
        __builtin_amdgcn_global_load_lds((const unsigned*)((const char*)(gbase) + (voff)[_i]), (PG8_LAS unsigned*)(lds + (bufoff) + ldsw + _i * 8192), 16, 0, 0); } while (0)
#define PG8_LDA(dst, b, h) do { _Pragma("unroll") for (int m = 0; m < 4; ++m) _Pragma("unroll") for (int k = 0; k < 2; ++k) dst[m][k] = *(const PG8_LAS bf16x8*)(lds + PG8_SA(b, h) + aoff + m * 2048 + k * 1024); } while (0)
#define PG8_LDB(dst, b, h) do { _Pragma("unroll") for (int n = 0; n < 2; ++n) _Pragma("unroll") for (int k = 0; k < 2; ++k) dst[n][k] = *(const PG8_LAS bf16x8*)(lds + PG8_SB(b, h) + boff + n * 2048 + k * 1024); } while (0)
#define PG8_MMA(ai, bj, At, Bt) do { __builtin_amdgcn_s_setprio(1); _Pragma("unroll") for (int m = 0; m < 4; ++m) _Pragma("unroll") for (int n = 0; n < 2; ++n) _Pragma("unroll") for (int k = 0; k < 2; ++k) \
        acc[ai][bj][m][n] = __builtin_amdgcn_mfma_f32_16x16x32_bf16(Bt[n][k], At[m][k], acc[ai][bj][m][n], 0, 0, 0); __builtin_amdgcn_s_setprio(0); } while (0)
#define PG8_WAIT_V(n) asm volatile("s_waitcnt vmcnt(" #n ")" ::: "memory")
#define PG8_WAIT_L(n) asm volatile("s_waitcnt lgkmcnt(" #n ")" ::: "memory")
#define PG8_BAR __builtin_amdgcn_s_barrier()
#define PG8_SCHED __builtin_amdgcn_sched_barrier(0)
    Unit cur, nxt; int ui = 0;
    if (!S.next(0, cur)) return;
    f32x4 acc[2][2][4][2];
#pragma unroll
    for (int a = 0; a < 2; ++a)
#pragma unroll
        for (int b = 0; b < 2; ++b)
#pragma unroll
            for (int m = 0; m < 4; ++m)
#pragma unroll
                for (int n = 0; n < 2; ++n) acc[a][b][m][n] = (f32x4){0.f, 0.f, 0.f, 0.f};
    bf16x8 At[4][2], B0[2][2], B1[2][2];
    const char* cA = (const char*)g.A + (size_t)cur.pm * tstepA; const char* cB = (const char*)g.Bt + (size_t)cur.pn * tstepB;
    S.a_ready(cur);
    if constexpr (SP2) {
        PG8_STAGE(PG8_SB(0, 0), cB, voffB); PG8_STAGE(PG8_SB(0, 1), cB + hstepB, voffB); PG8_STAGE(PG8_SA(0, 0), cA, voffA); PG8_STAGE(PG8_SA(0, 1), cA + hstepA, voffA);
        if (wr == 1) PG8_BAR;
        PG8_WAIT_V(2); PG8_BAR;
        PG8_STAGE(PG8_SB(1, 0), cB + kstep, voffB); PG8_STAGE(PG8_SA(1, 0), cA + kstep, voffA); PG8_STAGE(PG8_SB(1, 1), cB + hstepB + kstep, voffB);
        PG8_WAIT_V(6); PG8_BAR;
    } else {
        PG8_STAGE(PG8_SB(0, 0), cB, voffB); PG8_STAGE(PG8_SA(0, 0), cA, voffA); PG8_STAGE(PG8_SB(0, 1), cB + hstepB, voffB); PG8_STAGE(PG8_SA(0, 1), cA + hstepA, voffA);
        if (wr == 1) PG8_BAR;
        PG8_WAIT_V(4); PG8_BAR;
        PG8_STAGE(PG8_SB(1, 0), cB + kstep, voffB); PG8_STAGE(PG8_SA(1, 0), cA + kstep, voffA); PG8_STAGE(PG8_SB(1, 1), cB + hstepB + kstep, voffB);
        PG8_WAIT_V(6); PG8_BAR;
    }
    for (;;) {
        const bool has_next = S.next(ui + 1, nxt);
        const char* nA = has_next ? (const char*)g.A + (size_t)nxt.pm * tstepA : cA; const char* nB = has_next ? (const char*)g.Bt + (size_t)nxt.pn * tstepB : cB;
        for (int t = 0; t < nt; t += 2) {
            const bool last = (t == nt - 2);
            const char* a1 = cA + (size_t)(t + 1) * kstep;
            const char* a2 = last ? nA : cA + (size_t)(t + 2) * kstep; const char* b2 = last ? nB : cB + (size_t)(t + 2) * kstep;
            const char* a3 = a2 + kstep; const char* b3 = b2 + kstep;
            if (last && has_next) S.a_ready(nxt);
            if constexpr (SP2) {
            PG8_LDB(B0, 0, 0); PG8_LDB(B1, 0, 1); PG8_SCHED; PG8_LDA(At, 0, 0); PG8_STAGE(PG8_SA(1, 1), a1 + hstepA, voffA);
            PG8_WAIT_V(8); PG8_WAIT_L(0); PG8_BAR; PG8_MMA(0, 0, At, B0); PG8_MMA(0, 1, At, B1); PG8_BAR; PG8_SCHED;
            PG8_LDA(At, 0, 1); PG8_STAGE(PG8_SB(0, 0), b2, voffB); PG8_STAGE(PG8_SB(0, 1), b2 + hstepB, voffB); PG8_STAGE(PG8_SA(0, 0), a2, voffA);
            PG8_WAIT_V(8); PG8_WAIT_L(0); PG8_BAR; PG8_MMA(1, 0, At, B0); PG8_MMA(1, 1, At, B1); PG8_BAR; PG8_SCHED;
            PG8_LDB(B0, 1, 0); PG8_LDB(B1, 1, 1); PG8_SCHED; PG8_LDA(At, 1, 0); PG8_STAGE(PG8_SA(0, 1), a2 + hstepA, voffA);
            PG8_WAIT_V(8); PG8_WAIT_L(0); PG8_BAR; PG8_MMA(0, 0, At, B0); PG8_MMA(0, 1, At, B1); PG8_BAR; PG8_SCHED;
            PG8_LDA(At, 1, 1); PG8_STAGE(PG8_SB(1, 0), b3, voffB); PG8_STAGE(PG8_SB(1, 1), b3 + hstepB, voffB); PG8_STAGE(PG8_SA(1, 0), a3, voffA);
            PG8_WAIT_V(8); PG8_WAIT_L(0); PG8_BAR; PG8_MMA(1, 0, At, B0); PG8_MMA(1, 1, At, B1); PG8_BAR; PG8_SCHED;
            } else {
            PG8_LDB(B0, 0, 0); PG8_SCHED; PG8_LDA(At, 0, 0); PG8_STAGE(PG8_SA(1, 1), a1 + hstepA, voffA);
            PG8_WAIT_L(8); PG8_BAR; PG8_WAIT_L(0); PG8_MMA(0, 0, At, B0); PG8_BAR; PG8_SCHED;
            PG8_LDB(B1, 0, 1); PG8_STAGE(PG8_SB(0, 0), b2, voffB);
            PG8_BAR; PG8_WAIT_L(0); PG8_MMA(0, 1, At, B1); PG8_BAR;
            PG8_LDA(At, 0, 1); PG8_STAGE(PG8_SA(0, 0), a2, voffA);
            PG8_BAR; PG8_WAIT_L(0); PG8_MMA(1, 0, At, B0); PG8_BAR; PG8_SCHED;
            PG8_STAGE(PG8_SB(0, 1), b2 + hstepB, voffB);
            PG8_WAIT_V(6); PG8_BAR; PG8_MMA(1, 1, At, B1); PG8_BAR;
            PG8_LDB(B0, 1, 0); PG8_SCHED; PG8_LDA(At, 1, 0); PG8_STAGE(PG8_SA(0, 1), a2 + hstepA, voffA);
            PG8_WAIT_L(8); PG8_BAR; PG8_WAIT_L(0); PG8_MMA(0, 0, At, B0); PG8_BAR; PG8_SCHED;
            PG8_LDB(B1, 1, 1); PG8_STAGE(PG8_SB(1, 0), b3, voffB);
            PG8_BAR; PG8_WAIT_L(0); PG8_MMA(0, 1, At, B1); PG8_BAR;
            PG8_LDA(At, 1, 1); PG8_STAGE(PG8_SA(1, 0), a3, voffA);
            PG8_BAR; PG8_WAIT_L(0); PG8_MMA(1, 0, At, B0); PG8_BAR; PG8_SCHED;
            PG8_STAGE(PG8_SB(1, 1), b3 + hstepB, voffB);
            PG8_WAIT_V(6); PG8_BAR; PG8_MMA(1, 1, At, B1); PG8_BAR;
            }
        }
        if constexpr (ALIGN_EPI) { if (wr == 0) PG8_BAR; }
        if constexpr (!Epi::AFTER_DRAIN) { int wr_ = wr, wc_ = wc; asm volatile("" : "+s"(wr_), "+s"(wc_)); const int l_ = olane(); const int fr_ = l_ & 15, fq_ = l_ >> 4; E(acc, cur, wr_, wc_, fr_, fq_); S.done(cur); }
        if (!has_next) break;
#pragma unroll
        for (int a = 0; a < 2; ++a)
#pragma unroll
            for (int b = 0; b < 2; ++b)
#pragma unroll
                for (int m = 0; m < 4; ++m)
#pragma unroll
                    for (int n = 0; n < 2; ++n) acc[a][b][m][n] = (f32x4){0.f, 0.f, 0.f, 0.f};
        cur = nxt; cA = nA; cB = nB; ++ui;
        if constexpr (ALIGN_EPI) { if (wr == 1) PG8_BAR; }
    }
    PG8_WAIT_V(0);
    if constexpr (!ALIGN_EPI) { if (wr == 0) PG8_BAR; }
    PG8_BAR;
    if constexpr (Epi::AFTER_DRAIN) { E.fused(acc, cur, wr, wc, fr, fq, lds, wid, lane); S.done(cur); }
#undef PG8_SA
#undef PG8_SB
#undef PG8_STAGE
#undef PG8_LDA
#undef PG8_LDB
#undef PG8_MMA
#undef PG8_WAIT_V
#undef PG8_WAIT_L
#undef PG8_BAR
#undef PG8_SCHED
}
}
#define GAS __attribute__((address_space(1)))
#define LAS __attribute__((address_space(3)))
typedef unsigned short bf16;
typedef unsigned v4u __attribute__((ext_vector_type(4)));
typedef float f32x4 __attribute__((ext_vector_type(4)));
typedef short bf16x8 __attribute__((ext_vector_type(8)));
typedef GAS unsigned gu32;
typedef GAS unsigned long long gu64;
#define RLX_AGENT __ATOMIC_RELAXED, __HIP_MEMORY_SCOPE_AGENT
#define LDS_WAIT() asm volatile("s_waitcnt lgkmcnt(0)" ::: "memory")
#define VM_WAIT() asm volatile("s_waitcnt vmcnt(0)" ::: "memory")
__device__ __forceinline__ unsigned long long rt() { return __builtin_amdgcn_s_memrealtime(); }
__device__ __forceinline__ unsigned f2bf(float f) { unsigned u = __builtin_bit_cast(unsigned, f); return (u + 0x7fffu + ((u >> 16) & 1u)) >> 16; }
__device__ __forceinline__ unsigned pk2(float lo, float hi) { return f2bf(lo) | (f2bf(hi) << 16); }

#define XB_TMO      128
#define XB_XCNT(j)  (256  + 64 * (j))
#define XB_XSUB(j)  (1280 + 64 * (j))
#define XB_XGEN(j)  (2304 + 64 * (j))
#define XB_TOP      3328
#define XB_TOPGEN   3392
#define XCD_BAR_WORDS 3456
#define XB_SPIN_CAP (1u << 18)

__device__ __forceinline__ unsigned xb_ld(unsigned* p)              { return __hip_atomic_load(p, __ATOMIC_RELAXED, __HIP_MEMORY_SCOPE_AGENT); }
__device__ __forceinline__ unsigned xb_add(unsigned* p, unsigned v) { return __hip_atomic_fetch_add(p, v, __ATOMIC_RELAXED, __HIP_MEMORY_SCOPE_AGENT); }
__device__ __forceinline__ unsigned xb_xcc_id() { return (unsigned)__builtin_amdgcn_s_getreg((3 << 11) | 20) & 0xFu; }
#define XB_SPIN(cond, bar) do { unsigned _sp = 0; while (cond) { __builtin_amdgcn_s_sleep(1); \
    if ((++_sp & 255u) == 0u) { if (xb_ld(&(bar)[XB_TMO])) break; if (_sp > XB_SPIN_CAP) { atomicAdd(&(bar)[XB_TMO], 1u); break; } } } } while (0)

struct XcdBarrier {
    unsigned* bar; unsigned x;
    volatile LAS unsigned* st;
};

__device__ __forceinline__ XcdBarrier xcd_barrier_post(unsigned* bar, volatile LAS unsigned* st, const int tid) {
    XcdBarrier b; b.bar = bar; b.x = xb_xcc_id(); b.st = st;
    if (tid == 0) (void)xb_add(&bar[XB_XCNT(b.x)], 1u);
    return b;
}
__device__ __forceinline__ void xcd_barrier_complete(unsigned* bar, unsigned x, unsigned& nloc, unsigned& nx) {
    const unsigned G = gridDim.x * gridDim.y * gridDim.z;
    unsigned sum, cnt, mine, sp = 0u;
    for (;;) {
        sum = 0u; cnt = 0u; mine = 0u;
#pragma unroll
        for (unsigned j = 0; j < 16; ++j) { const unsigned c = xb_ld(&bar[XB_XCNT(j)]); sum += c; cnt += (c > 0u) ? 1u : 0u; mine = (j == x) ? c : mine; }
        if (sum == G) break;
        __builtin_amdgcn_s_sleep(1);
        if ((++sp & 255u) == 0u) { if (xb_ld(&bar[XB_TMO])) break; if (sp > XB_SPIN_CAP) { atomicAdd(&bar[XB_TMO], 1u); break; } }
    }
    nloc = mine > 0u ? mine : 1u; nx = cnt > 0u ? cnt : 1u;
}

__device__ __forceinline__ void xcd_barrier(const XcdBarrier& b, const int tid) {
    asm volatile("s_waitcnt vmcnt(0)" ::: "memory");
    __syncthreads();
    if (tid == 0) {
        unsigned* bar = b.bar; asm volatile("" : "+s"(bar));
        __builtin_amdgcn_s_waitcnt(0);
        unsigned nloc = b.st[0], nx = b.st[1];
        if (nloc == 0u) { xcd_barrier_complete(bar, b.x, nloc, nx); b.st[0] = nloc; b.st[1] = nx; }
        const unsigned old = xb_add(&bar[XB_XSUB(b.x)], 1u);
        const unsigned gen = old / nloc;
        if (old + 1u == (gen + 1u) * nloc) {
            __builtin_amdgcn_fence(__ATOMIC_RELEASE, "agent");
            asm volatile("s_waitcnt vmcnt(0)" ::: "memory");
            const unsigned og = xb_add(&bar[XB_TOP], 1u);
            const unsigned tg = og / nx;
            if (og + 1u == (tg + 1u) * nx) xb_add(&bar[XB_TOPGEN], 1u);
            else XB_SPIN(xb_ld(&bar[XB_TOPGEN]) == tg, bar);
            __builtin_amdgcn_fence(__ATOMIC_ACQUIRE, "agent");
            xb_add(&bar[XB_XGEN(b.x)], 1u);
            asm volatile("s_waitcnt vmcnt(0)" ::: "memory");
        } else {
            XB_SPIN(xb_ld(&bar[XB_XGEN(b.x)]) == gen, bar);
            __builtin_amdgcn_fence(__ATOMIC_ACQUIRE, "agent");
            asm volatile("s_waitcnt vmcnt(0)" ::: "memory");
        }
    }
    __syncthreads();
}

namespace att {
typedef __hip_bfloat16 hbf16;
typedef short bf16x8 __attribute__((ext_vector_type(8)));
typedef short s16x4 __attribute__((ext_vector_type(4)));
typedef float f32x16 __attribute__((ext_vector_type(16)));
typedef float f32x4 __attribute__((ext_vector_type(4)));
typedef unsigned u32x4 __attribute__((ext_vector_type(4)));
typedef unsigned long long u64;
constexpr int QBLK = 32, KVBLK = 64;
constexpr int SHM_V = KVBLK * 128 * 2;
constexpr float THR2 = 11.0f;
#define ATT_SBAR() __builtin_amdgcn_sched_barrier(0)
__device__ __forceinline__ int v_st(int k, int c) { const int kk = (k & ~0xC) | ((k & 4) << 1) | ((k & 8) >> 1); return ((kk >> 3) * 4 + (c >> 5)) * 512 + ((kk & 7) * 32 + (c & 31)) * 2; }
__device__ __forceinline__ int v_rd_base(int lane) { return ((lane & 3) << 3) | (((lane >> 2) & 3) << 6) | (((lane >> 4) & 1) << 5) | (((lane >> 5) & 1) << 8); }
constexpr int v_rd_off(int d0, int ks, int half) { return d0 * 512 + ks * 4096 + half * 2048; }
__device__ __forceinline__ int crow(int r, int hi) { return (r & 3) + 8 * (r >> 2) + 4 * hi; }
__device__ __forceinline__ unsigned cvtpk(float lo, float hi) { unsigned r; asm volatile("v_cvt_pk_bf16_f32 %0, %1, %2" : "=v"(r) : "v"(lo), "v"(hi)); return r; }

struct UnitArgs {
    const unsigned short* Q; int ldq;
    const unsigned short* K; int ldk;
    const unsigned short* V; int ldv;
    unsigned short* O; int ldo;
    int qlo;
    int NT;
    const float* kbias;
    const u64* bm;
    int tid;
};

__device__ __forceinline__ void mask_causal(f32x16& p0, f32x16& p1, int dq) {
    const float NEG = -__builtin_inff();
#pragma unroll
    for (int r = 0; r < 16; ++r) { const int c = (r & 3) + 8 * (r >> 2); if (dq - c < 0) p0[r] = NEG; if (dq - c - 32 < 0) p1[r] = NEG; }
}
__device__ __forceinline__ void mask_bits(f32x16& p0, f32x16& p1, u64 w, int hi) {
    const float NEG = -__builtin_inff(); const unsigned lo = (unsigned)w >> (4 * hi), hh = (unsigned)(w >> 32) >> (4 * hi);
#pragma unroll
    for (int r = 0; r < 16; ++r) { const int c = (r & 3) + 8 * (r >> 2); if (!((lo >> c) & 1u)) p0[r] = NEG; if (!((hh >> c) & 1u)) p1[r] = NEG; }
}
__device__ __forceinline__ void partialSM(f32x16& p0, f32x16& p1, float& m_reg, float& mn, float& alpha) {
    float pmax = p0[0];
#pragma unroll
    for (int r = 1; r < 16; ++r) pmax = fmaxf(pmax, p0[r]);
#pragma unroll
    for (int r = 0; r < 16; ++r) pmax = fmaxf(pmax, p1[r]);
    { auto rr = __builtin_amdgcn_permlane32_swap(__float_as_uint(pmax), __float_as_uint(pmax), false, false); pmax = fmaxf(__uint_as_float(rr[0]), __uint_as_float(rr[1])); }
    if (__builtin_expect(__all((pmax - m_reg) <= THR2), 1)) { mn = m_reg; alpha = 1.f; }
    else { mn = fmaxf(m_reg, pmax); alpha = __builtin_amdgcn_exp2f(m_reg - mn); m_reg = mn; }
#pragma unroll
    for (int r = 0; r < 16; ++r) p0[r] = p0[r] - mn;
#pragma unroll
    for (int r = 0; r < 16; ++r) p1[r] = p1[r] - mn;
#pragma unroll
    for (int r = 0; r < 16; ++r) p0[r] = __builtin_amdgcn_exp2f(p0[r]);
}
__device__ __forceinline__ void finishSM(f32x16& p0, f32x16& p1, float alpha, float& l_reg, bf16x8& pa0, bf16x8& pa1, bf16x8& pa2, bf16x8& pa3) {
#pragma unroll
    for (int r = 0; r < 16; ++r) p1[r] = __builtin_amdgcn_exp2f(p1[r]);
    float ps = 0;
#pragma unroll
    for (int r = 0; r < 16; ++r) ps += p0[r];
#pragma unroll
    for (int r = 0; r < 16; ++r) ps += p1[r];
    { auto rr = __builtin_amdgcn_permlane32_swap(__float_as_uint(ps), __float_as_uint(ps), false, false); ps = __uint_as_float(rr[0]) + __uint_as_float(rr[1]); }
    l_reg = l_reg * alpha + ps;
#define ATT_PK4(P, B_, OUT) do { unsigned a0 = cvtpk(P[B_+0], P[B_+1]), a1 = cvtpk(P[B_+2], P[B_+3]);                          \
        unsigned b0 = cvtpk(P[B_+4], P[B_+5]), b1 = cvtpk(P[B_+6], P[B_+7]);                                             \
        auto r0 = __builtin_amdgcn_permlane32_swap(a0, b0, false, false); auto r1 = __builtin_amdgcn_permlane32_swap(a1, b1, false, false); \
        u32x4 w = {r0[0], r1[0], r0[1], r1[1]}; OUT = *reinterpret_cast<bf16x8*>(&w); } while (0)
    ATT_PK4(p0, 0, pa0); ATT_PK4(p0, 8, pa1); ATT_PK4(p1, 0, pa2); ATT_PK4(p1, 8, pa3);
#undef ATT_PK4
}
template <int VB>
__device__ __forceinline__ void pv_tile(f32x16* o, int vb0, bf16x8 pa0, bf16x8 pa1, bf16x8 pa2, bf16x8 pa3) {
#define ATT_TRRD(dst, off) asm volatile("ds_read_b64_tr_b16 %0, %1 offset:%2" : "=&v"(dst) : "v"(vb0), "i"(off) : "memory")
#define ATT_PV_D0(d0) do { s16x4 l0, l1, l2, l3, h0, h1, h2, h3; constexpr int b_ = VB * SHM_V + v_rd_off(d0, 0, 0); \
        ATT_TRRD(l0, b_); ATT_TRRD(h0, b_ + 2048); ATT_TRRD(l1, b_ + 4096); ATT_TRRD(h1, b_ + 6144); ATT_TRRD(l2, b_ + 8192); ATT_TRRD(h2, b_ + 10240); ATT_TRRD(l3, b_ + 12288); ATT_TRRD(h3, b_ + 14336); \
        asm volatile("s_waitcnt lgkmcnt(0)" ::: "memory"); ATT_SBAR();   \
        o[d0] = __builtin_amdgcn_mfma_f32_32x32x16_bf16(pa0, (bf16x8){l0[0], l0[1], l0[2], l0[3], h0[0], h0[1], h0[2], h0[3]}, o[d0], 0, 0, 0);   \
        o[d0] = __builtin_amdgcn_mfma_f32_32x32x16_bf16(pa1, (bf16x8){l1[0], l1[1], l1[2], l1[3], h1[0], h1[1], h1[2], h1[3]}, o[d0], 0, 0, 0);   \
        o[d0] = __builtin_amdgcn_mfma_f32_32x32x16_bf16(pa2, (bf16x8){l2[0], l2[1], l2[2], l2[3], h2[0], h2[1], h2[2], h2[3]}, o[d0], 0, 0, 0);   \
        o[d0] = __builtin_amdgcn_mfma_f32_32x32x16_bf16(pa3, (bf16x8){l3[0], l3[1], l3[2], l3[3], h3[0], h3[1], h3[2], h3[3]}, o[d0], 0, 0, 0); } while (0)
    ATT_PV_D0(0); ATT_PV_D0(1); ATT_PV_D0(2); ATT_PV_D0(3);
#undef ATT_PV_D0
#undef ATT_TRRD
}

template <int DQK, int MODE>
__device__ __forceinline__ void attn_unit(const UnitArgs& a, char* lds) {
    constexpr int SHM_K = KVBLK * DQK * 2, RS = DQK * 2, ND = DQK / 16, NKC = DQK / 64;
    int tid = a.tid; asm volatile("" : "+v"(tid)); const int wid = __builtin_amdgcn_readfirstlane(tid >> 6), lane = tid & 63, r32 = lane & 31, hi = lane >> 5;
    char* V_lds = lds; char* K_lds = lds + 2 * SHM_V;
    float* ws = (float*)(lds + 2 * SHM_V + 2 * SHM_K) + wid * 64; float* li_l = ws; float* al_l = ws + 32;
    float* kbl = (float*)(lds + 2 * SHM_V + 2 * SHM_K + 2048);
    const int NT = a.NT;
    const int qlo = a.qlo, qm = qlo + r32 - 4 * hi;
    const int srow = tid >> 3, c8 = tid & 7;
    const int kws = srow * RS + ((c8 * 16) ^ ((srow & 7) << 4));
    const int vst0 = v_st(srow, c8 * 8);
    const unsigned short* kg = a.K + (size_t)srow * a.ldk + c8 * 8;
    const unsigned short* vg = a.V + (size_t)srow * a.ldv + c8 * 8;
    const u64* bmrow = (MODE == 2) ? a.bm + (size_t)r32 * 64 : nullptr;
    bf16x8 st_k[NKC], st_v[2]; float st_b = 0.f; u64 mw_ld = 0, mw_cur = 0;
#define ATT_VMW() asm volatile("s_waitcnt vmcnt(0)" ::: "memory")
#define ATT_SLOAD(t) do { const size_t ko_ = (size_t)(t) * KVBLK * a.ldk, vo_ = (size_t)(t) * KVBLK * a.ldv; \
        _Pragma("unroll") for (int i_ = 0; i_ < NKC; ++i_) st_k[i_] = *(const bf16x8*)(kg + ko_ + i_ * 64); \
        _Pragma("unroll") for (int i_ = 0; i_ < 2; ++i_) st_v[i_] = *(const bf16x8*)(vg + vo_ + i_ * 64); \
        if (MODE == 1) { if (tid < 64) st_b = a.kbias[(t) * KVBLK + tid]; } \
        if (MODE == 2) { mw_ld = bmrow[(t)]; } } while (0)
#define ATT_SWRITE(bf) do { \
        _Pragma("unroll") for (int i_ = 0; i_ < NKC; ++i_) *(bf16x8*)(K_lds + (bf) * SHM_K + kws + i_ * 128) = st_k[i_]; \
        _Pragma("unroll") for (int i_ = 0; i_ < 2; ++i_) *(bf16x8*)(V_lds + (bf) * SHM_V + vst0 + i_ * 1024) = st_v[i_]; \
        if (MODE == 1) { if (tid < 64) kbl[(bf) * 64 + tid] = st_b; } } while (0)
    const int vb0 = (int)(uintptr_t)V_lds + v_rd_base(lane);
    float m_reg = -1e30f, l_reg = 0; f32x16 o[4] = {};
#define ATT_RESC(al) do { if (__any((al) < 1.f)) { if (hi == 0) al_l[r32] = (al); asm volatile("s_waitcnt lgkmcnt(0)" ::: "memory");              \
                     _Pragma("unroll") for (int d_ = 0; d_ < 4; ++d_) _Pragma("unroll") for (int r = 0; r < 16; ++r) o[d_][r] *= al_l[crow(r, hi)]; } } while (0)
#define ATT_MASKT(P0_, P1_, t) do { const int kb_ = (t) * KVBLK; \
        if (MODE == 2) { mask_bits(P0_, P1_, mw_cur, hi); } \
        else { if (kb_ + KVBLK - 1 > qlo) mask_causal(P0_, P1_, qm - kb_); } } while (0)
#define ATT_QKT(KB, P0_, P1_) do { \
        if (MODE == 1) { const float* kb__ = kbl + (KB) * 64 + 4 * hi; \
            _Pragma("unroll") for (int j_ = 0; j_ < 4; ++j_) { const f32x4 b0_ = *(const f32x4*)(kb__ + 8 * j_), b1_ = *(const f32x4*)(kb__ + 32 + 8 * j_); \
                _Pragma("unroll") for (int e_ = 0; e_ < 4; ++e_) { P0_[4 * j_ + e_] = b0_[e_]; P1_[4 * j_ + e_] = b1_[e_]; } } } \
        else { P0_ = f32x16{}; P1_ = f32x16{}; } \
        const char* kbp_[4]; \
        _Pragma("unroll") for (int dd_ = 0; dd_ < 4; ++dd_) kbp_[dd_] = K_lds + (KB) * SHM_K + r32 * RS + (((dd_ * 16 + hi * 8) * 2) ^ ((r32 & 7) << 4)); \
        _Pragma("unroll") for (int d0_ = 0; d0_ < ND; ++d0_) { const char* a_ = kbp_[d0_ & 3] + (d0_ >> 2) * 128; \
            const bf16x8 b0_ = *reinterpret_cast<const bf16x8*>(a_); const bf16x8 b1_ = *reinterpret_cast<const bf16x8*>(a_ + 32 * RS); \
            P0_ = __builtin_amdgcn_mfma_f32_32x32x16_bf16(b0_, qr[d0_], P0_, 0, 0, 0); \
            P1_ = __builtin_amdgcn_mfma_f32_32x32x16_bf16(b1_, qr[d0_], P1_, 0, 0, 0); } } while (0)
    ATT_SLOAD(0);
    bf16x8 qr[ND];
#pragma unroll
    for (int d0 = 0; d0 < ND; ++d0) qr[d0] = *(const bf16x8*)(a.Q + (size_t)r32 * a.ldq + d0 * 16 + hi * 8);
    f32x16 p0, p1; float mn, al; bf16x8 pa0, pa1, pa2, pa3;
#define ATT_STEP(t, BUF) do { \
        ATT_VMW(); ATT_SWRITE(BUF); mw_cur = mw_ld; \
        if ((t) + 1 < NT) { ATT_SLOAD((t) + 1); } \
        __syncthreads(); \
        ATT_SBAR(); ATT_QKT(BUF, p0, p1); \
        ATT_MASKT(p0, p1, (t)); partialSM(p0, p1, m_reg, mn, al); ATT_RESC(al); \
        finishSM(p0, p1, al, l_reg, pa0, pa1, pa2, pa3); ATT_SBAR(); \
        pv_tile<BUF>(o, vb0, pa0, pa1, pa2, pa3); } while (0)
    for (int t = 0; t < NT; t += 2) {
        ATT_STEP(t, 0);
        if (t + 1 < NT) ATT_STEP(t + 1, 1);
    }
#undef ATT_STEP
    if (hi == 0) li_l[r32] = l_reg; asm volatile("s_waitcnt lgkmcnt(0)" ::: "memory");
    float rli[16];
#pragma unroll
    for (int r = 0; r < 16; ++r) rli[r] = __builtin_amdgcn_rcpf(li_l[crow(r, hi)]);
#pragma unroll
    for (int r = 0; r < 16; ++r) { const int orow = crow(r, hi);
#pragma unroll
        for (int d0 = 0; d0 < 4; ++d0) { const float v = o[d0][r] * rli[r]; const float vn = xor_f<1>(v);
            if ((r32 & 1) == 0) *(unsigned*)(a.O + (size_t)orow * a.ldo + d0 * 32 + r32) = cvtpk(v, vn); } }
    __syncthreads();
#undef ATT_VMW
#undef ATT_SLOAD
#undef ATT_SWRITE
#undef ATT_RESC
#undef ATT_MASKT
#undef ATT_QKT
}
#undef ATT_SBAR
}

namespace tk {
typedef short bf16x8 __attribute__((ext_vector_type(8)));
typedef float f32x16 __attribute__((ext_vector_type(16)));
typedef float f32x4 __attribute__((ext_vector_type(4)));
typedef unsigned u32x4 __attribute__((ext_vector_type(4)));
typedef unsigned long long u64;
constexpr int TOPK = 256;
__device__ __forceinline__ float wave_min(float v) { return wmin_f(v); }
__device__ __forceinline__ float wave_max(float v) { return wmax_f(v); }
__device__ __forceinline__ int rdlane_i(int v, int src_uniform) { return __builtin_amdgcn_readlane(v, __builtin_amdgcn_readfirstlane(src_uniform)); }

__device__ __forceinline__ void topk_unit(const unsigned short* EP, const float* misc32, u64* BM, int b, int g, char* lds, char* lds_hist, char* lds_cand, const int tid_in) {
    int tid = tid_in; asm volatile("" : "+v"(tid)); const int wid = __builtin_amdgcn_readfirstlane(tid >> 6), lane = tid & 63, r32 = lane & 31, hi = lane >> 5;
    float* S = (float*)lds;
    const int q0 = g * 8; const size_t tok0 = (size_t)b * SEQ;
    {
        bf16x8 af[2][4];
        const int a_ = r32 >> 3, hp = (r32 >> 2) & 1, c_ = r32 & 3; const int qsub = 2 * hp + (a_ >> 1), head = 4 * (a_ & 1) + c_;
#pragma unroll
        for (int T = 0; T < 2; ++T)
#pragma unroll
            for (int d0 = 0; d0 < 4; ++d0) af[T][d0] = *(const bf16x8*)(EP + (tok0 + q0 + 4 * T + qsub) * N_E_IN + 768 + head * 64 + d0 * 16 + hi * 8);
        f32x4 wv[2][2][2];
#pragma unroll
        for (int T = 0; T < 2; ++T)
#pragma unroll
            for (int qq = 0; qq < 2; ++qq) { const float* wp = misc32 + (tok0 + q0 + 4 * T + 2 * hi + qq) * 16; wv[T][qq][0] = *(const f32x4*)wp; wv[T][qq][1] = *(const f32x4*)(wp + 4); }
        const int nkb = (q0 + 8 + 31) >> 5;
        for (int kb = wid; kb < nkb; kb += 8) {
            const int key = kb * 32 + r32;
            bf16x8 bfr[4];
#pragma unroll
            for (int d0 = 0; d0 < 4; ++d0) bfr[d0] = *(const bf16x8*)(EP + (tok0 + key) * N_E_IN + 1280 + d0 * 16 + hi * 8);
#pragma unroll
            for (int T = 0; T < 2; ++T) { f32x16 acc = {};
#pragma unroll
                for (int d0 = 0; d0 < 4; ++d0) acc = __builtin_amdgcn_mfma_f32_32x32x16_bf16(af[T][d0], bfr[d0], acc, 0, 0, 0);
#pragma unroll
                for (int qq = 0; qq < 2; ++qq) { float s = 0.f;
#pragma unroll
                    for (int e = 0; e < 8; ++e) s += wv[T][qq][e >> 2][e & 3] * fmaxf(acc[qq * 8 + e], 0.f);
                    S[(4 * T + 2 * hi + qq) * 4096 + key] = s; } }
        }
    }
    __syncthreads();
    const int qpos = q0 + wid; const int n = qpos + 1; const int ni = (n + 63) >> 6;
    const float NEG = -__builtin_inff();
    float sc[64];
#pragma unroll
    for (int i = 0; i < 64; ++i) { sc[i] = NEG; if (i < ni) { const int key = 64 * i + lane; const float v = S[wid * 4096 + key]; sc[i] = (key <= qpos) ? v : NEG; } }
    u64 myword = 0ull;
    if (n <= TOPK) {
#pragma unroll
        for (int i = 0; i < 4; ++i) { const u64 w = __ballot(64 * i + lane <= qpos); if (lane == i) myword = w; }
    } else {
        unsigned* hist = (unsigned*)lds_hist + wid * 256; float* cand = (float*)lds_cand + wid * 64;
        float lo, hv;
        { float mn = __builtin_inff(), mx = NEG;
#pragma unroll
          for (int i = 0; i < 64; ++i) if (i < ni) { mx = fmaxf(mx, sc[i]); mn = fminf(mn, (sc[i] == NEG) ? __builtin_inff() : sc[i]); }
          lo = wave_min(mn); hv = wave_max(mx); }
        int need = TOPK; float T_ = lo; int n_eq = 0; bool done = false;
        for (int level = 0; level < 48 && !done; ++level) {
            if (!(lo < hv)) { T_ = lo; n_eq = need; done = true; break; }
            const float scale = 256.0f / (hv - lo);
            { unsigned z_ = 0u; asm volatile("" : "+v"(z_)); *(u32x4*)(hist + 4 * lane) = (u32x4){z_, z_, z_, z_}; }
            asm volatile("s_waitcnt lgkmcnt(0)" ::: "memory");
#pragma unroll
            for (int i = 0; i < 64; ++i) if (i < ni) { const float s = sc[i]; const bool inr = (s >= lo) && (s <= hv); int bin = (int)((s - lo) * scale); bin = bin > 255 ? 255 : (bin < 0 ? 0 : bin);
                if (inr) __hip_atomic_fetch_add(hist + bin, 1u, __ATOMIC_RELAXED, __HIP_MEMORY_SCOPE_WORKGROUP); }
            asm volatile("s_waitcnt lgkmcnt(0)" ::: "memory");
            const u32x4 hq = *(const u32x4*)(hist + 4 * lane);
            const int tl = (int)(hq[0] + hq[1] + hq[2] + hq[3]);
            int suf = tl;
#pragma unroll
            for (int o = 1; o < 64; o <<= 1) { const int v = down_i(suf, o); if (lane + o < 64) suf += v; }
            const int above = suf - tl;
            const bool mine = (above < need) && (need <= suf);
            int bsel = 0, cab = 0, cin = 0;
            if (mine) { int c = above;
                if (need <= c + (int)hq[3]) { bsel = 3; cab = c; cin = (int)hq[3]; }
                else { c += (int)hq[3];
                    if (need <= c + (int)hq[2]) { bsel = 2; cab = c; cin = (int)hq[2]; }
                    else { c += (int)hq[2];
                        if (need <= c + (int)hq[1]) { bsel = 1; cab = c; cin = (int)hq[1]; }
                        else { c += (int)hq[1]; bsel = 0; cab = c; cin = (int)hq[0]; } } }
                bsel += 4 * lane; }
            const u64 mm = __ballot(mine); const int src = (int)__ffsll((long long)mm) - 1;
            const int bstar = rdlane_i(bsel, src), cabove = rdlane_i(cab, src), cnt_in = rdlane_i(cin, src);
            need -= cabove;
            if (cnt_in <= 64) {
                int base = 0;
#pragma unroll
                for (int i = 0; i < 64; ++i) if (i < ni) { const float s = sc[i]; const bool inr = (s >= lo) && (s <= hv); int bin = (int)((s - lo) * scale); bin = bin > 255 ? 255 : (bin < 0 ? 0 : bin);
                    const bool pr = inr && (bin == bstar); const u64 bl = __ballot(pr);
                    if (pr) cand[base + __popcll(bl & ((1ull << lane) - 1ull))] = s;
                    base += __popcll(bl); }
                asm volatile("s_waitcnt lgkmcnt(0)" ::: "memory");
                const float v = (lane < cnt_in) ? cand[lane] : NEG;
                int gt = 0, ge = 0;
#pragma unroll
                for (int j = 0; j < 64; ++j) { const float vj = __int_as_float(__builtin_amdgcn_readlane(__float_as_int(v), j)); gt += (vj > v) ? 1 : 0; ge += (vj >= v) ? 1 : 0; }
                const bool ok = (lane < cnt_in) && (gt < need) && (need <= ge);
                const u64 okm = __ballot(ok); const int s2 = (int)__ffsll((long long)okm) - 1;
                T_ = __int_as_float(rdlane_i(__float_as_int(v), s2)); n_eq = need - rdlane_i(gt, s2); done = true;
            } else {
                float mn = __builtin_inff(), mx = NEG;
#pragma unroll
                for (int i = 0; i < 64; ++i) if (i < ni) { const float s = sc[i]; const bool inr = (s >= lo) && (s <= hv); int bin = (int)((s - lo) * scale); bin = bin > 255 ? 255 : (bin < 0 ? 0 : bin);
                    if (inr && bin == bstar) { mn = fminf(mn, s); mx = fmaxf(mx, s); } }
                lo = wave_min(mn); hv = wave_max(mx);
            }
        }
        int eqrun = 0;
#pragma unroll
        for (int i = 0; i < 64; ++i) if (i < ni) { const float s = sc[i]; const bool eq = (s == T_); const u64 be = __ballot(eq);
            const int rk = eqrun + __popcll(be & ((1ull << lane) - 1ull));
            const bool sel = (s > T_) || (eq && rk < n_eq);
            const u64 w = __ballot(sel); eqrun += __popcll(be);
            if (lane == i) myword = w; }
    }
    BM[(tok0 + qpos) * 64 + lane] = myword;
    __syncthreads();
}

__device__ __forceinline__ void cumsum_unit(const float* misc32, float* cumb, int b, int h, char* lds, const int tid_in) {
    int tid = tid_in; asm volatile("" : "+v"(tid)); const int wid = tid >> 6, lane = tid & 63;
    float* wsum = (float*)lds;
    float v[8]; float run = 0.f;
#pragma unroll
    for (int j = 0; j < 8; ++j) { run += misc32[((size_t)b * SEQ + tid * 8 + j) * 16 + 8 + h]; v[j] = run; }
    float inc = run;
#pragma unroll
    for (int o = 1; o < 64; o <<= 1) { const float t = up_f(inc, o); if (lane >= o) inc += t; }
    if (lane == 63) wsum[wid] = inc;
    __syncthreads();
    float off = inc - run;
    for (int w = 0; w < wid; ++w) off += wsum[w];
#pragma unroll
    for (int j = 0; j < 8; ++j) cumb[(size_t)h * MTOK + (size_t)b * SEQ + tid * 8 + j] = -LOG2E * (off + v[j]);
    __syncthreads();
}
}

namespace ssd {
typedef short bf16x8 __attribute__((ext_vector_type(8)));
typedef float f32x16 __attribute__((ext_vector_type(16)));
typedef float f32x4 __attribute__((ext_vector_type(4)));
typedef unsigned u32x4 __attribute__((ext_vector_type(4)));
typedef unsigned u32x2 __attribute__((ext_vector_type(2)));
constexpr int LD = 136;
constexpr int O_CS = 0, O_BS = 34816, O_BWT = 69632, O_XT = 104448, O_SB = 121856;
constexpr int ZLD = 72;
__device__ __forceinline__ unsigned short f2bf16(float f) { unsigned u = __float_as_uint(f); return (unsigned short)((u + 0x7fffu + ((u >> 16) & 1u)) >> 16); }
__device__ __forceinline__ float bf2f(unsigned short h) { return __uint_as_float(((unsigned)h) << 16); }
__device__ __forceinline__ unsigned pk(float lo, float hi) { unsigned r; asm volatile("v_cvt_pk_bf16_f32 %0, %1, %2" : "=v"(r) : "v"(lo), "v"(hi)); return r; }
__device__ __forceinline__ f32x16 mma(const unsigned short* Ab, const unsigned short* Bb, int nk, f32x16 acc, int hi) {
    for (int d0 = 0; d0 < nk; ++d0) { const bf16x8 a = *(const bf16x8*)(Ab + d0 * 16 + hi * 8), b = *(const bf16x8*)(Bb + d0 * 16 + hi * 8);
        acc = __builtin_amdgcn_mfma_f32_32x32x16_bf16(a, b, acc, 0, 0, 0); }
    return acc;
}
__device__ __forceinline__ float siluf(float v) { return v / (1.0f + __expf(-v)); }

__device__ __forceinline__ void ssd_unit(const unsigned short* XBC, unsigned short* AO, const float* dt32, float* ssy, const float* conv_w, const float* conv_b,
                                         float a_log_h, float d_skip_h, int b, int h, char* lds, char* lds_small, const int tid_in) {
    int tid = tid_in; asm volatile("" : "+v"(tid)); const int wid = __builtin_amdgcn_readfirstlane(tid >> 6), lane = tid & 63, r32 = lane & 31, hi = lane >> 5;
    unsigned short* Cs = (unsigned short*)(lds + O_CS); unsigned short* Bs = (unsigned short*)(lds + O_BS); unsigned short* BwT = (unsigned short*)(lds + O_BWT);
    unsigned short* xT = (unsigned short*)(lds + O_XT); unsigned short* Sb = (unsigned short*)(lds + O_SB);
    unsigned short* Ms = Bs; unsigned short* Ys = Bs; unsigned short* Zs = Cs;
    float* cumL = (float*)lds_small; float* dtL = cumL + 128; float* wsum = cumL + 256;
    const int g = h >> 2; const float Ah = -__expf(a_log_h);
    for (int i = tid; i < 64 * LD / 2; i += 512) ((unsigned*)Sb)[i] = 0u;
    f32x16 accS = {};
    const bool ctask = tid < 320; const int cg = tid % 40, seg = tid / 40;
    int ccol, ckind, cloc;
    if (cg < 8) { ckind = 0; cloc = cg * 8; ccol = h * 64 + cloc; } else if (cg < 24) { ckind = 1; cloc = (cg - 8) * 8; ccol = 1024 + g * 128 + cloc; } else { ckind = 2; cloc = (cg - 24) * 8; ccol = 1536 + g * 128 + cloc; }
    float cw[4][8], cb[8];
    if (ctask) {
#pragma unroll
        for (int j = 0; j < 4; ++j) { const f32x4 w0 = *(const f32x4*)(conv_w + j * 2048 + ccol), w1 = *(const f32x4*)(conv_w + j * 2048 + ccol + 4);
#pragma unroll
            for (int e = 0; e < 4; ++e) { cw[j][e] = w0[e]; cw[j][4 + e] = w1[e]; } }
        const f32x4 b0 = *(const f32x4*)(conv_b + ccol), b1 = *(const f32x4*)(conv_b + ccol + 4);
#pragma unroll
        for (int e = 0; e < 4; ++e) { cb[e] = b0[e]; cb[4 + e] = b1[e]; }
    }
    const int li2 = wid & 3, pi = wid >> 2;
    __syncthreads();
    for (int c = 0; c < SEQ / 128; ++c) {
        const size_t tb = (size_t)b * SEQ + (size_t)c * 128;
        u32x4 zreg[2];
#pragma unroll
        for (int i = 0; i < 2; ++i) { const int idx = tid + 512 * i, row = idx >> 3, ch = idx & 7; zreg[i] = *(const u32x4*)(AO + (tb + row) * K_O_OUT + 512 + h * 64 + ch * 8); }
        if (tid < 128) { const float dt = dt32[(tb + tid) * 16 + h]; float inc = dt * Ah;
#pragma unroll
            for (int o = 1; o < 64; o <<= 1) { const float t = up_f(inc, o); if (lane >= o) inc += t; }
            if (lane == 63) wsum[wid] = inc;
            dtL[tid] = dt; cumL[tid] = inc; }
        __syncthreads();
        if (tid >= 64 && tid < 128) cumL[tid] += wsum[0];
        __syncthreads();
        const float cend = cumL[127];
        if (ctask) {
            const int l0 = seg * 16; float r0[8], r1[8], r2[8];
#define SSD_HALO(dst, k) do { const int l_ = l0 - 3 + (k); \
                if (c == 0 && l_ < 0) { _Pragma("unroll") for (int e = 0; e < 8; ++e) dst[e] = 0.f; } \
                else { const u32x4 raw_ = *(const u32x4*)(XBC + (size_t)((long)tb + l_) * 2048 + ccol); \
                    _Pragma("unroll") for (int e = 0; e < 4; ++e) { dst[2 * e] = __uint_as_float(raw_[e] << 16); dst[2 * e + 1] = __uint_as_float(raw_[e] & 0xffff0000u); } } } while (0)
            SSD_HALO(r0, 0); SSD_HALO(r1, 1); SSD_HALO(r2, 2);
#undef SSD_HALO
#pragma unroll 4
            for (int i = 0; i < 16; ++i) { const int l = l0 + i; const u32x4 raw = *(const u32x4*)(XBC + (tb + l) * 2048 + ccol); float cur[8], val[8];
#pragma unroll
                for (int e = 0; e < 4; ++e) { cur[2 * e] = __uint_as_float(raw[e] << 16); cur[2 * e + 1] = __uint_as_float(raw[e] & 0xffff0000u); }
#pragma unroll
                for (int e = 0; e < 8; ++e) { const float v = cb[e] + cw[0][e] * r0[e] + cw[1][e] * r1[e] + cw[2][e] * r2[e] + cw[3][e] * cur[e]; val[e] = siluf(v); r0[e] = r1[e]; r1[e] = r2[e]; r2[e] = cur[e]; }
                if (ckind == 0) {
#pragma unroll
                    for (int e = 0; e < 8; ++e) xT[(cloc + e) * LD + l] = f2bf16(val[e]); }
                else if (ckind == 1) { const float wl = dtL[l] * __expf(cend - cumL[l]);
                    u32x4 w; w.x = pk(val[0], val[1]); w.y = pk(val[2], val[3]); w.z = pk(val[4], val[5]); w.w = pk(val[6], val[7]); *(u32x4*)(Bs + l * LD + cloc) = w;
#pragma unroll
                    for (int e = 0; e < 8; ++e) BwT[(cloc + e) * LD + l] = f2bf16(val[e] * wl); }
                else { u32x4 w; w.x = pk(val[0], val[1]); w.y = pk(val[2], val[3]); w.z = pk(val[4], val[5]); w.w = pk(val[6], val[7]); *(u32x4*)(Cs + l * LD + cloc) = w; } }
        }
        __syncthreads();
        unsigned mreg[2][8];
        { const int li = wid >> 1; const int l = li * 32 + r32; const float cl = cumL[l];
#pragma unroll
          for (int q = 0; q < 2; ++q) { const int si = 2 * (wid & 1) + q;
              if (si <= li) { f32x16 acc = {}; acc = mma(Bs + (si * 32 + r32) * LD, Cs + l * LD, 8, acc, hi);
#pragma unroll
                  for (int j = 0; j < 4; ++j) { const int s0 = si * 32 + 8 * j + 4 * hi; const f32x4 cs4 = *(const f32x4*)(cumL + s0), dt4 = *(const f32x4*)(dtL + s0); float mv[4];
#pragma unroll
                      for (int e = 0; e < 4; ++e) mv[e] = (s0 + e <= l) ? acc[4 * j + e] * __expf(cl - cs4[e]) * dt4[e] : 0.f;
                      mreg[q][2 * j] = pk(mv[0], mv[1]); mreg[q][2 * j + 1] = pk(mv[2], mv[3]); } }
              else {
#pragma unroll
                  for (int j = 0; j < 8; ++j) mreg[q][j] = 0u; } } }
        f32x16 accY = {};
        { const int l = li2 * 32 + r32; accY = mma(Sb + (pi * 32 + r32) * LD, Cs + l * LD, 8, accY, hi); const float el = __expf(cumL[l]);
#pragma unroll
          for (int r = 0; r < 16; ++r) accY[r] *= el; }
        __syncthreads();
        { const int li = wid >> 1; const int l = li * 32 + r32;
#pragma unroll
          for (int q = 0; q < 2; ++q) { const int si = 2 * (wid & 1) + q;
#pragma unroll
              for (int j = 0; j < 4; ++j) { u32x2 w; w.x = mreg[q][2 * j]; w.y = mreg[q][2 * j + 1]; *(u32x2*)(Ms + l * LD + si * 32 + 8 * j + 4 * hi) = w; } } }
#pragma unroll
        for (int i = 0; i < 2; ++i) { const int idx = tid + 512 * i, row = idx >> 3, ch = idx & 7; *(u32x4*)(Zs + row * ZLD + ch * 8) = zreg[i]; }
        __syncthreads();
        unsigned yreg[8]; float ssq = 0.f;
        { const int l = li2 * 32 + r32;
          accY = mma(xT + (pi * 32 + r32) * LD, Ms + l * LD, 2 * (li2 + 1), accY, hi);
          const float dec = __expf(cend);
#pragma unroll
          for (int r = 0; r < 16; ++r) accS[r] *= dec;
          accS = mma(BwT + (li2 * 32 + r32) * LD, xT + (pi * 32 + r32) * LD, 8, accS, hi);
#pragma unroll
          for (int j = 0; j < 4; ++j) { const int p0 = pi * 32 + 8 * j + 4 * hi; const u32x2 zz = *(const u32x2*)(Zs + l * ZLD + p0); float yg[4];
#pragma unroll
              for (int e = 0; e < 4; ++e) { const float xv = bf2f(xT[(p0 + e) * LD + l]); const float y = accY[4 * j + e] + d_skip_h * xv;
                  const float zv = (e & 1) ? __uint_as_float(zz[e >> 1] & 0xffff0000u) : __uint_as_float(zz[e >> 1] << 16);
                  yg[e] = y * siluf(zv); ssq += yg[e] * yg[e]; }
              yreg[2 * j] = pk(yg[0], yg[1]); yreg[2 * j + 1] = pk(yg[2], yg[3]); }
          ssq += xor_f<32>(ssq);
          if (hi == 0) ssy[(tb + l) * 32 + h * 2 + pi] = ssq; }
        __syncthreads();
        { const int l = li2 * 32 + r32;
#pragma unroll
          for (int j = 0; j < 4; ++j) { u32x2 w; w.x = yreg[2 * j]; w.y = yreg[2 * j + 1]; *(u32x2*)(Ys + l * ZLD + pi * 32 + 8 * j + 4 * hi) = w; }
          const int p = pi * 32 + r32;
#pragma unroll
          for (int j = 0; j < 4; ++j) { u32x2 w; w.x = pk(accS[4 * j], accS[4 * j + 1]); w.y = pk(accS[4 * j + 2], accS[4 * j + 3]); *(u32x2*)(Sb + p * LD + li2 * 32 + 8 * j + 4 * hi) = w; } }
        __syncthreads();
#pragma unroll
        for (int i = 0; i < 2; ++i) { const int idx = tid + 512 * i, row = idx >> 3, ch = idx & 7; *(u32x4*)(AO + (tb + row) * K_O_OUT + 512 + h * 64 + ch * 8) = *(const u32x4*)(Ys + row * ZLD + ch * 8); }
    }
    __syncthreads();
}
}

constexpr int NWAVES = 8;
#ifndef EN_MASK
#define EN_MASK 0xFFFF
#endif
#define EN(b) (((EN_MASK) >> (b)) & 1)
struct Args {
    const float* in[28]; float* out; unsigned char* ws; int ph_lo, ph_hi;
};
struct Frame {
    LAS unsigned char* lds; volatile LAS unsigned* MISC; gu32* ctl; int tid, lane, wave, G;
};
typedef pg8::bf16_t bf16_t;

enum { MAP_ID = 0, MAP_EVEN_IN = 1, MAP_ODD_IN = 2, MAP_UQ = 3 };
__device__ __forceinline__ int colmap(int map, int n) {
    if (map == MAP_EVEN_IN) { if (n < 1352) return n; if (n < 1356) return 2888 + (n - 1352); if (n < 1536) return -1; return 1352 + (n - 1536); }
    if (map == MAP_ODD_IN) { if (n < 640) return n; if (n < 704) { const int jj = n - 640; return 640 + ((jj & 1) ? 32 : 0) + (jj >> 1); } if (n < 720) return 3776 + (n - 704); if (n < 768) return -1; return 704 + (n - 768); }
    if (map == MAP_UQ) { const int h = n >> 8, j = n & 255; if (j < 128) return 192 * h + j; if (j < 192) { const int jj = j - 128; return 192 * h + 128 + ((jj & 1) ? 32 : 0) + (jj >> 1); } return -1; }
    return n;
}
struct WJob { const float* W; bf16* dst; const float* gain; int K, Nsrc, Ndst, map, gk0; };
__device__ __forceinline__ void wconv_item(const WJob& J, LAS float* scr, int item, int lane) {
    const int nblk = J.Ndst / 32, kb = item / nblk, nb = item % nblk, k0 = 64 * kb, n0 = 32 * nb;
    const int sc = colmap(J.map, n0 + (lane & 31));
#pragma unroll 8
    for (int i = 0; i < 32; ++i) { const int kk = 2 * i + (lane >> 5); float v = 0.f;
        if (sc >= 0) { v = J.W[(size_t)(k0 + kk) * J.Nsrc + sc]; if (J.gain && (k0 + kk) >= J.gk0) v *= J.gain[k0 + kk - J.gk0]; }
        scr[kk * 33 + (lane & 31)] = v; }
    LDS_WAIT(); asm volatile("" ::: "memory");
    const int c = lane & 7;
#pragma unroll
    for (int j = 0; j < 4; ++j) { const int n = (lane >> 3) + 8 * j; const LAS float* s = scr + (8 * c) * 33 + n;
        v4u o; o.x = pk2(s[0 * 33], s[1 * 33]); o.y = pk2(s[2 * 33], s[3 * 33]); o.z = pk2(s[4 * 33], s[5 * 33]); o.w = pk2(s[6 * 33], s[7 * 33]);
        *(GAS v4u*)(J.dst + (size_t)(n0 + n) * J.K + k0 + 8 * c) = o; }
    LDS_WAIT(); asm volatile("" ::: "memory");
}
__device__ __forceinline__ float wave_sum(float v) { return wsum_f(v); }

__global__ void __launch_bounds__(NWAVES * 64, 2) trunk_fwd(Args args) {
    extern __shared__ __attribute__((aligned(16))) unsigned char lds[];
    {
        LAS unsigned char* L0 = (LAS unsigned char*)lds; const int t0 = threadIdx.x;
        for (int u = t0; u < (LDS_BYTES - LDS_MISC) / 4; u += NWAVES * 64) ((LAS unsigned*)(L0 + LDS_MISC))[u] = 0u;
        __syncthreads();
        volatile LAS unsigned* pt0 = (volatile LAS unsigned*)(L0 + LDS_MISC + 128);
        if (t0 < 30) { const unsigned long long p = (t0 < 28) ? (unsigned long long)args.in[t0] : (t0 == 28 ? (unsigned long long)args.out : (unsigned long long)args.ws);
            pt0[2 * t0] = (unsigned)p; pt0[2 * t0 + 1] = (unsigned)(p >> 32); }
        __syncthreads();
    }
    const int wave_s = __builtin_amdgcn_readfirstlane((int)(threadIdx.x >> 6));
#define PTR(k) ((const float*)(const GAS float*)(((unsigned long long)(unsigned)__builtin_amdgcn_readfirstlane((int)ptab[2 * (k) + 1]) << 32) | (unsigned long long)(unsigned)__builtin_amdgcn_readfirstlane((int)ptab[2 * (k)])))
    XcdBarrier bar = xcd_barrier_post((unsigned*)((gu32*)(args.ws + WS_CTL) + CW_BAR), (volatile LAS unsigned*)((LAS unsigned char*)lds + LDS_MISC) + 8, otid(wave_s));
    const int lo = args.ph_lo, hi = args.ph_hi;
#define IN(k) (lo <= (k) && (k) < hi)
#define SEAM(k) do { if (IN(k) && IN((k) + 1)) xcd_barrier(bar, otid(wave_s)); } while (0)
#define ENV_NOLAYER() \
        LAS unsigned char* L_ = (LAS unsigned char*)lds; asm volatile("" : "+s"(L_)); \
        int bid = blockIdx.x; asm volatile("" : "+s"(bid)); int GG = gridDim.x; asm volatile("" : "+s"(GG)); \
        const int tid = otid(wave_s); \
        volatile LAS unsigned* ptab = (volatile LAS unsigned*)(L_ + LDS_MISC + 128); \
        unsigned char* ws = (unsigned char*)PTR(29); float* out = (float*)PTR(28);
#define ENV() \
        LAS unsigned char* L_ = (LAS unsigned char*)lds; asm volatile("" : "+s"(L_)); \
        int bid = blockIdx.x; asm volatile("" : "+s"(bid)); int GG = gridDim.x; asm volatile("" : "+s"(GG)); \
        const int tid = otid(wave_s); const int lane = tid & 63; const int wave = __builtin_amdgcn_readfirstlane(tid >> 6); (void)lane; (void)wave; (void)bid; (void)GG; \
        char* glds = (char*)L_; PG8_LAS float* stat = (PG8_LAS float*)(L_ + LDS_STAT); volatile LAS unsigned* MISCp = (volatile LAS unsigned*)(L_ + LDS_MISC); \
        volatile LAS unsigned* ptab = (volatile LAS unsigned*)(L_ + LDS_MISC + 128); (void)glds; (void)stat; (void)MISCp; \
        unsigned char* ws = (unsigned char*)PTR(29); float* out = (float*)PTR(28); gu32* ctl = (gu32*)(ws + WS_CTL); (void)out; (void)ctl; \
        float* ssp = (float*)(ws + WS_SSP); float* cumb = (float*)(ws + WS_CUMB); float* misc32 = (float*)(ws + WS_MISC32); float* gss = (float*)(ws + WS_GSS); \
        float* ssy = (float*)(ws + WS_SSY); float* rope = (float*)(ws + WS_ROPE); unsigned long long* BM = (unsigned long long*)(ws + WS_BM); \
        bf16* XB = (bf16*)(ws + WS_XB); bf16* QB = XB; \
        bf16* EP = (bf16*)(ws + WS_R + R_EP); bf16* AOE = (bf16*)(ws + WS_R + R_AOE); \
        bf16* C1 = (bf16*)(ws + WS_R + R_C1); bf16* AO = (bf16*)(ws + WS_R + R_AO); bf16* XBC = (bf16*)(ws + WS_R + R_XBC); bf16* KK = (bf16*)(ws + WS_R + R_KK); bf16* VV = (bf16*)(ws + WS_R + R_VV); \
        bf16* HB = (bf16*)(ws + WS_R + R_H); unsigned char* wsw = ws + WS_W; \
        const bf16* W1t = (const bf16*)(wsw + ((layer & 1) ? WO_1 : WE_1)); const bf16* W2t = (const bf16*)(wsw + ((layer & 1) ? WO_2 : WE_2)); \
        (void)ssp; (void)cumb; (void)misc32; (void)gss; (void)ssy; (void)rope; (void)BM; (void)XB; (void)QB; (void)EP; (void)AOE; (void)C1; (void)AO; (void)XBC; (void)KK; (void)VV; (void)HB; (void)W1t; (void)W2t;

    {
        constexpr int layer = 0;
        const int li = layer >> 1; const int gp0 = layer * 7;
        if ((layer & 1) == 0) {
            if (EN(0) && IN(gp0 + 0)) { ENV();
                LAS float* scr = (LAS float*)(L_ + wave * 16384);
                const int gw = bid * NWAVES + wave, NGW = GG * NWAVES;
                int it = gw;
#define WJOB(Wp, dstp, gainp, K_, Nsrc_, Ndst_, map_, gk0_) do { const WJob J_{Wp, dstp, gainp, K_, Nsrc_, Ndst_, map_, gk0_}; const int nit_ = ((K_) / 64) * ((Ndst_) / 32); \
                    for (; it < nit_; it += NGW) wconv_item(J_, scr, it, lane); it -= nit_; } while (0)
                WJOB(PTR(3) + (size_t)li * 1024 * 2892, (bf16*)(wsw + WE_IN), PTR(2) + li * 1024, 1024, 2892, 3072, MAP_EVEN_IN, 0);
                WJOB(PTR(9) + (size_t)li * 1024 * 1024, (bf16*)(wsw + WE_OUT), (const float*)nullptr, 1024, 1024, 1024, MAP_ID, 0);
                WJOB(PTR(26) + (size_t)(2 * li) * 1024 * 4096, (bf16*)(wsw + WE_1), PTR(25) + (2 * li) * 1024, 1024, 4096, 4096, MAP_ID, 0);
                WJOB(PTR(27) + (size_t)(2 * li) * 4096 * 1024, (bf16*)(wsw + WE_2), (const float*)nullptr, 4096, 1024, 1024, MAP_ID, 0);
                WJOB(PTR(11) + (size_t)li * 1024 * 3792, (bf16*)(wsw + WO_IN), PTR(10) + li * 1024, 1024, 3792, 3840, MAP_ODD_IN, 0);
                WJOB(PTR(14) + (size_t)li * 384 * 768, (bf16*)(wsw + WO_UQ), PTR(12) + li * 384, 384, 768, 1024, MAP_UQ, 0);
                WJOB(PTR(15) + (size_t)li * 256 * 1024, (bf16*)(wsw + WO_UKV), PTR(13) + li * 256, 256, 1024, 1024, MAP_ID, 0);
                WJOB(PTR(24) + (size_t)li * 1536 * 1024, (bf16*)(wsw + WO_OUT), PTR(23) + li * 1024, 1536, 1024, 1024, MAP_ID, 512);
                WJOB(PTR(26) + (size_t)(2 * li + 1) * 1024 * 4096, (bf16*)(wsw + WO_1), PTR(25) + (2 * li + 1) * 1024, 1024, 4096, 4096, MAP_ID, 0);
                WJOB(PTR(27) + (size_t)(2 * li + 1) * 4096 * 1024, (bf16*)(wsw + WO_2), (const float*)nullptr, 4096, 1024, 1024, MAP_ID, 0);
#undef WJOB
                if (layer == 0) { const float* x_in = PTR(0); const int* positions = (const int*)PTR(1);
                    for (int m = gw; m < MTOK; m += NGW) {
                        const GAS f32x4* xr = (const GAS f32x4*)(x_in + (size_t)m * DM) + lane; f32x4 v[4]; float s = 0.f;
#pragma unroll
                        for (int j = 0; j < 4; ++j) { v[j] = xr[64 * j]; s += (v[j].x * v[j].x + v[j].y * v[j].y) + (v[j].z * v[j].z + v[j].w * v[j].w); }
                        s = wave_sum(s);
                        GAS unsigned long long* o8 = (GAS unsigned long long*)(XB + (size_t)m * DM) + lane;
#pragma unroll
                        for (int j = 0; j < 4; ++j) o8[64 * j] = (unsigned long long)pk2(v[j].x, v[j].y) | ((unsigned long long)pk2(v[j].z, v[j].w) << 32);
                        if (lane < 4) ssp[(size_t)lane * MTOK + m] = (lane == 0) ? s : 0.f;
                    }
                    for (int idx = bid * 512 + tid; idx < MTOK * 32; idx += GG * 512) { const int tok = idx >> 5, i = idx & 31;
                        const float inv = powf(10000.0f, -(float)i / 32.0f); const float ang = (float)positions[tok] * inv; const float sn = sinf(ang), cs = cosf(ang);
                        rope[(size_t)idx * 2] = cs; rope[(size_t)idx * 2 + 1] = sn; }
                }
            }
            SEAM(gp0 + 0);
            if (EN(1) && IN(gp0 + 1)) { ENV();
                pg8::Gemm g{XB, (const bf16*)(wsw + WE_IN), MTOK, N_E_IN, DM, DM}; pg8::StaticOrder S; S.init(MTOK, N_E_IN, GG, bid);
                pg8::EpiEvenIn E{EP, ssp, misc32, PTR(5) + li * 128, PTR(6) + li * 128, PTR(7) + li * 128, PTR(8) + li * 128, PTR(4) + li * 4, stat};
                pg8::gemm_phase<pg8::EpiEvenIn, pg8::StaticOrder, true, true>(L_, g, S, E, tid);
            }
            SEAM(gp0 + 1);
            if (EN(2) && IN(gp0 + 2)) { ENV();
                gu32* qh = ctl + CW_QUEUE + 64 * (layer * 4 + 0);
                for (;;) {
                    if (tid == 0) MISCp[4] = __hip_atomic_fetch_add(qh, 1u, RLX_AGENT);
                    __syncthreads();
                    const int u = (int)MISCp[4];
                    if (u >= 32 + 4096) break;
                    if (u < 32) tk::cumsum_unit(misc32, cumb, u >> 2, u & 3, glds, tid);
                    else { const int v = u - 32; tk::topk_unit(EP, misc32, BM, v & 7, 511 - (v >> 3), glds, glds + LDS_STAT, glds + LDS_CAND, tid); }
                }
            }
            SEAM(gp0 + 2);
            if (IN(gp0 + 3)) { ENV();
                gu32* qh = ctl + CW_QUEUE + 64 * (layer * 4 + 1);
                for (;;) {
                    if (tid == 0) MISCp[4] = __hip_atomic_fetch_add(qh, 1u, RLX_AGENT);
                    __syncthreads();
                    const int u = (int)MISCp[4];
                    if (u >= 1024) break;
                    const int i = u >> 1; att::UnitArgs a;
                    if ((u & 1) == 0) { if (EN(3)) {
                        const int qb = 15 - (i >> 5), bh = i & 31, b = bh >> 2, h = bh & 3; const size_t r0 = (size_t)b * SEQ + qb * 256 + 32 * wave;
                        a.Q = EP + r0 * N_E_IN + 1536 + 128 * h; a.ldq = N_E_IN; a.K = EP + (size_t)b * SEQ * N_E_IN + 2048 + 128 * h; a.ldk = N_E_IN; a.V = EP + (size_t)b * SEQ * N_E_IN + 2560 + 128 * h; a.ldv = N_E_IN;
                        a.O = AOE + r0 * DM + 512 + 128 * h; a.ldo = DM; a.qlo = qb * 256 + 32 * wave; a.NT = 4 * (qb + 1); a.kbias = cumb + (size_t)h * MTOK + (size_t)b * SEQ; a.bm = nullptr; a.tid = tid;
                        att::attn_unit<128, 1>(a, glds); }
                    } else if (EN(4)) {
                        const int j = 63 - (i >> 3), b = i & 7, head = wave >> 1, sub = wave & 1; const size_t r0 = (size_t)b * SEQ + j * 64 + 32 * sub;
                        a.Q = EP + r0 * N_E_IN + 128 * head; a.ldq = N_E_IN; a.K = EP + (size_t)b * SEQ * N_E_IN + 512; a.ldk = N_E_IN; a.V = EP + (size_t)b * SEQ * N_E_IN + 640; a.ldv = N_E_IN;
                        a.O = AOE + r0 * DM + 128 * head; a.ldo = DM; a.qlo = j * 64 + 32 * sub; a.NT = j + 1; a.kbias = nullptr; a.bm = BM + r0 * 64; a.tid = tid;
                        att::attn_unit<128, 2>(a, glds);
                    }
                }
            }
            SEAM(gp0 + 3);
            if (EN(5) && IN(gp0 + 4)) { ENV();
                pg8::Gemm g{AOE, (const bf16*)(wsw + WE_OUT), MTOK, DM, DM, DM}; pg8::StaticOrder S; S.init(MTOK, DM, GG, bid);
                pg8::EpiResid E{layer == 0 ? PTR(0) : (const float*)out, out, XB, ssp, stat};
                pg8::gemm_phase<pg8::EpiResid, pg8::StaticOrder, true, true>(L_, g, S, E, tid);
            }
            SEAM(gp0 + 4);
        } else {
            if (EN(6) && IN(gp0 + 0)) { ENV();
                pg8::Gemm g{XB, (const bf16*)(wsw + WO_IN), MTOK, N_O_IN, DM, DM}; pg8::StaticOrder S; S.init(MTOK, N_O_IN, GG, bid);
                pg8::EpiOddIn E{C1, AO, XBC, ssp, gss, misc32, PTR(20) + li * 16, stat};
                pg8::gemm_phase<pg8::EpiOddIn, pg8::StaticOrder, true, true>(L_, g, S, E, tid);
            }
            SEAM(gp0 + 0);
            if (EN(7) && IN(gp0 + 1)) { ENV();
                if (EN(12)) { pg8::Gemm g{C1, (const bf16*)(wsw + WO_UQ), MTOK, 1024, 384, 768}; pg8::StaticOrder S; S.init(MTOK, 1024, GG, bid);
                  pg8::EpiUq E{QB, gss, PTR(16) + li * 192, rope, stat};
                  pg8::gemm_phase<pg8::EpiUq, pg8::StaticOrder, true, true>(L_, g, S, E, tid); }
                if (EN(13)) { pg8::Gemm g{C1 + 384, (const bf16*)(wsw + WO_UKV), MTOK, 1024, 256, 768}; pg8::StaticOrder S; S.init(MTOK, 1024, GG, bid);
                  pg8::EpiUkv E{KK, VV, C1, gss, PTR(17) + li * 192, rope, stat};
                  pg8::gemm_phase<pg8::EpiUkv, pg8::StaticOrder, true, true>(L_, g, S, E, tid); }
            }
            SEAM(gp0 + 1);
            if (IN(gp0 + 2)) { ENV();
                gu32* qh = ctl + CW_QUEUE + 64 * (layer * 4 + 0);
                for (;;) {
                    if (tid == 0) MISCp[4] = __hip_atomic_fetch_add(qh, 1u, RLX_AGENT);
                    __syncthreads();
                    const int u = (int)MISCp[4];
                    if (u >= 128 + 512) break;
                    if (u < 128) { if (EN(8)) { const int b = u >> 4, h = u & 15;
                        ssd::ssd_unit(XBC, AO, misc32, ssy, PTR(18) + (size_t)li * 4 * 2048, PTR(19) + li * 2048, PTR(21)[li * 16 + h], PTR(22)[li * 16 + h], b, h, glds, glds + LDS_STAT, tid); }
                    } else if (EN(9)) { const int i = u - 128; const int qb = 15 - (i >> 5), bh = i & 31, b = bh >> 2, h = bh & 3; const size_t r0 = (size_t)b * SEQ + qb * 256 + 32 * wave; att::UnitArgs a;
                        a.Q = QB + r0 * 768 + 192 * h; a.ldq = 768; a.K = KK + (size_t)b * SEQ * 768 + 192 * h; a.ldk = 768; a.V = VV + (size_t)b * SEQ * 512 + 128 * h; a.ldv = 512;
                        a.O = AO + r0 * K_O_OUT + 128 * h; a.ldo = K_O_OUT; a.qlo = qb * 256 + 32 * wave; a.NT = 4 * (qb + 1); a.kbias = nullptr; a.bm = nullptr; a.tid = tid;
                        att::attn_unit<192, 0>(a, glds);
                    }
                }
            }
            SEAM(gp0 + 2);
            if (EN(10) && IN(gp0 + 3)) { ENV();
                for (int idx = bid * 512 + tid; idx < MTOK * 128; idx += GG * 512) { const int tok = idx >> 7, ch = idx & 127, gq = ch >> 5;
                    const f32x4 s0 = *(const f32x4*)(ssy + (size_t)tok * 32 + gq * 8), s1 = *(const f32x4*)(ssy + (size_t)tok * 32 + gq * 8 + 4);
                    const float r = rsqrtf((((s0[0] + s0[1]) + (s0[2] + s0[3])) + ((s1[0] + s1[1]) + (s1[2] + s1[3]))) * (1.0f / 256.0f) + EPS);
                    v4u* p = (v4u*)(AO + (size_t)tok * K_O_OUT + 512 + ch * 8); const v4u raw = *p; v4u o;
#pragma unroll
                    for (int e = 0; e < 4; ++e) o[e] = pg8::cvt_pk_bf16(__uint_as_float(raw[e] << 16) * r, __uint_as_float(raw[e] & 0xffff0000u) * r);
                    *p = o; }
            }
            SEAM(gp0 + 3);
            if (EN(5) && IN(gp0 + 4)) { ENV();
                pg8::Gemm g{AO, (const bf16*)(wsw + WO_OUT), MTOK, DM, K_O_OUT, K_O_OUT}; pg8::StaticOrder S; S.init(MTOK, DM, GG, bid);
                pg8::EpiResid E{(const float*)out, out, XB, ssp, stat};
                pg8::gemm_phase<pg8::EpiResid, pg8::StaticOrder, true, true>(L_, g, S, E, tid);
            }
            SEAM(gp0 + 4);
        }
        if (EN(11) && IN(gp0 + 5)) { ENV();
            pg8::Gemm g{XB, W1t, MTOK, DFF, DM, DM}; pg8::StaticOrder S; S.init(MTOK, DFF, GG, bid);
            pg8::EpiMlpUp E{HB, ssp};
            pg8::gemm_phase<pg8::EpiMlpUp, pg8::StaticOrder, true, true>(L_, g, S, E, tid);
        }
        SEAM(gp0 + 5);
        if (EN(5) && IN(gp0 + 6)) { ENV();
            pg8::Gemm g{HB, W2t, MTOK, DM, DFF, DFF}; pg8::StaticOrder S; S.init(MTOK, DM, GG, bid);
            pg8::EpiResid E{(const float*)out, out, XB, ssp, stat};
            pg8::gemm_phase<pg8::EpiResid, pg8::StaticOrder, true, true>(L_, g, S, E, tid);
        }
        if (layer < 3) SEAM(gp0 + 6);
    }
    {
        constexpr int layer = 1;
        const int li = layer >> 1; const int gp0 = layer * 7;
        if ((layer & 1) == 0) {
            if (EN(0) && IN(gp0 + 0)) { ENV();
                LAS float* scr = (LAS float*)(L_ + wave * 16384);
                const int gw = bid * NWAVES + wave, NGW = GG * NWAVES;
                int it = gw;
#define WJOB(Wp, dstp, gainp, K_, Nsrc_, Ndst_, map_, gk0_) do { const WJob J_{Wp, dstp, gainp, K_, Nsrc_, Ndst_, map_, gk0_}; const int nit_ = ((K_) / 64) * ((Ndst_) / 32); \
                    for (; it < nit_; it += NGW) wconv_item(J_, scr, it, lane); it -= nit_; } while (0)
                WJOB(PTR(3) + (size_t)li * 1024 * 2892, (bf16*)(wsw + WE_IN), PTR(2) + li * 1024, 1024, 2892, 3072, MAP_EVEN_IN, 0);
                WJOB(PTR(9) + (size_t)li * 1024 * 1024, (bf16*)(wsw + WE_OUT), (const float*)nullptr, 1024, 1024, 1024, MAP_ID, 0);
                WJOB(PTR(26) + (size_t)(2 * li) * 1024 * 4096, (bf16*)(wsw + WE_1), PTR(25) + (2 * li) * 1024, 1024, 4096, 4096, MAP_ID, 0);
                WJOB(PTR(27) + (size_t)(2 * li) * 4096 * 1024, (bf16*)(wsw + WE_2), (const float*)nullptr, 4096, 1024, 1024, MAP_ID, 0);
                WJOB(PTR(11) + (size_t)li * 1024 * 3792, (bf16*)(wsw + WO_IN), PTR(10) + li * 1024, 1024, 3792, 3840, MAP_ODD_IN, 0);
                WJOB(PTR(14) + (size_t)li * 384 * 768, (bf16*)(wsw + WO_UQ), PTR(12) + li * 384, 384, 768, 1024, MAP_UQ, 0);
                WJOB(PTR(15) + (size_t)li * 256 * 1024, (bf16*)(wsw + WO_UKV), PTR(13) + li * 256, 256, 1024, 1024, MAP_ID, 0);
                WJOB(PTR(24) + (size_t)li * 1536 * 1024, (bf16*)(wsw + WO_OUT), PTR(23) + li * 1024, 1536, 1024, 1024, MAP_ID, 512);
                WJOB(PTR(26) + (size_t)(2 * li + 1) * 1024 * 4096, (bf16*)(wsw + WO_1), PTR(25) + (2 * li + 1) * 1024, 1024, 4096, 4096, MAP_ID, 0);
                WJOB(PTR(27) + (size_t)(2 * li + 1) * 4096 * 1024, (bf16*)(wsw + WO_2), (const float*)nullptr, 4096, 1024, 1024, MAP_ID, 0);
#undef WJOB
                if (layer == 0) { const float* x_in = PTR(0); const int* positions = (const int*)PTR(1);
                    for (int m = gw; m < MTOK; m += NGW) {
                        const GAS f32x4* xr = (const GAS f32x4*)(x_in + (size_t)m * DM) + lane; f32x4 v[4]; float s = 0.f;
#pragma unroll
                        for (int j = 0; j < 4; ++j) { v[j] = xr[64 * j]; s += (v[j].x * v[j].x + v[j].y * v[j].y) + (v[j].z * v[j].z + v[j].w * v[j].w); }
                        s = wave_sum(s);
                        GAS unsigned long long* o8 = (GAS unsigned long long*)(XB + (size_t)m * DM) + lane;
#pragma unroll
                        for (int j = 0; j < 4; ++j) o8[64 * j] = (unsigned long long)pk2(v[j].x, v[j].y) | ((unsigned long long)pk2(v[j].z, v[j].w) << 32);
                        if (lane < 4) ssp[(size_t)lane * MTOK + m] = (lane == 0) ? s : 0.f;
                    }
                    for (int idx = bid * 512 + tid; idx < MTOK * 32; idx += GG * 512) { const int tok = idx >> 5, i = idx & 31;
                        const float inv = powf(10000.0f, -(float)i / 32.0f); const float ang = (float)positions[tok] * inv; const float sn = sinf(ang), cs = cosf(ang);
                        rope[(size_t)idx * 2] = cs; rope[(size_t)idx * 2 + 1] = sn; }
                }
            }
            SEAM(gp0 + 0);
            if (EN(1) && IN(gp0 + 1)) { ENV();
                pg8::Gemm g{XB, (const bf16*)(wsw + WE_IN), MTOK, N_E_IN, DM, DM}; pg8::StaticOrder S; S.init(MTOK, N_E_IN, GG, bid);
                pg8::EpiEvenIn E{EP, ssp, misc32, PTR(5) + li * 128, PTR(6) + li * 128, PTR(7) + li * 128, PTR(8) + li * 128, PTR(4) + li * 4, stat};
                pg8::gemm_phase<pg8::EpiEvenIn, pg8::StaticOrder, true, true>(L_, g, S, E, tid);
            }
            SEAM(gp0 + 1);
            if (EN(2) && IN(gp0 + 2)) { ENV();
                gu32* qh = ctl + CW_QUEUE + 64 * (layer * 4 + 0);
                for (;;) {
                    if (tid == 0) MISCp[4] = __hip_atomic_fetch_add(qh, 1u, RLX_AGENT);
                    __syncthreads();
                    const int u = (int)MISCp[4];
                    if (u >= 32 + 4096) break;
                    if (u < 32) tk::cumsum_unit(misc32, cumb, u >> 2, u & 3, glds, tid);
                    else { const int v = u - 32; tk::topk_unit(EP, misc32, BM, v & 7, 511 - (v >> 3), glds, glds + LDS_STAT, glds + LDS_CAND, tid); }
                }
            }
            SEAM(gp0 + 2);
            if (IN(gp0 + 3)) { ENV();
                gu32* qh = ctl + CW_QUEUE + 64 * (layer * 4 + 1);
                for (;;) {
                    if (tid == 0) MISCp[4] = __hip_atomic_fetch_add(qh, 1u, RLX_AGENT);
                    __syncthreads();
                    const int u = (int)MISCp[4];
                    if (u >= 1024) break;
                    const int i = u >> 1; att::UnitArgs a;
                    if ((u & 1) == 0) { if (EN(3)) {
                        const int qb = 15 - (i >> 5), bh = i & 31, b = bh >> 2, h = bh & 3; const size_t r0 = (size_t)b * SEQ + qb * 256 + 32 * wave;
                        a.Q = EP + r0 * N_E_IN + 1536 + 128 * h; a.ldq = N_E_IN; a.K = EP + (size_t)b * SEQ * N_E_IN + 2048 + 128 * h; a.ldk = N_E_IN; a.V = EP + (size_t)b * SEQ * N_E_IN + 2560 + 128 * h; a.ldv = N_E_IN;
                        a.O = AOE + r0 * DM + 512 + 128 * h; a.ldo = DM; a.qlo = qb * 256 + 32 * wave; a.NT = 4 * (qb + 1); a.kbias = cumb + (size_t)h * MTOK + (size_t)b * SEQ; a.bm = nullptr; a.tid = tid;
                        att::attn_unit<128, 1>(a, glds); }
                    } else if (EN(4)) {
                        const int j = 63 - (i >> 3), b = i & 7, head = wave >> 1, sub = wave & 1; const size_t r0 = (size_t)b * SEQ + j * 64 + 32 * sub;
                        a.Q = EP + r0 * N_E_IN + 128 * head; a.ldq = N_E_IN; a.K = EP + (size_t)b * SEQ * N_E_IN + 512; a.ldk = N_E_IN; a.V = EP + (size_t)b * SEQ * N_E_IN + 640; a.ldv = N_E_IN;
                        a.O = AOE + r0 * DM + 128 * head; a.ldo = DM; a.qlo = j * 64 + 32 * sub; a.NT = j + 1; a.kbias = nullptr; a.bm = BM + r0 * 64; a.tid = tid;
                        att::attn_unit<128, 2>(a, glds);
                    }
                }
            }
            SEAM(gp0 + 3);
            if (EN(5) && IN(gp0 + 4)) { ENV();
                pg8::Gemm g{AOE, (const bf16*)(wsw + WE_OUT), MTOK, DM, DM, DM}; pg8::StaticOrder S; S.init(MTOK, DM, GG, bid);
                pg8::EpiResid E{layer == 0 ? PTR(0) : (const float*)out, out, XB, ssp, stat};
                pg8::gemm_phase<pg8::EpiResid, pg8::StaticOrder, true, true>(L_, g, S, E, tid);
            }
            SEAM(gp0 + 4);
        } else {
            if (EN(6) && IN(gp0 + 0)) { ENV();
                pg8::Gemm g{XB, (const bf16*)(wsw + WO_IN), MTOK, N_O_IN, DM, DM}; pg8::StaticOrder S; S.init(MTOK, N_O_IN, GG, bid);
                pg8::EpiOddIn E{C1, AO, XBC, ssp, gss, misc32, PTR(20) + li * 16, stat};
                pg8::gemm_phase<pg8::EpiOddIn, pg8::StaticOrder, true, true>(L_, g, S, E, tid);
            }
            SEAM(gp0 + 0);
            if (EN(7) && IN(gp0 + 1)) { ENV();
                if (EN(12)) { pg8::Gemm g{C1, (const bf16*)(wsw + WO_UQ), MTOK, 1024, 384, 768}; pg8::StaticOrder S; S.init(MTOK, 1024, GG, bid);
                  pg8::EpiUq E{QB, gss, PTR(16) + li * 192, rope, stat};
                  pg8::gemm_phase<pg8::EpiUq, pg8::StaticOrder, true, true>(L_, g, S, E, tid); }
                if (EN(13)) { pg8::Gemm g{C1 + 384, (const bf16*)(wsw + WO_UKV), MTOK, 1024, 256, 768}; pg8::StaticOrder S; S.init(MTOK, 1024, GG, bid);
                  pg8::EpiUkv E{KK, VV, C1, gss, PTR(17) + li * 192, rope, stat};
                  pg8::gemm_phase<pg8::EpiUkv, pg8::StaticOrder, true, true>(L_, g, S, E, tid); }
            }
            SEAM(gp0 + 1);
            if (IN(gp0 + 2)) { ENV();
                gu32* qh = ctl + CW_QUEUE + 64 * (layer * 4 + 0);
                for (;;) {
                    if (tid == 0) MISCp[4] = __hip_atomic_fetch_add(qh, 1u, RLX_AGENT);
                    __syncthreads();
                    const int u = (int)MISCp[4];
                    if (u >= 128 + 512) break;
                    if (u < 128) { if (EN(8)) { const int b = u >> 4, h = u & 15;
                        ssd::ssd_unit(XBC, AO, misc32, ssy, PTR(18) + (size_t)li * 4 * 2048, PTR(19) + li * 2048, PTR(21)[li * 16 + h], PTR(22)[li * 16 + h], b, h, glds, glds + LDS_STAT, tid); }
                    } else if (EN(9)) { const int i = u - 128; const int qb = 15 - (i >> 5), bh = i & 31, b = bh >> 2, h = bh & 3; const size_t r0 = (size_t)b * SEQ + qb * 256 + 32 * wave; att::UnitArgs a;
                        a.Q = QB + r0 * 768 + 192 * h; a.ldq = 768; a.K = KK + (size_t)b * SEQ * 768 + 192 * h; a.ldk = 768; a.V = VV + (size_t)b * SEQ * 512 + 128 * h; a.ldv = 512;
                        a.O = AO + r0 * K_O_OUT + 128 * h; a.ldo = K_O_OUT; a.qlo = qb * 256 + 32 * wave; a.NT = 4 * (qb + 1); a.kbias = nullptr; a.bm = nullptr; a.tid = tid;
                        att::attn_unit<192, 0>(a, glds);
                    }
                }
            }
            SEAM(gp0 + 2);
            if (EN(10) && IN(gp0 + 3)) { ENV();
                for (int idx = bid * 512 + tid; idx < MTOK * 128; idx += GG * 512) { const int tok = idx >> 7, ch = idx & 127, gq = ch >> 5;
                    const f32x4 s0 = *(const f32x4*)(ssy + (size_t)tok * 32 + gq * 8), s1 = *(const f32x4*)(ssy + (size_t)tok * 32 + gq * 8 + 4);
                    const float r = rsqrtf((((s0[0] + s0[1]) + (s0[2] + s0[3])) + ((s1[0] + s1[1]) + (s1[2] + s1[3]))) * (1.0f / 256.0f) + EPS);
                    v4u* p = (v4u*)(AO + (size_t)tok * K_O_OUT + 512 + ch * 8); const v4u raw = *p; v4u o;
#pragma unroll
                    for (int e = 0; e < 4; ++e) o[e] = pg8::cvt_pk_bf16(__uint_as_float(raw[e] << 16) * r, __uint_as_float(raw[e] & 0xffff0000u) * r);
                    *p = o; }
            }
            SEAM(gp0 + 3);
            if (EN(5) && IN(gp0 + 4)) { ENV();
                pg8::Gemm g{AO, (const bf16*)(wsw + WO_OUT), MTOK, DM, K_O_OUT, K_O_OUT}; pg8::StaticOrder S; S.init(MTOK, DM, GG, bid);
                pg8::EpiResid E{(const float*)out, out, XB, ssp, stat};
                pg8::gemm_phase<pg8::EpiResid, pg8::StaticOrder, true, true>(L_, g, S, E, tid);
            }
            SEAM(gp0 + 4);
        }
        if (EN(11) && IN(gp0 + 5)) { ENV();
            pg8::Gemm g{XB, W1t, MTOK, DFF, DM, DM}; pg8::StaticOrder S; S.init(MTOK, DFF, GG, bid);
            pg8::EpiMlpUp E{HB, ssp};
            pg8::gemm_phase<pg8::EpiMlpUp, pg8::StaticOrder, true, true>(L_, g, S, E, tid);
        }
        SEAM(gp0 + 5);
        if (EN(5) && IN(gp0 + 6)) { ENV();
            pg8::Gemm g{HB, W2t, MTOK, DM, DFF, DFF}; pg8::StaticOrder S; S.init(MTOK, DM, GG, bid);
            pg8::EpiResid E{(const float*)out, out, XB, ssp, stat};
            pg8::gemm_phase<pg8::EpiResid, pg8::StaticOrder, true, true>(L_, g, S, E, tid);
        }
        if (layer < 3) SEAM(gp0 + 6);
    }
    {
        constexpr int layer = 2;
        const int li = layer >> 1; const int gp0 = layer * 7;
        if ((layer & 1) == 0) {
            if (EN(0) && IN(gp0 + 0)) { ENV();
                LAS float* scr = (LAS float*)(L_ + wave * 16384);
                const int gw = bid * NWAVES + wave, NGW = GG * NWAVES;
                int it = gw;
#define WJOB(Wp, dstp, gainp, K_, Nsrc_, Ndst_, map_, gk0_) do { const WJob J_{Wp, dstp, gainp, K_, Nsrc_, Ndst_, map_, gk0_}; const int nit_ = ((K_) / 64) * ((Ndst_) / 32); \
                    for (; it < nit_; it += NGW) wconv_item(J_, scr, it, lane); it -= nit_; } while (0)
                WJOB(PTR(3) + (size_t)li * 1024 * 2892, (bf16*)(wsw + WE_IN), PTR(2) + li * 1024, 1024, 2892, 3072, MAP_EVEN_IN, 0);
                WJOB(PTR(9) + (size_t)li * 1024 * 1024, (bf16*)(wsw + WE_OUT), (const float*)nullptr, 1024, 1024, 1024, MAP_ID, 0);
                WJOB(PTR(26) + (size_t)(2 * li) * 1024 * 4096, (bf16*)(wsw + WE_1), PTR(25) + (2 * li) * 1024, 1024, 4096, 4096, MAP_ID, 0);
                WJOB(PTR(27) + (size_t)(2 * li) * 4096 * 1024, (bf16*)(wsw + WE_2), (const float*)nullptr, 4096, 1024, 1024, MAP_ID, 0);
                WJOB(PTR(11) + (size_t)li * 1024 * 3792, (bf16*)(wsw + WO_IN), PTR(10) + li * 1024, 1024, 3792, 3840, MAP_ODD_IN, 0);
                WJOB(PTR(14) + (size_t)li * 384 * 768, (bf16*)(wsw + WO_UQ), PTR(12) + li * 384, 384, 768, 1024, MAP_UQ, 0);
                WJOB(PTR(15) + (size_t)li * 256 * 1024, (bf16*)(wsw + WO_UKV), PTR(13) + li * 256, 256, 1024, 1024, MAP_ID, 0);
                WJOB(PTR(24) + (size_t)li * 1536 * 1024, (bf16*)(wsw + WO_OUT), PTR(23) + li * 1024, 1536, 1024, 1024, MAP_ID, 512);
                WJOB(PTR(26) + (size_t)(2 * li + 1) * 1024 * 4096, (bf16*)(wsw + WO_1), PTR(25) + (2 * li + 1) * 1024, 1024, 4096, 4096, MAP_ID, 0);
                WJOB(PTR(27) + (size_t)(2 * li + 1) * 4096 * 1024, (bf16*)(wsw + WO_2), (const float*)nullptr, 4096, 1024, 1024, MAP_ID, 0);
#undef WJOB
                if (layer == 0) { const float* x_in = PTR(0); const int* positions = (const int*)PTR(1);
                    for (int m = gw; m < MTOK; m += NGW) {
                        const GAS f32x4* xr = (const GAS f32x4*)(x_in + (size_t)m * DM) + lane; f32x4 v[4]; float s = 0.f;
#pragma unroll
                        for (int j = 0; j < 4; ++j) { v[j] = xr[64 * j]; s += (v[j].x * v[j].x + v[j].y * v[j].y) + (v[j].z * v[j].z + v[j].w * v[j].w); }
                        s = wave_sum(s);
                        GAS unsigned long long* o8 = (GAS unsigned long long*)(XB + (size_t)m * DM) + lane;
#pragma unroll
                        for (int j = 0; j < 4; ++j) o8[64 * j] = (unsigned long long)pk2(v[j].x, v[j].y) | ((unsigned long long)pk2(v[j].z, v[j].w) << 32);
                        if (lane < 4) ssp[(size_t)lane * MTOK + m] = (lane == 0) ? s : 0.f;
                    }
                    for (int idx = bid * 512 + tid; idx < MTOK * 32; idx += GG * 512) { const int tok = idx >> 5, i = idx & 31;
                        const float inv = powf(10000.0f, -(float)i / 32.0f); const float ang = (float)positions[tok] * inv; const float sn = sinf(ang), cs = cosf(ang);
                        rope[(size_t)idx * 2] = cs; rope[(size_t)idx * 2 + 1] = sn; }
                }
            }
            SEAM(gp0 + 0);
            if (EN(1) && IN(gp0 + 1)) { ENV();
                pg8::Gemm g{XB, (const bf16*)(wsw + WE_IN), MTOK, N_E_IN, DM, DM}; pg8::StaticOrder S; S.init(MTOK, N_E_IN, GG, bid);
                pg8::EpiEvenIn E{EP, ssp, misc32, PTR(5) + li * 128, PTR(6) + li * 128, PTR(7) + li * 128, PTR(8) + li * 128, PTR(4) + li * 4, stat};
                pg8::gemm_phase<pg8::EpiEvenIn, pg8::StaticOrder, true, true>(L_, g, S, E, tid);
            }
            SEAM(gp0 + 1);
            if (EN(2) && IN(gp0 + 2)) { ENV();
                gu32* qh = ctl + CW_QUEUE + 64 * (layer * 4 + 0);
                for (;;) {
                    if (tid == 0) MISCp[4] = __hip_atomic_fetch_add(qh, 1u, RLX_AGENT);
                    __syncthreads();
                    const int u = (int)MISCp[4];
                    if (u >= 32 + 4096) break;
                    if (u < 32) tk::cumsum_unit(misc32, cumb, u >> 2, u & 3, glds, tid);
                    else { const int v = u - 32; tk::topk_unit(EP, misc32, BM, v & 7, 511 - (v >> 3), glds, glds + LDS_STAT, glds + LDS_CAND, tid); }
                }
            }
            SEAM(gp0 + 2);
            if (IN(gp0 + 3)) { ENV();
                gu32* qh = ctl + CW_QUEUE + 64 * (layer * 4 + 1);
                for (;;) {
                    if (tid == 0) MISCp[4] = __hip_atomic_fetch_add(qh, 1u, RLX_AGENT);
                    __syncthreads();
                    const int u = (int)MISCp[4];
                    if (u >= 1024) break;
                    const int i = u >> 1; att::UnitArgs a;
                    if ((u & 1) == 0) { if (EN(3)) {
                        const int qb = 15 - (i >> 5), bh = i & 31, b = bh >> 2, h = bh & 3; const size_t r0 = (size_t)b * SEQ + qb * 256 + 32 * wave;
                        a.Q = EP + r0 * N_E_IN + 1536 + 128 * h; a.ldq = N_E_IN; a.K = EP + (size_t)b * SEQ * N_E_IN + 2048 + 128 * h; a.ldk = N_E_IN; a.V = EP + (size_t)b * SEQ * N_E_IN + 2560 + 128 * h; a.ldv = N_E_IN;
                        a.O = AOE + r0 * DM + 512 + 128 * h; a.ldo = DM; a.qlo = qb * 256 + 32 * wave; a.NT = 4 * (qb + 1); a.kbias = cumb + (size_t)h * MTOK + (size_t)b * SEQ; a.bm = nullptr; a.tid = tid;
                        att::attn_unit<128, 1>(a, glds); }
                    } else if (EN(4)) {
                        const int j = 63 - (i >> 3), b = i & 7, head = wave >> 1, sub = wave & 1; const size_t r0 = (size_t)b * SEQ + j * 64 + 32 * sub;
                        a.Q = EP + r0 * N_E_IN + 128 * head; a.ldq = N_E_IN; a.K = EP + (size_t)b * SEQ * N_E_IN + 512; a.ldk = N_E_IN; a.V = EP + (size_t)b * SEQ * N_E_IN + 640; a.ldv = N_E_IN;
                        a.O = AOE + r0 * DM + 128 * head; a.ldo = DM; a.qlo = j * 64 + 32 * sub; a.NT = j + 1; a.kbias = nullptr; a.bm = BM + r0 * 64; a.tid = tid;
                        att::attn_unit<128, 2>(a, glds);
                    }
                }
            }
            SEAM(gp0 + 3);
            if (EN(5) && IN(gp0 + 4)) { ENV();
                pg8::Gemm g{AOE, (const bf16*)(wsw + WE_OUT), MTOK, DM, DM, DM}; pg8::StaticOrder S; S.init(MTOK, DM, GG, bid);
                pg8::EpiResid E{layer == 0 ? PTR(0) : (const float*)out, out, XB, ssp, stat};
                pg8::gemm_phase<pg8::EpiResid, pg8::StaticOrder, true, true>(L_, g, S, E, tid);
            }
            SEAM(gp0 + 4);
        } else {
            if (EN(6) && IN(gp0 + 0)) { ENV();
                pg8::Gemm g{XB, (const bf16*)(wsw + WO_IN), MTOK, N_O_IN, DM, DM}; pg8::StaticOrder S; S.init(MTOK, N_O_IN, GG, bid);
                pg8::EpiOddIn E{C1, AO, XBC, ssp, gss, misc32, PTR(20) + li * 16, stat};
                pg8::gemm_phase<pg8::EpiOddIn, pg8::StaticOrder, true, true>(L_, g, S, E, tid);
            }
            SEAM(gp0 + 0);
            if (EN(7) && IN(gp0 + 1)) { ENV();
                if (EN(12)) { pg8::Gemm g{C1, (const bf16*)(wsw + WO_UQ), MTOK, 1024, 384, 768}; pg8::StaticOrder S; S.init(MTOK, 1024, GG, bid);
                  pg8::EpiUq E{QB, gss, PTR(16) + li * 192, rope, stat};
                  pg8::gemm_phase<pg8::EpiUq, pg8::StaticOrder, true, true>(L_, g, S, E, tid); }
                if (EN(13)) { pg8::Gemm g{C1 + 384, (const bf16*)(wsw + WO_UKV), MTOK, 1024, 256, 768}; pg8::StaticOrder S; S.init(MTOK, 1024, GG, bid);
                  pg8::EpiUkv E{KK, VV, C1, gss, PTR(17) + li * 192, rope, stat};
                  pg8::gemm_phase<pg8::EpiUkv, pg8::StaticOrder, true, true>(L_, g, S, E, tid); }
            }
            SEAM(gp0 + 1);
            if (IN(gp0 + 2)) { ENV();
                gu32* qh = ctl + CW_QUEUE + 64 * (layer * 4 + 0);
                for (;;) {
                    if (tid == 0) MISCp[4] = __hip_atomic_fetch_add(qh, 1u, RLX_AGENT);
                    __syncthreads();
                    const int u = (int)MISCp[4];
                    if (u >= 128 + 512) break;
                    if (u < 128) { if (EN(8)) { const int b = u >> 4, h = u & 15;
                        ssd::ssd_unit(XBC, AO, misc32, ssy, PTR(18) + (size_t)li * 4 * 2048, PTR(19) + li * 2048, PTR(21)[li * 16 + h], PTR(22)[li * 16 + h], b, h, glds, glds + LDS_STAT, tid); }
                    } else if (EN(9)) { const int i = u - 128; const int qb = 15 - (i >> 5), bh = i & 31, b = bh >> 2, h = bh & 3; const size_t r0 = (size_t)b * SEQ + qb * 256 + 32 * wave; att::UnitArgs a;
                        a.Q = QB + r0 * 768 + 192 * h; a.ldq = 768; a.K = KK + (size_t)b * SEQ * 768 + 192 * h; a.ldk = 768; a.V = VV + (size_t)b * SEQ * 512 + 128 * h; a.ldv = 512;
                        a.O = AO + r0 * K_O_OUT + 128 * h; a.ldo = K_O_OUT; a.qlo = qb * 256 + 32 * wave; a.NT = 4 * (qb + 1); a.kbias = nullptr; a.bm = nullptr; a.tid = tid;
                        att::attn_unit<192, 0>(a, glds);
                    }
                }
            }
            SEAM(gp0 + 2);
            if (EN(10) && IN(gp0 + 3)) { ENV();
                for (int idx = bid * 512 + tid; idx < MTOK * 128; idx += GG * 512) { const int tok = idx >> 7, ch = idx & 127, gq = ch >> 5;
                    const f32x4 s0 = *(const f32x4*)(ssy + (size_t)tok * 32 + gq * 8), s1 = *(const f32x4*)(ssy + (size_t)tok * 32 + gq * 8 + 4);
                    const float r = rsqrtf((((s0[0] + s0[1]) + (s0[2] + s0[3])) + ((s1[0] + s1[1]) + (s1[2] + s1[3]))) * (1.0f / 256.0f) + EPS);
                    v4u* p = (v4u*)(AO + (size_t)tok * K_O_OUT + 512 + ch * 8); const v4u raw = *p; v4u o;
#pragma unroll
                    for (int e = 0; e < 4; ++e) o[e] = pg8::cvt_pk_bf16(__uint_as_float(raw[e] << 16) * r, __uint_as_float(raw[e] & 0xffff0000u) * r);
                    *p = o; }
            }
            SEAM(gp0 + 3);
            if (EN(5) && IN(gp0 + 4)) { ENV();
                pg8::Gemm g{AO, (const bf16*)(wsw + WO_OUT), MTOK, DM, K_O_OUT, K_O_OUT}; pg8::StaticOrder S; S.init(MTOK, DM, GG, bid);
                pg8::EpiResid E{(const float*)out, out, XB, ssp, stat};
                pg8::gemm_phase<pg8::EpiResid, pg8::StaticOrder, true, true>(L_, g, S, E, tid);
            }
            SEAM(gp0 + 4);
        }
        if (EN(11) && IN(gp0 + 5)) { ENV();
            pg8::Gemm g{XB, W1t, MTOK, DFF, DM, DM}; pg8::StaticOrder S; S.init(MTOK, DFF, GG, bid);
            pg8::EpiMlpUp E{HB, ssp};
            pg8::gemm_phase<pg8::EpiMlpUp, pg8::StaticOrder, true, true>(L_, g, S, E, tid);
        }
        SEAM(gp0 + 5);
        if (EN(5) && IN(gp0 + 6)) { ENV();
            pg8::Gemm g{HB, W2t, MTOK, DM, DFF, DFF}; pg8::StaticOrder S; S.init(MTOK, DM, GG, bid);
            pg8::EpiResid E{(const float*)out, out, XB, ssp, stat};
            pg8::gemm_phase<pg8::EpiResid, pg8::StaticOrder, true, true>(L_, g, S, E, tid);
        }
        if (layer < 3) SEAM(gp0 + 6);
    }
    {
        constexpr int layer = 3;
        const int li = layer >> 1; const int gp0 = layer * 7;
        if ((layer & 1) == 0) {
            if (EN(0) && IN(gp0 + 0)) { ENV();
                LAS float* scr = (LAS float*)(L_ + wave * 16384);
                const int gw = bid * NWAVES + wave, NGW = GG * NWAVES;
                int it = gw;
#define WJOB(Wp, dstp, gainp, K_, Nsrc_, Ndst_, map_, gk0_) do { const WJob J_{Wp, dstp, gainp, K_, Nsrc_, Ndst_, map_, gk0_}; const int nit_ = ((K_) / 64) * ((Ndst_) / 32); \
                    for (; it < nit_; it += NGW) wconv_item(J_, scr, it, lane); it -= nit_; } while (0)
                WJOB(PTR(3) + (size_t)li * 1024 * 2892, (bf16*)(wsw + WE_IN), PTR(2) + li * 1024, 1024, 2892, 3072, MAP_EVEN_IN, 0);
                WJOB(PTR(9) + (size_t)li * 1024 * 1024, (bf16*)(wsw + WE_OUT), (const float*)nullptr, 1024, 1024, 1024, MAP_ID, 0);
                WJOB(PTR(26) + (size_t)(2 * li) * 1024 * 4096, (bf16*)(wsw + WE_1), PTR(25) + (2 * li) * 1024, 1024, 4096, 4096, MAP_ID, 0);
                WJOB(PTR(27) + (size_t)(2 * li) * 4096 * 1024, (bf16*)(wsw + WE_2), (const float*)nullptr, 4096, 1024, 1024, MAP_ID, 0);
                WJOB(PTR(11) + (size_t)li * 1024 * 3792, (bf16*)(wsw + WO_IN), PTR(10) + li * 1024, 1024, 3792, 3840, MAP_ODD_IN, 0);
                WJOB(PTR(14) + (size_t)li * 384 * 768, (bf16*)(wsw + WO_UQ), PTR(12) + li * 384, 384, 768, 1024, MAP_UQ, 0);
                WJOB(PTR(15) + (size_t)li * 256 * 1024, (bf16*)(wsw + WO_UKV), PTR(13) + li * 256, 256, 1024, 1024, MAP_ID, 0);
                WJOB(PTR(24) + (size_t)li * 1536 * 1024, (bf16*)(wsw + WO_OUT), PTR(23) + li * 1024, 1536, 1024, 1024, MAP_ID, 512);
                WJOB(PTR(26) + (size_t)(2 * li + 1) * 1024 * 4096, (bf16*)(wsw + WO_1), PTR(25) + (2 * li + 1) * 1024, 1024, 4096, 4096, MAP_ID, 0);
                WJOB(PTR(27) + (size_t)(2 * li + 1) * 4096 * 1024, (bf16*)(wsw + WO_2), (const float*)nullptr, 4096, 1024, 1024, MAP_ID, 0);
#undef WJOB
                if (layer == 0) { const float* x_in = PTR(0); const int* positions = (const int*)PTR(1);
                    for (int m = gw; m < MTOK; m += NGW) {
                        const GAS f32x4* xr = (const GAS f32x4*)(x_in + (size_t)m * DM) + lane; f32x4 v[4]; float s = 0.f;
#pragma unroll
                        for (int j = 0; j < 4; ++j) { v[j] = xr[64 * j]; s += (v[j].x * v[j].x + v[j].y * v[j].y) + (v[j].z * v[j].z + v[j].w * v[j].w); }
                        s = wave_sum(s);
                        GAS unsigned long long* o8 = (GAS unsigned long long*)(XB + (size_t)m * DM) + lane;
#pragma unroll
                        for (int j = 0; j < 4; ++j) o8[64 * j] = (unsigned long long)pk2(v[j].x, v[j].y) | ((unsigned long long)pk2(v[j].z, v[j].w) << 32);
                        if (lane < 4) ssp[(size_t)lane * MTOK + m] = (lane == 0) ? s : 0.f;
                    }
                    for (int idx = bid * 512 + tid; idx < MTOK * 32; idx += GG * 512) { const int tok = idx >> 5, i = idx & 31;
                        const float inv = powf(10000.0f, -(float)i / 32.0f); const float ang = (float)positions[tok] * inv; const float sn = sinf(ang), cs = cosf(ang);
                        rope[(size_t)idx * 2] = cs; rope[(size_t)idx * 2 + 1] = sn; }
                }
            }
            SEAM(gp0 + 0);
            if (EN(1) && IN(gp0 + 1)) { ENV();
                pg8::Gemm g{XB, (const bf16*)(wsw + WE_IN), MTOK, N_E_IN, DM, DM}; pg8::StaticOrder S; S.init(MTOK, N_E_IN, GG, bid);
                pg8::EpiEvenIn E{EP, ssp, misc32, PTR(5) + li * 128, PTR(6) + li * 128, PTR(7) + li * 128, PTR(8) + li * 128, PTR(4) + li * 4, stat};
                pg8::gemm_phase<pg8::EpiEvenIn, pg8::StaticOrder, true, true>(L_, g, S, E, tid);
            }
            SEAM(gp0 + 1);
            if (EN(2) && IN(gp0 + 2)) { ENV();
                gu32* qh = ctl + CW_QUEUE + 64 * (layer * 4 + 0);
                for (;;) {
                    if (tid == 0) MISCp[4] = __hip_atomic_fetch_add(qh, 1u, RLX_AGENT);
                    __syncthreads();
                    const int u = (int)MISCp[4];
                    if (u >= 32 + 4096) break;
                    if (u < 32) tk::cumsum_unit(misc32, cumb, u >> 2, u & 3, glds, tid);
                    else { const int v = u - 32; tk::topk_unit(EP, misc32, BM, v & 7, 511 - (v >> 3), glds, glds + LDS_STAT, glds + LDS_CAND, tid); }
                }
            }
            SEAM(gp0 + 2);
            if (IN(gp0 + 3)) { ENV();
                gu32* qh = ctl + CW_QUEUE + 64 * (layer * 4 + 1);
                for (;;) {
                    if (tid == 0) MISCp[4] = __hip_atomic_fetch_add(qh, 1u, RLX_AGENT);
                    __syncthreads();
                    const int u = (int)MISCp[4];
                    if (u >= 1024) break;
                    const int i = u >> 1; att::UnitArgs a;
                    if ((u & 1) == 0) { if (EN(3)) {
                        const int qb = 15 - (i >> 5), bh = i & 31, b = bh >> 2, h = bh & 3; const size_t r0 = (size_t)b * SEQ + qb * 256 + 32 * wave;
                        a.Q = EP + r0 * N_E_IN + 1536 + 128 * h; a.ldq = N_E_IN; a.K = EP + (size_t)b * SEQ * N_E_IN + 2048 + 128 * h; a.ldk = N_E_IN; a.V = EP + (size_t)b * SEQ * N_E_IN + 2560 + 128 * h; a.ldv = N_E_IN;
                        a.O = AOE + r0 * DM + 512 + 128 * h; a.ldo = DM; a.qlo = qb * 256 + 32 * wave; a.NT = 4 * (qb + 1); a.kbias = cumb + (size_t)h * MTOK + (size_t)b * SEQ; a.bm = nullptr; a.tid = tid;
                        att::attn_unit<128, 1>(a, glds); }
                    } else if (EN(4)) {
                        const int j = 63 - (i >> 3), b = i & 7, head = wave >> 1, sub = wave & 1; const size_t r0 = (size_t)b * SEQ + j * 64 + 32 * sub;
                        a.Q = EP + r0 * N_E_IN + 128 * head; a.ldq = N_E_IN; a.K = EP + (size_t)b * SEQ * N_E_IN + 512; a.ldk = N_E_IN; a.V = EP + (size_t)b * SEQ * N_E_IN + 640; a.ldv = N_E_IN;
                        a.O = AOE + r0 * DM + 128 * head; a.ldo = DM; a.qlo = j * 64 + 32 * sub; a.NT = j + 1; a.kbias = nullptr; a.bm = BM + r0 * 64; a.tid = tid;
                        att::attn_unit<128, 2>(a, glds);
                    }
                }
            }
            SEAM(gp0 + 3);
            if (EN(5) && IN(gp0 + 4)) { ENV();
                pg8::Gemm g{AOE, (const bf16*)(wsw + WE_OUT), MTOK, DM, DM, DM}; pg8::StaticOrder S; S.init(MTOK, DM, GG, bid);
                pg8::EpiResid E{layer == 0 ? PTR(0) : (const float*)out, out, XB, ssp, stat};
                pg8::gemm_phase<pg8::EpiResid, pg8::StaticOrder, true, true>(L_, g, S, E, tid);
            }
            SEAM(gp0 + 4);
        } else {
            if (EN(6) && IN(gp0 + 0)) { ENV();
                pg8::Gemm g{XB, (const bf16*)(wsw + WO_IN), MTOK, N_O_IN, DM, DM}; pg8::StaticOrder S; S.init(MTOK, N_O_IN, GG, bid);
                pg8::EpiOddIn E{C1, AO, XBC, ssp, gss, misc32, PTR(20) + li * 16, stat};
                pg8::gemm_phase<pg8::EpiOddIn, pg8::StaticOrder, true, true>(L_, g, S, E, tid);
            }
            SEAM(gp0 + 0);
            if (EN(7) && IN(gp0 + 1)) { ENV();
                if (EN(12)) { pg8::Gemm g{C1, (const bf16*)(wsw + WO_UQ), MTOK, 1024, 384, 768}; pg8::StaticOrder S; S.init(MTOK, 1024, GG, bid);
                  pg8::EpiUq E{QB, gss, PTR(16) + li * 192, rope, stat};
                  pg8::gemm_phase<pg8::EpiUq, pg8::StaticOrder, true, true>(L_, g, S, E, tid); }
                if (EN(13)) { pg8::Gemm g{C1 + 384, (const bf16*)(wsw + WO_UKV), MTOK, 1024, 256, 768}; pg8::StaticOrder S; S.init(MTOK, 1024, GG, bid);
                  pg8::EpiUkv E{KK, VV, C1, gss, PTR(17) + li * 192, rope, stat};
                  pg8::gemm_phase<pg8::EpiUkv, pg8::StaticOrder, true, true>(L_, g, S, E, tid); }
            }
            SEAM(gp0 + 1);
            if (IN(gp0 + 2)) { ENV();
                gu32* qh = ctl + CW_QUEUE + 64 * (layer * 4 + 0);
                for (;;) {
                    if (tid == 0) MISCp[4] = __hip_atomic_fetch_add(qh, 1u, RLX_AGENT);
                    __syncthreads();
                    const int u = (int)MISCp[4];
                    if (u >= 128 + 512) break;
                    if (u < 128) { if (EN(8)) { const int b = u >> 4, h = u & 15;
                        ssd::ssd_unit(XBC, AO, misc32, ssy, PTR(18) + (size_t)li * 4 * 2048, PTR(19) + li * 2048, PTR(21)[li * 16 + h], PTR(22)[li * 16 + h], b, h, glds, glds + LDS_STAT, tid); }
                    } else if (EN(9)) { const int i = u - 128; const int qb = 15 - (i >> 5), bh = i & 31, b = bh >> 2, h = bh & 3; const size_t r0 = (size_t)b * SEQ + qb * 256 + 32 * wave; att::UnitArgs a;
                        a.Q = QB + r0 * 768 + 192 * h; a.ldq = 768; a.K = KK + (size_t)b * SEQ * 768 + 192 * h; a.ldk = 768; a.V = VV + (size_t)b * SEQ * 512 + 128 * h; a.ldv = 512;
                        a.O = AO + r0 * K_O_OUT + 128 * h; a.ldo = K_O_OUT; a.qlo = qb * 256 + 32 * wave; a.NT = 4 * (qb + 1); a.kbias = nullptr; a.bm = nullptr; a.tid = tid;
                        att::attn_unit<192, 0>(a, glds);
                    }
                }
            }
            SEAM(gp0 + 2);
            if (EN(10) && IN(gp0 + 3)) { ENV();
                for (int idx = bid * 512 + tid; idx < MTOK * 128; idx += GG * 512) { const int tok = idx >> 7, ch = idx & 127, gq = ch >> 5;
                    const f32x4 s0 = *(const f32x4*)(ssy + (size_t)tok * 32 + gq * 8), s1 = *(const f32x4*)(ssy + (size_t)tok * 32 + gq * 8 + 4);
                    const float r = rsqrtf((((s0[0] + s0[1]) + (s0[2] + s0[3])) + ((s1[0] + s1[1]) + (s1[2] + s1[3]))) * (1.0f / 256.0f) + EPS);
                    v4u* p = (v4u*)(AO + (size_t)tok * K_O_OUT + 512 + ch * 8); const v4u raw = *p; v4u o;
#pragma unroll
                    for (int e = 0; e < 4; ++e) o[e] = pg8::cvt_pk_bf16(__uint_as_float(raw[e] << 16) * r, __uint_as_float(raw[e] & 0xffff0000u) * r);
                    *p = o; }
            }
            SEAM(gp0 + 3);
            if (EN(5) && IN(gp0 + 4)) { ENV();
                pg8::Gemm g{AO, (const bf16*)(wsw + WO_OUT), MTOK, DM, K_O_OUT, K_O_OUT}; pg8::StaticOrder S; S.init(MTOK, DM, GG, bid);
                pg8::EpiResid E{(const float*)out, out, XB, ssp, stat};
                pg8::gemm_phase<pg8::EpiResid, pg8::StaticOrder, true, true>(L_, g, S, E, tid);
            }
            SEAM(gp0 + 4);
        }
        if (EN(11) && IN(gp0 + 5)) { ENV();
            pg8::Gemm g{XB, W1t, MTOK, DFF, DM, DM}; pg8::StaticOrder S; S.init(MTOK, DFF, GG, bid);
            pg8::EpiMlpUp E{HB, ssp};
            pg8::gemm_phase<pg8::EpiMlpUp, pg8::StaticOrder, true, true>(L_, g, S, E, tid);
        }
        SEAM(gp0 + 5);
        if (EN(5) && IN(gp0 + 6)) { ENV();
            pg8::Gemm g{HB, W2t, MTOK, DM, DFF, DFF}; pg8::StaticOrder S; S.init(MTOK, DM, GG, bid);
            pg8::EpiResid E{(const float*)out, out, XB, ssp, stat};
            pg8::gemm_phase<pg8::EpiResid, pg8::StaticOrder, true, true>(L_, g, S, E, tid);
        }
        if (layer < 3) SEAM(gp0 + 6);
    }
#if defined(DBG_STOP)
    { ENV_NOLAYER();
      xcd_barrier(bar, otid(wave_s));
      const size_t n = (size_t)MTOK * DM;
      for (size_t i = (size_t)bid * 512 + tid; i < n; i += (size_t)GG * 512) {
          float v;
#if DBG_KIND == 0
          v = __uint_as_float(((unsigned)((const bf16*)(ws + (size_t)DBG_OFF))[i]) << 16);
#elif DBG_KIND == 1
          v = ((const float*)(ws + (size_t)DBG_OFF))[i];
#elif DBG_KIND == 2
          v = out[i];
#else
          v = (float)(((const unsigned*)(ws + (size_t)DBG_OFF))[i] & 0xffffu);
#endif
          if (!(fabsf(v) < 1e30f)) v = 30000.0f;
          out[i] = v; } }
#endif
#undef IN
#undef SEAM
#undef PTR
#undef ENV
}

#ifndef MK_SPLIT
#define MK_SPLIT 0
#endif
extern "C" void kernel_launch(void* const* d_in, const int* in_sizes, int n_in, void* d_out, int out_size, void* d_ws, size_t ws_size, hipStream_t stream) {
    static int grid = 0;
    if (grid == 0) {
        if (n_in != 28 || out_size != MTOK * DM || ws_size < WS_END) { fprintf(stderr, "kernel_launch: unexpected problem shape (n_in %d, out %d, ws %zu)\n", n_in, out_size, ws_size); grid = -1; return; }
        int dev = 0, cus = 0, per_cu = 0;
        if (hipGetDevice(&dev) != hipSuccess || hipDeviceGetAttribute(&cus, hipDeviceAttributeMultiprocessorCount, dev) != hipSuccess) { grid = -1; return; }
        if (hipFuncSetAttribute((const void*)trunk_fwd, hipFuncAttributeMaxDynamicSharedMemorySize, LDS_BYTES) != hipSuccess) { fprintf(stderr, "kernel_launch: hipFuncSetAttribute failed\n"); grid = -1; return; }
        if (hipOccupancyMaxActiveBlocksPerMultiprocessor(&per_cu, (const void*)trunk_fwd, NWAVES * 64, LDS_BYTES) != hipSuccess || per_cu < 1) { fprintf(stderr, "kernel_launch: occupancy query says %d\n", per_cu); }
        (void)hipGetLastError();
        grid = cus;
    }
    if (grid < 0) return;
    (void)hipMemsetAsync((char*)d_ws + WS_CTL, 0, CTL_ZERO_BYTES, stream);
    Args a{};
    for (int i = 0; i < 28; ++i) a.in[i] = (const float*)d_in[i];
    a.out = (float*)d_out; a.ws = (unsigned char*)d_ws;
#if MK_SPLIT
    for (int p = 0; p < 28; ++p) { a.ph_lo = p; a.ph_hi = p + 1; hipLaunchKernelGGL(trunk_fwd, dim3(grid), dim3(NWAVES * 64), LDS_BYTES, stream, a); }
#else
#if defined(DBG_STOP)
    a.ph_lo = 0; a.ph_hi = DBG_STOP;
#else
    a.ph_lo = 0; a.ph_hi = 28;
#endif
    hipLaunchKernelGGL(trunk_fwd, dim3(grid), dim3(NWAVES * 64), LDS_BYTES, stream, a);
#endif
}
```

```cpp
#include <hip/hip_runtime.h>
#include <hip/hip_bf16.h>
#include <cstdio>
#include <cstdint>
#include <cmath>

constexpr int BATCH = 8, SEQ = 4096, DM = 1024, MTOK = BATCH * SEQ, DFF = 4096;
constexpr int N_E_IN = 3072, N_O_IN = 3840;
constexpr int K_O_OUT = 1536;
constexpr float EPS = 1e-6f;
constexpr float LOG2E = 1.4426950408889634f;
constexpr float QSCALE128 = 0.08838834764831845f * LOG2E;
constexpr float QSCALE192 = 0.07216878364870323f * LOG2E;

constexpr size_t MiB = 1u << 20;
constexpr size_t WS_CTL = 0, CTL_ZERO_BYTES = 1 * MiB;
constexpr size_t WS_SSP = 1 * MiB;
constexpr size_t WS_CUMB = WS_SSP + 512 * 1024;
constexpr size_t WS_MISC32 = 2 * MiB;
constexpr size_t WS_GSS = 4 * MiB;
constexpr size_t WS_SSY = 5 * MiB;
constexpr size_t WS_ROPE = 9 * MiB;
constexpr size_t WS_BM = 17 * MiB;
constexpr size_t WS_W = 33 * MiB;
constexpr size_t WS_XB = 85 * MiB;
constexpr size_t WS_R = 149 * MiB;
constexpr size_t WS_END = 501 * MiB;
constexpr size_t WE_IN = 0, WE_OUT = 6 * MiB, WE_1 = 8 * MiB, WE_2 = 16 * MiB;
constexpr size_t WO_IN = 24 * MiB, WO_UQ = 24 * MiB + 7680 * 1024, WO_UKV = WO_UQ + 768 * 1024, WO_OUT = WO_UKV + 512 * 1024, WO_1 = 36 * MiB, WO_2 = 44 * MiB;
static_assert(WO_OUT + 3 * MiB <= WO_1, "weights map");
constexpr size_t R_EP = 0, R_AOE = 192 * MiB;
constexpr size_t R_C1 = 0, R_AO = 48 * MiB, R_XBC = 144 * MiB, R_KK = 272 * MiB, R_VV = 320 * MiB;
constexpr size_t R_H = 0;
constexpr int CW_TMO = 0;
constexpr int CW_BAR = 4096;
constexpr int CW_QUEUE = 16384;

constexpr int RING_BYTES = 131072;
constexpr int LDS_STAT = 139264;
constexpr int LDS_CAND = 147456;
constexpr int LDS_FAC = 149504;
constexpr int LDS_MISC = 155136;
constexpr int LDS_BYTES = 155648;


__device__ __forceinline__ int olane() { int l; asm volatile("v_mbcnt_lo_u32_b32 %0, -1, 0\n\tv_mbcnt_hi_u32_b32 %0, -1, %0" : "=v"(l)); return l; }
__device__ __forceinline__ int otid(int wave_s) { return (wave_s << 6) | olane(); }
template <int M> __device__ __forceinline__ float xor_f(float v) {
    if constexpr (M == 32) { auto rr = __builtin_amdgcn_permlane32_swap(__float_as_uint(v), __float_as_uint(v), false, false); return __uint_as_float(rr[0] == __float_as_uint(v) ? rr[1] : rr[0]); }
    else return __int_as_float(__builtin_amdgcn_ds_swizzle(__float_as_int(v), (M << 10) | 0x1f));
}
__device__ __forceinline__ float up_f(float v, int o) { const int l = olane(); const int s = (l - o) < 0 ? l : (l - o); return __int_as_float(__builtin_amdgcn_ds_bpermute(s << 2, __float_as_int(v))); }
__device__ __forceinline__ int down_i(int v, int o) { const int l = olane(); const int s = (l + o) > 63 ? l : (l + o); return __builtin_amdgcn_ds_bpermute(s << 2, v); }
__device__ __forceinline__ float wsum_f(float v) { v += xor_f<1>(v); v += xor_f<2>(v); v += xor_f<4>(v); v += xor_f<8>(v); v += xor_f<16>(v); v += xor_f<32>(v); return v; }
__device__ __forceinline__ float wmin_f(float v) { v = fminf(v, xor_f<1>(v)); v = fminf(v, xor_f<2>(v)); v = fminf(v, xor_f<4>(v)); v = fminf(v, xor_f<8>(v)); v = fminf(v, xor_f<16>(v)); v = fminf(v, xor_f<32>(v)); return v; }
__device__ __forceinline__ float wmax_f(float v) { v = fmaxf(v, xor_f<1>(v)); v = fmaxf(v, xor_f<2>(v)); v = fmaxf(v, xor_f<4>(v)); v = fmaxf(v, xor_f<8>(v)); v = fmaxf(v, xor_f<16>(v)); v = fmaxf(v, xor_f<32>(v)); return v; }
namespace pg8 {
#define PG8_LAS __attribute__((address_space(3)))
typedef unsigned short bf16_t;
typedef short bf16x8 __attribute__((ext_vector_type(8)));
typedef float f32x4 __attribute__((ext_vector_type(4)));
typedef unsigned u32x4 __attribute__((ext_vector_type(4)));
constexpr int BM = 256, BK = 64, HALF = 128, HTB = HALF * BK * 2  , STAGE_BYTES = 8 * HTB, NXCD = 8, WGM = 8;

__host__ __device__ __forceinline__ int lds_byte(int r, int c) { const int st = (r >> 4) * 2 + (c >> 5), rr = r & 15, cc = c & 31, ob = rr * 64 + cc * 2; return st * 1024 + (ob ^ (((ob >> 9) & 1) << 5)); }
__host__ __device__ __forceinline__ void stage_rc(int b, int& R, int& C) { const int st = b / 1024, sb = b % 1024, swz = sb ^ (((sb >> 9) & 1) << 5); R = (st >> 1) * 16 + swz / 64; C = (st & 1) * 32 + (swz % 64) / 2; }
__host__ __device__ __forceinline__ int perm32(int rho) { const int n = rho >> 4, i = rho & 15; return 8 * (i >> 2) + 4 * n + (i & 3); }

struct Unit { int pm, pn; };
struct Gemm { const bf16_t* A; const bf16_t* Bt; int M, N, K, lda; };

struct StaticOrder {
    int nM, nN, nwg, G, c;
    __host__ __device__ void init(int M, int N, int G_, int c_) { nM = M / BM; nN = N / BM; nwg = nM * nN; G = G_; c = c_; }
    __host__ __device__ bool next(int i, Unit& u) const {
        const long L = (long)i * G + c; if (L >= nwg) return false;
        int wgid = (int)L; { const int q = nwg / NXCD, r = nwg % NXCD, xcd = wgid % NXCD, off = wgid / NXCD; wgid = (xcd < r ? xcd * (q + 1) : r * (q + 1) + (xcd - r) * q) + off; }
        const int nig = WGM * nN, gid = wgid / nig, fm = gid * WGM, gsz = (nM - fm) < WGM ? (nM - fm) : WGM;
        u.pm = fm + ((wgid % nig) % gsz); u.pn = (wgid % nig) / gsz; return true;
    }
    __device__ __forceinline__ void a_ready(const Unit&) const {}
    __device__ __forceinline__ void done(const Unit&) const {}
};


__device__ __forceinline__ unsigned cvt_pk_bf16(float lo, float hi) { unsigned r; asm volatile("v_cvt_pk_bf16_f32 %0, %1, %2" : "=v"(r) : "v"(lo), "v"(hi)); return r; }
typedef unsigned u32x2 __attribute__((ext_vector_type(2)));
#define EPI_BAR() do { asm volatile("s_waitcnt lgkmcnt(0)" ::: "memory"); __builtin_amdgcn_s_barrier(); asm volatile("" ::: "memory"); } while (0)
__device__ __forceinline__ float sq4(const f32x4 x) { return (x[0] * x[0] + x[1] * x[1]) + (x[2] * x[2] + x[3] * x[3]); }
__device__ __forceinline__ float red_fq(float q) { q += xor_f<16>(q); q += xor_f<32>(q); return q; }
__device__ __forceinline__ u32x4 pack8(const f32x4 a, const f32x4 b) { u32x4 w; w.x = cvt_pk_bf16(a[0], a[1]); w.y = cvt_pk_bf16(a[2], a[3]); w.z = cvt_pk_bf16(b[0], b[1]); w.w = cvt_pk_bf16(b[2], b[3]); return w; }
__device__ __forceinline__ float row_rs(const float* ssp, int row) { const float ss = (ssp[row] + ssp[MTOK + row]) + (ssp[2 * MTOK + row] + ssp[3 * MTOK + row]); return rsqrtf(ss * (1.0f / 1024.0f) + EPS); }
__device__ __forceinline__ float log_sigmoidf(float x) { return fminf(x, 0.f) - __logf(1.0f + __expf(-fabsf(x))); }
__device__ __forceinline__ float softplusf(float x) { return fmaxf(x, 0.f) + __logf(1.0f + __expf(-fabsf(x))); }

struct EpiEvenIn {
    static constexpr bool PERM = true, AFTER_DRAIN = false;
    bf16_t* EP; const float* ssp; float* misc32; const float* qn_a; const float* kn_a; const float* qn_b; const float* kn_b; const float* b_f; PG8_LAS float* st;
    __device__ __forceinline__ void operator()(f32x4 (&acc)[2][2][4][2], const Unit& u, int wr, int wc, int fr, int fq) const {
        const int tid_ = ((wr * 4 + wc) << 6) | (fq << 4) | fr;
        const int pn = u.pn;
        const float* g0 = nullptr; const float* g1 = nullptr; float s0 = 1.f, s1 = 1.f;
        if (pn <= 1) { g0 = qn_a; g1 = qn_a; s0 = QSCALE128; s1 = QSCALE128; }
        else if (pn == 2) { g0 = kn_a; }
        else if (pn == 6 || pn == 7) { g0 = qn_b; g1 = qn_b; s0 = QSCALE128; s1 = QSCALE128; }
        else if (pn == 8 || pn == 9) { g0 = kn_b; g1 = kn_b; }
        int rl0 = wr * 64 + fr; asm volatile("" : "+v"(rl0)); const int row0 = u.pm * BM + rl0;
        { const int tid = tid_; if (tid < 256) { st[2048 + tid] = row_rs(ssp, u.pm * BM + tid);
            const float* g = (tid >> 7) ? g1 : g0; st[2304 + tid] = g ? g[tid & 127] * ((tid >> 7) ? s1 : s0) : 1.f; } }
        EPI_BAR();
#pragma unroll
        for (int ai = 0; ai < 2; ++ai)
#pragma unroll
            for (int m = 0; m < 4; ++m) { const int rl = ai * HALF + rl0 + m * 16; const float rs = st[2048 + rl];
#pragma unroll
                for (int bj = 0; bj < 2; ++bj) { acc[ai][bj][m][0] *= rs; acc[ai][bj][m][1] *= rs;
                    if (g0 != nullptr) { const float q = red_fq(sq4(acc[ai][bj][m][0]) + sq4(acc[ai][bj][m][1])); if (fq == 0) st[(rl * 2 + bj) * 4 + wc] = q; } } }
        if (g0 != nullptr) EPI_BAR();
#pragma unroll
        for (int ai = 0; ai < 2; ++ai)
#pragma unroll
            for (int m = 0; m < 4; ++m) { const int rl = ai * HALF + rl0 + m * 16; bf16_t* rowp = EP + (size_t)(u.pm * BM + rl) * N_E_IN + pn * BM + wc * 32 + fq * 8;
#pragma unroll
                for (int bj = 0; bj < 2; ++bj) { float f = 1.f;
                    if ((bj ? g1 : g0) != nullptr) { const f32x4 p = *(const PG8_LAS f32x4*)(st + (rl * 2 + bj) * 4); f = rsqrtf(((p[0] + p[1]) + (p[2] + p[3])) * (1.0f / 128.0f) + EPS); }
                    const PG8_LAS float* gp = st + 2304 + bj * HALF + wc * 32 + fq * 8;
                    const f32x4 v0 = acc[ai][bj][m][0] * *(const PG8_LAS f32x4*)gp * f, v1 = acc[ai][bj][m][1] * *(const PG8_LAS f32x4*)(gp + 4) * f;
                    *(u32x4*)(rowp + bj * HALF) = pack8(v0, v1); }
                asm volatile("" ::: "memory"); }
        if (pn == 5 && wc == 2 && fq < 2) {
#pragma unroll
            for (int ai = 0; ai < 2; ++ai)
#pragma unroll
                for (int m = 0; m < 4; ++m) { float* mp = misc32 + (size_t)(row0 + ai * HALF + m * 16) * 16;
                    if (fq == 0) { *(f32x4*)(mp) = acc[ai][0][m][0]; *(f32x4*)(mp + 4) = acc[ai][0][m][1]; }
                    else { const f32x4 v = acc[ai][0][m][0], bf = *(const f32x4*)b_f; f32x4 lf;
#pragma unroll
                        for (int j = 0; j < 4; ++j) lf[j] = log_sigmoidf(v[j] + bf[j]);
                        *(f32x4*)(mp + 8) = lf; } }
        }
    }
};

struct EpiResid {
    static constexpr bool PERM = true, AFTER_DRAIN = false;
    bf16_t* xb; float* ssp; PG8_LAS float* st; float* fout;
    __device__ __forceinline__ void operator()(f32x4 (&acc)[2][2][4][2], const Unit& u, int wr, int wc, int fr, int fq) const {
        const int tid_ = ((wr * 4 + wc) << 6) | (fq << 4) | fr;
        int rl0 = wr * 64 + fr; asm volatile("" : "+v"(rl0));
#pragma unroll
        for (int ai = 0; ai < 2; ++ai) {
            u32x4 raw[4][2];
#pragma unroll
            for (int m = 0; m < 4; ++m) { const size_t off = (size_t)(u.pm * BM + ai * HALF + rl0 + m * 16) * DM + u.pn * BM + wc * 32 + fq * 8;
                raw[m][0] = *(const u32x4*)(xb + off); raw[m][1] = *(const u32x4*)(xb + off + HALF); }
#pragma unroll
            for (int m = 0; m < 4; ++m) { const int rl = ai * HALF + rl0 + m * 16; const size_t off = (size_t)(u.pm * BM + rl) * DM + u.pn * BM + wc * 32 + fq * 8; float q = 0.f;
#pragma unroll
                for (int bj = 0; bj < 2; ++bj) { const u32x4 rw = raw[m][bj]; f32x4 v0, v1;
                    v0[0] = __uint_as_float(rw[0] << 16); v0[1] = __uint_as_float(rw[0] & 0xffff0000u); v0[2] = __uint_as_float(rw[1] << 16); v0[3] = __uint_as_float(rw[1] & 0xffff0000u);
                    v1[0] = __uint_as_float(rw[2] << 16); v1[1] = __uint_as_float(rw[2] & 0xffff0000u); v1[2] = __uint_as_float(rw[3] << 16); v1[3] = __uint_as_float(rw[3] & 0xffff0000u);
                    v0 += acc[ai][bj][m][0]; v1 += acc[ai][bj][m][1];
                    if (fout) { *(f32x4*)(fout + off + bj * HALF) = v0; *(f32x4*)(fout + off + bj * HALF + 4) = v1; }
                    else { *(u32x4*)(xb + off + bj * HALF) = pack8(v0, v1); q += sq4(v0) + sq4(v1); } }
                if (!fout) { q = red_fq(q); if (fq == 0) st[rl * 4 + wc] = q; } }
            asm volatile("" ::: "memory"); }
        if (fout) return;
        EPI_BAR();
        if (tid_ < 256) { const f32x4 p = *(const PG8_LAS f32x4*)(st + tid_ * 4); ssp[(size_t)u.pn * MTOK + u.pm * BM + tid_] = (p[0] + p[1]) + (p[2] + p[3]); }
    }
};

struct EpiMlpUp {
    static constexpr bool PERM = true, AFTER_DRAIN = false;
    bf16_t* H; const float* ssp;
    __device__ __forceinline__ void operator()(f32x4 (&acc)[2][2][4][2], const Unit& u, int wr, int wc, int fr, int fq) const {
        int row0 = u.pm * BM + wr * 64 + fr; asm volatile("" : "+v"(row0));
        float s4[2][4][4];
#pragma unroll
        for (int ai = 0; ai < 2; ++ai)
#pragma unroll
            for (int m = 0; m < 4; ++m) { const int row = row0 + ai * HALF + m * 16;
#pragma unroll
                for (int p = 0; p < 4; ++p) s4[ai][m][p] = ssp[(size_t)p * MTOK + row]; }
#pragma unroll
        for (int ai = 0; ai < 2; ++ai)
#pragma unroll
            for (int m = 0; m < 4; ++m) { const int row = row0 + ai * HALF + m * 16; const float rs = rsqrtf(((s4[ai][m][0] + s4[ai][m][1]) + (s4[ai][m][2] + s4[ai][m][3])) * (1.0f / 1024.0f) + EPS);
                bf16_t* rowp = H + (size_t)row * DFF + u.pn * BM + wc * 32 + fq * 8;
#pragma unroll
                for (int bj = 0; bj < 2; ++bj) { f32x4 v0 = acc[ai][bj][m][0] * rs, v1 = acc[ai][bj][m][1] * rs;
#pragma unroll
                    for (int j = 0; j < 4; ++j) { const float a = fmaxf(v0[j], 0.f), b = fmaxf(v1[j], 0.f); v0[j] = a * a; v1[j] = b * b; }
                    *(u32x4*)(rowp + bj * HALF) = pack8(v0, v1); } }
    }
};

struct EpiOddIn {
    static constexpr bool PERM = true, AFTER_DRAIN = false;
    bf16_t* C1; bf16_t* AO; bf16_t* XBC; const float* ssp; float* gss; float* dt32; const float* dt_bias; PG8_LAS float* st;
    __device__ __forceinline__ void operator()(f32x4 (&acc)[2][2][4][2], const Unit& u, int wr, int wc, int fr, int fq) const {
        const int tid_ = ((wr * 4 + wc) << 6) | (fq << 4) | fr;
        const int pn = u.pn; int rl0 = wr * 64 + fr; asm volatile("" : "+v"(rl0)); const int row0 = u.pm * BM + rl0;
        bf16_t* dst; int ld;
        if (pn < 3) { dst = C1 + pn * BM; ld = 768; } else if (pn < 7) { dst = AO + 512 + (pn - 3) * BM; ld = K_O_OUT; } else { dst = XBC + (pn - 7) * BM; ld = 2048; }
        { const int tid = tid_; if (tid < 256) st[2048 + tid] = row_rs(ssp, u.pm * BM + tid); }
        EPI_BAR();
#pragma unroll
        for (int ai = 0; ai < 2; ++ai)
#pragma unroll
            for (int m = 0; m < 4; ++m) { const int rl = ai * HALF + rl0 + m * 16; const float rs = st[2048 + rl]; bf16_t* rowp = dst + (size_t)(u.pm * BM + rl) * ld + wc * 32 + fq * 8;
#pragma unroll
                for (int bj = 0; bj < 2; ++bj) { acc[ai][bj][m][0] *= rs; acc[ai][bj][m][1] *= rs; *(u32x4*)(rowp + bj * HALF) = pack8(acc[ai][bj][m][0], acc[ai][bj][m][1]); }
                asm volatile("" ::: "memory"); }
        if (pn < 3) {
#pragma unroll
            for (int ai = 0; ai < 2; ++ai)
#pragma unroll
                for (int m = 0; m < 4; ++m)
#pragma unroll
                    for (int bj = 0; bj < 2; ++bj) { float q = sq4(acc[ai][bj][m][0]) + sq4(acc[ai][bj][m][1]);
                        if (pn == 2 && bj == 1 && wc >= 2) q = 0.f;
                        q = red_fq(q); if (fq == 0) st[((ai * HALF + rl0 + m * 16) * 2 + bj) * 4 + wc] = q; }
            EPI_BAR();
            const int tid = tid_;
            if (tid < 256) {
#pragma unroll
                for (int bj = 0; bj < 2; ++bj) { const f32x4 p = *(const PG8_LAS f32x4*)(st + (tid * 2 + bj) * 4); gss[(size_t)(u.pm * BM + tid) * 8 + 2 * pn + bj] = (p[0] + p[1]) + (p[2] + p[3]); } }
            if (pn == 2 && wc == 2 && fq < 2) {
                const f32x4 b0 = *(const f32x4*)(dt_bias + fq * 8), b1 = *(const f32x4*)(dt_bias + fq * 8 + 4);
#pragma unroll
                for (int ai = 0; ai < 2; ++ai)
#pragma unroll
                    for (int m = 0; m < 4; ++m) { float* mp = dt32 + (size_t)(row0 + ai * HALF + m * 16) * 16 + fq * 8; f32x4 d0, d1;
#pragma unroll
                        for (int j = 0; j < 4; ++j) { d0[j] = softplusf(acc[ai][1][m][0][j] + b0[j]); d1[j] = softplusf(acc[ai][1][m][1][j] + b1[j]); }
                        *(f32x4*)mp = d0; *(f32x4*)(mp + 4) = d1; }
            }
        }
    }
};

struct EpiUq {
    static constexpr bool PERM = true, AFTER_DRAIN = false;
    bf16_t* Q; const float* gss; const float* qn_c; const float* rope; PG8_LAS float* st;
    __device__ __forceinline__ void operator()(f32x4 (&acc)[2][2][4][2], const Unit& u, int wr, int wc, int fr, int fq) const {
        const int tid_ = ((wr * 4 + wc) << 6) | (fq << 4) | fr;
        const int h = u.pn; int rl0 = wr * 64 + fr; asm volatile("" : "+v"(rl0));
        { const int tid = tid_; if (tid < 256) { const float* gp = gss + (size_t)(u.pm * BM + tid) * 8; st[2048 + tid] = rsqrtf(((gp[0] + gp[1]) + gp[2]) * (1.0f / 384.0f) + EPS);
            float gg = 0.f; if (tid < 128) gg = qn_c[tid]; else if (tid < 192) { const int jj = tid - 128; gg = qn_c[128 + ((jj & 1) ? 32 : 0) + (jj >> 1)]; }
            st[2304 + tid] = gg * QSCALE192; } }
        EPI_BAR();
#pragma unroll
        for (int ai = 0; ai < 2; ++ai)
#pragma unroll
            for (int m = 0; m < 4; ++m) { const int rl = ai * HALF + rl0 + m * 16; const float rc = st[2048 + rl]; float q = 0.f;
#pragma unroll
                for (int bj = 0; bj < 2; ++bj) { acc[ai][bj][m][0] *= rc; acc[ai][bj][m][1] *= rc; q += sq4(acc[ai][bj][m][0]) + sq4(acc[ai][bj][m][1]); }
                q = red_fq(q); if (fq == 0) st[rl * 4 + wc] = q; }
        EPI_BAR();
        const int i0 = (wc & 1) * 16 + fq * 4;
        f32x4 cs[2][4][2];
        if (wc < 2) {
#pragma unroll
            for (int ai = 0; ai < 2; ++ai)
#pragma unroll
                for (int m = 0; m < 4; ++m) { const float* rp = rope + ((size_t)(u.pm * BM + ai * HALF + rl0 + m * 16) * 32 + i0) * 2; cs[ai][m][0] = *(const f32x4*)rp; cs[ai][m][1] = *(const f32x4*)(rp + 4); }
        }
#pragma unroll
        for (int ai = 0; ai < 2; ++ai)
#pragma unroll
            for (int m = 0; m < 4; ++m) { const int rl = ai * HALF + rl0 + m * 16; const int row = u.pm * BM + rl;
                const f32x4 p = *(const PG8_LAS f32x4*)(st + rl * 4); const float f = rsqrtf(((p[0] + p[1]) + (p[2] + p[3])) * (1.0f / 192.0f) + EPS);
                bf16_t* rowp = Q + (size_t)row * 768 + h * 192; const PG8_LAS float* gp = st + 2304 + wc * 32 + fq * 8;
                *(u32x4*)(rowp + wc * 32 + fq * 8) = pack8(acc[ai][0][m][0] * *(const PG8_LAS f32x4*)gp * f, acc[ai][0][m][1] * *(const PG8_LAS f32x4*)(gp + 4) * f);
                if (wc < 2) { const f32x4 cs0 = cs[ai][m][0], cs1 = cs[ai][m][1];
                    const f32x4 a = acc[ai][1][m][0] * *(const PG8_LAS f32x4*)(gp + HALF) * f, b = acc[ai][1][m][1] * *(const PG8_LAS f32x4*)(gp + HALF + 4) * f;
                    f32x4 o0, o1;
                    o0[0] = a[0] * cs0[0] - a[1] * cs0[1]; o0[1] = a[1] * cs0[0] + a[0] * cs0[1]; o0[2] = a[2] * cs0[2] - a[3] * cs0[3]; o0[3] = a[3] * cs0[2] + a[2] * cs0[3];
                    o1[0] = b[0] * cs1[0] - b[1] * cs1[1]; o1[1] = b[1] * cs1[0] + b[0] * cs1[1]; o1[2] = b[2] * cs1[2] - b[3] * cs1[3]; o1[3] = b[3] * cs1[2] + b[2] * cs1[3];
                    *(u32x4*)(rowp + 128 + wc * 32 + fq * 8) = pack8(o0, o1); } }
    }
};

struct EpiUkv {
    static constexpr bool PERM = true, AFTER_DRAIN = false;
    bf16_t* KK; bf16_t* VV; const bf16_t* C1; const float* gss; const float* kn_c; const float* rope; PG8_LAS float* st;
    __device__ __forceinline__ void operator()(f32x4 (&acc)[2][2][4][2], const Unit& u, int wr, int wc, int fr, int fq) const {
        const int tid_ = ((wr * 4 + wc) << 6) | (fq << 4) | fr;
        const int h = u.pn; int rl0 = wr * 64 + fr; asm volatile("" : "+v"(rl0)); const int tid = tid_;
        if (tid < 256) { const float* gp = gss + (size_t)(u.pm * BM + tid) * 8; st[2048 + tid] = rsqrtf((gp[3] + gp[4]) * (1.0f / 256.0f) + EPS);
            float gg = 0.f; if (tid < 128) gg = kn_c[tid]; else if (tid < 192) { const int jj = tid - 128; gg = kn_c[128 + ((jj & 1) ? 32 : 0) + (jj >> 1)]; }
            st[2304 + tid] = gg; }
        EPI_BAR();
#pragma unroll
        for (int ai = 0; ai < 2; ++ai)
#pragma unroll
            for (int m = 0; m < 4; ++m) { const int rl = ai * HALF + rl0 + m * 16; const int row = u.pm * BM + rl; const float rc = st[2048 + rl];
#pragma unroll
                for (int bj = 0; bj < 2; ++bj) { acc[ai][bj][m][0] *= rc; acc[ai][bj][m][1] *= rc; }
                *(u32x4*)(VV + (size_t)row * 512 + h * 128 + wc * 32 + fq * 8) = pack8(acc[ai][1][m][0], acc[ai][1][m][1]);
                const float q = red_fq(sq4(acc[ai][0][m][0]) + sq4(acc[ai][0][m][1])); if (fq == 0) st[rl * 4 + wc] = q;
                asm volatile("" ::: "memory"); }
        EPI_BAR();
        if (tid < 256) { const f32x4 p = *(const PG8_LAS f32x4*)(st + tid * 4); const float ss = ((p[0] + p[1]) + (p[2] + p[3])) + gss[(size_t)(u.pm * BM + tid) * 8 + 5];
            st[2048 + tid] = rsqrtf(ss * (1.0f / 192.0f) + EPS); }
        EPI_BAR();
#pragma unroll
        for (int ai = 0; ai < 2; ++ai)
#pragma unroll
            for (int m = 0; m < 4; ++m) { const int rl = ai * HALF + rl0 + m * 16; const float f = st[2048 + rl]; const PG8_LAS float* gp = st + 2304 + wc * 32 + fq * 8;
                *(u32x4*)(KK + (size_t)(u.pm * BM + rl) * 768 + h * 192 + wc * 32 + fq * 8) = pack8(acc[ai][0][m][0] * *(const PG8_LAS f32x4*)gp * f, acc[ai][0][m][1] * *(const PG8_LAS f32x4*)(gp + 4) * f);
                asm volatile("" ::: "memory"); }
        { const int rl = tid >> 1, ib = (tid & 1) * 16; const int row = u.pm * BM + rl; const float f = st[2048 + rl];
          const bf16_t* src = C1 + (size_t)row * 768 + 640 + ib * 2; bf16_t* dstp = KK + (size_t)row * 768 + h * 192 + 128 + ib * 2; const float* rp = rope + ((size_t)row * 32 + ib) * 2;
          const PG8_LAS float* gq = st + 2304 + 128 + ib * 2;
#pragma unroll
          for (int c = 0; c < 4; ++c) { const u32x4 raw = *(const u32x4*)(src + c * 8); const f32x4 g0 = *(const PG8_LAS f32x4*)(gq + c * 8), g1 = *(const PG8_LAS f32x4*)(gq + c * 8 + 4);
              const f32x4 cA = *(const f32x4*)(rp + c * 8), cB = *(const f32x4*)(rp + c * 8 + 4);
              f32x4 xa, xb;
              xa[0] = __uint_as_float(raw[0] << 16) * g0[0] * f; xa[1] = __uint_as_float(raw[0] & 0xffff0000u) * g0[1] * f; xa[2] = __uint_as_float(raw[1] << 16) * g0[2] * f; xa[3] = __uint_as_float(raw[1] & 0xffff0000u) * g0[3] * f;
              xb[0] = __uint_as_float(raw[2] << 16) * g1[0] * f; xb[1] = __uint_as_float(raw[2] & 0xffff0000u) * g1[1] * f; xb[2] = __uint_as_float(raw[3] << 16) * g1[2] * f; xb[3] = __uint_as_float(raw[3] & 0xffff0000u) * g1[3] * f;
              f32x4 o0, o1;
              o0[0] = xa[0] * cA[0] - xa[1] * cA[1]; o0[1] = xa[1] * cA[0] + xa[0] * cA[1]; o0[2] = xa[2] * cA[2] - xa[3] * cA[3]; o0[3] = xa[3] * cA[2] + xa[2] * cA[3];
              o1[0] = xb[0] * cB[0] - xb[1] * cB[1]; o1[1] = xb[1] * cB[0] + xb[0] * cB[1]; o1[2] = xb[2] * cB[2] - xb[3] * cB[3]; o1[3] = xb[3] * cB[2] + xb[2] * cB[3];
              *(u32x4*)(dstp + c * 8) = pack8(o0, o1); } }
    }
};

struct GroupScaleHook {
    static constexpr bool ACTIVE = true;
    const float* ssy; PG8_LAS float* fac;
    __device__ __forceinline__ void step(int t, f32x4 (&acc)[2][2][4][2], const Unit& u, int wid, int wr) const {
        if (t == 0) {
            if (wid < 4) { const int tid = (wid << 6) | olane(); const float* sp = ssy + (size_t)(u.pm * BM + tid) * 32; float r[4];
#pragma unroll
                for (int gq = 0; gq < 4; ++gq) { const f32x4 s0 = *(const f32x4*)(sp + gq * 8), s1 = *(const f32x4*)(sp + gq * 8 + 4);
                    r[gq] = rsqrtf((((s0[0] + s0[1]) + (s0[2] + s0[3])) + ((s1[0] + s1[1]) + (s1[2] + s1[3]))) * (1.0f / 256.0f) + EPS); }
                PG8_LAS float* fp = fac + tid * 5; fp[0] = 1.0f / r[0]; fp[1] = r[0] / r[1]; fp[2] = r[1] / r[2]; fp[3] = r[2] / r[3]; fp[4] = r[3]; }
        } else if (t >= 8 && (t & 3) == 0) { scale(acc, (t - 8) >> 2, wr); }
    }
    __device__ __forceinline__ void finish(f32x4 (&acc)[2][2][4][2], const Unit&, int wr) const { scale(acc, 4, wr); }
    __device__ __forceinline__ void scale(f32x4 (&acc)[2][2][4][2], int k, int wr) const {
        const int rl0 = wr * 64 + (olane() & 15);
#pragma unroll
        for (int ai = 0; ai < 2; ++ai)
#pragma unroll
            for (int m = 0; m < 4; ++m) { const float f = fac[(ai * HALF + rl0 + m * 16) * 5 + k];
#pragma unroll
                for (int bj = 0; bj < 2; ++bj) { acc[ai][bj][m][0] *= f; acc[ai][bj][m][1] *= f; } }
    }
};
struct NoHook { static constexpr bool ACTIVE = false; };
template <class Epi, class Sched, bool ALIGN_EPI = false, bool SP2 = false, class KHook = NoHook>
__device__ __forceinline__ void gemm_phase(PG8_LAS unsigned char* lds, const Gemm g, const Sched& S, const Epi& E, const int tid_in, const KHook HK = KHook()) {
    int tid = tid_in; asm volatile("" : "+v"(tid)); const int wid = __builtin_amdgcn_readfirstlane(tid >> 6), lane = tid & 63, wr = wid >> 2, wc = wid & 3, fr = lane & 15, fq = lane >> 4;
    const int K = g.K, nt = K / BK;
    unsigned voffA[2], voffB[2];
#pragma unroll
    for (int i = 0; i < 2; ++i) { int R, C; stage_rc(tid * 16 + i * 8192, R, C); const int Rb = Epi::PERM ? ((R & ~31) + perm32(R & 31)) : R;
        voffA[i] = (unsigned)(R * g.lda + C) * 2u; voffB[i] = (unsigned)(Rb * K + C) * 2u; }
    const size_t kstep = (size_t)(BK * 2);
    const size_t hstepA = (size_t)HALF * g.lda * 2, hstepB = (size_t)HALF * K * 2;
    const size_t tstepA = 2 * hstepA, tstepB = 2 * hstepB;
    const unsigned ldsw = (unsigned)wid * 1024u;
    const int aoff = lds_byte(wr * 64 + fr, fq * 8), boff = lds_byte(wc * 32 + fr, fq * 8);
#define PG8_SA(b, h) (((b) * 2 + (h)) * HTB)
#define PG8_SB(b, h) ((4 + (b) * 2 + (h)) * HTB)
#define PG8_STAGE(bufoff, gbase, voff) do { _Pragma("unroll") for (int _i = 0; _i < 2; ++_i) \
        __builtin_amdgcn_global_load_lds((const unsigned*)((const char*)(gbase) + (voff)[_i]), (PG8_LAS unsigned*)(lds + (bufoff) + ldsw + _i * 8192), 16, 0, 0); } while (0)
#define PG8_LDA(dst, b, h) do { _Pragma("unroll") for (int m = 0; m < 4; ++m) _Pragma("unroll") for (int k = 0; k < 2; ++k) dst[m][k] = *(const PG8_LAS bf16x8*)(lds + PG8_SA(b, h) + aoff + m * 2048 + k * 1024); } while (0)
#define PG8_LDB(dst, b, h) do { _Pragma("unroll") for (int n = 0; n < 2; ++n) _Pragma("unroll") for (int k = 0; k < 2; ++k) dst[n][k] = *(const PG8_LAS bf16x8*)(lds + PG8_SB(b, h) + boff + n * 2048 + k * 1024); } while (0)
#define PG8_MMA(ai, bj, At, Bt) do { __builtin_amdgcn_s_setprio(1); _Pragma("unroll") for (int m = 0; m < 4; ++m) _Pragma("unroll") for (int n = 0; n < 2; ++n) _Pragma("unroll") for (int k = 0; k < 2; ++k) \
        acc[ai][bj][m][n] = __builtin_amdgcn_mfma_f32_16x16x32_bf16(Bt[n][k], At[m][k], acc[ai][bj][m][n], 0, 0, 0); __builtin_amdgcn_s_setprio(0); } while (0)
#define PG8_WAIT_V(n) asm volatile("s_waitcnt vmcnt(" #n ")" ::: "memory")
#define PG8_WAIT_L(n) asm volatile("s_waitcnt lgkmcnt(" #n ")" ::: "memory")
#define PG8_BAR __builtin_amdgcn_s_barrier()
#define PG8_SCHED __builtin_amdgcn_sched_barrier(0)
    Unit cur, nxt; int ui = 0;
    if (!S.next(0, cur)) return;
    f32x4 acc[2][2][4][2];
#pragma unroll
    for (int a = 0; a < 2; ++a)
#pragma unroll
        for (int b = 0; b < 2; ++b)
#pragma unroll
            for (int m = 0; m < 4; ++m)
#pragma unroll
                for (int n = 0; n < 2; ++n) acc[a][b][m][n] = (f32x4){0.f, 0.f, 0.f, 0.f};
    bf16x8 At[4][2], B0[2][2], B1[2][2];
    const char* cA = (const char*)g.A + (size_t)cur.pm * tstepA; const char* cB = (const char*)g.Bt + (size_t)cur.pn * tstepB;
    S.a_ready(cur);
    if constexpr (SP2) {
        PG8_STAGE(PG8_SB(0, 0), cB, voffB); PG8_STAGE(PG8_SB(0, 1), cB + hstepB, voffB); PG8_STAGE(PG8_SA(0, 0), cA, voffA); PG8_STAGE(PG8_SA(0, 1), cA + hstepA, voffA);
        if (wr == 1) PG8_BAR;
        PG8_WAIT_V(2); PG8_BAR;
        PG8_STAGE(PG8_SB(1, 0), cB + kstep, voffB); PG8_STAGE(PG8_SA(1, 0), cA + kstep, voffA); PG8_STAGE(PG8_SB(1, 1), cB + hstepB + kstep, voffB);
        PG8_WAIT_V(6); PG8_BAR;
    } else {
        PG8_STAGE(PG8_SB(0, 0), cB, voffB); PG8_STAGE(PG8_SA(0, 0), cA, voffA); PG8_STAGE(PG8_SB(0, 1), cB + hstepB, voffB); PG8_STAGE(PG8_SA(0, 1), cA + hstepA, voffA);
        if (wr == 1) PG8_BAR;
        PG8_WAIT_V(4); PG8_BAR;
        PG8_STAGE(PG8_SB(1, 0), cB + kstep, voffB); PG8_STAGE(PG8_SA(1, 0), cA + kstep, voffA); PG8_STAGE(PG8_SB(1, 1), cB + hstepB + kstep, voffB);
        PG8_WAIT_V(6); PG8_BAR;
    }
    for (;;) {
        const bool has_next = S.next(ui + 1, nxt);
        const char* nA = has_next ? (const char*)g.A + (size_t)nxt.pm * tstepA : cA; const char* nB = has_next ? (const char*)g.Bt + (size_t)nxt.pn * tstepB : cB;
        for (int t = 0; t < nt; t += 2) {
            if constexpr (KHook::ACTIVE) HK.step(t, acc, cur, wid, wr);
            const bool last = (t == nt - 2);
            const char* a1 = cA + (size_t)(t + 1) * kstep;
            const char* a2 = last ? nA : cA + (size_t)(t + 2) * kstep; const char* b2 = last ? nB : cB + (size_t)(t + 2) * kstep;
            const char* a3 = a2 + kstep; const char* b3 = b2 + kstep;
            if (last && has_next) S.a_ready(nxt);
            if constexpr (SP2) {
            PG8_LDB(B0, 0, 0); PG8_LDB(B1, 0, 1); PG8_SCHED; PG8_LDA(At, 0, 0); PG8_STAGE(PG8_SA(1, 1), a1 + hstepA, voffA);
            PG8_WAIT_V(8); PG8_WAIT_L(0); PG8_BAR; PG8_MMA(0, 0, At, B0); PG8_MMA(0, 1, At, B1); PG8_BAR; PG8_SCHED;
            PG8_LDA(At, 0, 1); PG8_STAGE(PG8_SB(0, 0), b2, voffB); PG8_STAGE(PG8_SB(0, 1), b2 + hstepB, voffB); PG8_STAGE(PG8_SA(0, 0), a2, voffA);
            PG8_WAIT_V(8); PG8_WAIT_L(0); PG8_BAR; PG8_MMA(1, 0, At, B0); PG8_MMA(1, 1, At, B1); PG8_BAR; PG8_SCHED;
            PG8_LDB(B0, 1, 0); PG8_LDB(B1, 1, 1); PG8_SCHED; PG8_LDA(At, 1, 0); PG8_STAGE(PG8_SA(0, 1), a2 + hstepA, voffA);
            PG8_WAIT_V(8); PG8_WAIT_L(0); PG8_BAR; PG8_MMA(0, 0, At, B0); PG8_MMA(0, 1, At, B1); PG8_BAR; PG8_SCHED;
            PG8_LDA(At, 1, 1); PG8_STAGE(PG8_SB(1, 0), b3, voffB); PG8_STAGE(PG8_SB(1, 1), b3 + hstepB, voffB); PG8_STAGE(PG8_SA(1, 0), a3, voffA);
            PG8_WAIT_V(8); PG8_WAIT_L(0); PG8_BAR; PG8_MMA(1, 0, At, B0); PG8_MMA(1, 1, At, B1); PG8_BAR; PG8_SCHED;
            } else {
            PG8_LDB(B0, 0, 0); PG8_SCHED; PG8_LDA(At, 0, 0); PG8_STAGE(PG8_SA(1, 1), a1 + hstepA, voffA);
            PG8_WAIT_L(8); PG8_BAR; PG8_WAIT_L(0); PG8_MMA(0, 0, At, B0); PG8_BAR; PG8_SCHED;
            PG8_LDB(B1, 0, 1); PG8_STAGE(PG8_SB(0, 0), b2, voffB);
            PG8_BAR; PG8_WAIT_L(0); PG8_MMA(0, 1, At, B1); PG8_BAR;
            PG8_LDA(At, 0, 1); PG8_STAGE(PG8_SA(0, 0), a2, voffA);
            PG8_BAR; PG8_WAIT_L(0); PG8_MMA(1, 0, At, B0); PG8_BAR; PG8_SCHED;
            PG8_STAGE(PG8_SB(0, 1), b2 + hstepB, voffB);
            PG8_WAIT_V(6); PG8_BAR; PG8_MMA(1, 1, At, B1); PG8_BAR;
            PG8_LDB(B0, 1, 0); PG8_SCHED; PG8_LDA(At, 1, 0); PG8_STAGE(PG8_SA(0, 1), a2 + hstepA, voffA);
            PG8_WAIT_L(8); PG8_BAR; PG8_WAIT_L(0); PG8_MMA(0, 0, At, B0); PG8_BAR; PG8_SCHED;
            PG8_LDB(B1, 1, 1); PG8_STAGE(PG8_SB(1, 0), b3, voffB);
            PG8_BAR; PG8_WAIT_L(0); PG8_MMA(0, 1, At, B1); PG8_BAR;
            PG8_LDA(At, 1, 1); PG8_STAGE(PG8_SA(1, 0), a3, voffA);
            PG8_BAR; PG8_WAIT_L(0); PG8_MMA(1, 0, At, B0); PG8_BAR; PG8_SCHED;
            PG8_STAGE(PG8_SB(1, 1), b3 + hstepB, voffB);
            PG8_WAIT_V(6); PG8_BAR; PG8_MMA(1, 1, At, B1); PG8_BAR;
            }
        }
        if constexpr (KHook::ACTIVE) HK.finish(acc, cur, wr);
        if constexpr (ALIGN_EPI) { if (wr == 0) PG8_BAR; }
        if constexpr (!Epi::AFTER_DRAIN) { int wr_ = wr, wc_ = wc; asm volatile("" : "+s"(wr_), "+s"(wc_)); const int l_ = olane(); const int fr_ = l_ & 15, fq_ = l_ >> 4; E(acc, cur, wr_, wc_, fr_, fq_); S.done(cur); }
        if (!has_next) break;
#pragma unroll
        for (int a = 0; a < 2; ++a)
#pragma unroll
            for (int b = 0; b < 2; ++b)
#pragma unroll
                for (int m = 0; m < 4; ++m)
#pragma unroll
                    for (int n = 0; n < 2; ++n) acc[a][b][m][n] = (f32x4){0.f, 0.f, 0.f, 0.f};
        cur = nxt; cA = nA; cB = nB; ++ui;
        if constexpr (ALIGN_EPI) { if (wr == 1) PG8_BAR; }
    }
    PG8_WAIT_V(0);
    if constexpr (!ALIGN_EPI) { if (wr == 0) PG8_BAR; }
    PG8_BAR;
    if constexpr (Epi::AFTER_DRAIN) { E.fused(acc, cur, wr, wc, fr, fq, lds, wid, lane); S.done(cur); }
#undef PG8_SA
#undef PG8_SB
#undef PG8_STAGE
#undef PG8_LDA
#undef PG8_LDB
#undef PG8_MMA
#undef PG8_WAIT_V
#undef PG8_WAIT_L
#undef PG8_BAR
#undef PG8_SCHED
}
}
#define GAS __attribute__((address_space(1)))
#define LAS __attribute__((address_space(3)))
typedef unsigned short bf16;
typedef unsigned v4u __attribute__((ext_vector_type(4)));
typedef float f32x4 __attribute__((ext_vector_type(4)));
typedef short bf16x8 __attribute__((ext_vector_type(8)));
typedef GAS unsigned gu32;
typedef GAS unsigned long long gu64;
#define RLX_AGENT __ATOMIC_RELAXED, __HIP_MEMORY_SCOPE_AGENT
#define LDS_WAIT() asm volatile("s_waitcnt lgkmcnt(0)" ::: "memory")
#define VM_WAIT() asm volatile("s_waitcnt vmcnt(0)" ::: "memory")
__device__ __forceinline__ unsigned long long rt() { return __builtin_amdgcn_s_memrealtime(); }
__device__ __forceinline__ unsigned f2bf(float f) { unsigned u = __builtin_bit_cast(unsigned, f); return (u + 0x7fffu + ((u >> 16) & 1u)) >> 16; }
__device__ __forceinline__ unsigned pk2(float lo, float hi) { return f2bf(lo) | (f2bf(hi) << 16); }

#define XB_TMO      128
#define XB_XCNT(j)  (256  + 64 * (j))
#define XB_XSUB(j)  (1280 + 64 * (j))
#define XB_XGEN(j)  (2304 + 64 * (j))
#define XB_TOP      3328
#define XB_TOPGEN   3392
#define XCD_BAR_WORDS 3456
#define XB_SPIN_CAP (1u << 18)

__device__ __forceinline__ unsigned xb_ld(unsigned* p)              { return __hip_atomic_load(p, __ATOMIC_RELAXED, __HIP_MEMORY_SCOPE_AGENT); }
__device__ __forceinline__ unsigned xb_add(unsigned* p, unsigned v) { return __hip_atomic_fetch_add(p, v, __ATOMIC_RELAXED, __HIP_MEMORY_SCOPE_AGENT); }
__device__ __forceinline__ unsigned xb_xcc_id() { return (unsigned)__builtin_amdgcn_s_getreg((3 << 11) | 20) & 0xFu; }
#define XB_SPIN(cond, bar) do { unsigned _sp = 0; while (cond) { __builtin_amdgcn_s_sleep(1); \
    if ((++_sp & 255u) == 0u) { if (xb_ld(&(bar)[XB_TMO])) break; if (_sp > XB_SPIN_CAP) { atomicAdd(&(bar)[XB_TMO], 1u); break; } } } } while (0)

struct XcdBarrier {
    unsigned* bar; unsigned x;
    volatile LAS unsigned* st;
};

__device__ __forceinline__ XcdBarrier xcd_barrier_post(unsigned* bar, volatile LAS unsigned* st, const int tid) {
    XcdBarrier b; b.bar = bar; b.x = xb_xcc_id(); b.st = st;
    if (tid == 0) (void)xb_add(&bar[XB_XCNT(b.x)], 1u);
    return b;
}
__device__ __forceinline__ void xcd_barrier_complete(unsigned* bar, unsigned x, unsigned& nloc, unsigned& nx) {
    const unsigned G = gridDim.x * gridDim.y * gridDim.z;
    unsigned sum, cnt, mine, sp = 0u;
    for (;;) {
        sum = 0u; cnt = 0u; mine = 0u;
#pragma unroll
        for (unsigned j = 0; j < 16; ++j) { const unsigned c = xb_ld(&bar[XB_XCNT(j)]); sum += c; cnt += (c > 0u) ? 1u : 0u; mine = (j == x) ? c : mine; }
        if (sum == G) break;
        __builtin_amdgcn_s_sleep(1);
        if ((++sp & 255u) == 0u) { if (xb_ld(&bar[XB_TMO])) break; if (sp > XB_SPIN_CAP) { atomicAdd(&bar[XB_TMO], 1u); break; } }
    }
    nloc = mine > 0u ? mine : 1u; nx = cnt > 0u ? cnt : 1u;
}

__device__ __forceinline__ void xcd_barrier(const XcdBarrier& b, const int tid) {
    asm volatile("s_waitcnt vmcnt(0)" ::: "memory");
    __syncthreads();
    if (tid == 0) {
        unsigned* bar = b.bar; asm volatile("" : "+s"(bar));
        __builtin_amdgcn_s_waitcnt(0);
        unsigned nloc = b.st[0], nx = b.st[1];
        if (nloc == 0u) { xcd_barrier_complete(bar, b.x, nloc, nx); b.st[0] = nloc; b.st[1] = nx; }
        const unsigned old = xb_add(&bar[XB_XSUB(b.x)], 1u);
        const unsigned gen = old / nloc;
        if (old + 1u == (gen + 1u) * nloc) {
            __builtin_amdgcn_fence(__ATOMIC_RELEASE, "agent");
            asm volatile("s_waitcnt vmcnt(0)" ::: "memory");
            const unsigned og = xb_add(&bar[XB_TOP], 1u);
            const unsigned tg = og / nx;
            if (og + 1u == (tg + 1u) * nx) xb_add(&bar[XB_TOPGEN], 1u);
            else XB_SPIN(xb_ld(&bar[XB_TOPGEN]) == tg, bar);
            __builtin_amdgcn_fence(__ATOMIC_ACQUIRE, "agent");
            xb_add(&bar[XB_XGEN(b.x)], 1u);
            asm volatile("s_waitcnt vmcnt(0)" ::: "memory");
        } else {
            XB_SPIN(xb_ld(&bar[XB_XGEN(b.x)]) == gen, bar);
            __builtin_amdgcn_fence(__ATOMIC_ACQUIRE, "agent");
            asm volatile("s_waitcnt vmcnt(0)" ::: "memory");
        }
    }
    __syncthreads();
}

namespace att {
typedef __hip_bfloat16 hbf16;
typedef short bf16x8 __attribute__((ext_vector_type(8)));
typedef short s16x4 __attribute__((ext_vector_type(4)));
typedef float f32x16 __attribute__((ext_vector_type(16)));
typedef float f32x4 __attribute__((ext_vector_type(4)));
typedef unsigned u32x4 __attribute__((ext_vector_type(4)));
typedef unsigned long long u64;
constexpr int QBLK = 32, KVBLK = 64;
constexpr int SHM_V = KVBLK * 128 * 2;
constexpr float THR2 = 11.0f;
#define ATT_SBAR() __builtin_amdgcn_sched_barrier(0)
__device__ __forceinline__ int v_st(int k, int c) { const int kk = (k & ~0xC) | ((k & 4) << 1) | ((k & 8) >> 1); return ((kk >> 3) * 4 + (c >> 5)) * 512 + ((kk & 7) * 32 + (c & 31)) * 2; }
__device__ __forceinline__ int v_rd_base(int lane) { return ((lane & 3) << 3) | (((lane >> 2) & 3) << 6) | (((lane >> 4) & 1) << 5) | (((lane >> 5) & 1) << 8); }
constexpr int v_rd_off(int d0, int ks, int half) { return d0 * 512 + ks * 4096 + half * 2048; }
__device__ __forceinline__ int crow(int r, int hi) { return (r & 3) + 8 * (r >> 2) + 4 * hi; }
__device__ __forceinline__ unsigned cvtpk(float lo, float hi) { unsigned r; asm volatile("v_cvt_pk_bf16_f32 %0, %1, %2" : "=v"(r) : "v"(lo), "v"(hi)); return r; }

struct UnitArgs {
    const unsigned short* Q; int ldq;
    const unsigned short* K; int ldk;
    const unsigned short* V; int ldv;
    unsigned short* O; int ldo;
    int qlo;
    int NT;
    const float* kbias;
    const u64* bm;
    int tid;
    const float* gq; const float* gk;
};

__device__ __forceinline__ void mask_causal(f32x16& p0, f32x16& p1, int dq) {
    const float NEG = -__builtin_inff();
#pragma unroll
    for (int r = 0; r < 16; ++r) { const int c = (r & 3) + 8 * (r >> 2); if (dq - c < 0) p0[r] = NEG; if (dq - c - 32 < 0) p1[r] = NEG; }
}
__device__ __forceinline__ void mask_bits(f32x16& p0, f32x16& p1, u64 w, int hi) {
    const float NEG = -__builtin_inff(); const unsigned lo = (unsigned)w >> (4 * hi), hh = (unsigned)(w >> 32) >> (4 * hi);
#pragma unroll
    for (int r = 0; r < 16; ++r) { const int c = (r & 3) + 8 * (r >> 2);
        const unsigned m0 = (unsigned)__builtin_amdgcn_sbfe((int)lo, c, 1), m1 = (unsigned)__builtin_amdgcn_sbfe((int)hh, c, 1);
        p0[r] = __uint_as_float((__float_as_uint(p0[r]) & m0) | (__float_as_uint(NEG) & ~m0)); p1[r] = __uint_as_float((__float_as_uint(p1[r]) & m1) | (__float_as_uint(NEG) & ~m1)); }
}
__device__ __forceinline__ void partialSM(f32x16& p0, f32x16& p1, float& m_reg, float& mn, float& alpha, const bool fixedref) {
    if (fixedref) { mn = 0.f; alpha = 1.f; }
    else {
        float pmax = p0[0];
#pragma unroll
        for (int r = 1; r < 16; ++r) pmax = fmaxf(pmax, p0[r]);
#pragma unroll
        for (int r = 0; r < 16; ++r) pmax = fmaxf(pmax, p1[r]);
        { auto rr = __builtin_amdgcn_permlane32_swap(__float_as_uint(pmax), __float_as_uint(pmax), false, false); pmax = fmaxf(__uint_as_float(rr[0]), __uint_as_float(rr[1])); }
        if (__builtin_expect(__all((pmax - m_reg) <= THR2), 1)) { mn = m_reg; alpha = 1.f; }
        else { mn = fmaxf(m_reg, pmax); alpha = __builtin_amdgcn_exp2f(m_reg - mn); m_reg = mn; }
    }
    if (!fixedref) {
#pragma unroll
        for (int r = 0; r < 16; ++r) p0[r] = p0[r] - mn;
#pragma unroll
        for (int r = 0; r < 16; ++r) p1[r] = p1[r] - mn;
    }
#pragma unroll
    for (int r = 0; r < 16; ++r) p0[r] = __builtin_amdgcn_exp2f(p0[r]);
}
__device__ __forceinline__ void finishSM(f32x16& p0, f32x16& p1, float alpha, float& l_reg, bf16x8& pa0, bf16x8& pa1, bf16x8& pa2, bf16x8& pa3) {
#pragma unroll
    for (int r = 0; r < 16; ++r) p1[r] = __builtin_amdgcn_exp2f(p1[r]);
    float ps = 0;
#pragma unroll
    for (int r = 0; r < 16; ++r) ps += p0[r];
#pragma unroll
    for (int r = 0; r < 16; ++r) ps += p1[r];
    { auto rr = __builtin_amdgcn_permlane32_swap(__float_as_uint(ps), __float_as_uint(ps), false, false); ps = __uint_as_float(rr[0]) + __uint_as_float(rr[1]); }
    l_reg = l_reg * alpha + ps;
#define ATT_PK4(P, B_, OUT) do { unsigned a0 = cvtpk(P[B_+0], P[B_+1]), a1 = cvtpk(P[B_+2], P[B_+3]);                          \
        unsigned b0 = cvtpk(P[B_+4], P[B_+5]), b1 = cvtpk(P[B_+6], P[B_+7]);                                             \
        auto r0 = __builtin_amdgcn_permlane32_swap(a0, b0, false, false); auto r1 = __builtin_amdgcn_permlane32_swap(a1, b1, false, false); \
        u32x4 w = {r0[0], r1[0], r0[1], r1[1]}; OUT = *reinterpret_cast<bf16x8*>(&w); } while (0)
    ATT_PK4(p0, 0, pa0); ATT_PK4(p0, 8, pa1); ATT_PK4(p1, 0, pa2); ATT_PK4(p1, 8, pa3);
#undef ATT_PK4
}
template <int VB>
__device__ __forceinline__ void pv_tile(f32x16* o, int vb0, bf16x8 pa0, bf16x8 pa1, bf16x8 pa2, bf16x8 pa3) {
#define ATT_TRRD(dst, off) asm volatile("ds_read_b64_tr_b16 %0, %1 offset:%2" : "=&v"(dst) : "v"(vb0), "i"(off) : "memory")
#define ATT_PV_D0(d0) do { s16x4 l0, l1, l2, l3, h0, h1, h2, h3; constexpr int b_ = VB * SHM_V + v_rd_off(d0, 0, 0); \
        ATT_TRRD(l0, b_); ATT_TRRD(h0, b_ + 2048); ATT_TRRD(l1, b_ + 4096); ATT_TRRD(h1, b_ + 6144); ATT_TRRD(l2, b_ + 8192); ATT_TRRD(h2, b_ + 10240); ATT_TRRD(l3, b_ + 12288); ATT_TRRD(h3, b_ + 14336); \
        asm volatile("s_waitcnt lgkmcnt(0)" ::: "memory"); ATT_SBAR();   \
        o[d0] = __builtin_amdgcn_mfma_f32_32x32x16_bf16(pa0, (bf16x8){l0[0], l0[1], l0[2], l0[3], h0[0], h0[1], h0[2], h0[3]}, o[d0], 0, 0, 0);   \
        o[d0] = __builtin_amdgcn_mfma_f32_32x32x16_bf16(pa1, (bf16x8){l1[0], l1[1], l1[2], l1[3], h1[0], h1[1], h1[2], h1[3]}, o[d0], 0, 0, 0);   \
        o[d0] = __builtin_amdgcn_mfma_f32_32x32x16_bf16(pa2, (bf16x8){l2[0], l2[1], l2[2], l2[3], h2[0], h2[1], h2[2], h2[3]}, o[d0], 0, 0, 0);   \
        o[d0] = __builtin_amdgcn_mfma_f32_32x32x16_bf16(pa3, (bf16x8){l3[0], l3[1], l3[2], l3[3], h3[0], h3[1], h3[2], h3[3]}, o[d0], 0, 0, 0); } while (0)
    ATT_PV_D0(0); ATT_PV_D0(1); ATT_PV_D0(2); ATT_PV_D0(3);
#undef ATT_PV_D0
#undef ATT_TRRD
}

template <int DQK, int MODE>
__device__ __forceinline__ void attn_unit(const UnitArgs& a, char* lds) {
    constexpr int SHM_K = KVBLK * DQK * 2, RS = DQK * 2, ND = DQK / 16, NKC = DQK / 64;
    int tid = a.tid; asm volatile("" : "+v"(tid)); const int wid = __builtin_amdgcn_readfirstlane(tid >> 6), lane = tid & 63, r32 = lane & 31, hi = lane >> 5;
    char* V_lds = lds; char* K_lds = lds + 2 * SHM_V;
    float* ws = (float*)(lds + 2 * SHM_V + 2 * SHM_K) + wid * 64; float* li_l = ws; float* al_l = ws + 32;
    float* kbl = (float*)(lds + 2 * SHM_V + 2 * SHM_K + 2048);
    const int NT = a.NT;
    const int qlo = a.qlo, qm = qlo + r32 - 4 * hi;
    const int srow = tid >> 3, c8 = tid & 7;
    const int kws = srow * RS + ((c8 * 16) ^ ((srow & 7) << 4));
    const int vst0 = v_st(srow, c8 * 8);
    const unsigned short* kg = a.K + (size_t)srow * a.ldk + c8 * 8;
    const unsigned short* vg = a.V + (size_t)srow * a.ldv + c8 * 8;
    const u64* bmrow = (MODE == 2) ? a.bm + (size_t)r32 * 64 : nullptr;
    bf16x8 st_k[NKC], st_v[2]; float st_b = 0.f; u64 mw_ld = 0, mw_cur = 0;
#define ATT_VMW() asm volatile("s_waitcnt vmcnt(0)" ::: "memory")
#define ATT_SLOAD(t) do { const size_t ko_ = (size_t)(t) * KVBLK * a.ldk, vo_ = (size_t)(t) * KVBLK * a.ldv; \
        _Pragma("unroll") for (int i_ = 0; i_ < NKC; ++i_) st_k[i_] = *(const bf16x8*)(kg + ko_ + i_ * 64); \
        _Pragma("unroll") for (int i_ = 0; i_ < 2; ++i_) st_v[i_] = *(const bf16x8*)(vg + vo_ + i_ * 64); \
        if (MODE == 1) { if (tid < 64) st_b = a.kbias[(t) * KVBLK + tid]; } \
        if (MODE == 2) { mw_ld = bmrow[(t)]; } } while (0)
#define ATT_SWRITE(bf) do { \
        _Pragma("unroll") for (int i_ = 0; i_ < NKC; ++i_) *(bf16x8*)(K_lds + (bf) * SHM_K + kws + i_ * 128) = st_k[i_]; \
        _Pragma("unroll") for (int i_ = 0; i_ < 2; ++i_) *(bf16x8*)(V_lds + (bf) * SHM_V + vst0 + i_ * 1024) = st_v[i_]; \
        if (MODE == 1) { if (tid < 64) kbl[(bf) * 64 + tid] = st_b; } } while (0)
    const int vb0 = (int)(uintptr_t)V_lds + v_rd_base(lane);
    float m_reg = -1e30f, l_reg = 0; f32x16 o[4] = {};
    bool fixedref;
    { float gqm = 0.f, gkm = 0.f;
#pragma unroll
      for (int i = 0; i < DQK / 64; ++i) { gqm = fmaxf(gqm, fabsf(a.gq[lane + 64 * i])); gkm = fmaxf(gkm, fabsf(a.gk[lane + 64 * i])); }
      gqm = wmax_f(gqm); gkm = wmax_f(gkm);
      const float bound = (float)DQK * (DQK == 128 ? QSCALE128 : QSCALE192) * 1.01f * gqm * gkm;
      fixedref = bound <= 40.0f;
      if (fixedref) m_reg = ((MODE == 1) ? a.kbias[qlo + r32] : 0.f) + bound - THR2; }
    const float cinit = fixedref ? -m_reg : 0.f;
#define ATT_RESC(al) do { if (__any((al) < 1.f)) { if (hi == 0) al_l[r32] = (al); asm volatile("s_waitcnt lgkmcnt(0)" ::: "memory");              \
                     _Pragma("unroll") for (int d_ = 0; d_ < 4; ++d_) _Pragma("unroll") for (int r = 0; r < 16; ++r) o[d_][r] *= al_l[crow(r, hi)]; } } while (0)
#define ATT_MASKT(P0_, P1_, t) do { const int kb_ = (t) * KVBLK; \
        if (MODE == 2) { mask_bits(P0_, P1_, mw_cur, hi); } \
        else { if (kb_ + KVBLK - 1 > qlo) mask_causal(P0_, P1_, qm - kb_); } } while (0)
#define ATT_QKT(KB, P0_, P1_) do { \
        if (MODE == 1) { const float* kb__ = kbl + (KB) * 64 + 4 * hi; \
            _Pragma("unroll") for (int j_ = 0; j_ < 4; ++j_) { const f32x4 b0_ = *(const f32x4*)(kb__ + 8 * j_), b1_ = *(const f32x4*)(kb__ + 32 + 8 * j_); \
                _Pragma("unroll") for (int e_ = 0; e_ < 4; ++e_) { P0_[4 * j_ + e_] = b0_[e_] + cinit; P1_[4 * j_ + e_] = b1_[e_] + cinit; } } } \
        else { _Pragma("unroll") for (int r_ = 0; r_ < 16; ++r_) { P0_[r_] = cinit; P1_[r_] = cinit; } } \
        const char* kbp_[4]; \
        _Pragma("unroll") for (int dd_ = 0; dd_ < 4; ++dd_) kbp_[dd_] = K_lds + (KB) * SHM_K + r32 * RS + (((dd_ * 16 + hi * 8) * 2) ^ ((r32 & 7) << 4)); \
        _Pragma("unroll") for (int d0_ = 0; d0_ < ND; ++d0_) { const char* a_ = kbp_[d0_ & 3] + (d0_ >> 2) * 128; \
            const bf16x8 b0_ = *reinterpret_cast<const bf16x8*>(a_); const bf16x8 b1_ = *reinterpret_cast<const bf16x8*>(a_ + 32 * RS); \
            P0_ = __builtin_amdgcn_mfma_f32_32x32x16_bf16(b0_, qr[d0_], P0_, 0, 0, 0); \
            P1_ = __builtin_amdgcn_mfma_f32_32x32x16_bf16(b1_, qr[d0_], P1_, 0, 0, 0); } } while (0)
    const int grp = wid >> 2;
    int t0 = 0;
    if (MODE == 1 && fixedref) { const int q0u = qlo - 32 * wid; const float bq0 = a.kbias[q0u];
        const float kbl_ = (lane < NT) ? a.kbias[64 * lane + 63] : __builtin_inff();
        const u64 okm = __ballot(kbl_ - bq0 >= -(150.0f + THR2 + 4.0f));
        t0 = (int)__ffsll((long long)okm) - 1; t0 = __builtin_amdgcn_readfirstlane(t0 < 0 ? 0 : t0) & ~1; }
    ATT_SLOAD(t0);
    bf16x8 qr[ND];
#pragma unroll
    for (int d0 = 0; d0 < ND; ++d0) qr[d0] = *(const bf16x8*)(a.Q + (size_t)r32 * a.ldq + d0 * 16 + hi * 8);
    ATT_VMW(); ATT_SWRITE(0); mw_cur = mw_ld;
    if (NT > t0 + 1) ATT_SLOAD(t0 + 1);
    __syncthreads();
    if (grp == 1) __syncthreads();
    f32x16 p0, p1; float mn, al; bf16x8 pa0, pa1, pa2, pa3;
#define ATT_STAGE_NEXT(t) do { if ((t) + 1 < NT) { ATT_VMW(); if (((t) + 1) & 1) { ATT_SWRITE(1); } else { ATT_SWRITE(0); } mw_cur = mw_ld; if ((t) + 2 < NT) { ATT_SLOAD((t) + 2); } } } while (0)
#define ATT_STEP(t, BUF) do { \
        ATT_SBAR(); ATT_QKT(BUF, p0, p1); \
        ATT_MASKT(p0, p1, (t)); partialSM(p0, p1, m_reg, mn, al, fixedref); \
        if (grp == 1) ATT_STAGE_NEXT(t); \
        __syncthreads(); \
        if (grp == 0) ATT_STAGE_NEXT(t); \
        ATT_RESC(al); \
        finishSM(p0, p1, al, l_reg, pa0, pa1, pa2, pa3); ATT_SBAR(); \
        pv_tile<BUF>(o, vb0, pa0, pa1, pa2, pa3); \
        __syncthreads(); } while (0)
    for (int t = t0; t < NT; t += 2) {
        ATT_STEP(t, 0);
        if (t + 1 < NT) ATT_STEP(t + 1, 1);
    }
    if (grp == 0) __syncthreads();
#undef ATT_STEP
#undef ATT_STAGE_NEXT
    if (hi == 0) li_l[r32] = l_reg; asm volatile("s_waitcnt lgkmcnt(0)" ::: "memory");
    float rli[16];
#pragma unroll
    for (int r = 0; r < 16; ++r) rli[r] = __builtin_amdgcn_rcpf(li_l[crow(r, hi)]);
#pragma unroll
    for (int r = 0; r < 16; ++r) { const int orow = crow(r, hi);
#pragma unroll
        for (int d0 = 0; d0 < 4; ++d0) { const float v = o[d0][r] * rli[r]; const float vn = xor_f<1>(v);
            if ((r32 & 1) == 0) *(unsigned*)(a.O + (size_t)orow * a.ldo + d0 * 32 + r32) = cvtpk(v, vn); } }
    __syncthreads();
#undef ATT_VMW
#undef ATT_SLOAD
#undef ATT_SWRITE
#undef ATT_RESC
#undef ATT_MASKT
#undef ATT_QKT
}
#undef ATT_SBAR
}

namespace tk {
typedef short bf16x8 __attribute__((ext_vector_type(8)));
typedef float f32x16 __attribute__((ext_vector_type(16)));
typedef float f32x4 __attribute__((ext_vector_type(4)));
typedef unsigned u32x4 __attribute__((ext_vector_type(4)));
typedef unsigned long long u64;
constexpr int TOPK = 256;
__device__ __forceinline__ float wave_min(float v) { return wmin_f(v); }
__device__ __forceinline__ float wave_max(float v) { return wmax_f(v); }
__device__ __forceinline__ int rdlane_i(int v, int src_uniform) { return __builtin_amdgcn_readlane(v, __builtin_amdgcn_readfirstlane(src_uniform)); }

__device__ __forceinline__ void topk_unit(const unsigned short* EP, const float* misc32, u64* BM, int b, int g, char* lds, char* lds_hist, char* lds_cand, const int tid_in) {
    int tid = tid_in; asm volatile("" : "+v"(tid)); const int wid = __builtin_amdgcn_readfirstlane(tid >> 6), lane = tid & 63, r32 = lane & 31, hi = lane >> 5;
    float* S = (float*)lds;
    const int q0 = g * 8; const size_t tok0 = (size_t)b * SEQ;
    {
        typedef float f32x4a __attribute__((ext_vector_type(4)));
        const int j16 = lane & 15, kg = lane >> 4;
        bf16x8 af[4][2];
        const int nkb = (q0 + 8 + 31) >> 5;
        const unsigned short* kbase = EP + tok0 * N_E_IN + 1280 + kg * 8 + (size_t)j16 * N_E_IN;
        bf16x8 bA[4], bB[4];
#define TK_LOADB(dst, kb_) do { _Pragma("unroll") for (int f_ = 0; f_ < 4; ++f_) dst[f_] = *(const bf16x8*)(kbase + ((size_t)(kb_) * 32 + (f_ >> 1) * 16) * N_E_IN + (f_ & 1) * 32); } while (0)
        if (wid < nkb) TK_LOADB(bA, wid);
#pragma unroll
        for (int rt = 0; rt < 4; ++rt)
#pragma unroll
            for (int ks = 0; ks < 2; ++ks) af[rt][ks] = *(const bf16x8*)(EP + (tok0 + q0 + 2 * (j16 >> 2) + (rt >> 1)) * N_E_IN + 768 + (4 * (rt & 1) + (j16 & 3)) * 64 + ks * 32 + kg * 8);
        f32x4 wv[2][2];
#pragma unroll
        for (int qq = 0; qq < 2; ++qq) { const float* wp = misc32 + (tok0 + q0 + 2 * kg + qq) * 16; wv[qq][0] = *(const f32x4*)wp; wv[qq][1] = *(const f32x4*)(wp + 4); }
#if defined(TKS_CHECK)
#define TK_HEADSUM(s, w_, lo_, hi_) float s = w_[0][0] * __int_as_float(max(__float_as_int(lo_[0]), 0)), s2_ = w_[1][0] * __int_as_float(max(__float_as_int(hi_[0]), 0)); \
            _Pragma("unroll") for (int e = 1; e < 4; ++e) { s = __builtin_fmaf(w_[0][e], __int_as_float(max(__float_as_int(lo_[e]), 0)), s); s2_ = __builtin_fmaf(w_[1][e], __int_as_float(max(__float_as_int(hi_[e]), 0)), s2_); } s += s2_
#else
#define TK_HEADSUM(s, w_, lo_, hi_) float s = 0.f; \
            _Pragma("unroll") for (int e = 0; e < 4; ++e) s += w_[0][e] * __int_as_float(max(__float_as_int(lo_[e]), 0)); \
            _Pragma("unroll") for (int e = 0; e < 4; ++e) s += w_[1][e] * __int_as_float(max(__float_as_int(hi_[e]), 0))
#endif
#define TK_SCORE(bf, kb_) do { f32x4a ac_[2][4]; \
            _Pragma("unroll") for (int kgp = 0; kgp < 2; ++kgp) _Pragma("unroll") for (int rt = 0; rt < 4; ++rt) ac_[kgp][rt] = (f32x4a){0.f, 0.f, 0.f, 0.f}; \
            _Pragma("unroll") for (int ks = 0; ks < 2; ++ks) _Pragma("unroll") for (int rt = 0; rt < 4; ++rt) _Pragma("unroll") for (int kgp = 0; kgp < 2; ++kgp) \
                ac_[kgp][rt] = __builtin_amdgcn_mfma_f32_16x16x32_bf16(af[rt][ks], bf[2 * kgp + ks], ac_[kgp][rt], 0, 0, 0); \
            _Pragma("unroll") for (int kgp = 0; kgp < 2; ++kgp) _Pragma("unroll") for (int qq = 0; qq < 2; ++qq) { TK_HEADSUM(s, wv[qq], ac_[kgp][2 * qq], ac_[kgp][2 * qq + 1]); \
                S[(2 * kg + qq) * 4096 + (kb_) * 32 + kgp * 16 + j16] = s; } } while (0)
#define TK_SCORE2(bf0, kb0_, bf1, kb1_) do { const int kbs_[2] = {(kb0_), (kb1_)}; f32x4a ac_[2][2][4]; \
            _Pragma("unroll") for (int blk = 0; blk < 2; ++blk) _Pragma("unroll") for (int kgp = 0; kgp < 2; ++kgp) _Pragma("unroll") for (int rt = 0; rt < 4; ++rt) ac_[blk][kgp][rt] = (f32x4a){0.f, 0.f, 0.f, 0.f}; \
            _Pragma("unroll") for (int ks = 0; ks < 2; ++ks) _Pragma("unroll") for (int rt = 0; rt < 4; ++rt) _Pragma("unroll") for (int kgp = 0; kgp < 2; ++kgp) { \
                ac_[0][kgp][rt] = __builtin_amdgcn_mfma_f32_16x16x32_bf16(af[rt][ks], bf0[2 * kgp + ks], ac_[0][kgp][rt], 0, 0, 0); ac_[1][kgp][rt] = __builtin_amdgcn_mfma_f32_16x16x32_bf16(af[rt][ks], bf1[2 * kgp + ks], ac_[1][kgp][rt], 0, 0, 0); } \
            _Pragma("unroll") for (int blk = 0; blk < 2; ++blk) _Pragma("unroll") for (int kgp = 0; kgp < 2; ++kgp) _Pragma("unroll") for (int qq = 0; qq < 2; ++qq) { TK_HEADSUM(s, wv[qq], ac_[blk][kgp][2 * qq], ac_[blk][kgp][2 * qq + 1]); \
                S[(2 * kg + qq) * 4096 + kbs_[blk] * 32 + kgp * 16 + j16] = s; } } while (0)
        if (wid + 8 < nkb) TK_LOADB(bB, wid + 8);
        bf16x8 bC[4], bD[4];
        for (int kb = wid; kb < nkb; kb += 32) {
            if (kb + 16 < nkb) { TK_LOADB(bC, kb + 16); if (kb + 24 < nkb) TK_LOADB(bD, kb + 24); }
            if (kb + 8 < nkb) TK_SCORE2(bA, kb, bB, kb + 8); else TK_SCORE(bA, kb);
            if (kb + 16 < nkb) {
                if (kb + 32 < nkb) { TK_LOADB(bA, kb + 32); if (kb + 40 < nkb) TK_LOADB(bB, kb + 40); }
                if (kb + 24 < nkb) TK_SCORE2(bC, kb + 16, bD, kb + 24); else TK_SCORE(bC, kb + 16);
            }
        }
#undef TK_SCORE2
#undef TK_HEADSUM
#undef TK_LOADB
#undef TK_SCORE
    }
    __syncthreads();
    const int qpos = q0 + wid; const int n = qpos + 1; const int ni = (n + 63) >> 6;
    const float NEG = -__builtin_inff(), PINF = __builtin_inff();
    float sc[64]; float mn0 = PINF, mx0 = NEG;
#define TK_NI(var) int var = ni; asm volatile("" : "+s"(var))
    { TK_NI(nic);
#pragma unroll
      for (int c8 = 0; c8 < 8; ++c8) { if (c8 * 8 < nic) {
#pragma unroll
          for (int e = 0; e < 8; ++e) { const int i = c8 * 8 + e; const int key = 64 * i + lane; const float v = S[wid * 4096 + key]; const bool adm = key <= qpos; sc[i] = adm ? v : NEG; mx0 = fmaxf(mx0, sc[i]); mn0 = fminf(mn0, adm ? v : PINF); } }
        else {
#pragma unroll
          for (int e = 0; e < 8; ++e) sc[c8 * 8 + e] = NEG; } } }
    u64 myword = 0ull;
#ifndef TK_REP_SEL
#define TK_REP_SEL 1
#endif
    for (int rsel_ = 0; rsel_ < TK_REP_SEL; ++rsel_) {
    if (n <= TOPK) {
#pragma unroll
        for (int i = 0; i < 4; ++i) { const u64 w = __ballot(64 * i + lane <= qpos); if (lane == i) myword = w; }
    } else {
        unsigned* hist = (unsigned*)lds_hist + wid * 320; float* cand = (float*)lds_cand + wid * 64;
        float lo = wave_min(mn0), hv = wave_max(mx0);
        int need = TOPK; float T_ = lo; int n_eq = 0; bool done = false, all_eq = false;
        for (int level = 0; level < 48 && !done; ++level) {
            if (!(lo < hv)) { T_ = lo; n_eq = need; done = true; break; }
            const float scale = 255.5f / (hv - lo);
            { unsigned z_ = 0u; asm volatile("" : "+v"(z_)); *(u32x4*)(hist + 4 * lane) = (u32x4){z_, z_, z_, z_}; }
            asm volatile("s_waitcnt lgkmcnt(0)" ::: "memory");
            { TK_NI(nic);
#pragma unroll
              for (int c8 = 0; c8 < 8; ++c8) if (c8 * 8 < nic) {
#pragma unroll
                for (int e = 0; e < 8; ++e) { const float s = sc[c8 * 8 + e]; const float d = s - lo; const bool inr = (s <= hv) && (d >= 0.0f); int bin = (int)(d * scale); bin = bin > 255 ? 255 : bin;
                    bin = inr ? bin : 256 + lane;
                    __hip_atomic_fetch_add(hist + bin, 1u, __ATOMIC_RELAXED, __HIP_MEMORY_SCOPE_WORKGROUP); } } }
            asm volatile("s_waitcnt lgkmcnt(0)" ::: "memory");
            const u32x4 hq = *(const u32x4*)(hist + 4 * lane);
            const int tl = (int)(hq[0] + hq[1] + hq[2] + hq[3]);
            int suf = tl;
#pragma unroll
            for (int o = 1; o < 64; o <<= 1) { const int v = down_i(suf, o); if (lane + o < 64) suf += v; }
            const int above = suf - tl;
            const bool mine = (above < need) && (need <= suf);
            int bsel = 0, cab = 0, cin = 0;
            if (mine) { int c = above;
                if (need <= c + (int)hq[3]) { bsel = 3; cab = c; cin = (int)hq[3]; }
                else { c += (int)hq[3];
                    if (need <= c + (int)hq[2]) { bsel = 2; cab = c; cin = (int)hq[2]; }
                    else { c += (int)hq[2];
                        if (need <= c + (int)hq[1]) { bsel = 1; cab = c; cin = (int)hq[1]; }
                        else { c += (int)hq[1]; bsel = 0; cab = c; cin = (int)hq[0]; } } }
                bsel += 4 * lane; }
            const u64 mm = __ballot(mine); const int src = (int)__ffsll((long long)mm) - 1;
            const int bstar = rdlane_i(bsel, src), cabove = rdlane_i(cab, src), cnt_in = rdlane_i(cin, src);
            need -= cabove;
            if (cnt_in <= 64) {
                int base = 0;
                { TK_NI(nic);
#pragma unroll
                  for (int c8 = 0; c8 < 8; ++c8) if (c8 * 8 < nic) {
#pragma unroll
                    for (int e = 0; e < 8; ++e) { const float s = sc[c8 * 8 + e]; const float d = s - lo; int bin = (int)(d * scale); bin = bin > 255 ? 255 : bin;
                        const bool pr = (s <= hv) && (d >= 0.0f) && (bin == bstar); const u64 bl = __ballot(pr);
                        if (bl) { if (pr) cand[base + __popcll(bl & ((1ull << lane) - 1ull))] = s; base += __popcll(bl); } } } }
                asm volatile("s_waitcnt lgkmcnt(0)" ::: "memory");
                const float v = (lane < cnt_in) ? cand[lane] : NEG;
                int gt = 0, ge = 0;
                for (int j = 0; j < cnt_in; ++j) { const float vj = __int_as_float(__builtin_amdgcn_readlane(__float_as_int(v), j)); gt += (vj > v) ? 1 : 0; ge += (vj >= v) ? 1 : 0; }
                const bool ok = (lane < cnt_in) && (gt < need) && (need <= ge);
                const u64 okm = __ballot(ok); const int s2 = (int)__ffsll((long long)okm) - 1;
                T_ = __int_as_float(rdlane_i(__float_as_int(v), s2)); const int gtT = rdlane_i(gt, s2), geT = rdlane_i(ge, s2); n_eq = need - gtT; all_eq = (n_eq == geT - gtT); done = true;
            } else {
                float mn = PINF, mx = NEG;
#pragma unroll
                for (int i = 0; i < 64; ++i) { const float s = sc[i]; const float d = s - lo; int bin = (int)(d * scale); bin = bin > 255 ? 255 : bin;
                    const bool pr = (s <= hv) && (d >= 0.0f) && bin == bstar; mn = fminf(mn, pr ? s : PINF); mx = fmaxf(mx, pr ? s : NEG); }
                lo = wave_min(mn); hv = wave_max(mx);
            }
        }
        if (all_eq) {
            { TK_NI(nic);
#pragma unroll
              for (int c8 = 0; c8 < 8; ++c8) if (c8 * 8 < nic) {
#pragma unroll
                for (int e = 0; e < 8; ++e) { const int i = c8 * 8 + e; const u64 w = __ballot(sc[i] >= T_); if (lane == i) myword = w; } } }
        } else {
            int eqrun = 0;
#pragma unroll
            for (int i = 0; i < 64; ++i) { const float s = sc[i]; const bool eq = (s == T_); const u64 be = __ballot(eq);
                const int rk = eqrun + __popcll(be & ((1ull << lane) - 1ull));
                const bool sel = (s > T_) || (eq && rk < n_eq);
                const u64 w = __ballot(sel); eqrun += __popcll(be);
                if (lane == i) myword = w; }
        }
    }
    }
    BM[(tok0 + qpos) * 64 + lane] = myword;
    __syncthreads();
}

__device__ __forceinline__ void cumsum_unit(const float* misc32, float* cumb, int b, int h, char* lds, const int tid_in) {
    int tid = tid_in; asm volatile("" : "+v"(tid)); const int wid = tid >> 6, lane = tid & 63;
    float* wsum = (float*)lds;
    float v[8]; float run = 0.f;
#pragma unroll
    for (int j = 0; j < 8; ++j) { run += misc32[((size_t)b * SEQ + tid * 8 + j) * 16 + 8 + h]; v[j] = run; }
    float inc = run;
#pragma unroll
    for (int o = 1; o < 64; o <<= 1) { const float t = up_f(inc, o); if (lane >= o) inc += t; }
    if (lane == 63) wsum[wid] = inc;
    __syncthreads();
    float off = inc - run;
    for (int w = 0; w < wid; ++w) off += wsum[w];
#pragma unroll
    for (int j = 0; j < 8; ++j) cumb[(size_t)h * MTOK + (size_t)b * SEQ + tid * 8 + j] = -LOG2E * (off + v[j]);
    __syncthreads();
}
}

namespace tkr {
typedef short bf16x8 __attribute__((ext_vector_type(8)));
typedef float f32x4 __attribute__((ext_vector_type(4)));
typedef unsigned u32x4 __attribute__((ext_vector_type(4)));
typedef unsigned long long u64;
constexpr int TOPK = 256;
using tk::rdlane_i; using tk::wave_min; using tk::wave_max;

__device__ __forceinline__ u64 select64(const float (&sc)[64], const float mn0, const float mx0, const int qpos, char* lds_hist, char* lds_cand, const int wsel, const int lane) {
    const int n = qpos + 1; const int ni = (n + 63) >> 6;
    const float NEG = -__builtin_inff(), PINF = __builtin_inff();
#define TK_NI(var) int var = ni; asm volatile("" : "+s"(var))
    u64 myword = 0ull;
    if (n <= TOPK) {
#pragma unroll
        for (int i = 0; i < 4; ++i) { const u64 w = __ballot(64 * i + lane <= qpos); if (lane == i) myword = w; }
    } else {
        unsigned* hist = (unsigned*)lds_hist + wsel * 320; float* cand = (float*)lds_cand + wsel * 64;
        float lo = wave_min(mn0), hv = wave_max(mx0);
        int need = TOPK; float T_ = lo; int n_eq = 0; bool done = false, all_eq = false;
        for (int level = 0; level < 48 && !done; ++level) {
            if (!(lo < hv)) { T_ = lo; n_eq = need; done = true; break; }
            const float scale = 255.5f / (hv - lo);
            unsigned pkb[32];
            { unsigned z_ = 0u; asm volatile("" : "+v"(z_)); *(u32x4*)(hist + 4 * lane) = (u32x4){z_, z_, z_, z_}; }
            asm volatile("s_waitcnt lgkmcnt(0)" ::: "memory");
            { TK_NI(nic);
#pragma unroll
              for (int c8 = 0; c8 < 8; ++c8) if (c8 * 8 < nic) {
#pragma unroll
                for (int e = 0; e < 8; ++e) { const float s = sc[c8 * 8 + e]; const float d = s - lo; const bool inr = (s <= hv) && (d >= 0.0f); int bin = (int)(d * scale); bin = bin > 255 ? 255 : bin;
                    bin = inr ? bin : 256 + lane;
                    const unsigned bc_ = (unsigned)bin;
                    if (e & 1) pkb[c8 * 4 + (e >> 1)] |= bc_ << 16; else pkb[c8 * 4 + (e >> 1)] = bc_;
                    __hip_atomic_fetch_add(hist + bin, 1u, __ATOMIC_RELAXED, __HIP_MEMORY_SCOPE_WORKGROUP); } } }
            asm volatile("s_waitcnt lgkmcnt(0)" ::: "memory");
            const u32x4 hq = *(const u32x4*)(hist + 4 * lane);
            const int tl = (int)(hq[0] + hq[1] + hq[2] + hq[3]);
            int suf = tl;
#pragma unroll
            for (int o = 1; o < 64; o <<= 1) { const int v = down_i(suf, o); if (lane + o < 64) suf += v; }
            const int above = suf - tl;
            const bool mine = (above < need) && (need <= suf);
            int bsel = 0, cab = 0, cin = 0;
            if (mine) { int c = above;
                if (need <= c + (int)hq[3]) { bsel = 3; cab = c; cin = (int)hq[3]; }
                else { c += (int)hq[3];
                    if (need <= c + (int)hq[2]) { bsel = 2; cab = c; cin = (int)hq[2]; }
                    else { c += (int)hq[2];
                        if (need <= c + (int)hq[1]) { bsel = 1; cab = c; cin = (int)hq[1]; }
                        else { c += (int)hq[1]; bsel = 0; cab = c; cin = (int)hq[0]; } } }
                bsel += 4 * lane; }
            const u64 mm = __ballot(mine); const int src = (int)__ffsll((long long)mm) - 1;
            const int bstar = rdlane_i(bsel, src), cabove = rdlane_i(cab, src), cnt_in = rdlane_i(cin, src);
            need -= cabove;
            if (cnt_in <= 64) {
                int base = 0;
                { TK_NI(nic);
#pragma unroll
                  for (int c8 = 0; c8 < 8; ++c8) if (c8 * 8 < nic) {
#pragma unroll
                    for (int e = 0; e < 8; ++e) { const float s = sc[c8 * 8 + e];
                        const bool pr = ((pkb[c8 * 4 + (e >> 1)] >> (16 * (e & 1))) & 0xffffu) == (unsigned)bstar; const u64 bl = __ballot(pr);
                        if (bl) { if (pr) cand[base + __popcll(bl & ((1ull << lane) - 1ull))] = s; base += __popcll(bl); } } } }
                asm volatile("s_waitcnt lgkmcnt(0)" ::: "memory");
                const float v = (lane < cnt_in) ? cand[lane] : NEG;
                int gt = 0, ge = 0;
                for (int j = 0; j < cnt_in; ++j) { const float vj = __int_as_float(__builtin_amdgcn_readlane(__float_as_int(v), j)); gt += (vj > v) ? 1 : 0; ge += (vj >= v) ? 1 : 0; }
                const bool ok = (lane < cnt_in) && (gt < need) && (need <= ge);
                const u64 okm = __ballot(ok); const int s2 = (int)__ffsll((long long)okm) - 1;
                T_ = __int_as_float(rdlane_i(__float_as_int(v), s2)); const int gtT = rdlane_i(gt, s2), geT = rdlane_i(ge, s2); n_eq = need - gtT; all_eq = (n_eq == geT - gtT); done = true;
            } else {
                float mn = PINF, mx = NEG;
                { TK_NI(nic);
#pragma unroll
                  for (int c8 = 0; c8 < 8; ++c8) if (c8 * 8 < nic) {
#pragma unroll
                    for (int e = 0; e < 8; ++e) { const float s = sc[c8 * 8 + e];
                        const bool pr = ((pkb[c8 * 4 + (e >> 1)] >> (16 * (e & 1))) & 0xffffu) == (unsigned)bstar; mn = fminf(mn, pr ? s : PINF); mx = fmaxf(mx, pr ? s : NEG); } } }
                lo = wave_min(mn); hv = wave_max(mx);
            }
        }
        if (all_eq) {
            { TK_NI(nic);
#pragma unroll
              for (int c8 = 0; c8 < 8; ++c8) if (c8 * 8 < nic) {
#pragma unroll
                for (int e = 0; e < 8; ++e) { const int i = c8 * 8 + e; const u64 w = __ballot(sc[i] >= T_); if (lane == i) myword = w; } } }
        } else {
            int eqrun = 0;
#pragma unroll
            for (int i = 0; i < 64; ++i) { const float s = sc[i]; const bool eq = (s == T_); const u64 be = __ballot(eq);
                const int rk = eqrun + __popcll(be & ((1ull << lane) - 1ull));
                const bool sel = (s > T_) || (eq && rk < n_eq);
                const u64 w = __ballot(sel); eqrun += __popcll(be);
                if (lane == i) myword = w; }
        }
    }

#undef TK_NI
    (void)PINF;
    return myword;
}

__device__ __forceinline__ void regsel_unit(const unsigned short* EP, const float* misc32, u64* BM, int b, int g16, char* lds, char* lds_hist, char* lds_cand, const int tid_in) {
    int tid = tid_in; asm volatile("" : "+v"(tid)); const int wid = __builtin_amdgcn_readfirstlane(tid >> 6), lane = tid & 63, hi = lane >> 5, j16 = lane & 15, kg = lane >> 4;
    const bool godd = (kg & 1) != 0;
    const int q0 = g16 * 16; const size_t tok0 = (size_t)b * SEQ; const int qpos = q0 + 2 * wid + hi;
    char* kst = lds;
    bf16x8 af[2];
#pragma unroll
    for (int ks = 0; ks < 2; ++ks) af[ks] = *(const bf16x8*)(EP + (tok0 + q0 + 2 * wid + (j16 >> 3)) * N_E_IN + 768 + (j16 & 7) * 64 + ks * 32 + kg * 8);
    const f32x4 wq = *(const f32x4*)(misc32 + (tok0 + qpos) * 16 + (godd ? 4 : 0));
    const int nkb = (q0 + 16 + 31) >> 5, nch = (nkb + 3) >> 2;
    typedef __attribute__((address_space(3))) unsigned lds_u32; typedef __attribute__((address_space(3))) char lds_char;
    const unsigned short* gsrc = EP + (tok0 + 8 * wid + (lane >> 3)) * N_E_IN + 1280 + (((lane & 7) ^ ((lane >> 3) & 7)) << 3);
#define TKR_ISSUE(c_) do { const char* gp_ = (const char*)(gsrc + (size_t)(c_) * 128 * N_E_IN); lds_char* d_ = (lds_char*)(kst + ((c_) & 7) * 16384 + wid * 1024); \
        __builtin_amdgcn_global_load_lds((const unsigned*)gp_, (lds_u32*)d_, 16, 0, 0); __builtin_amdgcn_global_load_lds((const unsigned*)(gp_ + (size_t)64 * N_E_IN * 2), (lds_u32*)(d_ + 8192), 16, 0, 0); } while (0)
    const int frow = j16 * 128, fsw = j16 & 7;
    const int klim = qpos - (lane & 31);
    const float NEGI = -__builtin_inff();
    float blk[128];
#define TKR_HALF(c_, h_) do { \
        f32x4 a0_[2], a1_[2]; \
        _Pragma("unroll") for (int b2 = 0; b2 < 2; ++b2) { const int bl = 2 * (h_) + b2; a0_[b2] = (f32x4){0.f, 0.f, 0.f, 0.f}; a1_[b2] = (f32x4){0.f, 0.f, 0.f, 0.f}; \
            _Pragma("unroll") for (int ks = 0; ks < 2; ++ks) { const int off_ = bl * 4096 + (((ks * 4 + kg) ^ fsw) << 4); \
                const bf16x8 b0_ = *(const bf16x8*)(kc_ + off_), b1_ = *(const bf16x8*)(kc_ + 16 * 128 + off_); \
                a0_[b2] = __builtin_amdgcn_mfma_f32_16x16x32_bf16(af[ks], b0_, a0_[b2], 0, 0, 0); a1_[b2] = __builtin_amdgcn_mfma_f32_16x16x32_bf16(af[ks], b1_, a1_[b2], 0, 0, 0); } } \
        _Pragma("unroll") for (int b2 = 0; b2 < 2; ++b2) { \
            float p0 = wq[0] * __int_as_float(max(__float_as_int(a0_[b2][0]), 0)), p1 = wq[0] * __int_as_float(max(__float_as_int(a1_[b2][0]), 0)); \
            _Pragma("unroll") for (int e = 1; e < 4; ++e) { p0 = __builtin_fmaf(wq[e], __int_as_float(max(__float_as_int(a0_[b2][e]), 0)), p0); p1 = __builtin_fmaf(wq[e], __int_as_float(max(__float_as_int(a1_[b2][e]), 0)), p1); } \
              \
            const auto sw_ = __builtin_amdgcn_permlane16_swap(__float_as_uint(p0), __float_as_uint(p1), false, false); const float s_ = __uint_as_float(sw_[0]) + __uint_as_float(sw_[1]); blk[4 * (c_) + 2 * (h_) + b2] = ((4 * (c_) + 2 * (h_) + b2) * 32 <= klim) ? s_ : NEGI; } } while (0)
#define TKR_CHUNK(c_) do { const char* kc_ = kst + ((c_) & 7) * 16384 + frow; TKR_HALF(c_, 0); __builtin_amdgcn_sched_barrier(0); TKR_HALF(c_, 1); } while (0)
    asm volatile("" ::: "memory");
    __builtin_amdgcn_s_barrier();
    asm volatile("" ::: "memory");
#pragma unroll
    for (int c = 0; c < 6; ++c) if (c < nch) TKR_ISSUE(c);
#define TKR_STEP(c_) do { if ((c_) < nch) { const int r_ = nch - 1 - (c_); \
            if (r_ >= 5) asm volatile("s_waitcnt vmcnt(10)" ::: "memory"); else if (r_ == 4) asm volatile("s_waitcnt vmcnt(8)" ::: "memory"); else if (r_ == 3) asm volatile("s_waitcnt vmcnt(6)" ::: "memory"); \
            else if (r_ == 2) asm volatile("s_waitcnt vmcnt(4)" ::: "memory"); else if (r_ == 1) asm volatile("s_waitcnt vmcnt(2)" ::: "memory"); else asm volatile("s_waitcnt vmcnt(0)" ::: "memory"); \
            __builtin_amdgcn_s_barrier(); asm volatile("" ::: "memory"); \
            if ((c_) + 6 < nch) TKR_ISSUE((c_) + 6); \
            TKR_CHUNK(c_); } \
        else { _Pragma("unroll") for (int bl = 0; bl < 4; ++bl) blk[4 * (c_) + bl] = NEGI; } } while (0)
#pragma unroll
    for (int c = 0; c < 32; ++c) TKR_STEP(c);
#undef TKR_STEP
#undef TKR_CHUNK
#undef TKR_HALF
#undef TKR_ISSUE
#pragma unroll
    for (int i = 0; i < 64; ++i) { auto rr = __builtin_amdgcn_permlane32_swap(__float_as_uint(blk[2 * i]), __float_as_uint(blk[2 * i + 1]), false, false); blk[2 * i] = __uint_as_float(rr[0]); blk[2 * i + 1] = __uint_as_float(rr[1]); }
#pragma unroll
    for (int qq = 0; qq < 2; ++qq) {
        const int qp = q0 + 2 * wid + qq;
        float sc[64]; float mn0 = __builtin_inff(), mx0 = NEGI;
#pragma unroll
        for (int i = 0; i < 64; ++i) { const float v = blk[2 * i + qq]; sc[i] = v; mx0 = fmaxf(mx0, v); mn0 = fminf(mn0, (v == NEGI) ? __builtin_inff() : v); }
        const u64 word = select64(sc, mn0, mx0, qp, lds_hist, lds_cand, wid, lane);
        BM[(tok0 + qp) * 64 + lane] = word;
    }
}
}

namespace ssd {
typedef short bf16x8 __attribute__((ext_vector_type(8)));
typedef float f32x16 __attribute__((ext_vector_type(16)));
typedef float f32x4 __attribute__((ext_vector_type(4)));
typedef unsigned u32x4 __attribute__((ext_vector_type(4)));
typedef unsigned u32x2 __attribute__((ext_vector_type(2)));
constexpr int LD = 136;
constexpr int O_CS = 0, O_BS = 34816, O_BWT = 69632, O_XT = 104448, O_SB = 121856;
constexpr int ZLD = 72;
__device__ __forceinline__ unsigned short f2bf16(float f) { unsigned u = __float_as_uint(f); return (unsigned short)((u + 0x7fffu + ((u >> 16) & 1u)) >> 16); }
__device__ __forceinline__ float bf2f(unsigned short h) { return __uint_as_float(((unsigned)h) << 16); }
typedef float f32x2_t __attribute__((ext_vector_type(2))); typedef __bf16 bf16x2_t __attribute__((ext_vector_type(2)));
__device__ __forceinline__ unsigned pk_v(float lo, float hi) { const f32x2_t v = {lo, hi}; const bf16x2_t b = __builtin_convertvector(v, bf16x2_t); return __builtin_bit_cast(unsigned, b); }
__device__ __forceinline__ unsigned pk(float lo, float hi) { unsigned r; asm volatile("v_cvt_pk_bf16_f32 %0, %1, %2" : "=v"(r) : "v"(lo), "v"(hi)); return r; }
template <int NK>
__device__ __forceinline__ f32x16 mma(const unsigned short* Ab, const unsigned short* Bb, f32x16 acc, int hi) {
    bf16x8 a[NK], b[NK];
#pragma unroll
    for (int d0 = 0; d0 < NK; ++d0) { a[d0] = *(const bf16x8*)(Ab + d0 * 16 + hi * 8); b[d0] = *(const bf16x8*)(Bb + d0 * 16 + hi * 8); }
#pragma unroll
    for (int d0 = 0; d0 < NK; ++d0) acc = __builtin_amdgcn_mfma_f32_32x32x16_bf16(a[d0], b[d0], acc, 0, 0, 0);
    return acc;
}
__device__ __forceinline__ float siluf(float v) { return v * __builtin_amdgcn_rcpf(1.0f + __expf(-v)); }

__device__ __forceinline__ void conv_halo_save(const unsigned short* XBC, unsigned short* HALO, int unit, const int tid) {
    const int b = unit >> 5, c = unit & 31, cg = tid & 255, rh = tid >> 8; const long tb = (long)b * SEQ + c * 128;
#pragma unroll
    for (int k = 0; k < 3; ++k) { const long l = tb + rh * 64 - 3 + k; u32x4 v = (u32x4){0u, 0u, 0u, 0u};
        if (!(c == 0 && rh == 0)) v = *(const u32x4*)(XBC + (size_t)l * 2048 + cg * 8);
        *(u32x4*)(HALO + ((size_t)(unit * 2 + rh) * 3 + k) * 2048 + cg * 8) = v; }
}
__device__ __forceinline__ void conv_unit(unsigned short* XBC, const unsigned short* HALO, const float* conv_w, const float* conv_b, int unit, const int tid) {
    const int b = unit >> 5, c = unit & 31, cg = tid & 255, rh = tid >> 8; const size_t tb = (size_t)b * SEQ + (size_t)c * 128 + rh * 64; const int col = cg * 8;
    float cw[4][8], cb[8], r0[8], r1[8], r2[8];
#pragma unroll
    for (int j = 0; j < 4; ++j) { const f32x4 w0 = *(const f32x4*)(conv_w + j * 2048 + col), w1 = *(const f32x4*)(conv_w + j * 2048 + col + 4);
#pragma unroll
        for (int e = 0; e < 4; ++e) { cw[j][e] = w0[e]; cw[j][4 + e] = w1[e]; } }
    { const f32x4 b0 = *(const f32x4*)(conv_b + col), b1 = *(const f32x4*)(conv_b + col + 4);
#pragma unroll
      for (int e = 0; e < 4; ++e) { cb[e] = b0[e]; cb[4 + e] = b1[e]; } }
#define CV_UNPK(dst, raw) do { _Pragma("unroll") for (int e = 0; e < 4; ++e) { dst[2 * e] = __uint_as_float(raw[e] << 16); dst[2 * e + 1] = __uint_as_float(raw[e] & 0xffff0000u); } } while (0)
    { const unsigned short* hp = HALO + ((size_t)(unit * 2 + rh) * 3) * 2048 + col;
      const u32x4 h0 = *(const u32x4*)hp, h1 = *(const u32x4*)(hp + 2048), h2 = *(const u32x4*)(hp + 4096); CV_UNPK(r0, h0); CV_UNPK(r1, h1); CV_UNPK(r2, h2); }
    unsigned short* base = XBC + tb * 2048 + col;
    for (int i0 = 0; i0 < 64; i0 += 8) {
        u32x4 raw[8];
#pragma unroll
        for (int i = 0; i < 8; ++i) raw[i] = *(const u32x4*)(base + (size_t)(i0 + i) * 2048);
#pragma unroll
        for (int i = 0; i < 8; ++i) { float cur[8], val[8]; CV_UNPK(cur, raw[i]);
#pragma unroll
            for (int e = 0; e < 8; ++e) { const float v = cb[e] + cw[0][e] * r0[e] + cw[1][e] * r1[e] + cw[2][e] * r2[e] + cw[3][e] * cur[e];
                val[e] = v * __builtin_amdgcn_rcpf(1.0f + __expf(-v)); r0[e] = r1[e]; r1[e] = r2[e]; r2[e] = cur[e]; }
            u32x4 w; w.x = pk(val[0], val[1]); w.y = pk(val[2], val[3]); w.z = pk(val[4], val[5]); w.w = pk(val[6], val[7]);
            *(u32x4*)(base + (size_t)(i0 + i) * 2048) = w; }
    }
#undef CV_UNPK
}

__device__ __forceinline__ void ssd_unit(const unsigned short* XBC, unsigned short* AO, unsigned short* Yo, int ldy, const float* dt32, float* ssy,
                                         float a_log_h, float d_skip_h, int b, int h, char* lds, char* lds_small, const int tid_in) {
    int tid = tid_in; asm volatile("" : "+v"(tid)); const int wid = __builtin_amdgcn_readfirstlane(tid >> 6), lane = tid & 63, r32 = lane & 31, hi = lane >> 5;
    unsigned short* Cs = (unsigned short*)(lds + O_CS); unsigned short* Bs = (unsigned short*)(lds + O_BS); unsigned short* BwT = (unsigned short*)(lds + O_BWT);
    unsigned short* xT = (unsigned short*)(lds + O_XT); unsigned short* Sb = (unsigned short*)(lds + O_SB);
    unsigned short* Ms = Bs; unsigned short* Ys = Bs; unsigned short* Zs = Cs;
    float* cumL = (float*)lds_small; float* dtL = cumL + 128; float* wL = cumL + 256;
    const int g = h >> 2; const float Ah = -__expf(a_log_h);
    for (int i = tid; i < 64 * LD / 2; i += 512) ((unsigned*)Sb)[i] = 0u;
    f32x16 accS = {};
    const int li2 = wid & 3, pi = wid >> 2;
    const unsigned short* gB = XBC + 1024 + g * 128 + (tid & 15) * 8; const unsigned short* gC = XBC + 1536 + g * 128 + (tid & 15) * 8; const unsigned short* gX = XBC + h * 64 + (wid >> 2) * 32 + 8 * hi + (size_t)((wid & 3) * 32 + r32) * 2048;
    u32x4 tB[4], tC[4], tX[2], zreg[2]; float dtn = 0.f, dtn1 = 0.f;
#define SSD_FETCH(cc) do { const size_t tb_ = (size_t)b * SEQ + (size_t)(cc) * 128; \
        _Pragma("unroll") for (int i = 0; i < 4; ++i) { const size_t row = tb_ + (tid >> 4) + 32 * i; tB[i] = *(const u32x4*)(gB + row * 2048); tC[i] = *(const u32x4*)(gC + row * 2048); } \
        _Pragma("unroll") for (int i = 0; i < 2; ++i) { const size_t row = tb_ + (tid >> 3) + 64 * i; tX[i] = *(const u32x4*)(gX + tb_ * 2048 + 16 * i); \
            zreg[i] = *(const u32x4*)(AO + row * K_O_OUT + 512 + h * 64 + (tid & 7) * 8); } \
        if (wid == 0) { dtn = dt32[(tb_ + 2 * lane) * 16 + h]; dtn1 = dt32[(tb_ + 2 * lane + 1) * 16 + h]; } } while (0)
    bf16x8 idf[2];
#pragma unroll
    for (int s = 0; s < 2; ++s)
#pragma unroll
        for (int e = 0; e < 8; ++e) idf[s][e] = (16 * s + 8 * hi + e == r32) ? (short)0x3F80 : (short)0;
    SSD_FETCH(0);
    __syncthreads();
    for (int c = 0; c < SEQ / 128; ++c) {
        const size_t tb = (size_t)b * SEQ + (size_t)c * 128;
#ifndef SSD_RP1
#define SSD_RP1 1
#define SSD_RP2 1
#define SSD_RP3 1
#define SSD_RP5 1
#endif
        if (wid == 0) { const float d0 = dtn, d1 = dtn1; const float a0 = d0 * Ah, a1 = d1 * Ah; float inc = a0 + a1;
#pragma unroll
            for (int o = 1; o < 64; o <<= 1) { const float t = up_f(inc, o); if (lane >= o) inc += t; }
            const float c1 = inc, c0 = inc - a1; const float ce = __int_as_float(__builtin_amdgcn_readlane(__float_as_int(inc), 63));
            typedef float f32x2_ __attribute__((ext_vector_type(2)));
            *(f32x2_*)(dtL + 2 * lane) = (f32x2_){d0, d1}; *(f32x2_*)(cumL + 2 * lane) = (f32x2_){c0, c1};
            *(f32x2_*)(wL + 2 * lane) = (f32x2_){d0 * __expf(ce - c0), d1 * __expf(ce - c1)}; }
        __syncthreads();
        const float cend = cumL[127];
        for (int rp2 = 0; rp2 < SSD_RP2; ++rp2) {
#pragma unroll
        for (int i = 0; i < 4; ++i) { const int row = (tid >> 4) + 32 * i, c0 = (tid & 15) * 8; *(u32x4*)(Cs + row * LD + c0) = tC[i]; *(u32x4*)(Bs + row * LD + c0) = tB[i]; }
        }
        const bf16x8 xf0 = __builtin_bit_cast(bf16x8, tX[0]), xf1 = __builtin_bit_cast(bf16x8, tX[1]);
        u32x4 zcur[2] = {zreg[0], zreg[1]};
        if (c + 1 < SEQ / 128) SSD_FETCH(c + 1);
        __syncthreads();
        { const int lt = wid >> 1;
#pragma unroll
          for (int q2 = 0; q2 < 2; ++q2) { const int nt = 2 * (wid & 1) + q2; const unsigned short* tp = Bs + (lt * 32 + r32) * LD + nt * 32 + 8 * hi;
              f32x16 t = {}; t = __builtin_amdgcn_mfma_f32_32x32x16_bf16(*(const bf16x8*)tp, idf[0], t, 0, 0, 0); t = __builtin_amdgcn_mfma_f32_32x32x16_bf16(*(const bf16x8*)(tp + 16), idf[1], t, 0, 0, 0);
#pragma unroll
              for (int j = 0; j < 4; ++j) { const int l0 = lt * 32 + 8 * j + 4 * hi; const f32x4 w4 = *(const f32x4*)(wL + l0); float v[4];
#pragma unroll
                  for (int e = 0; e < 4; ++e) v[e] = t[4 * j + e] * w4[e];
                  u32x2 w; w.x = pk(v[0], v[1]); w.y = pk(v[2], v[3]); *(u32x2*)(BwT + (nt * 32 + r32) * LD + l0) = w; } }
          const int lx = wid & 3, pt = wid >> 2;
          f32x16 t = {}; t = __builtin_amdgcn_mfma_f32_32x32x16_bf16(xf0, idf[0], t, 0, 0, 0); t = __builtin_amdgcn_mfma_f32_32x32x16_bf16(xf1, idf[1], t, 0, 0, 0);
#pragma unroll
          for (int j = 0; j < 4; ++j) { u32x2 w; w.x = pk_v(t[4 * j], t[4 * j + 1]); w.y = pk_v(t[4 * j + 2], t[4 * j + 3]); *(u32x2*)(xT + (pt * 32 + r32) * LD + lx * 32 + 8 * j + 4 * hi) = w; } }
        unsigned mreg[2][8]; f32x16 accY = {};
        for (int rp3 = 0; rp3 < SSD_RP3; ++rp3) { accY = f32x16{};
        { const int li = wid >> 1; const int l = li * 32 + r32; const float cl = cumL[l];
#pragma unroll
          for (int q = 0; q < 2; ++q) { const int si = 2 * (wid & 1) + q;
              if (si <= li) { f32x16 acc = {}; acc = mma<8>(Bs + (si * 32 + r32) * LD, Cs + l * LD, acc, hi);
#pragma unroll
                  for (int j = 0; j < 4; ++j) { const int s0 = si * 32 + 8 * j + 4 * hi; const f32x4 cs4 = *(const f32x4*)(cumL + s0), dt4 = *(const f32x4*)(dtL + s0); float mv[4];
#pragma unroll
                      for (int e = 0; e < 4; ++e) { mv[e] = (s0 + e <= l) ? acc[4 * j + e] * __expf(cl - cs4[e]) * dt4[e] : 0.f; if (s0 + e == l) mv[e] += d_skip_h; }
                      mreg[q][2 * j] = pk(mv[0], mv[1]); mreg[q][2 * j + 1] = pk(mv[2], mv[3]); } }
              else {
#pragma unroll
                  for (int j = 0; j < 8; ++j) mreg[q][j] = 0u; } } }
        { const int l = li2 * 32 + r32; accY = mma<8>(Sb + (pi * 32 + r32) * LD, Cs + l * LD, accY, hi); const float el = __expf(cumL[l]);
#pragma unroll
          for (int r = 0; r < 16; ++r) accY[r] *= el; }
        }
        __syncthreads();
        { const int li = wid >> 1; const int l = li * 32 + r32;
#pragma unroll
          for (int q = 0; q < 2; ++q) { const int si = 2 * (wid & 1) + q;
#pragma unroll
              for (int j = 0; j < 4; ++j) { u32x2 w; w.x = mreg[q][2 * j]; w.y = mreg[q][2 * j + 1]; *(u32x2*)(Ms + l * LD + si * 32 + 8 * j + 4 * hi) = w; } } }
#pragma unroll
        for (int i = 0; i < 2; ++i) { const int row = (tid >> 3) + 64 * i, ch = tid & 7; *(u32x4*)(Zs + row * ZLD + ch * 8) = zcur[i]; }
        __syncthreads();
        unsigned yreg[8]; float ssq = 0.f;
        { const int l = li2 * 32 + r32;
          accY = mma<8>(xT + (pi * 32 + r32) * LD, Ms + l * LD, accY, hi);
          const float dec = __expf(cend);
#pragma unroll
          for (int r = 0; r < 16; ++r) accS[r] *= dec;
          accS = mma<8>(BwT + (li2 * 32 + r32) * LD, xT + (pi * 32 + r32) * LD, accS, hi);
#pragma unroll
          for (int j = 0; j < 4; ++j) { const int p0 = pi * 32 + 8 * j + 4 * hi; const u32x2 zz = *(const u32x2*)(Zs + l * ZLD + p0); float yg[4];
#pragma unroll
              for (int e = 0; e < 4; ++e) { const float y = accY[4 * j + e];
                  const float zv = (e & 1) ? __uint_as_float(zz[e >> 1] & 0xffff0000u) : __uint_as_float(zz[e >> 1] << 16);
                  yg[e] = y * siluf(zv); ssq += yg[e] * yg[e]; }
              yreg[2 * j] = pk(yg[0], yg[1]); yreg[2 * j + 1] = pk(yg[2], yg[3]); }
          ssq += xor_f<32>(ssq);
          if (hi == 0) ssy[(tb + l) * 32 + h * 2 + pi] = ssq; }
        __syncthreads();
        { const int l = li2 * 32 + r32;
#pragma unroll
          for (int j = 0; j < 4; ++j) { u32x2 w; w.x = yreg[2 * j]; w.y = yreg[2 * j + 1]; *(u32x2*)(Ys + l * ZLD + pi * 32 + 8 * j + 4 * hi) = w; }
          const int p = pi * 32 + r32;
#pragma unroll
          for (int j = 0; j < 4; ++j) { u32x2 w; w.x = pk(accS[4 * j], accS[4 * j + 1]); w.y = pk(accS[4 * j + 2], accS[4 * j + 3]); *(u32x2*)(Sb + p * LD + li2 * 32 + 8 * j + 4 * hi) = w; } }
        __syncthreads();
#pragma unroll
        for (int i = 0; i < 2; ++i) { const int idx = tid + 512 * i, row = idx >> 3, ch = idx & 7; *(u32x4*)(Yo + (tb + row) * ldy + h * 64 + ch * 8) = *(const u32x4*)(Ys + row * ZLD + ch * 8); }
    }
    __syncthreads();
#undef SSD_FETCH
}
}

constexpr int NWAVES = 8;
#ifndef EN_MASK
#define EN_MASK 0xFFFF
#endif
#ifndef REP_MASK
#define REP_MASK 0
#endif
#define REPS(b) ((((REP_MASK) >> (b)) & 1) + 1)
#define EN(b) (((EN_MASK) >> (b)) & 1)
struct Args {
    const float* in[28]; float* out; unsigned char* ws; int ph_lo, ph_hi;
};
struct Frame {
    LAS unsigned char* lds; volatile LAS unsigned* MISC; gu32* ctl; int tid, lane, wave, G;
};
typedef pg8::bf16_t bf16_t;

enum { MAP_ID = 0, MAP_EVEN_IN = 1, MAP_ODD_IN = 2, MAP_UQ = 3 };
__device__ __forceinline__ int colmap(int map, int n) {
    if (map == MAP_EVEN_IN) { if (n < 1352) return n; if (n < 1356) return 2888 + (n - 1352); if (n < 1536) return -1; return 1352 + (n - 1536); }
    if (map == MAP_ODD_IN) { if (n < 640) return n; if (n < 704) { const int jj = n - 640; return 640 + ((jj & 1) ? 32 : 0) + (jj >> 1); } if (n < 720) return 3776 + (n - 704); if (n < 768) return -1; return 704 + (n - 768); }
    if (map == MAP_UQ) { const int h = n >> 8, j = n & 255; if (j < 128) return 192 * h + j; if (j < 192) { const int jj = j - 128; return 192 * h + 128 + ((jj & 1) ? 32 : 0) + (jj >> 1); } return -1; }
    return n;
}
struct WJob { const float* W; bf16* dst; const float* gain; int K, Nsrc, Ndst, map, gk0; };
__device__ __forceinline__ void wconv_item(const WJob& J, LAS float* scr, int item, int lane) {
    const int nblk = J.Ndst / 32, kb = item / nblk, nb = item % nblk, k0 = 64 * kb, n0 = 32 * nb;
    const int sc = colmap(J.map, n0 + (lane & 31));
    float wv_[32];
#pragma unroll
    for (int i = 0; i < 32; ++i) { const int kk = 2 * i + (lane >> 5); wv_[i] = (sc >= 0) ? J.W[(size_t)(k0 + kk) * J.Nsrc + sc] : 0.f; }
#pragma unroll
    for (int i = 0; i < 32; ++i) { const int kk = 2 * i + (lane >> 5); float v = wv_[i];
        if (J.gain && (k0 + kk) >= J.gk0) v *= J.gain[k0 + kk - J.gk0];
        scr[kk * 33 + (lane & 31)] = v; }
    LDS_WAIT(); asm volatile("" ::: "memory");
    const int c = lane & 7;
#pragma unroll
    for (int j = 0; j < 4; ++j) { const int n = (lane >> 3) + 8 * j; const LAS float* s = scr + (8 * c) * 33 + n;
        v4u o; o.x = pk2(s[0 * 33], s[1 * 33]); o.y = pk2(s[2 * 33], s[3 * 33]); o.z = pk2(s[4 * 33], s[5 * 33]); o.w = pk2(s[6 * 33], s[7 * 33]);
        *(GAS v4u*)(J.dst + (size_t)(n0 + n) * J.K + k0 + 8 * c) = o; }
    LDS_WAIT(); asm volatile("" ::: "memory");
}
__device__ __forceinline__ float wave_sum(float v) { return wsum_f(v); }

__global__ void __launch_bounds__(NWAVES * 64, 2) trunk_fwd(Args args) {
    extern __shared__ __attribute__((aligned(16))) unsigned char lds[];
    {
        LAS unsigned char* L0 = (LAS unsigned char*)lds; const int t0 = threadIdx.x;
        for (int u = t0; u < (LDS_BYTES - LDS_MISC) / 4; u += NWAVES * 64) ((LAS unsigned*)(L0 + LDS_MISC))[u] = 0u;
        __syncthreads();
        volatile LAS unsigned* pt0 = (volatile LAS unsigned*)(L0 + LDS_MISC + 128);
        if (t0 < 30) { const unsigned long long p = (t0 < 28) ? (unsigned long long)args.in[t0] : (t0 == 28 ? (unsigned long long)args.out : (unsigned long long)args.ws);
            pt0[2 * t0] = (unsigned)p; pt0[2 * t0 + 1] = (unsigned)(p >> 32); }
        __syncthreads();
    }
    const int wave_s = __builtin_amdgcn_readfirstlane((int)(threadIdx.x >> 6));
#define PTR(k) ((const float*)(const GAS float*)(((unsigned long long)(unsigned)__builtin_amdgcn_readfirstlane((int)ptab[2 * (k) + 1]) << 32) | (unsigned long long)(unsigned)__builtin_amdgcn_readfirstlane((int)ptab[2 * (k)])))
    XcdBarrier bar = xcd_barrier_post((unsigned*)((gu32*)(args.ws + WS_CTL) + CW_BAR), (volatile LAS unsigned*)((LAS unsigned char*)lds + LDS_MISC) + 8, otid(wave_s));
    const int lo = args.ph_lo, hi = args.ph_hi;
#define IN(k) (lo <= (k) && (k) < hi)
#if defined(TPROF)
#define TSTAMP(i) do { if (blockIdx.x == 0 && threadIdx.x == 0) ((volatile LAS unsigned*)((LAS unsigned char*)lds + LDS_MISC + 384))[(i)] = (unsigned)__builtin_amdgcn_s_memrealtime(); } while (0)
#else
#define TSTAMP(i) do { } while (0)
#endif
#define SEAM2(k, kn) do { if (IN(k) && IN(kn)) xcd_barrier(bar, otid(wave_s)); TSTAMP((k) + 1); } while (0)
#define SEAM(k) SEAM2(k, (k) + 1)
    TSTAMP(0);
#define ENV_NOLAYER() \
        LAS unsigned char* L_ = (LAS unsigned char*)lds; asm volatile("" : "+s"(L_)); \
        int bid = blockIdx.x; asm volatile("" : "+s"(bid)); int GG = gridDim.x; asm volatile("" : "+s"(GG)); \
        const int tid = otid(wave_s); \
        volatile LAS unsigned* ptab = (volatile LAS unsigned*)(L_ + LDS_MISC + 128); \
        unsigned char* ws = (unsigned char*)PTR(29); float* out = (float*)PTR(28);
#define ENV() \
        LAS unsigned char* L_ = (LAS unsigned char*)lds; asm volatile("" : "+s"(L_)); \
        int bid = blockIdx.x; asm volatile("" : "+s"(bid)); int GG = gridDim.x; asm volatile("" : "+s"(GG)); \
        const int tid = otid(wave_s); const int lane = tid & 63; const int wave = __builtin_amdgcn_readfirstlane(tid >> 6); (void)lane; (void)wave; (void)bid; (void)GG; \
        char* glds = (char*)L_; PG8_LAS float* stat = (PG8_LAS float*)(L_ + LDS_STAT); volatile LAS unsigned* MISCp = (volatile LAS unsigned*)(L_ + LDS_MISC); \
        volatile LAS unsigned* ptab = (volatile LAS unsigned*)(L_ + LDS_MISC + 128); (void)glds; (void)stat; (void)MISCp; \
        unsigned char* ws = (unsigned char*)PTR(29); float* out = (float*)PTR(28); gu32* ctl = (gu32*)(ws + WS_CTL); (void)out; (void)ctl; \
        float* ssp = (float*)(ws + WS_SSP); float* cumb = (float*)(ws + WS_CUMB); float* misc32 = (float*)(ws + WS_MISC32); float* gss = (float*)(ws + WS_GSS); \
        float* ssy = (float*)(ws + WS_SSY); float* rope = (float*)(ws + WS_ROPE); unsigned long long* BM = (unsigned long long*)(ws + WS_BM); \
        bf16* XB = (bf16*)(ws + WS_XB); bf16* QB = (bf16*)out; \
        bf16* EP = (bf16*)(ws + WS_R + R_EP); bf16* AOE = (bf16*)(ws + WS_R + R_AOE); \
        bf16* C1 = (bf16*)(ws + WS_R + R_C1); bf16* AO = (bf16*)(ws + WS_R + R_AO); bf16* XBC = (bf16*)(ws + WS_R + R_XBC); bf16* KK = (bf16*)(ws + WS_R + R_KK); bf16* VV = (bf16*)(ws + WS_R + R_VV); \
        bf16* HB = (bf16*)(ws + WS_R + R_H); unsigned char* wsw = ws + WS_W; \
        const bf16* W1t = (const bf16*)(wsw + ((layer & 1) ? WO_1 : WE_1)); const bf16* W2t = (const bf16*)(wsw + ((layer & 1) ? WO_2 : WE_2)); \
        (void)ssp; (void)cumb; (void)misc32; (void)gss; (void)ssy; (void)rope; (void)BM; (void)XB; (void)QB; (void)EP; (void)AOE; (void)C1; (void)AO; (void)XBC; (void)KK; (void)VV; (void)HB; (void)W1t; (void)W2t;

    {
        constexpr int layer = 0;
        const int li = layer >> 1; const int gp0 = layer * 8;
        if ((layer & 1) == 0) {
            for (int rep = 0; rep < REPS(0); ++rep) { if (rep) xcd_barrier(bar, otid(wave_s));
            if (EN(0) && IN(gp0 + 0)) { ENV();
                LAS float* scr = (LAS float*)(L_ + wave * 16384);
                const int gw = bid * NWAVES + wave, NGW = GG * NWAVES;
                int it = gw;
#define WJOB(Wp, dstp, gainp, K_, Nsrc_, Ndst_, map_, gk0_) do { const WJob J_{Wp, dstp, gainp, K_, Nsrc_, Ndst_, map_, gk0_}; const int nit_ = ((K_) / 64) * ((Ndst_) / 32); \
                    for (; it < nit_; it += NGW) wconv_item(J_, scr, it, lane); it -= nit_; } while (0)
                WJOB(PTR(3) + (size_t)li * 1024 * 2892, (bf16*)(wsw + WE_IN), PTR(2) + li * 1024, 1024, 2892, 3072, MAP_EVEN_IN, 0);
                WJOB(PTR(9) + (size_t)li * 1024 * 1024, (bf16*)(wsw + WE_OUT), (const float*)nullptr, 1024, 1024, 1024, MAP_ID, 0);
                WJOB(PTR(26) + (size_t)(2 * li) * 1024 * 4096, (bf16*)(wsw + WE_1), PTR(25) + (2 * li) * 1024, 1024, 4096, 4096, MAP_ID, 0);
                WJOB(PTR(27) + (size_t)(2 * li) * 4096 * 1024, (bf16*)(wsw + WE_2), (const float*)nullptr, 4096, 1024, 1024, MAP_ID, 0);
                WJOB(PTR(11) + (size_t)li * 1024 * 3792, (bf16*)(wsw + WO_IN), PTR(10) + li * 1024, 1024, 3792, 3840, MAP_ODD_IN, 0);
                WJOB(PTR(14) + (size_t)li * 384 * 768, (bf16*)(wsw + WO_UQ), PTR(12) + li * 384, 384, 768, 1024, MAP_UQ, 0);
                WJOB(PTR(15) + (size_t)li * 256 * 1024, (bf16*)(wsw + WO_UKV), PTR(13) + li * 256, 256, 1024, 1024, MAP_ID, 0);
                WJOB(PTR(24) + (size_t)li * 1536 * 1024, (bf16*)(wsw + WO_OUT), PTR(23) + li * 1024, 1536, 1024, 1024, MAP_ID, 512);
                WJOB(PTR(26) + (size_t)(2 * li + 1) * 1024 * 4096, (bf16*)(wsw + WO_1), PTR(25) + (2 * li + 1) * 1024, 1024, 4096, 4096, MAP_ID, 0);
                WJOB(PTR(27) + (size_t)(2 * li + 1) * 4096 * 1024, (bf16*)(wsw + WO_2), (const float*)nullptr, 4096, 1024, 1024, MAP_ID, 0);
#undef WJOB
                if (layer == 0) { const float* x_in = PTR(0); const int* positions = (const int*)PTR(1);
                    for (int m0 = gw; m0 < MTOK; m0 += 2 * NGW) {
                        const int m1 = m0 + NGW; const bool two = m1 < MTOK;
                        const GAS f32x4* xa = (const GAS f32x4*)(x_in + (size_t)m0 * DM) + lane; const GAS f32x4* xb2 = (const GAS f32x4*)(x_in + (size_t)(two ? m1 : m0) * DM) + lane; f32x4 va[4], vb[4]; float sa = 0.f, sb = 0.f;
#pragma unroll
                        for (int j = 0; j < 4; ++j) { va[j] = xa[64 * j]; vb[j] = xb2[64 * j]; }
#pragma unroll
                        for (int j = 0; j < 4; ++j) { sa += (va[j].x * va[j].x + va[j].y * va[j].y) + (va[j].z * va[j].z + va[j].w * va[j].w); sb += (vb[j].x * vb[j].x + vb[j].y * vb[j].y) + (vb[j].z * vb[j].z + vb[j].w * vb[j].w); }
                        sa = wave_sum(sa); sb = wave_sum(sb);
                        GAS unsigned long long* oa = (GAS unsigned long long*)(XB + (size_t)m0 * DM) + lane;
#pragma unroll
                        for (int j = 0; j < 4; ++j) oa[64 * j] = (unsigned long long)pk2(va[j].x, va[j].y) | ((unsigned long long)pk2(va[j].z, va[j].w) << 32);
                        if (lane < 4) ssp[(size_t)lane * MTOK + m0] = (lane == 0) ? sa : 0.f;
                        if (two) { GAS unsigned long long* ob = (GAS unsigned long long*)(XB + (size_t)m1 * DM) + lane;
#pragma unroll
                            for (int j = 0; j < 4; ++j) ob[64 * j] = (unsigned long long)pk2(vb[j].x, vb[j].y) | ((unsigned long long)pk2(vb[j].z, vb[j].w) << 32);
                            if (lane < 4) ssp[(size_t)lane * MTOK + m1] = (lane == 0) ? sb : 0.f; }
                    }
                    for (int idx = bid * 512 + tid; idx < MTOK * 32; idx += GG * 512) { const int tok = idx >> 5, i = idx & 31;
                        const float inv = powf(10000.0f, -(float)i / 32.0f); const float ang = (float)positions[tok] * inv; const float sn = sinf(ang), cs = cosf(ang);
                        rope[(size_t)idx * 2] = cs; rope[(size_t)idx * 2 + 1] = sn; }
                }
            }
            }
            SEAM(gp0 + 0);
            for (int rep = 0; rep < REPS(1); ++rep) { if (rep) xcd_barrier(bar, otid(wave_s));
            if (EN(1) && IN(gp0 + 1)) { ENV();
                pg8::Gemm g{XB, (const bf16*)(wsw + WE_IN), MTOK, N_E_IN, DM, DM}; pg8::StaticOrder S; S.init(MTOK, N_E_IN, GG, bid);
                pg8::EpiEvenIn E{EP, ssp, misc32, PTR(5) + li * 128, PTR(6) + li * 128, PTR(7) + li * 128, PTR(8) + li * 128, PTR(4) + li * 4, stat};
                pg8::gemm_phase<pg8::EpiEvenIn, pg8::StaticOrder, true, true>(L_, g, S, E, tid);
            }
            }
            SEAM(gp0 + 1);
            for (int rep = 0; rep < REPS(2); ++rep) { if (rep) xcd_barrier(bar, otid(wave_s));
            if (EN(2) && IN(gp0 + 2)) { ENV();
                if (bid < 32) tk::cumsum_unit(misc32, cumb, bid >> 2, bid & 3, glds, tid);
#if defined(TKS_CHECK)
                for (int v = bid; v < 4096; v += GG) tk::topk_unit(EP, misc32, BM, v & 7, 511 - (v >> 3), glds, glds + LDS_STAT, glds + LDS_FAC, tid);
                __syncthreads();
#define TKR_DST ((unsigned long long*)out)
#else
#define TKR_DST BM
#endif
                { gu32* qh2 = ctl + CW_QUEUE + 8192 + 64 * layer;
                  int v = bid;
                  for (;;) {
                    if (v >= 2048) break;
                    tkr::regsel_unit(EP, misc32, TKR_DST, v & 7, 255 - (v >> 3), glds, glds + LDS_STAT, glds + LDS_FAC, tid);
                    if (tid == 0) MISCp[4] = __hip_atomic_fetch_add(qh2, 1u, RLX_AGENT);
                    __syncthreads();
                    v = GG + (int)MISCp[4];
                    __syncthreads(); } }
#undef TKR_DST
            }
            }
#if defined(TKS_CHECK)
            if (IN(gp0 + 2)) { xcd_barrier(bar, otid(wave_s)); { ENV();
                unsigned bad = 0u; const unsigned long long* B2 = (const unsigned long long*)out;
                for (size_t i = (size_t)bid * 512 + tid; i < (size_t)MTOK * 64; i += (size_t)GG * 512) bad += (BM[i] != B2[i]) ? 1u : 0u;
                if (bad) __hip_atomic_fetch_add(ctl + 2048, bad, RLX_AGENT); } }
#endif
            SEAM(gp0 + 2);
            for (int rep = 0; rep < REPS(3); ++rep) { if (rep) xcd_barrier(bar, otid(wave_s));
            if (IN(gp0 + 3)) { ENV();
                gu32* qh = ctl + CW_QUEUE + 64 * (layer * 4 + 1 + 2 * rep);
                for (;;) {
                    if (tid == 0) MISCp[4] = __hip_atomic_fetch_add(qh, 1u, RLX_AGENT);
                    __syncthreads();
                    const int u = (int)MISCp[4];
                    if (u >= 1024) break;
                    const int i = u >> 1; att::UnitArgs a;
                    if ((u & 1) == 0) { if (EN(3) && !(rep == 1 && ((REP_MASK >> 18) & 1))) {
                        const int qb = 15 - (i >> 5), bh = i & 31, b = bh >> 2, h = bh & 3; const size_t r0 = (size_t)b * SEQ + qb * 256 + 32 * wave;
                        a.Q = EP + r0 * N_E_IN + 1536 + 128 * h; a.ldq = N_E_IN; a.K = EP + (size_t)b * SEQ * N_E_IN + 2048 + 128 * h; a.ldk = N_E_IN; a.V = EP + (size_t)b * SEQ * N_E_IN + 2560 + 128 * h; a.ldv = N_E_IN;
                        a.O = AOE + r0 * DM + 512 + 128 * h; a.ldo = DM; a.qlo = qb * 256 + 32 * wave; a.NT = 4 * (qb + 1); a.kbias = cumb + (size_t)h * MTOK + (size_t)b * SEQ; a.bm = nullptr; a.tid = tid; a.gq = PTR(7) + li * 128; a.gk = PTR(8) + li * 128;
                        att::attn_unit<128, 1>(a, glds); }
                    } else if (EN(4) && !(rep == 1 && ((REP_MASK >> 19) & 1))) {
                        const int j = 63 - (i >> 3), b = i & 7, head = wave >> 1, sub = wave & 1; const size_t r0 = (size_t)b * SEQ + j * 64 + 32 * sub;
                        a.Q = EP + r0 * N_E_IN + 128 * head; a.ldq = N_E_IN; a.K = EP + (size_t)b * SEQ * N_E_IN + 512; a.ldk = N_E_IN; a.V = EP + (size_t)b * SEQ * N_E_IN + 640; a.ldv = N_E_IN;
                        a.O = AOE + r0 * DM + 128 * head; a.ldo = DM; a.qlo = j * 64 + 32 * sub; a.NT = j + 1; a.kbias = nullptr; a.bm = BM + r0 * 64; a.tid = tid; a.gq = PTR(5) + li * 128; a.gk = PTR(6) + li * 128;
                        att::attn_unit<128, 2>(a, glds);
                    }
                }
            }
            }
            SEAM(gp0 + 3);
            if (EN(5) && IN(gp0 + 4)) { ENV();
                pg8::Gemm g{AOE, (const bf16*)(wsw + WE_OUT), MTOK, DM, DM, DM}; pg8::StaticOrder S; S.init(MTOK, DM, GG, bid);
                pg8::EpiResid E{XB, ssp, stat, (float*)nullptr};
                pg8::gemm_phase<pg8::EpiResid, pg8::StaticOrder, true, true>(L_, g, S, E, tid);
            }
            SEAM2(gp0 + 4, gp0 + 6);
        } else {
            for (int rep = 0; rep < REPS(6); ++rep) { if (rep) xcd_barrier(bar, otid(wave_s));
            if (EN(6) && IN(gp0 + 0)) { ENV();
                pg8::Gemm g{XB, (const bf16*)(wsw + WO_IN), MTOK, N_O_IN, DM, DM}; pg8::StaticOrder S; S.init(MTOK, N_O_IN, GG, bid);
                pg8::EpiOddIn E{C1, AO, XBC, ssp, gss, misc32, PTR(20) + li * 16, stat};
                pg8::gemm_phase<pg8::EpiOddIn, pg8::StaticOrder, true, true>(L_, g, S, E, tid);
            }
            }
            SEAM(gp0 + 0);
            for (int rep = 0; rep < REPS(7); ++rep) { if (rep) xcd_barrier(bar, otid(wave_s));
            if (EN(7) && IN(gp0 + 1)) { ENV();
                if (rep == 0) for (int u = bid; u < 256; u += GG) ssd::conv_halo_save(XBC, (bf16*)(ws + WS_BM), u, tid);
                if (EN(12)) { pg8::Gemm g{C1, (const bf16*)(wsw + WO_UQ), MTOK, 1024, 384, 768}; pg8::StaticOrder S; S.init(MTOK, 1024, GG, bid);
                  pg8::EpiUq E{QB, gss, PTR(16) + li * 192, rope, stat};
                  pg8::gemm_phase<pg8::EpiUq, pg8::StaticOrder, true, true>(L_, g, S, E, tid); }
                if (EN(13)) { pg8::Gemm g{C1 + 384, (const bf16*)(wsw + WO_UKV), MTOK, 1024, 256, 768}; pg8::StaticOrder S; S.init(MTOK, 1024, GG, bid);
                  pg8::EpiUkv E{KK, VV, C1, gss, PTR(17) + li * 192, rope, stat};
                  pg8::gemm_phase<pg8::EpiUkv, pg8::StaticOrder, true, true>(L_, g, S, E, tid); }
            }
            }
            SEAM(gp0 + 1);
            if (IN(gp0 + 2)) { ENV();
                for (int u = bid; u < 256; u += GG) ssd::conv_unit(XBC, (const bf16*)(ws + WS_BM), PTR(18) + (size_t)li * 4 * 2048, PTR(19) + li * 2048, u, tid);
            }
            SEAM(gp0 + 2);
            for (int rep = 0; rep < REPS(9); ++rep) { if (rep) xcd_barrier(bar, otid(wave_s));
            if (IN(gp0 + 3)) { ENV();
                gu32* qh = ctl + CW_QUEUE + 64 * (layer * 4 + 0 + 2 * rep);
                for (;;) {
                    if (tid == 0) MISCp[4] = __hip_atomic_fetch_add(qh, 1u, RLX_AGENT);
                    __syncthreads();
                    const int u = (int)MISCp[4];
                    if (u >= 128 + 512) break;
                    if (u < 128) { if (EN(8) && rep == 0) { const int b = u >> 4, h = u & 15;
                        ssd::ssd_unit(XBC, AO, AO + 512, K_O_OUT, misc32, ssy, PTR(21)[li * 16 + h], PTR(22)[li * 16 + h], b, h, glds, glds + LDS_STAT, tid); }
                    } else if (EN(9)) { const int i = u - 128; const int qb = 15 - (i >> 5), bh = i & 31, b = bh >> 2, h = bh & 3; const size_t r0 = (size_t)b * SEQ + qb * 256 + 32 * wave; att::UnitArgs a;
                        a.Q = QB + r0 * 768 + 192 * h; a.ldq = 768; a.K = KK + (size_t)b * SEQ * 768 + 192 * h; a.ldk = 768; a.V = VV + (size_t)b * SEQ * 512 + 128 * h; a.ldv = 512;
                        a.O = AO + r0 * K_O_OUT + 128 * h; a.ldo = K_O_OUT; a.qlo = qb * 256 + 32 * wave; a.NT = 4 * (qb + 1); a.kbias = nullptr; a.bm = nullptr; a.tid = tid; a.gq = PTR(16) + li * 192; a.gk = PTR(17) + li * 192;
                        att::attn_unit<192, 0>(a, glds);
                    }
                }
            }
            }
#if defined(PROBE_SSD)
            if (IN(gp0 + 3)) { xcd_barrier(bar, otid(wave_s)); { ENV();
                for (int u = bid; u < 128; u += GG) { const int b = u >> 4, h = u & 15;
                    ssd::ssd_unit(XBC, AO, (bf16*)out + (size_t)24 * 1024 * 1024, 1024, misc32, (float*)(ws + WS_BM), PTR(21)[li * 16 + h], PTR(22)[li * 16 + h], b, h, glds, glds + LDS_STAT, tid); } } }
#endif
            SEAM2(gp0 + 3, gp0 + 5);
            if (EN(5) && IN(gp0 + 5)) { ENV();
                pg8::Gemm g{AO, (const bf16*)(wsw + WO_OUT), MTOK, DM, K_O_OUT, K_O_OUT}; pg8::StaticOrder S; S.init(MTOK, DM, GG, bid);
                pg8::EpiResid E{XB, ssp, stat, (float*)nullptr};
                const pg8::GroupScaleHook HK{ssy, (PG8_LAS float*)(L_ + LDS_FAC)};
                pg8::gemm_phase<pg8::EpiResid, pg8::StaticOrder, true, true, pg8::GroupScaleHook>(L_, g, S, E, tid, HK);
            }
            SEAM(gp0 + 5);
        }
        for (int rep = 0; rep < REPS(5); ++rep) { if (rep) xcd_barrier(bar, otid(wave_s));
        if (EN(11) && IN(gp0 + 6)) { ENV();
            pg8::Gemm g{XB, W1t, MTOK, DFF, DM, DM}; pg8::StaticOrder S; S.init(MTOK, DFF, GG, bid);
            pg8::EpiMlpUp E{HB, ssp};
            pg8::gemm_phase<pg8::EpiMlpUp, pg8::StaticOrder, true, true>(L_, g, S, E, tid);
        }
        }
        SEAM(gp0 + 6);
        if (EN(5) && IN(gp0 + 7)) { ENV();
            pg8::Gemm g{HB, W2t, MTOK, DM, DFF, DFF}; pg8::StaticOrder S; S.init(MTOK, DM, GG, bid);
            pg8::EpiResid E{XB, ssp, stat, layer == 3 ? out : (float*)nullptr};
            pg8::gemm_phase<pg8::EpiResid, pg8::StaticOrder, true, true>(L_, g, S, E, tid);
        }
        if (layer < 3) SEAM(gp0 + 7);
    }
    {
        constexpr int layer = 1;
        const int li = layer >> 1; const int gp0 = layer * 8;
        if ((layer & 1) == 0) {
            for (int rep = 0; rep < REPS(0); ++rep) { if (rep) xcd_barrier(bar, otid(wave_s));
            if (EN(0) && IN(gp0 + 0)) { ENV();
                LAS float* scr = (LAS float*)(L_ + wave * 16384);
                const int gw = bid * NWAVES + wave, NGW = GG * NWAVES;
                int it = gw;
#define WJOB(Wp, dstp, gainp, K_, Nsrc_, Ndst_, map_, gk0_) do { const WJob J_{Wp, dstp, gainp, K_, Nsrc_, Ndst_, map_, gk0_}; const int nit_ = ((K_) / 64) * ((Ndst_) / 32); \
                    for (; it < nit_; it += NGW) wconv_item(J_, scr, it, lane); it -= nit_; } while (0)
                WJOB(PTR(3) + (size_t)li * 1024 * 2892, (bf16*)(wsw + WE_IN), PTR(2) + li * 1024, 1024, 2892, 3072, MAP_EVEN_IN, 0);
                WJOB(PTR(9) + (size_t)li * 1024 * 1024, (bf16*)(wsw + WE_OUT), (const float*)nullptr, 1024, 1024, 1024, MAP_ID, 0);
                WJOB(PTR(26) + (size_t)(2 * li) * 1024 * 4096, (bf16*)(wsw + WE_1), PTR(25) + (2 * li) * 1024, 1024, 4096, 4096, MAP_ID, 0);
                WJOB(PTR(27) + (size_t)(2 * li) * 4096 * 1024, (bf16*)(wsw + WE_2), (const float*)nullptr, 4096, 1024, 1024, MAP_ID, 0);
                WJOB(PTR(11) + (size_t)li * 1024 * 3792, (bf16*)(wsw + WO_IN), PTR(10) + li * 1024, 1024, 3792, 3840, MAP_ODD_IN, 0);
                WJOB(PTR(14) + (size_t)li * 384 * 768, (bf16*)(wsw + WO_UQ), PTR(12) + li * 384, 384, 768, 1024, MAP_UQ, 0);
                WJOB(PTR(15) + (size_t)li * 256 * 1024, (bf16*)(wsw + WO_UKV), PTR(13) + li * 256, 256, 1024, 1024, MAP_ID, 0);
                WJOB(PTR(24) + (size_t)li * 1536 * 1024, (bf16*)(wsw + WO_OUT), PTR(23) + li * 1024, 1536, 1024, 1024, MAP_ID, 512);
                WJOB(PTR(26) + (size_t)(2 * li + 1) * 1024 * 4096, (bf16*)(wsw + WO_1), PTR(25) + (2 * li + 1) * 1024, 1024, 4096, 4096, MAP_ID, 0);
                WJOB(PTR(27) + (size_t)(2 * li + 1) * 4096 * 1024, (bf16*)(wsw + WO_2), (const float*)nullptr, 4096, 1024, 1024, MAP_ID, 0);
#undef WJOB
                if (layer == 0) { const float* x_in = PTR(0); const int* positions = (const int*)PTR(1);
                    for (int m0 = gw; m0 < MTOK; m0 += 2 * NGW) {
                        const int m1 = m0 + NGW; const bool two = m1 < MTOK;
                        const GAS f32x4* xa = (const GAS f32x4*)(x_in + (size_t)m0 * DM) + lane; const GAS f32x4* xb2 = (const GAS f32x4*)(x_in + (size_t)(two ? m1 : m0) * DM) + lane; f32x4 va[4], vb[4]; float sa = 0.f, sb = 0.f;
#pragma unroll
                        for (int j = 0; j < 4; ++j) { va[j] = xa[64 * j]; vb[j] = xb2[64 * j]; }
#pragma unroll
                        for (int j = 0; j < 4; ++j) { sa += (va[j].x * va[j].x + va[j].y * va[j].y) + (va[j].z * va[j].z + va[j].w * va[j].w); sb += (vb[j].x * vb[j].x + vb[j].y * vb[j].y) + (vb[j].z * vb[j].z + vb[j].w * vb[j].w); }
                        sa = wave_sum(sa); sb = wave_sum(sb);
                        GAS unsigned long long* oa = (GAS unsigned long long*)(XB + (size_t)m0 * DM) + lane;
#pragma unroll
                        for (int j = 0; j < 4; ++j) oa[64 * j] = (unsigned long long)pk2(va[j].x, va[j].y) | ((unsigned long long)pk2(va[j].z, va[j].w) << 32);
                        if (lane < 4) ssp[(size_t)lane * MTOK + m0] = (lane == 0) ? sa : 0.f;
                        if (two) { GAS unsigned long long* ob = (GAS unsigned long long*)(XB + (size_t)m1 * DM) + lane;
#pragma unroll
                            for (int j = 0; j < 4; ++j) ob[64 * j] = (unsigned long long)pk2(vb[j].x, vb[j].y) | ((unsigned long long)pk2(vb[j].z, vb[j].w) << 32);
                            if (lane < 4) ssp[(size_t)lane * MTOK + m1] = (lane == 0) ? sb : 0.f; }
                    }
                    for (int idx = bid * 512 + tid; idx < MTOK * 32; idx += GG * 512) { const int tok = idx >> 5, i = idx & 31;
                        const float inv = powf(10000.0f, -(float)i / 32.0f); const float ang = (float)positions[tok] * inv; const float sn = sinf(ang), cs = cosf(ang);
                        rope[(size_t)idx * 2] = cs; rope[(size_t)idx * 2 + 1] = sn; }
                }
            }
            }
            SEAM(gp0 + 0);
            for (int rep = 0; rep < REPS(1); ++rep) { if (rep) xcd_barrier(bar, otid(wave_s));
            if (EN(1) && IN(gp0 + 1)) { ENV();
                pg8::Gemm g{XB, (const bf16*)(wsw + WE_IN), MTOK, N_E_IN, DM, DM}; pg8::StaticOrder S; S.init(MTOK, N_E_IN, GG, bid);
                pg8::EpiEvenIn E{EP, ssp, misc32, PTR(5) + li * 128, PTR(6) + li * 128, PTR(7) + li * 128, PTR(8) + li * 128, PTR(4) + li * 4, stat};
                pg8::gemm_phase<pg8::EpiEvenIn, pg8::StaticOrder, true, true>(L_, g, S, E, tid);
            }
            }
            SEAM(gp0 + 1);
            for (int rep = 0; rep < REPS(2); ++rep) { if (rep) xcd_barrier(bar, otid(wave_s));
            if (EN(2) && IN(gp0 + 2)) { ENV();
                if (bid < 32) tk::cumsum_unit(misc32, cumb, bid >> 2, bid & 3, glds, tid);
#if defined(TKS_CHECK)
                for (int v = bid; v < 4096; v += GG) tk::topk_unit(EP, misc32, BM, v & 7, 511 - (v >> 3), glds, glds + LDS_STAT, glds + LDS_FAC, tid);
                __syncthreads();
#define TKR_DST ((unsigned long long*)out)
#else
#define TKR_DST BM
#endif
                { gu32* qh2 = ctl + CW_QUEUE + 8192 + 64 * layer;
                  int v = bid;
                  for (;;) {
                    if (v >= 2048) break;
                    tkr::regsel_unit(EP, misc32, TKR_DST, v & 7, 255 - (v >> 3), glds, glds + LDS_STAT, glds + LDS_FAC, tid);
                    if (tid == 0) MISCp[4] = __hip_atomic_fetch_add(qh2, 1u, RLX_AGENT);
                    __syncthreads();
                    v = GG + (int)MISCp[4];
                    __syncthreads(); } }
#undef TKR_DST
            }
            }
#if defined(TKS_CHECK)
            if (IN(gp0 + 2)) { xcd_barrier(bar, otid(wave_s)); { ENV();
                unsigned bad = 0u; const unsigned long long* B2 = (const unsigned long long*)out;
                for (size_t i = (size_t)bid * 512 + tid; i < (size_t)MTOK * 64; i += (size_t)GG * 512) bad += (BM[i] != B2[i]) ? 1u : 0u;
                if (bad) __hip_atomic_fetch_add(ctl + 2048, bad, RLX_AGENT); } }
#endif
            SEAM(gp0 + 2);
            for (int rep = 0; rep < REPS(3); ++rep) { if (rep) xcd_barrier(bar, otid(wave_s));
            if (IN(gp0 + 3)) { ENV();
                gu32* qh = ctl + CW_QUEUE + 64 * (layer * 4 + 1 + 2 * rep);
                for (;;) {
                    if (tid == 0) MISCp[4] = __hip_atomic_fetch_add(qh, 1u, RLX_AGENT);
                    __syncthreads();
                    const int u = (int)MISCp[4];
                    if (u >= 1024) break;
                    const int i = u >> 1; att::UnitArgs a;
                    if ((u & 1) == 0) { if (EN(3) && !(rep == 1 && ((REP_MASK >> 18) & 1))) {
                        const int qb = 15 - (i >> 5), bh = i & 31, b = bh >> 2, h = bh & 3; const size_t r0 = (size_t)b * SEQ + qb * 256 + 32 * wave;
                        a.Q = EP + r0 * N_E_IN + 1536 + 128 * h; a.ldq = N_E_IN; a.K = EP + (size_t)b * SEQ * N_E_IN + 2048 + 128 * h; a.ldk = N_E_IN; a.V = EP + (size_t)b * SEQ * N_E_IN + 2560 + 128 * h; a.ldv = N_E_IN;
                        a.O = AOE + r0 * DM + 512 + 128 * h; a.ldo = DM; a.qlo = qb * 256 + 32 * wave; a.NT = 4 * (qb + 1); a.kbias = cumb + (size_t)h * MTOK + (size_t)b * SEQ; a.bm = nullptr; a.tid = tid; a.gq = PTR(7) + li * 128; a.gk = PTR(8) + li * 128;
                        att::attn_unit<128, 1>(a, glds); }
                    } else if (EN(4) && !(rep == 1 && ((REP_MASK >> 19) & 1))) {
                        const int j = 63 - (i >> 3), b = i & 7, head = wave >> 1, sub = wave & 1; const size_t r0 = (size_t)b * SEQ + j * 64 + 32 * sub;
                        a.Q = EP + r0 * N_E_IN + 128 * head; a.ldq = N_E_IN; a.K = EP + (size_t)b * SEQ * N_E_IN + 512; a.ldk = N_E_IN; a.V = EP + (size_t)b * SEQ * N_E_IN + 640; a.ldv = N_E_IN;
                        a.O = AOE + r0 * DM + 128 * head; a.ldo = DM; a.qlo = j * 64 + 32 * sub; a.NT = j + 1; a.kbias = nullptr; a.bm = BM + r0 * 64; a.tid = tid; a.gq = PTR(5) + li * 128; a.gk = PTR(6) + li * 128;
                        att::attn_unit<128, 2>(a, glds);
                    }
                }
            }
            }
            SEAM(gp0 + 3);
            if (EN(5) && IN(gp0 + 4)) { ENV();
                pg8::Gemm g{AOE, (const bf16*)(wsw + WE_OUT), MTOK, DM, DM, DM}; pg8::StaticOrder S; S.init(MTOK, DM, GG, bid);
                pg8::EpiResid E{XB, ssp, stat, (float*)nullptr};
                pg8::gemm_phase<pg8::EpiResid, pg8::StaticOrder, true, true>(L_, g, S, E, tid);
            }
            SEAM2(gp0 + 4, gp0 + 6);
        } else {
            for (int rep = 0; rep < REPS(6); ++rep) { if (rep) xcd_barrier(bar, otid(wave_s));
            if (EN(6) && IN(gp0 + 0)) { ENV();
                pg8::Gemm g{XB, (const bf16*)(wsw + WO_IN), MTOK, N_O_IN, DM, DM}; pg8::StaticOrder S; S.init(MTOK, N_O_IN, GG, bid);
                pg8::EpiOddIn E{C1, AO, XBC, ssp, gss, misc32, PTR(20) + li * 16, stat};
                pg8::gemm_phase<pg8::EpiOddIn, pg8::StaticOrder, true, true>(L_, g, S, E, tid);
            }
            }
            SEAM(gp0 + 0);
            for (int rep = 0; rep < REPS(7); ++rep) { if (rep) xcd_barrier(bar, otid(wave_s));
            if (EN(7) && IN(gp0 + 1)) { ENV();
                if (rep == 0) for (int u = bid; u < 256; u += GG) ssd::conv_halo_save(XBC, (bf16*)(ws + WS_BM), u, tid);
                if (EN(12)) { pg8::Gemm g{C1, (const bf16*)(wsw + WO_UQ), MTOK, 1024, 384, 768}; pg8::StaticOrder S; S.init(MTOK, 1024, GG, bid);
                  pg8::EpiUq E{QB, gss, PTR(16) + li * 192, rope, stat};
                  pg8::gemm_phase<pg8::EpiUq, pg8::StaticOrder, true, true>(L_, g, S, E, tid); }
                if (EN(13)) { pg8::Gemm g{C1 + 384, (const bf16*)(wsw + WO_UKV), MTOK, 1024, 256, 768}; pg8::StaticOrder S; S.init(MTOK, 1024, GG, bid);
                  pg8::EpiUkv E{KK, VV, C1, gss, PTR(17) + li * 192, rope, stat};
                  pg8::gemm_phase<pg8::EpiUkv, pg8::StaticOrder, true, true>(L_, g, S, E, tid); }
            }
            }
            SEAM(gp0 + 1);
            if (IN(gp0 + 2)) { ENV();
                for (int u = bid; u < 256; u += GG) ssd::conv_unit(XBC, (const bf16*)(ws + WS_BM), PTR(18) + (size_t)li * 4 * 2048, PTR(19) + li * 2048, u, tid);
            }
            SEAM(gp0 + 2);
            for (int rep = 0; rep < REPS(9); ++rep) { if (rep) xcd_barrier(bar, otid(wave_s));
            if (IN(gp0 + 3)) { ENV();
                gu32* qh = ctl + CW_QUEUE + 64 * (layer * 4 + 0 + 2 * rep);
                for (;;) {
                    if (tid == 0) MISCp[4] = __hip_atomic_fetch_add(qh, 1u, RLX_AGENT);
                    __syncthreads();
                    const int u = (int)MISCp[4];
                    if (u >= 128 + 512) break;
                    if (u < 128) { if (EN(8) && rep == 0) { const int b = u >> 4, h = u & 15;
                        ssd::ssd_unit(XBC, AO, AO + 512, K_O_OUT, misc32, ssy, PTR(21)[li * 16 + h], PTR(22)[li * 16 + h], b, h, glds, glds + LDS_STAT, tid); }
                    } else if (EN(9)) { const int i = u - 128; const int qb = 15 - (i >> 5), bh = i & 31, b = bh >> 2, h = bh & 3; const size_t r0 = (size_t)b * SEQ + qb * 256 + 32 * wave; att::UnitArgs a;
                        a.Q = QB + r0 * 768 + 192 * h; a.ldq = 768; a.K = KK + (size_t)b * SEQ * 768 + 192 * h; a.ldk = 768; a.V = VV + (size_t)b * SEQ * 512 + 128 * h; a.ldv = 512;
                        a.O = AO + r0 * K_O_OUT + 128 * h; a.ldo = K_O_OUT; a.qlo = qb * 256 + 32 * wave; a.NT = 4 * (qb + 1); a.kbias = nullptr; a.bm = nullptr; a.tid = tid; a.gq = PTR(16) + li * 192; a.gk = PTR(17) + li * 192;
                        att::attn_unit<192, 0>(a, glds);
                    }
                }
            }
            }
#if defined(PROBE_SSD)
            if (IN(gp0 + 3)) { xcd_barrier(bar, otid(wave_s)); { ENV();
                for (int u = bid; u < 128; u += GG) { const int b = u >> 4, h = u & 15;
                    ssd::ssd_unit(XBC, AO, (bf16*)out + (size_t)24 * 1024 * 1024, 1024, misc32, (float*)(ws + WS_BM), PTR(21)[li * 16 + h], PTR(22)[li * 16 + h], b, h, glds, glds + LDS_STAT, tid); } } }
#endif
            SEAM2(gp0 + 3, gp0 + 5);
            if (EN(5) && IN(gp0 + 5)) { ENV();
                pg8::Gemm g{AO, (const bf16*)(wsw + WO_OUT), MTOK, DM, K_O_OUT, K_O_OUT}; pg8::StaticOrder S; S.init(MTOK, DM, GG, bid);
                pg8::EpiResid E{XB, ssp, stat, (float*)nullptr};
                const pg8::GroupScaleHook HK{ssy, (PG8_LAS float*)(L_ + LDS_FAC)};
                pg8::gemm_phase<pg8::EpiResid, pg8::StaticOrder, true, true, pg8::GroupScaleHook>(L_, g, S, E, tid, HK);
            }
            SEAM(gp0 + 5);
        }
        for (int rep = 0; rep < REPS(5); ++rep) { if (rep) xcd_barrier(bar, otid(wave_s));
        if (EN(11) && IN(gp0 + 6)) { ENV();
            pg8::Gemm g{XB, W1t, MTOK, DFF, DM, DM}; pg8::StaticOrder S; S.init(MTOK, DFF, GG, bid);
            pg8::EpiMlpUp E{HB, ssp};
            pg8::gemm_phase<pg8::EpiMlpUp, pg8::StaticOrder, true, true>(L_, g, S, E, tid);
        }
        }
        SEAM(gp0 + 6);
        if (EN(5) && IN(gp0 + 7)) { ENV();
            pg8::Gemm g{HB, W2t, MTOK, DM, DFF, DFF}; pg8::StaticOrder S; S.init(MTOK, DM, GG, bid);
            pg8::EpiResid E{XB, ssp, stat, layer == 3 ? out : (float*)nullptr};
            pg8::gemm_phase<pg8::EpiResid, pg8::StaticOrder, true, true>(L_, g, S, E, tid);
        }
        if (layer < 3) SEAM(gp0 + 7);
    }
    {
        constexpr int layer = 2;
        const int li = layer >> 1; const int gp0 = layer * 8;
        if ((layer & 1) == 0) {
            for (int rep = 0; rep < REPS(0); ++rep) { if (rep) xcd_barrier(bar, otid(wave_s));
            if (EN(0) && IN(gp0 + 0)) { ENV();
                LAS float* scr = (LAS float*)(L_ + wave * 16384);
                const int gw = bid * NWAVES + wave, NGW = GG * NWAVES;
                int it = gw;
#define WJOB(Wp, dstp, gainp, K_, Nsrc_, Ndst_, map_, gk0_) do { const WJob J_{Wp, dstp, gainp, K_, Nsrc_, Ndst_, map_, gk0_}; const int nit_ = ((K_) / 64) * ((Ndst_) / 32); \
                    for (; it < nit_; it += NGW) wconv_item(J_, scr, it, lane); it -= nit_; } while (0)
                WJOB(PTR(3) + (size_t)li * 1024 * 2892, (bf16*)(wsw + WE_IN), PTR(2) + li * 1024, 1024, 2892, 3072, MAP_EVEN_IN, 0);
                WJOB(PTR(9) + (size_t)li * 1024 * 1024, (bf16*)(wsw + WE_OUT), (const float*)nullptr, 1024, 1024, 1024, MAP_ID, 0);
                WJOB(PTR(26) + (size_t)(2 * li) * 1024 * 4096, (bf16*)(wsw + WE_1), PTR(25) + (2 * li) * 1024, 1024, 4096, 4096, MAP_ID, 0);
                WJOB(PTR(27) + (size_t)(2 * li) * 4096 * 1024, (bf16*)(wsw + WE_2), (const float*)nullptr, 4096, 1024, 1024, MAP_ID, 0);
                WJOB(PTR(11) + (size_t)li * 1024 * 3792, (bf16*)(wsw + WO_IN), PTR(10) + li * 1024, 1024, 3792, 3840, MAP_ODD_IN, 0);
                WJOB(PTR(14) + (size_t)li * 384 * 768, (bf16*)(wsw + WO_UQ), PTR(12) + li * 384, 384, 768, 1024, MAP_UQ, 0);
                WJOB(PTR(15) + (size_t)li * 256 * 1024, (bf16*)(wsw + WO_UKV), PTR(13) + li * 256, 256, 1024, 1024, MAP_ID, 0);
                WJOB(PTR(24) + (size_t)li * 1536 * 1024, (bf16*)(wsw + WO_OUT), PTR(23) + li * 1024, 1536, 1024, 1024, MAP_ID, 512);
                WJOB(PTR(26) + (size_t)(2 * li + 1) * 1024 * 4096, (bf16*)(wsw + WO_1), PTR(25) + (2 * li + 1) * 1024, 1024, 4096, 4096, MAP_ID, 0);
                WJOB(PTR(27) + (size_t)(2 * li + 1) * 4096 * 1024, (bf16*)(wsw + WO_2), (const float*)nullptr, 4096, 1024, 1024, MAP_ID, 0);
#undef WJOB
                if (layer == 0) { const float* x_in = PTR(0); const int* positions = (const int*)PTR(1);
                    for (int m0 = gw; m0 < MTOK; m0 += 2 * NGW) {
                        const int m1 = m0 + NGW; const bool two = m1 < MTOK;
                        const GAS f32x4* xa = (const GAS f32x4*)(x_in + (size_t)m0 * DM) + lane; const GAS f32x4* xb2 = (const GAS f32x4*)(x_in + (size_t)(two ? m1 : m0) * DM) + lane; f32x4 va[4], vb[4]; float sa = 0.f, sb = 0.f;
#pragma unroll
                        for (int j = 0; j < 4; ++j) { va[j] = xa[64 * j]; vb[j] = xb2[64 * j]; }
#pragma unroll
                        for (int j = 0; j < 4; ++j) { sa += (va[j].x * va[j].x + va[j].y * va[j].y) + (va[j].z * va[j].z + va[j].w * va[j].w); sb += (vb[j].x * vb[j].x + vb[j].y * vb[j].y) + (vb[j].z * vb[j].z + vb[j].w * vb[j].w); }
                        sa = wave_sum(sa); sb = wave_sum(sb);
                        GAS unsigned long long* oa = (GAS unsigned long long*)(XB + (size_t)m0 * DM) + lane;
#pragma unroll
                        for (int j = 0; j < 4; ++j) oa[64 * j] = (unsigned long long)pk2(va[j].x, va[j].y) | ((unsigned long long)pk2(va[j].z, va[j].w) << 32);
                        if (lane < 4) ssp[(size_t)lane * MTOK + m0] = (lane == 0) ? sa : 0.f;
                        if (two) { GAS unsigned long long* ob = (GAS unsigned long long*)(XB + (size_t)m1 * DM) + lane;
#pragma unroll
                            for (int j = 0; j < 4; ++j) ob[64 * j] = (unsigned long long)pk2(vb[j].x, vb[j].y) | ((unsigned long long)pk2(vb[j].z, vb[j].w) << 32);
                            if (lane < 4) ssp[(size_t)lane * MTOK + m1] = (lane == 0) ? sb : 0.f; }
                    }
                    for (int idx = bid * 512 + tid; idx < MTOK * 32; idx += GG * 512) { const int tok = idx >> 5, i = idx & 31;
                        const float inv = powf(10000.0f, -(float)i / 32.0f); const float ang = (float)positions[tok] * inv; const float sn = sinf(ang), cs = cosf(ang);
                        rope[(size_t)idx * 2] = cs; rope[(size_t)idx * 2 + 1] = sn; }
                }
            }
            }
            SEAM(gp0 + 0);
            for (int rep = 0; rep < REPS(1); ++rep) { if (rep) xcd_barrier(bar, otid(wave_s));
            if (EN(1) && IN(gp0 + 1)) { ENV();
                pg8::Gemm g{XB, (const bf16*)(wsw + WE_IN), MTOK, N_E_IN, DM, DM}; pg8::StaticOrder S; S.init(MTOK, N_E_IN, GG, bid);
                pg8::EpiEvenIn E{EP, ssp, misc32, PTR(5) + li * 128, PTR(6) + li * 128, PTR(7) + li * 128, PTR(8) + li * 128, PTR(4) + li * 4, stat};
                pg8::gemm_phase<pg8::EpiEvenIn, pg8::StaticOrder, true, true>(L_, g, S, E, tid);
            }
            }
            SEAM(gp0 + 1);
            for (int rep = 0; rep < REPS(2); ++rep) { if (rep) xcd_barrier(bar, otid(wave_s));
            if (EN(2) && IN(gp0 + 2)) { ENV();
                if (bid < 32) tk::cumsum_unit(misc32, cumb, bid >> 2, bid & 3, glds, tid);
#if defined(TKS_CHECK)
                for (int v = bid; v < 4096; v += GG) tk::topk_unit(EP, misc32, BM, v & 7, 511 - (v >> 3), glds, glds + LDS_STAT, glds + LDS_FAC, tid);
                __syncthreads();
#define TKR_DST ((unsigned long long*)out)
#else
#define TKR_DST BM
#endif
                { gu32* qh2 = ctl + CW_QUEUE + 8192 + 64 * layer;
                  int v = bid;
                  for (;;) {
                    if (v >= 2048) break;
                    tkr::regsel_unit(EP, misc32, TKR_DST, v & 7, 255 - (v >> 3), glds, glds + LDS_STAT, glds + LDS_FAC, tid);
                    if (tid == 0) MISCp[4] = __hip_atomic_fetch_add(qh2, 1u, RLX_AGENT);
                    __syncthreads();
                    v = GG + (int)MISCp[4];
                    __syncthreads(); } }
#undef TKR_DST
            }
            }
#if defined(TKS_CHECK)
            if (IN(gp0 + 2)) { xcd_barrier(bar, otid(wave_s)); { ENV();
                unsigned bad = 0u; const unsigned long long* B2 = (const unsigned long long*)out;
                for (size_t i = (size_t)bid * 512 + tid; i < (size_t)MTOK * 64; i += (size_t)GG * 512) bad += (BM[i] != B2[i]) ? 1u : 0u;
                if (bad) __hip_atomic_fetch_add(ctl + 2048, bad, RLX_AGENT); } }
#endif
            SEAM(gp0 + 2);
            for (int rep = 0; rep < REPS(3); ++rep) { if (rep) xcd_barrier(bar, otid(wave_s));
            if (IN(gp0 + 3)) { ENV();
                gu32* qh = ctl + CW_QUEUE + 64 * (layer * 4 + 1 + 2 * rep);
                for (;;) {
                    if (tid == 0) MISCp[4] = __hip_atomic_fetch_add(qh, 1u, RLX_AGENT);
                    __syncthreads();
                    const int u = (int)MISCp[4];
                    if (u >= 1024) break;
                    const int i = u >> 1; att::UnitArgs a;
                    if ((u & 1) == 0) { if (EN(3) && !(rep == 1 && ((REP_MASK >> 18) & 1))) {
                        const int qb = 15 - (i >> 5), bh = i & 31, b = bh >> 2, h = bh & 3; const size_t r0 = (size_t)b * SEQ + qb * 256 + 32 * wave;
                        a.Q = EP + r0 * N_E_IN + 1536 + 128 * h; a.ldq = N_E_IN; a.K = EP + (size_t)b * SEQ * N_E_IN + 2048 + 128 * h; a.ldk = N_E_IN; a.V = EP + (size_t)b * SEQ * N_E_IN + 2560 + 128 * h; a.ldv = N_E_IN;
                        a.O = AOE + r0 * DM + 512 + 128 * h; a.ldo = DM; a.qlo = qb * 256 + 32 * wave; a.NT = 4 * (qb + 1); a.kbias = cumb + (size_t)h * MTOK + (size_t)b * SEQ; a.bm = nullptr; a.tid = tid; a.gq = PTR(7) + li * 128; a.gk = PTR(8) + li * 128;
                        att::attn_unit<128, 1>(a, glds); }
                    } else if (EN(4) && !(rep == 1 && ((REP_MASK >> 19) & 1))) {
                        const int j = 63 - (i >> 3), b = i & 7, head = wave >> 1, sub = wave & 1; const size_t r0 = (size_t)b * SEQ + j * 64 + 32 * sub;
                        a.Q = EP + r0 * N_E_IN + 128 * head; a.ldq = N_E_IN; a.K = EP + (size_t)b * SEQ * N_E_IN + 512; a.ldk = N_E_IN; a.V = EP + (size_t)b * SEQ * N_E_IN + 640; a.ldv = N_E_IN;
                        a.O = AOE + r0 * DM + 128 * head; a.ldo = DM; a.qlo = j * 64 + 32 * sub; a.NT = j + 1; a.kbias = nullptr; a.bm = BM + r0 * 64; a.tid = tid; a.gq = PTR(5) + li * 128; a.gk = PTR(6) + li * 128;
                        att::attn_unit<128, 2>(a, glds);
                    }
                }
            }
            }
            SEAM(gp0 + 3);
            if (EN(5) && IN(gp0 + 4)) { ENV();
                pg8::Gemm g{AOE, (const bf16*)(wsw + WE_OUT), MTOK, DM, DM, DM}; pg8::StaticOrder S; S.init(MTOK, DM, GG, bid);
                pg8::EpiResid E{XB, ssp, stat, (float*)nullptr};
                pg8::gemm_phase<pg8::EpiResid, pg8::StaticOrder, true, true>(L_, g, S, E, tid);
            }
            SEAM2(gp0 + 4, gp0 + 6);
        } else {
            for (int rep = 0; rep < REPS(6); ++rep) { if (rep) xcd_barrier(bar, otid(wave_s));
            if (EN(6) && IN(gp0 + 0)) { ENV();
                pg8::Gemm g{XB, (const bf16*)(wsw + WO_IN), MTOK, N_O_IN, DM, DM}; pg8::StaticOrder S; S.init(MTOK, N_O_IN, GG, bid);
                pg8::EpiOddIn E{C1, AO, XBC, ssp, gss, misc32, PTR(20) + li * 16, stat};
                pg8::gemm_phase<pg8::EpiOddIn, pg8::StaticOrder, true, true>(L_, g, S, E, tid);
            }
            }
            SEAM(gp0 + 0);
            for (int rep = 0; rep < REPS(7); ++rep) { if (rep) xcd_barrier(bar, otid(wave_s));
            if (EN(7) && IN(gp0 + 1)) { ENV();
                if (rep == 0) for (int u = bid; u < 256; u += GG) ssd::conv_halo_save(XBC, (bf16*)(ws + WS_BM), u, tid);
                if (EN(12)) { pg8::Gemm g{C1, (const bf16*)(wsw + WO_UQ), MTOK, 1024, 384, 768}; pg8::StaticOrder S; S.init(MTOK, 1024, GG, bid);
                  pg8::EpiUq E{QB, gss, PTR(16) + li * 192, rope, stat};
                  pg8::gemm_phase<pg8::EpiUq, pg8::StaticOrder, true, true>(L_, g, S, E, tid); }
                if (EN(13)) { pg8::Gemm g{C1 + 384, (const bf16*)(wsw + WO_UKV), MTOK, 1024, 256, 768}; pg8::StaticOrder S; S.init(MTOK, 1024, GG, bid);
                  pg8::EpiUkv E{KK, VV, C1, gss, PTR(17) + li * 192, rope, stat};
                  pg8::gemm_phase<pg8::EpiUkv, pg8::StaticOrder, true, true>(L_, g, S, E, tid); }
            }
            }
            SEAM(gp0 + 1);
            if (IN(gp0 + 2)) { ENV();
                for (int u = bid; u < 256; u += GG) ssd::conv_unit(XBC, (const bf16*)(ws + WS_BM), PTR(18) + (size_t)li * 4 * 2048, PTR(19) + li * 2048, u, tid);
            }
            SEAM(gp0 + 2);
            for (int rep = 0; rep < REPS(9); ++rep) { if (rep) xcd_barrier(bar, otid(wave_s));
            if (IN(gp0 + 3)) { ENV();
                gu32* qh = ctl + CW_QUEUE + 64 * (layer * 4 + 0 + 2 * rep);
                for (;;) {
                    if (tid == 0) MISCp[4] = __hip_atomic_fetch_add(qh, 1u, RLX_AGENT);
                    __syncthreads();
                    const int u = (int)MISCp[4];
                    if (u >= 128 + 512) break;
                    if (u < 128) { if (EN(8) && rep == 0) { const int b = u >> 4, h = u & 15;
                        ssd::ssd_unit(XBC, AO, AO + 512, K_O_OUT, misc32, ssy, PTR(21)[li * 16 + h], PTR(22)[li * 16 + h], b, h, glds, glds + LDS_STAT, tid); }
                    } else if (EN(9)) { const int i = u - 128; const int qb = 15 - (i >> 5), bh = i & 31, b = bh >> 2, h = bh & 3; const size_t r0 = (size_t)b * SEQ + qb * 256 + 32 * wave; att::UnitArgs a;
                        a.Q = QB + r0 * 768 + 192 * h; a.ldq = 768; a.K = KK + (size_t)b * SEQ * 768 + 192 * h; a.ldk = 768; a.V = VV + (size_t)b * SEQ * 512 + 128 * h; a.ldv = 512;
                        a.O = AO + r0 * K_O_OUT + 128 * h; a.ldo = K_O_OUT; a.qlo = qb * 256 + 32 * wave; a.NT = 4 * (qb + 1); a.kbias = nullptr; a.bm = nullptr; a.tid = tid; a.gq = PTR(16) + li * 192; a.gk = PTR(17) + li * 192;
                        att::attn_unit<192, 0>(a, glds);
                    }
                }
            }
            }
#if defined(PROBE_SSD)
            if (IN(gp0 + 3)) { xcd_barrier(bar, otid(wave_s)); { ENV();
                for (int u = bid; u < 128; u += GG) { const int b = u >> 4, h = u & 15;
                    ssd::ssd_unit(XBC, AO, (bf16*)out + (size_t)24 * 1024 * 1024, 1024, misc32, (float*)(ws + WS_BM), PTR(21)[li * 16 + h], PTR(22)[li * 16 + h], b, h, glds, glds + LDS_STAT, tid); } } }
#endif
            SEAM2(gp0 + 3, gp0 + 5);
            if (EN(5) && IN(gp0 + 5)) { ENV();
                pg8::Gemm g{AO, (const bf16*)(wsw + WO_OUT), MTOK, DM, K_O_OUT, K_O_OUT}; pg8::StaticOrder S; S.init(MTOK, DM, GG, bid);
                pg8::EpiResid E{XB, ssp, stat, (float*)nullptr};
                const pg8::GroupScaleHook HK{ssy, (PG8_LAS float*)(L_ + LDS_FAC)};
                pg8::gemm_phase<pg8::EpiResid, pg8::StaticOrder, true, true, pg8::GroupScaleHook>(L_, g, S, E, tid, HK);
            }
            SEAM(gp0 + 5);
        }
        for (int rep = 0; rep < REPS(5); ++rep) { if (rep) xcd_barrier(bar, otid(wave_s));
        if (EN(11) && IN(gp0 + 6)) { ENV();
            pg8::Gemm g{XB, W1t, MTOK, DFF, DM, DM}; pg8::StaticOrder S; S.init(MTOK, DFF, GG, bid);
            pg8::EpiMlpUp E{HB, ssp};
            pg8::gemm_phase<pg8::EpiMlpUp, pg8::StaticOrder, true, true>(L_, g, S, E, tid);
        }
        }
        SEAM(gp0 + 6);
        if (EN(5) && IN(gp0 + 7)) { ENV();
            pg8::Gemm g{HB, W2t, MTOK, DM, DFF, DFF}; pg8::StaticOrder S; S.init(MTOK, DM, GG, bid);
            pg8::EpiResid E{XB, ssp, stat, layer == 3 ? out : (float*)nullptr};
            pg8::gemm_phase<pg8::EpiResid, pg8::StaticOrder, true, true>(L_, g, S, E, tid);
        }
        if (layer < 3) SEAM(gp0 + 7);
    }
    {
        constexpr int layer = 3;
        const int li = layer >> 1; const int gp0 = layer * 8;
        if ((layer & 1) == 0) {
            for (int rep = 0; rep < REPS(0); ++rep) { if (rep) xcd_barrier(bar, otid(wave_s));
            if (EN(0) && IN(gp0 + 0)) { ENV();
                LAS float* scr = (LAS float*)(L_ + wave * 16384);
                const int gw = bid * NWAVES + wave, NGW = GG * NWAVES;
                int it = gw;
#define WJOB(Wp, dstp, gainp, K_, Nsrc_, Ndst_, map_, gk0_) do { const WJob J_{Wp, dstp, gainp, K_, Nsrc_, Ndst_, map_, gk0_}; const int nit_ = ((K_) / 64) * ((Ndst_) / 32); \
                    for (; it < nit_; it += NGW) wconv_item(J_, scr, it, lane); it -= nit_; } while (0)
                WJOB(PTR(3) + (size_t)li * 1024 * 2892, (bf16*)(wsw + WE_IN), PTR(2) + li * 1024, 1024, 2892, 3072, MAP_EVEN_IN, 0);
                WJOB(PTR(9) + (size_t)li * 1024 * 1024, (bf16*)(wsw + WE_OUT), (const float*)nullptr, 1024, 1024, 1024, MAP_ID, 0);
                WJOB(PTR(26) + (size_t)(2 * li) * 1024 * 4096, (bf16*)(wsw + WE_1), PTR(25) + (2 * li) * 1024, 1024, 4096, 4096, MAP_ID, 0);
                WJOB(PTR(27) + (size_t)(2 * li) * 4096 * 1024, (bf16*)(wsw + WE_2), (const float*)nullptr, 4096, 1024, 1024, MAP_ID, 0);
                WJOB(PTR(11) + (size_t)li * 1024 * 3792, (bf16*)(wsw + WO_IN), PTR(10) + li * 1024, 1024, 3792, 3840, MAP_ODD_IN, 0);
                WJOB(PTR(14) + (size_t)li * 384 * 768, (bf16*)(wsw + WO_UQ), PTR(12) + li * 384, 384, 768, 1024, MAP_UQ, 0);
                WJOB(PTR(15) + (size_t)li * 256 * 1024, (bf16*)(wsw + WO_UKV), PTR(13) + li * 256, 256, 1024, 1024, MAP_ID, 0);
                WJOB(PTR(24) + (size_t)li * 1536 * 1024, (bf16*)(wsw + WO_OUT), PTR(23) + li * 1024, 1536, 1024, 1024, MAP_ID, 512);
                WJOB(PTR(26) + (size_t)(2 * li + 1) * 1024 * 4096, (bf16*)(wsw + WO_1), PTR(25) + (2 * li + 1) * 1024, 1024, 4096, 4096, MAP_ID, 0);
                WJOB(PTR(27) + (size_t)(2 * li + 1) * 4096 * 1024, (bf16*)(wsw + WO_2), (const float*)nullptr, 4096, 1024, 1024, MAP_ID, 0);
#undef WJOB
                if (layer == 0) { const float* x_in = PTR(0); const int* positions = (const int*)PTR(1);
                    for (int m0 = gw; m0 < MTOK; m0 += 2 * NGW) {
                        const int m1 = m0 + NGW; const bool two = m1 < MTOK;
                        const GAS f32x4* xa = (const GAS f32x4*)(x_in + (size_t)m0 * DM) + lane; const GAS f32x4* xb2 = (const GAS f32x4*)(x_in + (size_t)(two ? m1 : m0) * DM) + lane; f32x4 va[4], vb[4]; float sa = 0.f, sb = 0.f;
#pragma unroll
                        for (int j = 0; j < 4; ++j) { va[j] = xa[64 * j]; vb[j] = xb2[64 * j]; }
#pragma unroll
                        for (int j = 0; j < 4; ++j) { sa += (va[j].x * va[j].x + va[j].y * va[j].y) + (va[j].z * va[j].z + va[j].w * va[j].w); sb += (vb[j].x * vb[j].x + vb[j].y * vb[j].y) + (vb[j].z * vb[j].z + vb[j].w * vb[j].w); }
                        sa = wave_sum(sa); sb = wave_sum(sb);
                        GAS unsigned long long* oa = (GAS unsigned long long*)(XB + (size_t)m0 * DM) + lane;
#pragma unroll
                        for (int j = 0; j < 4; ++j) oa[64 * j] = (unsigned long long)pk2(va[j].x, va[j].y) | ((unsigned long long)pk2(va[j].z, va[j].w) << 32);
                        if (lane < 4) ssp[(size_t)lane * MTOK + m0] = (lane == 0) ? sa : 0.f;
                        if (two) { GAS unsigned long long* ob = (GAS unsigned long long*)(XB + (size_t)m1 * DM) + lane;
#pragma unroll
                            for (int j = 0; j < 4; ++j) ob[64 * j] = (unsigned long long)pk2(vb[j].x, vb[j].y) | ((unsigned long long)pk2(vb[j].z, vb[j].w) << 32);
                            if (lane < 4) ssp[(size_t)lane * MTOK + m1] = (lane == 0) ? sb : 0.f; }
                    }
                    for (int idx = bid * 512 + tid; idx < MTOK * 32; idx += GG * 512) { const int tok = idx >> 5, i = idx & 31;
                        const float inv = powf(10000.0f, -(float)i / 32.0f); const float ang = (float)positions[tok] * inv; const float sn = sinf(ang), cs = cosf(ang);
                        rope[(size_t)idx * 2] = cs; rope[(size_t)idx * 2 + 1] = sn; }
                }
            }
            }
            SEAM(gp0 + 0);
            for (int rep = 0; rep < REPS(1); ++rep) { if (rep) xcd_barrier(bar, otid(wave_s));
            if (EN(1) && IN(gp0 + 1)) { ENV();
                pg8::Gemm g{XB, (const bf16*)(wsw + WE_IN), MTOK, N_E_IN, DM, DM}; pg8::StaticOrder S; S.init(MTOK, N_E_IN, GG, bid);
                pg8::EpiEvenIn E{EP, ssp, misc32, PTR(5) + li * 128, PTR(6) + li * 128, PTR(7) + li * 128, PTR(8) + li * 128, PTR(4) + li * 4, stat};
                pg8::gemm_phase<pg8::EpiEvenIn, pg8::StaticOrder, true, true>(L_, g, S, E, tid);
            }
            }
            SEAM(gp0 + 1);
            for (int rep = 0; rep < REPS(2); ++rep) { if (rep) xcd_barrier(bar, otid(wave_s));
            if (EN(2) && IN(gp0 + 2)) { ENV();
                if (bid < 32) tk::cumsum_unit(misc32, cumb, bid >> 2, bid & 3, glds, tid);
#if defined(TKS_CHECK)
                for (int v = bid; v < 4096; v += GG) tk::topk_unit(EP, misc32, BM, v & 7, 511 - (v >> 3), glds, glds + LDS_STAT, glds + LDS_FAC, tid);
                __syncthreads();
#define TKR_DST ((unsigned long long*)out)
#else
#define TKR_DST BM
#endif
                { gu32* qh2 = ctl + CW_QUEUE + 8192 + 64 * layer;
                  int v = bid;
                  for (;;) {
                    if (v >= 2048) break;
                    tkr::regsel_unit(EP, misc32, TKR_DST, v & 7, 255 - (v >> 3), glds, glds + LDS_STAT, glds + LDS_FAC, tid);
                    if (tid == 0) MISCp[4] = __hip_atomic_fetch_add(qh2, 1u, RLX_AGENT);
                    __syncthreads();
                    v = GG + (int)MISCp[4];
                    __syncthreads(); } }
#undef TKR_DST
            }
            }
#if defined(TKS_CHECK)
            if (IN(gp0 + 2)) { xcd_barrier(bar, otid(wave_s)); { ENV();
                unsigned bad = 0u; const unsigned long long* B2 = (const unsigned long long*)out;
                for (size_t i = (size_t)bid * 512 + tid; i < (size_t)MTOK * 64; i += (size_t)GG * 512) bad += (BM[i] != B2[i]) ? 1u : 0u;
                if (bad) __hip_atomic_fetch_add(ctl + 2048, bad, RLX_AGENT); } }
#endif
            SEAM(gp0 + 2);
            for (int rep = 0; rep < REPS(3); ++rep) { if (rep) xcd_barrier(bar, otid(wave_s));
            if (IN(gp0 + 3)) { ENV();
                gu32* qh = ctl + CW_QUEUE + 64 * (layer * 4 + 1 + 2 * rep);
                for (;;) {
                    if (tid == 0) MISCp[4] = __hip_atomic_fetch_add(qh, 1u, RLX_AGENT);
                    __syncthreads();
                    const int u = (int)MISCp[4];
                    if (u >= 1024) break;
                    const int i = u >> 1; att::UnitArgs a;
                    if ((u & 1) == 0) { if (EN(3) && !(rep == 1 && ((REP_MASK >> 18) & 1))) {
                        const int qb = 15 - (i >> 5), bh = i & 31, b = bh >> 2, h = bh & 3; const size_t r0 = (size_t)b * SEQ + qb * 256 + 32 * wave;
                        a.Q = EP + r0 * N_E_IN + 1536 + 128 * h; a.ldq = N_E_IN; a.K = EP + (size_t)b * SEQ * N_E_IN + 2048 + 128 * h; a.ldk = N_E_IN; a.V = EP + (size_t)b * SEQ * N_E_IN + 2560 + 128 * h; a.ldv = N_E_IN;
                        a.O = AOE + r0 * DM + 512 + 128 * h; a.ldo = DM; a.qlo = qb * 256 + 32 * wave; a.NT = 4 * (qb + 1); a.kbias = cumb + (size_t)h * MTOK + (size_t)b * SEQ; a.bm = nullptr; a.tid = tid; a.gq = PTR(7) + li * 128; a.gk = PTR(8) + li * 128;
                        att::attn_unit<128, 1>(a, glds); }
                    } else if (EN(4) && !(rep == 1 && ((REP_MASK >> 19) & 1))) {
                        const int j = 63 - (i >> 3), b = i & 7, head = wave >> 1, sub = wave & 1; const size_t r0 = (size_t)b * SEQ + j * 64 + 32 * sub;
                        a.Q = EP + r0 * N_E_IN + 128 * head; a.ldq = N_E_IN; a.K = EP + (size_t)b * SEQ * N_E_IN + 512; a.ldk = N_E_IN; a.V = EP + (size_t)b * SEQ * N_E_IN + 640; a.ldv = N_E_IN;
                        a.O = AOE + r0 * DM + 128 * head; a.ldo = DM; a.qlo = j * 64 + 32 * sub; a.NT = j + 1; a.kbias = nullptr; a.bm = BM + r0 * 64; a.tid = tid; a.gq = PTR(5) + li * 128; a.gk = PTR(6) + li * 128;
                        att::attn_unit<128, 2>(a, glds);
                    }
                }
            }
            }
            SEAM(gp0 + 3);
            if (EN(5) && IN(gp0 + 4)) { ENV();
                pg8::Gemm g{AOE, (const bf16*)(wsw + WE_OUT), MTOK, DM, DM, DM}; pg8::StaticOrder S; S.init(MTOK, DM, GG, bid);
                pg8::EpiResid E{XB, ssp, stat, (float*)nullptr};
                pg8::gemm_phase<pg8::EpiResid, pg8::StaticOrder, true, true>(L_, g, S, E, tid);
            }
            SEAM2(gp0 + 4, gp0 + 6);
        } else {
            for (int rep = 0; rep < REPS(6); ++rep) { if (rep) xcd_barrier(bar, otid(wave_s));
            if (EN(6) && IN(gp0 + 0)) { ENV();
                pg8::Gemm g{XB, (const bf16*)(wsw + WO_IN), MTOK, N_O_IN, DM, DM}; pg8::StaticOrder S; S.init(MTOK, N_O_IN, GG, bid);
                pg8::EpiOddIn E{C1, AO, XBC, ssp, gss, misc32, PTR(20) + li * 16, stat};
                pg8::gemm_phase<pg8::EpiOddIn, pg8::StaticOrder, true, true>(L_, g, S, E, tid);
            }
            }
            SEAM(gp0 + 0);
            for (int rep = 0; rep < REPS(7); ++rep) { if (rep) xcd_barrier(bar, otid(wave_s));
            if (EN(7) && IN(gp0 + 1)) { ENV();
                if (rep == 0) for (int u = bid; u < 256; u += GG) ssd::conv_halo_save(XBC, (bf16*)(ws + WS_BM), u, tid);
                if (EN(12)) { pg8::Gemm g{C1, (const bf16*)(wsw + WO_UQ), MTOK, 1024, 384, 768}; pg8::StaticOrder S; S.init(MTOK, 1024, GG, bid);
                  pg8::EpiUq E{QB, gss, PTR(16) + li * 192, rope, stat};
                  pg8::gemm_phase<pg8::EpiUq, pg8::StaticOrder, true, true>(L_, g, S, E, tid); }
                if (EN(13)) { pg8::Gemm g{C1 + 384, (const bf16*)(wsw + WO_UKV), MTOK, 1024, 256, 768}; pg8::StaticOrder S; S.init(MTOK, 1024, GG, bid);
                  pg8::EpiUkv E{KK, VV, C1, gss, PTR(17) + li * 192, rope, stat};
                  pg8::gemm_phase<pg8::EpiUkv, pg8::StaticOrder, true, true>(L_, g, S, E, tid); }
            }
            }
            SEAM(gp0 + 1);
            if (IN(gp0 + 2)) { ENV();
                for (int u = bid; u < 256; u += GG) ssd::conv_unit(XBC, (const bf16*)(ws + WS_BM), PTR(18) + (size_t)li * 4 * 2048, PTR(19) + li * 2048, u, tid);
            }
            SEAM(gp0 + 2);
            for (int rep = 0; rep < REPS(9); ++rep) { if (rep) xcd_barrier(bar, otid(wave_s));
            if (IN(gp0 + 3)) { ENV();
                gu32* qh = ctl + CW_QUEUE + 64 * (layer * 4 + 0 + 2 * rep);
                for (;;) {
                    if (tid == 0) MISCp[4] = __hip_atomic_fetch_add(qh, 1u, RLX_AGENT);
                    __syncthreads();
                    const int u = (int)MISCp[4];
                    if (u >= 128 + 512) break;
                    if (u < 128) { if (EN(8) && rep == 0) { const int b = u >> 4, h = u & 15;
                        ssd::ssd_unit(XBC, AO, AO + 512, K_O_OUT, misc32, ssy, PTR(21)[li * 16 + h], PTR(22)[li * 16 + h], b, h, glds, glds + LDS_STAT, tid); }
                    } else if (EN(9)) { const int i = u - 128; const int qb = 15 - (i >> 5), bh = i & 31, b = bh >> 2, h = bh & 3; const size_t r0 = (size_t)b * SEQ + qb * 256 + 32 * wave; att::UnitArgs a;
                        a.Q = QB + r0 * 768 + 192 * h; a.ldq = 768; a.K = KK + (size_t)b * SEQ * 768 + 192 * h; a.ldk = 768; a.V = VV + (size_t)b * SEQ * 512 + 128 * h; a.ldv = 512;
                        a.O = AO + r0 * K_O_OUT + 128 * h; a.ldo = K_O_OUT; a.qlo = qb * 256 + 32 * wave; a.NT = 4 * (qb + 1); a.kbias = nullptr; a.bm = nullptr; a.tid = tid; a.gq = PTR(16) + li * 192; a.gk = PTR(17) + li * 192;
                        att::attn_unit<192, 0>(a, glds);
                    }
                }
            }
            }
#if defined(PROBE_SSD)
            if (IN(gp0 + 3)) { xcd_barrier(bar, otid(wave_s)); { ENV();
                for (int u = bid; u < 128; u += GG) { const int b = u >> 4, h = u & 15;
                    ssd::ssd_unit(XBC, AO, (bf16*)out + (size_t)24 * 1024 * 1024, 1024, misc32, (float*)(ws + WS_BM), PTR(21)[li * 16 + h], PTR(22)[li * 16 + h], b, h, glds, glds + LDS_STAT, tid); } } }
#endif
            SEAM2(gp0 + 3, gp0 + 5);
            if (EN(5) && IN(gp0 + 5)) { ENV();
                pg8::Gemm g{AO, (const bf16*)(wsw + WO_OUT), MTOK, DM, K_O_OUT, K_O_OUT}; pg8::StaticOrder S; S.init(MTOK, DM, GG, bid);
                pg8::EpiResid E{XB, ssp, stat, (float*)nullptr};
                const pg8::GroupScaleHook HK{ssy, (PG8_LAS float*)(L_ + LDS_FAC)};
                pg8::gemm_phase<pg8::EpiResid, pg8::StaticOrder, true, true, pg8::GroupScaleHook>(L_, g, S, E, tid, HK);
            }
            SEAM(gp0 + 5);
        }
        for (int rep = 0; rep < REPS(5); ++rep) { if (rep) xcd_barrier(bar, otid(wave_s));
        if (EN(11) && IN(gp0 + 6)) { ENV();
            pg8::Gemm g{XB, W1t, MTOK, DFF, DM, DM}; pg8::StaticOrder S; S.init(MTOK, DFF, GG, bid);
            pg8::EpiMlpUp E{HB, ssp};
            pg8::gemm_phase<pg8::EpiMlpUp, pg8::StaticOrder, true, true>(L_, g, S, E, tid);
        }
        }
        SEAM(gp0 + 6);
        if (EN(5) && IN(gp0 + 7)) { ENV();
            pg8::Gemm g{HB, W2t, MTOK, DM, DFF, DFF}; pg8::StaticOrder S; S.init(MTOK, DM, GG, bid);
            pg8::EpiResid E{XB, ssp, stat, layer == 3 ? out : (float*)nullptr};
            pg8::gemm_phase<pg8::EpiResid, pg8::StaticOrder, true, true>(L_, g, S, E, tid);
        }
        if (layer < 3) SEAM(gp0 + 7);
    }
#if defined(TKS_CHECK)
    { ENV_NOLAYER();
      xcd_barrier(bar, otid(wave_s));
      if (bid == 0 && tid == 0) { const unsigned nb = __hip_atomic_load((gu32*)(ws + WS_CTL) + 2048, RLX_AGENT); if (nb) ((float*)PTR(28))[0] = 100.0f * (1.0f + log2f(1.0f + (float)nb)); } }
#endif
#if defined(TPROF)
    { ENV_NOLAYER();
      xcd_barrier(bar, otid(wave_s)); TSTAMP(31);
      __syncthreads();
      if (bid == 0) { volatile LAS unsigned* ts = (volatile LAS unsigned*)(L_ + LDS_MISC + 384);
          const float v1 = (float)(ts[TPROF_A1] - ts[TPROF_A0]) * 0.25f;
          const float v2 = (TPROF_B1 > 0) ? (float)(ts[TPROF_B1] - ts[TPROF_B0]) * (1.0f / 64.0f) : 1000.0f;
          if (tid == 0) out[0] = v1;
          for (int i = 1 + tid; i <= 1048576; i += 512) out[i] = v2; } }
#endif
#if defined(DBG_STOP)
    { ENV_NOLAYER();
      xcd_barrier(bar, otid(wave_s));
      const size_t n = (size_t)MTOK * DM;
      for (size_t i = (size_t)bid * 512 + tid; i < n; i += (size_t)GG * 512) {
          float v;
#if DBG_KIND == 0
          v = __uint_as_float(((unsigned)((const bf16*)(ws + (size_t)DBG_OFF))[i]) << 16);
#elif DBG_KIND == 1
          v = ((const float*)(ws + (size_t)DBG_OFF))[i];
#elif DBG_KIND == 2
          v = out[i];
#else
          v = (float)(((const unsigned*)(ws + (size_t)DBG_OFF))[i] & 0xffffu);
#endif
          if (!(fabsf(v) < 1e30f)) v = 30000.0f;
          out[i] = v; } }
#endif
#undef IN
#undef SEAM
#undef PTR
#undef ENV
}

#ifndef MK_SPLIT
#define MK_SPLIT 0
#endif
extern "C" void kernel_launch(void* const* d_in, const int* in_sizes, int n_in, void* d_out, int out_size, void* d_ws, size_t ws_size, hipStream_t stream) {
    static int grid = 0;
    if (grid == 0) {
        if (n_in != 28 || out_size != MTOK * DM || ws_size < WS_END) { fprintf(stderr, "kernel_launch: unexpected problem shape (n_in %d, out %d, ws %zu)\n", n_in, out_size, ws_size); grid = -1; return; }
        int dev = 0, cus = 0, per_cu = 0;
        if (hipGetDevice(&dev) != hipSuccess || hipDeviceGetAttribute(&cus, hipDeviceAttributeMultiprocessorCount, dev) != hipSuccess) { grid = -1; return; }
        if (hipFuncSetAttribute((const void*)trunk_fwd, hipFuncAttributeMaxDynamicSharedMemorySize, LDS_BYTES) != hipSuccess) { fprintf(stderr, "kernel_launch: hipFuncSetAttribute failed\n"); grid = -1; return; }
        if (hipOccupancyMaxActiveBlocksPerMultiprocessor(&per_cu, (const void*)trunk_fwd, NWAVES * 64, LDS_BYTES) != hipSuccess || per_cu < 1) { fprintf(stderr, "kernel_launch: occupancy query says %d\n", per_cu); }
        (void)hipGetLastError();
        grid = cus;
    }
    if (grid < 0) return;
    (void)hipMemsetAsync((char*)d_ws + WS_CTL, 0, CTL_ZERO_BYTES, stream);
    Args a{};
    for (int i = 0; i < 28; ++i) a.in[i] = (const float*)d_in[i];
    a.out = (float*)d_out; a.ws = (unsigned char*)d_ws;
#if MK_SPLIT
    for (int p = 0; p < 32; ++p) { a.ph_lo = p; a.ph_hi = p + 1; hipLaunchKernelGGL(trunk_fwd, dim3(grid), dim3(NWAVES * 64), LDS_BYTES, stream, a); }
#else
#if defined(DBG_STOP)
    a.ph_lo = 0; a.ph_hi = DBG_STOP;
#else
    a.ph_lo = 0; a.ph_hi = 32;
#endif
    hipLaunchKernelGGL(trunk_fwd, dim3(grid), dim3(NWAVES * 64), LDS_BYTES, stream, a);
#endif
}
```

```cpp
#include <hip/hip_runtime.h>
#include <hip/hip_bf16.h>
#include <cstdio>
#include <cstdint>
#include <cmath>

constexpr int BATCH = 8, SEQ = 4096, DM = 1024, MTOK = BATCH * SEQ, DFF = 4096;
constexpr int N_E_IN = 3072, N_O_IN = 3840;
constexpr int K_O_OUT = 1536;
constexpr float EPS = 1e-6f;
constexpr float LOG2E = 1.4426950408889634f;
constexpr float QSCALE128 = 0.08838834764831845f * LOG2E;
constexpr float QSCALE192 = 0.07216878364870323f * LOG2E;

constexpr size_t MiB = 1u << 20;
constexpr size_t WS_CTL = 0, CTL_ZERO_BYTES = 1 * MiB;
constexpr size_t WS_SSP = 1 * MiB;
constexpr size_t WS_CUMB = WS_SSP + 512 * 1024;
constexpr size_t WS_MISC32 = 2 * MiB;
constexpr size_t WS_GSS = 4 * MiB;
constexpr size_t WS_SSY = 5 * MiB;
constexpr size_t WS_ROPE = 9 * MiB;
constexpr size_t WS_BM = 17 * MiB;
constexpr size_t WS_W = 33 * MiB;
constexpr size_t WS_XB = 85 * MiB;
constexpr size_t WS_R = 149 * MiB;
constexpr size_t WS_END = 501 * MiB;
constexpr size_t WE_IN = 0, WE_OUT = 6 * MiB, WE_1 = 8 * MiB, WE_2 = 16 * MiB;
constexpr size_t WO_IN = 24 * MiB, WO_UQ = 24 * MiB + 7680 * 1024, WO_UKV = WO_UQ + 768 * 1024, WO_OUT = WO_UKV + 512 * 1024, WO_1 = 36 * MiB, WO_2 = 44 * MiB;
static_assert(WO_OUT + 3 * MiB <= WO_1, "weights map");
constexpr size_t R_EP = 0, R_AOE = 192 * MiB;
constexpr size_t R_C1 = 0, R_AO = 48 * MiB, R_XBC = 144 * MiB, R_KK = 272 * MiB, R_VV = 320 * MiB;
constexpr size_t R_H = 0;
constexpr int CW_TMO = 0;
constexpr int CW_BAR = 4096;
constexpr int CW_QUEUE = 16384;

constexpr int RING_BYTES = 131072;
constexpr int LDS_STAT = 139264;
constexpr int LDS_CAND = 147456;
constexpr int LDS_FAC = 149504;
constexpr int LDS_MISC = 155136;
constexpr int LDS_BYTES = 155648;


__device__ __forceinline__ int olane() { int l; asm volatile("v_mbcnt_lo_u32_b32 %0, -1, 0\n\tv_mbcnt_hi_u32_b32 %0, -1, %0" : "=v"(l)); return l; }
__device__ __forceinline__ int otid(int wave_s) { return (wave_s << 6) | olane(); }
template <int M> __device__ __forceinline__ float xor_f(float v) {
    if constexpr (M == 32) { auto rr = __builtin_amdgcn_permlane32_swap(__float_as_uint(v), __float_as_uint(v), false, false); return __uint_as_float(rr[0] == __float_as_uint(v) ? rr[1] : rr[0]); }
    else return __int_as_float(__builtin_amdgcn_ds_swizzle(__float_as_int(v), (M << 10) | 0x1f));
}
__device__ __forceinline__ float up_f(float v, int o) { const int l = olane(); const int s = (l - o) < 0 ? l : (l - o); return __int_as_float(__builtin_amdgcn_ds_bpermute(s << 2, __float_as_int(v))); }
__device__ __forceinline__ int down_i(int v, int o) { const int l = olane(); const int s = (l + o) > 63 ? l : (l + o); return __builtin_amdgcn_ds_bpermute(s << 2, v); }
__device__ __forceinline__ float wsum_f(float v) { v += xor_f<1>(v); v += xor_f<2>(v); v += xor_f<4>(v); v += xor_f<8>(v); v += xor_f<16>(v); v += xor_f<32>(v); return v; }
__device__ __forceinline__ float wmin_f(float v) { v = fminf(v, xor_f<1>(v)); v = fminf(v, xor_f<2>(v)); v = fminf(v, xor_f<4>(v)); v = fminf(v, xor_f<8>(v)); v = fminf(v, xor_f<16>(v)); v = fminf(v, xor_f<32>(v)); return v; }
__device__ __forceinline__ float wmax_f(float v) { v = fmaxf(v, xor_f<1>(v)); v = fmaxf(v, xor_f<2>(v)); v = fmaxf(v, xor_f<4>(v)); v = fmaxf(v, xor_f<8>(v)); v = fmaxf(v, xor_f<16>(v)); v = fmaxf(v, xor_f<32>(v)); return v; }
namespace pg8 {
#define PG8_LAS __attribute__((address_space(3)))
typedef unsigned short bf16_t;
typedef short bf16x8 __attribute__((ext_vector_type(8)));
typedef float f32x4 __attribute__((ext_vector_type(4)));
typedef unsigned u32x4 __attribute__((ext_vector_type(4)));
constexpr int BM = 256, BK = 64, HALF = 128, HTB = HALF * BK * 2  , STAGE_BYTES = 8 * HTB, NXCD = 8, WGM = 8;

__host__ __device__ __forceinline__ int lds_byte(int r, int c) { const int st = (r >> 4) * 2 + (c >> 5), rr = r & 15, cc = c & 31, ob = rr * 64 + cc * 2; return st * 1024 + (ob ^ (((ob >> 9) & 1) << 5)); }
__host__ __device__ __forceinline__ void stage_rc(int b, int& R, int& C) { const int st = b / 1024, sb = b % 1024, swz = sb ^ (((sb >> 9) & 1) << 5); R = (st >> 1) * 16 + swz / 64; C = (st & 1) * 32 + (swz % 64) / 2; }
__host__ __device__ __forceinline__ int perm32(int rho) { const int n = rho >> 4, i = rho & 15; return 8 * (i >> 2) + 4 * n + (i & 3); }

struct Unit { int pm, pn; };
struct Gemm { const bf16_t* A; const bf16_t* Bt; int M, N, K, lda; };

struct StaticOrder {
    int nM, nN, nwg, G, c;
    __host__ __device__ void init(int M, int N, int G_, int c_) { nM = M / BM; nN = N / BM; nwg = nM * nN; G = G_; c = c_; }
    __host__ __device__ bool next(int i, Unit& u) const {
        const long L = (long)i * G + c; if (L >= nwg) return false;
        int wgid = (int)L; { const int q = nwg / NXCD, r = nwg % NXCD, xcd = wgid % NXCD, off = wgid / NXCD; wgid = (xcd < r ? xcd * (q + 1) : r * (q + 1) + (xcd - r) * q) + off; }
        const int nig = WGM * nN, gid = wgid / nig, fm = gid * WGM, gsz = (nM - fm) < WGM ? (nM - fm) : WGM;
        u.pm = fm + ((wgid % nig) % gsz); u.pn = (wgid % nig) / gsz; return true;
    }
    __device__ __forceinline__ void a_ready(const Unit&) const {}
    __device__ __forceinline__ void done(const Unit&) const {}
};


__device__ __forceinline__ unsigned cvt_pk_bf16(float lo, float hi) { unsigned r; asm volatile("v_cvt_pk_bf16_f32 %0, %1, %2" : "=v"(r) : "v"(lo), "v"(hi)); return r; }
typedef unsigned u32x2 __attribute__((ext_vector_type(2)));
#define EPI_BAR() do { asm volatile("s_waitcnt lgkmcnt(0)" ::: "memory"); __builtin_amdgcn_s_barrier(); asm volatile("" ::: "memory"); } while (0)
__device__ __forceinline__ float sq4(const f32x4 x) { return (x[0] * x[0] + x[1] * x[1]) + (x[2] * x[2] + x[3] * x[3]); }
__device__ __forceinline__ float red_fq(float q) { q += xor_f<16>(q); q += xor_f<32>(q); return q; }
__device__ __forceinline__ u32x4 pack8(const f32x4 a, const f32x4 b) { u32x4 w; w.x = cvt_pk_bf16(a[0], a[1]); w.y = cvt_pk_bf16(a[2], a[3]); w.z = cvt_pk_bf16(b[0], b[1]); w.w = cvt_pk_bf16(b[2], b[3]); return w; }
__device__ __forceinline__ float row_rs(const float* ssp, int row) { const float ss = (ssp[row] + ssp[MTOK + row]) + (ssp[2 * MTOK + row] + ssp[3 * MTOK + row]); return rsqrtf(ss * (1.0f / 1024.0f) + EPS); }
__device__ __forceinline__ float log_sigmoidf(float x) { return fminf(x, 0.f) - __logf(1.0f + __expf(-fabsf(x))); }
__device__ __forceinline__ float softplusf(float x) { return fmaxf(x, 0.f) + __logf(1.0f + __expf(-fabsf(x))); }

struct EpiEvenIn {
    static constexpr bool PERM = true, AFTER_DRAIN = false;
    bf16_t* EP; const float* ssp; float* misc32; const float* qn_a; const float* kn_a; const float* qn_b; const float* kn_b; const float* b_f; PG8_LAS float* st;
    __device__ __forceinline__ void operator()(f32x4 (&acc)[2][2][4][2], const Unit& u, int wr, int wc, int fr, int fq) const {
        const int tid_ = ((wr * 4 + wc) << 6) | (fq << 4) | fr;
        const int pn = u.pn;
        const float* g0 = nullptr; const float* g1 = nullptr; float s0 = 1.f, s1 = 1.f;
        if (pn <= 1) { g0 = qn_a; g1 = qn_a; s0 = QSCALE128; s1 = QSCALE128; }
        else if (pn == 2) { g0 = kn_a; }
        else if (pn == 6 || pn == 7) { g0 = qn_b; g1 = qn_b; s0 = QSCALE128; s1 = QSCALE128; }
        else if (pn == 8 || pn == 9) { g0 = kn_b; g1 = kn_b; }
        int rl0 = wr * 64 + fr; asm volatile("" : "+v"(rl0)); const int row0 = u.pm * BM + rl0;
        { const int tid = tid_; if (tid < 256) { st[2048 + tid] = row_rs(ssp, u.pm * BM + tid);
            const float* g = (tid >> 7) ? g1 : g0; st[2304 + tid] = g ? g[tid & 127] * ((tid >> 7) ? s1 : s0) : 1.f; } }
        EPI_BAR();
#pragma unroll
        for (int ai = 0; ai < 2; ++ai)
#pragma unroll
            for (int m = 0; m < 4; ++m) { const int rl = ai * HALF + rl0 + m * 16; const float rs = st[2048 + rl];
#pragma unroll
                for (int bj = 0; bj < 2; ++bj) { acc[ai][bj][m][0] *= rs; acc[ai][bj][m][1] *= rs;
                    if (g0 != nullptr) { const float q = red_fq(sq4(acc[ai][bj][m][0]) + sq4(acc[ai][bj][m][1])); if (fq == 0) st[(rl * 2 + bj) * 4 + wc] = q; } } }
        if (g0 != nullptr) EPI_BAR();
#pragma unroll
        for (int ai = 0; ai < 2; ++ai)
#pragma unroll
            for (int m = 0; m < 4; ++m) { const int rl = ai * HALF + rl0 + m * 16; bf16_t* rowp = EP + (size_t)(u.pm * BM + rl) * N_E_IN + pn * BM + wc * 32 + fq * 8;
#pragma unroll
                for (int bj = 0; bj < 2; ++bj) { float f = 1.f;
                    if ((bj ? g1 : g0) != nullptr) { const f32x4 p = *(const PG8_LAS f32x4*)(st + (rl * 2 + bj) * 4); f = rsqrtf(((p[0] + p[1]) + (p[2] + p[3])) * (1.0f / 128.0f) + EPS); }
                    const PG8_LAS float* gp = st + 2304 + bj * HALF + wc * 32 + fq * 8;
                    const f32x4 v0 = acc[ai][bj][m][0] * *(const PG8_LAS f32x4*)gp * f, v1 = acc[ai][bj][m][1] * *(const PG8_LAS f32x4*)(gp + 4) * f;
                    *(u32x4*)(rowp + bj * HALF) = pack8(v0, v1); }
                asm volatile("" ::: "memory"); }
        if (pn == 5 && wc == 2 && fq < 2) {
#pragma unroll
            for (int ai = 0; ai < 2; ++ai)
#pragma unroll
                for (int m = 0; m < 4; ++m) { float* mp = misc32 + (size_t)(row0 + ai * HALF + m * 16) * 16;
                    if (fq == 0) { *(f32x4*)(mp) = acc[ai][0][m][0]; *(f32x4*)(mp + 4) = acc[ai][0][m][1]; }
                    else { const f32x4 v = acc[ai][0][m][0], bf = *(const f32x4*)b_f; f32x4 lf;
#pragma unroll
                        for (int j = 0; j < 4; ++j) lf[j] = log_sigmoidf(v[j] + bf[j]);
                        *(f32x4*)(mp + 8) = lf; } }
        }
    }
};

struct EpiResid {
    static constexpr bool PERM = true, AFTER_DRAIN = false;
    bf16_t* xb; float* ssp; PG8_LAS float* st; float* fout;
    __device__ __forceinline__ void operator()(f32x4 (&acc)[2][2][4][2], const Unit& u, int wr, int wc, int fr, int fq) const {
        const int tid_ = ((wr * 4 + wc) << 6) | (fq << 4) | fr;
        int rl0 = wr * 64 + fr; asm volatile("" : "+v"(rl0));
#pragma unroll
        for (int ai = 0; ai < 2; ++ai) {
            u32x4 raw[4][2];
#pragma unroll
            for (int m = 0; m < 4; ++m) { const size_t off = (size_t)(u.pm * BM + ai * HALF + rl0 + m * 16) * DM + u.pn * BM + wc * 32 + fq * 8;
                raw[m][0] = *(const u32x4*)(xb + off); raw[m][1] = *(const u32x4*)(xb + off + HALF); }
#pragma unroll
            for (int m = 0; m < 4; ++m) { const int rl = ai * HALF + rl0 + m * 16; const size_t off = (size_t)(u.pm * BM + rl) * DM + u.pn * BM + wc * 32 + fq * 8; float q = 0.f;
#pragma unroll
                for (int bj = 0; bj < 2; ++bj) { const u32x4 rw = raw[m][bj]; f32x4 v0, v1;
                    v0[0] = __uint_as_float(rw[0] << 16); v0[1] = __uint_as_float(rw[0] & 0xffff0000u); v0[2] = __uint_as_float(rw[1] << 16); v0[3] = __uint_as_float(rw[1] & 0xffff0000u);
                    v1[0] = __uint_as_float(rw[2] << 16); v1[1] = __uint_as_float(rw[2] & 0xffff0000u); v1[2] = __uint_as_float(rw[3] << 16); v1[3] = __uint_as_float(rw[3] & 0xffff0000u);
                    v0 += acc[ai][bj][m][0]; v1 += acc[ai][bj][m][1];
                    if (fout) { *(f32x4*)(fout + off + bj * HALF) = v0; *(f32x4*)(fout + off + bj * HALF + 4) = v1; }
                    else { *(u32x4*)(xb + off + bj * HALF) = pack8(v0, v1); q += sq4(v0) + sq4(v1); } }
                if (!fout) { q = red_fq(q); if (fq == 0) st[rl * 4 + wc] = q; } }
            asm volatile("" ::: "memory"); }
        if (fout) return;
        EPI_BAR();
        if (tid_ < 256) { const f32x4 p = *(const PG8_LAS f32x4*)(st + tid_ * 4); ssp[(size_t)u.pn * MTOK + u.pm * BM + tid_] = (p[0] + p[1]) + (p[2] + p[3]); }
    }
};

struct EpiMlpUp {
    static constexpr bool PERM = true, AFTER_DRAIN = false;
    bf16_t* H; const float* ssp;
    __device__ __forceinline__ void operator()(f32x4 (&acc)[2][2][4][2], const Unit& u, int wr, int wc, int fr, int fq) const {
        int row0 = u.pm * BM + wr * 64 + fr; asm volatile("" : "+v"(row0));
        float s4[2][4][4];
#pragma unroll
        for (int ai = 0; ai < 2; ++ai)
#pragma unroll
            for (int m = 0; m < 4; ++m) { const int row = row0 + ai * HALF + m * 16;
#pragma unroll
                for (int p = 0; p < 4; ++p) s4[ai][m][p] = ssp[(size_t)p * MTOK + row]; }
#pragma unroll
        for (int ai = 0; ai < 2; ++ai)
#pragma unroll
            for (int m = 0; m < 4; ++m) { const int row = row0 + ai * HALF + m * 16; const float rs = rsqrtf(((s4[ai][m][0] + s4[ai][m][1]) + (s4[ai][m][2] + s4[ai][m][3])) * (1.0f / 1024.0f) + EPS);
                bf16_t* rowp = H + (size_t)row * DFF + u.pn * BM + wc * 32 + fq * 8;
#pragma unroll
                for (int bj = 0; bj < 2; ++bj) { f32x4 v0 = acc[ai][bj][m][0] * rs, v1 = acc[ai][bj][m][1] * rs;
#pragma unroll
                    for (int j = 0; j < 4; ++j) { const float a = fmaxf(v0[j], 0.f), b = fmaxf(v1[j], 0.f); v0[j] = a * a; v1[j] = b * b; }
                    *(u32x4*)(rowp + bj * HALF) = pack8(v0, v1); } }
    }
};

struct EpiOddIn {
    static constexpr bool PERM = true, AFTER_DRAIN = false;
    bf16_t* C1; bf16_t* AO; bf16_t* XBC; const float* ssp; float* gss; float* dt32; const float* dt_bias; PG8_LAS float* st;
    __device__ __forceinline__ void operator()(f32x4 (&acc)[2][2][4][2], const Unit& u, int wr, int wc, int fr, int fq) const {
        const int tid_ = ((wr * 4 + wc) << 6) | (fq << 4) | fr;
        const int pn = u.pn; int rl0 = wr * 64 + fr; asm volatile("" : "+v"(rl0)); const int row0 = u.pm * BM + rl0;
        bf16_t* dst; int ld;
        if (pn < 3) { dst = C1 + pn * BM; ld = 768; } else if (pn < 7) { dst = AO + 512 + (pn - 3) * BM; ld = K_O_OUT; } else { dst = XBC + (pn - 7) * BM; ld = 2048; }
        { const int tid = tid_; if (tid < 256) st[2048 + tid] = row_rs(ssp, u.pm * BM + tid); }
        EPI_BAR();
#pragma unroll
        for (int ai = 0; ai < 2; ++ai)
#pragma unroll
            for (int m = 0; m < 4; ++m) { const int rl = ai * HALF + rl0 + m * 16; const float rs = st[2048 + rl]; bf16_t* rowp = dst + (size_t)(u.pm * BM + rl) * ld + wc * 32 + fq * 8;
#pragma unroll
                for (int bj = 0; bj < 2; ++bj) { acc[ai][bj][m][0] *= rs; acc[ai][bj][m][1] *= rs; *(u32x4*)(rowp + bj * HALF) = pack8(acc[ai][bj][m][0], acc[ai][bj][m][1]); }
                asm volatile("" ::: "memory"); }
        if (pn < 3) {
#pragma unroll
            for (int ai = 0; ai < 2; ++ai)
#pragma unroll
                for (int m = 0; m < 4; ++m)
#pragma unroll
                    for (int bj = 0; bj < 2; ++bj) { float q = sq4(acc[ai][bj][m][0]) + sq4(acc[ai][bj][m][1]);
                        if (pn == 2 && bj == 1 && wc >= 2) q = 0.f;
                        q = red_fq(q); if (fq == 0) st[((ai * HALF + rl0 + m * 16) * 2 + bj) * 4 + wc] = q; }
            EPI_BAR();
            const int tid = tid_;
            if (tid < 256) {
#pragma unroll
                for (int bj = 0; bj < 2; ++bj) { const f32x4 p = *(const PG8_LAS f32x4*)(st + (tid * 2 + bj) * 4); gss[(size_t)(u.pm * BM + tid) * 8 + 2 * pn + bj] = (p[0] + p[1]) + (p[2] + p[3]); } }
            if (pn == 2 && wc == 2 && fq < 2) {
                const f32x4 b0 = *(const f32x4*)(dt_bias + fq * 8), b1 = *(const f32x4*)(dt_bias + fq * 8 + 4);
#pragma unroll
                for (int ai = 0; ai < 2; ++ai)
#pragma unroll
                    for (int m = 0; m < 4; ++m) { float* mp = dt32 + (size_t)(row0 + ai * HALF + m * 16) * 16 + fq * 8; f32x4 d0, d1;
#pragma unroll
                        for (int j = 0; j < 4; ++j) { d0[j] = softplusf(acc[ai][1][m][0][j] + b0[j]); d1[j] = softplusf(acc[ai][1][m][1][j] + b1[j]); }
                        *(f32x4*)mp = d0; *(f32x4*)(mp + 4) = d1; }
            }
        }
    }
};

struct EpiUq {
    static constexpr bool PERM = true, AFTER_DRAIN = false;
    bf16_t* Q; const float* gss; const float* qn_c; const float* rope; PG8_LAS float* st;
    __device__ __forceinline__ void operator()(f32x4 (&acc)[2][2][4][2], const Unit& u, int wr, int wc, int fr, int fq) const {
        const int tid_ = ((wr * 4 + wc) << 6) | (fq << 4) | fr;
        const int h = u.pn; int rl0 = wr * 64 + fr; asm volatile("" : "+v"(rl0));
        { const int tid = tid_; if (tid < 256) { const float* gp = gss + (size_t)(u.pm * BM + tid) * 8; st[2048 + tid] = rsqrtf(((gp[0] + gp[1]) + gp[2]) * (1.0f / 384.0f) + EPS);
            float gg = 0.f; if (tid < 128) gg = qn_c[tid]; else if (tid < 192) { const int jj = tid - 128; gg = qn_c[128 + ((jj & 1) ? 32 : 0) + (jj >> 1)]; }
            st[2304 + tid] = gg * QSCALE192; } }
        EPI_BAR();
#pragma unroll
        for (int ai = 0; ai < 2; ++ai)
#pragma unroll
            for (int m = 0; m < 4; ++m) { const int rl = ai * HALF + rl0 + m * 16; const float rc = st[2048 + rl]; float q = 0.f;
#pragma unroll
                for (int bj = 0; bj < 2; ++bj) { acc[ai][bj][m][0] *= rc; acc[ai][bj][m][1] *= rc; q += sq4(acc[ai][bj][m][0]) + sq4(acc[ai][bj][m][1]); }
                q = red_fq(q); if (fq == 0) st[rl * 4 + wc] = q; }
        EPI_BAR();
        const int i0 = (wc & 1) * 16 + fq * 4;
        f32x4 cs[2][4][2];
        if (wc < 2) {
#pragma unroll
            for (int ai = 0; ai < 2; ++ai)
#pragma unroll
                for (int m = 0; m < 4; ++m) { const float* rp = rope + ((size_t)(u.pm * BM + ai * HALF + rl0 + m * 16) * 32 + i0) * 2; cs[ai][m][0] = *(const f32x4*)rp; cs[ai][m][1] = *(const f32x4*)(rp + 4); }
        }
#pragma unroll
        for (int ai = 0; ai < 2; ++ai)
#pragma unroll
            for (int m = 0; m < 4; ++m) { const int rl = ai * HALF + rl0 + m * 16; const int row = u.pm * BM + rl;
                const f32x4 p = *(const PG8_LAS f32x4*)(st + rl * 4); const float f = rsqrtf(((p[0] + p[1]) + (p[2] + p[3])) * (1.0f / 192.0f) + EPS);
                bf16_t* rowp = Q + (size_t)row * 768 + h * 192; const PG8_LAS float* gp = st + 2304 + wc * 32 + fq * 8;
                *(u32x4*)(rowp + wc * 32 + fq * 8) = pack8(acc[ai][0][m][0] * *(const PG8_LAS f32x4*)gp * f, acc[ai][0][m][1] * *(const PG8_LAS f32x4*)(gp + 4) * f);
                if (wc < 2) { const f32x4 cs0 = cs[ai][m][0], cs1 = cs[ai][m][1];
                    const f32x4 a = acc[ai][1][m][0] * *(const PG8_LAS f32x4*)(gp + HALF) * f, b = acc[ai][1][m][1] * *(const PG8_LAS f32x4*)(gp + HALF + 4) * f;
                    f32x4 o0, o1;
                    o0[0] = a[0] * cs0[0] - a[1] * cs0[1]; o0[1] = a[1] * cs0[0] + a[0] * cs0[1]; o0[2] = a[2] * cs0[2] - a[3] * cs0[3]; o0[3] = a[3] * cs0[2] + a[2] * cs0[3];
                    o1[0] = b[0] * cs1[0] - b[1] * cs1[1]; o1[1] = b[1] * cs1[0] + b[0] * cs1[1]; o1[2] = b[2] * cs1[2] - b[3] * cs1[3]; o1[3] = b[3] * cs1[2] + b[2] * cs1[3];
                    *(u32x4*)(rowp + 128 + wc * 32 + fq * 8) = pack8(o0, o1); } }
    }
};

struct EpiUkv {
    static constexpr bool PERM = true, AFTER_DRAIN = false;
    bf16_t* KK; bf16_t* VV; const bf16_t* C1; const float* gss; const float* kn_c; const float* rope; PG8_LAS float* st;
    __device__ __forceinline__ void operator()(f32x4 (&acc)[2][2][4][2], const Unit& u, int wr, int wc, int fr, int fq) const {
        const int tid_ = ((wr * 4 + wc) << 6) | (fq << 4) | fr;
        const int h = u.pn; int rl0 = wr * 64 + fr; asm volatile("" : "+v"(rl0)); const int tid = tid_;
        if (tid < 256) { const float* gp = gss + (size_t)(u.pm * BM + tid) * 8; st[2048 + tid] = rsqrtf((gp[3] + gp[4]) * (1.0f / 256.0f) + EPS);
            float gg = 0.f; if (tid < 128) gg = kn_c[tid]; else if (tid < 192) { const int jj = tid - 128; gg = kn_c[128 + ((jj & 1) ? 32 : 0) + (jj >> 1)]; }
            st[2304 + tid] = gg; }
        EPI_BAR();
#pragma unroll
        for (int ai = 0; ai < 2; ++ai)
#pragma unroll
            for (int m = 0; m < 4; ++m) { const int rl = ai * HALF + rl0 + m * 16; const int row = u.pm * BM + rl; const float rc = st[2048 + rl];
#pragma unroll
                for (int bj = 0; bj < 2; ++bj) { acc[ai][bj][m][0] *= rc; acc[ai][bj][m][1] *= rc; }
                *(u32x4*)(VV + (size_t)row * 512 + h * 128 + wc * 32 + fq * 8) = pack8(acc[ai][1][m][0], acc[ai][1][m][1]);
                const float q = red_fq(sq4(acc[ai][0][m][0]) + sq4(acc[ai][0][m][1])); if (fq == 0) st[rl * 4 + wc] = q;
                asm volatile("" ::: "memory"); }
        EPI_BAR();
        if (tid < 256) { const f32x4 p = *(const PG8_LAS f32x4*)(st + tid * 4); const float ss = ((p[0] + p[1]) + (p[2] + p[3])) + gss[(size_t)(u.pm * BM + tid) * 8 + 5];
            st[2048 + tid] = rsqrtf(ss * (1.0f / 192.0f) + EPS); }
        EPI_BAR();
#pragma unroll
        for (int ai = 0; ai < 2; ++ai)
#pragma unroll
            for (int m = 0; m < 4; ++m) { const int rl = ai * HALF + rl0 + m * 16; const float f = st[2048 + rl]; const PG8_LAS float* gp = st + 2304 + wc * 32 + fq * 8;
                *(u32x4*)(KK + (size_t)(u.pm * BM + rl) * 768 + h * 192 + wc * 32 + fq * 8) = pack8(acc[ai][0][m][0] * *(const PG8_LAS f32x4*)gp * f, acc[ai][0][m][1] * *(const PG8_LAS f32x4*)(gp + 4) * f);
                asm volatile("" ::: "memory"); }
        { const int rl = tid >> 1, ib = (tid & 1) * 16; const int row = u.pm * BM + rl; const float f = st[2048 + rl];
          const bf16_t* src = C1 + (size_t)row * 768 + 640 + ib * 2; bf16_t* dstp = KK + (size_t)row * 768 + h * 192 + 128 + ib * 2; const float* rp = rope + ((size_t)row * 32 + ib) * 2;
          const PG8_LAS float* gq = st + 2304 + 128 + ib * 2;
#pragma unroll
          for (int c = 0; c < 4; ++c) { const u32x4 raw = *(const u32x4*)(src + c * 8); const f32x4 g0 = *(const PG8_LAS f32x4*)(gq + c * 8), g1 = *(const PG8_LAS f32x4*)(gq + c * 8 + 4);
              const f32x4 cA = *(const f32x4*)(rp + c * 8), cB = *(const f32x4*)(rp + c * 8 + 4);
              f32x4 xa, xb;
              xa[0] = __uint_as_float(raw[0] << 16) * g0[0] * f; xa[1] = __uint_as_float(raw[0] & 0xffff0000u) * g0[1] * f; xa[2] = __uint_as_float(raw[1] << 16) * g0[2] * f; xa[3] = __uint_as_float(raw[1] & 0xffff0000u) * g0[3] * f;
              xb[0] = __uint_as_float(raw[2] << 16) * g1[0] * f; xb[1] = __uint_as_float(raw[2] & 0xffff0000u) * g1[1] * f; xb[2] = __uint_as_float(raw[3] << 16) * g1[2] * f; xb[3] = __uint_as_float(raw[3] & 0xffff0000u) * g1[3] * f;
              f32x4 o0, o1;
              o0[0] = xa[0] * cA[0] - xa[1] * cA[1]; o0[1] = xa[1] * cA[0] + xa[0] * cA[1]; o0[2] = xa[2] * cA[2] - xa[3] * cA[3]; o0[3] = xa[3] * cA[2] + xa[2] * cA[3];
              o1[0] = xb[0] * cB[0] - xb[1] * cB[1]; o1[1] = xb[1] * cB[0] + xb[0] * cB[1]; o1[2] = xb[2] * cB[2] - xb[3] * cB[3]; o1[3] = xb[3] * cB[2] + xb[2] * cB[3];
              *(u32x4*)(dstp + c * 8) = pack8(o0, o1); } }
    }
};

struct GroupScaleHook {
    static constexpr bool ACTIVE = true;
    const float* ssy; PG8_LAS float* fac;
    __device__ __forceinline__ void step(int t, f32x4 (&acc)[2][2][4][2], const Unit& u, int wid, int wr) const {
        if (t == 0) {
            if (wid < 4) { const int tid = (wid << 6) | olane(); const float* sp = ssy + (size_t)(u.pm * BM + tid) * 32; float r[4];
#pragma unroll
                for (int gq = 0; gq < 4; ++gq) { const f32x4 s0 = *(const f32x4*)(sp + gq * 8), s1 = *(const f32x4*)(sp + gq * 8 + 4);
                    r[gq] = rsqrtf((((s0[0] + s0[1]) + (s0[2] + s0[3])) + ((s1[0] + s1[1]) + (s1[2] + s1[3]))) * (1.0f / 256.0f) + EPS); }
                PG8_LAS float* fp = fac + tid * 5; fp[0] = 1.0f / r[0]; fp[1] = r[0] / r[1]; fp[2] = r[1] / r[2]; fp[3] = r[2] / r[3]; fp[4] = r[3]; }
        } else if (t >= 8 && (t & 3) == 0) { scale(acc, (t - 8) >> 2, wr); }
    }
    __device__ __forceinline__ void finish(f32x4 (&acc)[2][2][4][2], const Unit&, int wr) const { scale(acc, 4, wr); }
    __device__ __forceinline__ void scale(f32x4 (&acc)[2][2][4][2], int k, int wr) const {
        const int rl0 = wr * 64 + (olane() & 15);
#pragma unroll
        for (int ai = 0; ai < 2; ++ai)
#pragma unroll
            for (int m = 0; m < 4; ++m) { const float f = fac[(ai * HALF + rl0 + m * 16) * 5 + k];
#pragma unroll
                for (int bj = 0; bj < 2; ++bj) { acc[ai][bj][m][0] *= f; acc[ai][bj][m][1] *= f; } }
    }
};
struct NoHook { static constexpr bool ACTIVE = false; };
template <class Epi, class Sched, bool ALIGN_EPI = false, bool SP2 = false, class KHook = NoHook>
__device__ __forceinline__ void gemm_phase(PG8_LAS unsigned char* lds, const Gemm g, const Sched& S, const Epi& E, const int tid_in, const KHook HK = KHook()) {
    int tid = tid_in; asm volatile("" : "+v"(tid)); const int wid = __builtin_amdgcn_readfirstlane(tid >> 6), lane = tid & 63, wr = wid >> 2, wc = wid & 3, fr = lane & 15, fq = lane >> 4;
    const int K = g.K, nt = K / BK;
    unsigned voffA[2], voffB[2];
#pragma unroll
    for (int i = 0; i < 2; ++i) { int R, C; stage_rc(tid * 16 + i * 8192, R, C); const int Rb = Epi::PERM ? ((R & ~31) + perm32(R & 31)) : R;
        voffA[i] = (unsigned)(R * g.lda + C) * 2u; voffB[i] = (unsigned)(Rb * K + C) * 2u; }
    const size_t kstep = (size_t)(BK * 2);
    const size_t hstepA = (size_t)HALF * g.lda * 2, hstepB = (size_t)HALF * K * 2;
    const size_t tstepA = 2 * hstepA, tstepB = 2 * hstepB;
    const unsigned ldsw = (unsigned)wid * 1024u;
    const int aoff = lds_byte(wr * 64 + fr, fq * 8), boff = lds_byte(wc * 32 + fr, fq * 8);
#define PG8_SA(b, h) (((b) * 2 + (h)) * HTB)
#define PG8_SB(b, h) ((4 + (b) * 2 + (h)) * HTB)
#define PG8_STAGE(bufoff, gbase, voff) do { _Pragma("unroll") for (int _i = 0; _i < 2; ++_i) \
        __builtin_amdgcn_global_load_lds((const unsigned*)((const char*)(gbase) + (voff)[_i]), (PG8_LAS unsigned*)(lds + (bufoff) + ldsw + _i * 8192), 16, 0, 0); } while (0)
#define PG8_LDA(dst, b, h) do { _Pragma("unroll") for (int m = 0; m < 4; ++m) _Pragma("unroll") for (int k = 0; k < 2; ++k) dst[m][k] = *(const PG8_LAS bf16x8*)(lds + PG8_SA(b, h) + aoff + m * 2048 + k * 1024); } while (0)
#define PG8_LDB(dst, b, h) do { _Pragma("unroll") for (int n = 0; n < 2; ++n) _Pragma("unroll") for (int k = 0; k < 2; ++k) dst[n][k] = *(const PG8_LAS bf16x8*)(lds + PG8_SB(b, h) + boff + n * 2048 + k * 1024); } while (0)
#define PG8_MMA(ai, bj, At, Bt) do { __builtin_amdgcn_s_setprio(1); _Pragma("unroll") for (int m = 0; m < 4; ++m) _Pragma("unroll") for (int n = 0; n < 2; ++n) _Pragma("unroll") for (int k = 0; k < 2; ++k) \
        acc[ai][bj][m][n] = __builtin_amdgcn_mfma_f32_16x16x32_bf16(Bt[n][k], At[m][k], acc[ai][bj][m][n], 0, 0, 0); __builtin_amdgcn_s_setprio(0); } while (0)
#define PG8_WAIT_V(n) asm volatile("s_waitcnt vmcnt(" #n ")" ::: "memory")
#define PG8_WAIT_L(n) asm volatile("s_waitcnt lgkmcnt(" #n ")" ::: "memory")
#define PG8_BAR __builtin_amdgcn_s_barrier()
#define PG8_SCHED __builtin_amdgcn_sched_barrier(0)
    Unit cur, nxt; int ui = 0;
    if (!S.next(0, cur)) return;
    f32x4 acc[2][2][4][2];
#pragma unroll
    for (int a = 0; a < 2; ++a)
#pragma unroll
        for (int b = 0; b < 2; ++b)
#pragma unroll
            for (int m = 0; m < 4; ++m)
#pragma unroll
                for (int n = 0; n < 2; ++n) acc[a][b][m][n] = (f32x4){0.f, 0.f, 0.f, 0.f};
    bf16x8 At[4][2], B0[2][2], B1[2][2];
    const char* cA = (const char*)g.A + (size_t)cur.pm * tstepA; const char* cB = (const char*)g.Bt + (size_t)cur.pn * tstepB;
    S.a_ready(cur);
    if constexpr (SP2) {
        PG8_STAGE(PG8_SB(0, 0), cB, voffB); PG8_STAGE(PG8_SB(0, 1), cB + hstepB, voffB); PG8_STAGE(PG8_SA(0, 0), cA, voffA); PG8_STAGE(PG8_SA(0, 1), cA + hstepA, voffA);
        if (wr == 1) PG8_BAR;
        PG8_WAIT_V(2); PG8_BAR;
        PG8_STAGE(PG8_SB(1, 0), cB + kstep, voffB); PG8_STAGE(PG8_SA(1, 0), cA + kstep, voffA); PG8_STAGE(PG8_SB(1, 1), cB + hstepB + kstep, voffB);
        PG8_WAIT_V(6); PG8_BAR;
    } else {
        PG8_STAGE(PG8_SB(0, 0), cB, voffB); PG8_STAGE(PG8_SA(0, 0), cA, voffA); PG8_STAGE(PG8_SB(0, 1), cB + hstepB, voffB); PG8_STAGE(PG8_SA(0, 1), cA + hstepA, voffA);
        if (wr == 1) PG8_BAR;
        PG8_WAIT_V(4); PG8_BAR;
        PG8_STAGE(PG8_SB(1, 0), cB + kstep, voffB); PG8_STAGE(PG8_SA(1, 0), cA + kstep, voffA); PG8_STAGE(PG8_SB(1, 1), cB + hstepB + kstep, voffB);
        PG8_WAIT_V(6); PG8_BAR;
    }
    for (;;) {
        const bool has_next = S.next(ui + 1, nxt);
        const char* nA = has_next ? (const char*)g.A + (size_t)nxt.pm * tstepA : cA; const char* nB = has_next ? (const char*)g.Bt + (size_t)nxt.pn * tstepB : cB;
        for (int t = 0; t < nt; t += 2) {
            if constexpr (KHook::ACTIVE) HK.step(t, acc, cur, wid, wr);
            const bool last = (t == nt - 2);
            const char* a1 = cA + (size_t)(t + 1) * kstep;
            const char* a2 = last ? nA : cA + (size_t)(t + 2) * kstep; const char* b2 = last ? nB : cB + (size_t)(t + 2) * kstep;
            const char* a3 = a2 + kstep; const char* b3 = b2 + kstep;
            if (last && has_next) S.a_ready(nxt);
            if constexpr (SP2) {
            PG8_LDB(B0, 0, 0); PG8_LDB(B1, 0, 1); PG8_SCHED; PG8_LDA(At, 0, 0); PG8_STAGE(PG8_SA(1, 1), a1 + hstepA, voffA);
            PG8_WAIT_V(8); PG8_WAIT_L(0); PG8_BAR; PG8_MMA(0, 0, At, B0); PG8_MMA(0, 1, At, B1); PG8_BAR; PG8_SCHED;
            PG8_LDA(At, 0, 1); PG8_STAGE(PG8_SB(0, 0), b2, voffB); PG8_STAGE(PG8_SB(0, 1), b2 + hstepB, voffB); PG8_STAGE(PG8_SA(0, 0), a2, voffA);
            PG8_WAIT_V(8); PG8_WAIT_L(0); PG8_BAR; PG8_MMA(1, 0, At, B0); PG8_MMA(1, 1, At, B1); PG8_BAR; PG8_SCHED;
            PG8_LDB(B0, 1, 0); PG8_LDB(B1, 1, 1); PG8_SCHED; PG8_LDA(At, 1, 0); PG8_STAGE(PG8_SA(0, 1), a2 + hstepA, voffA);
            PG8_WAIT_V(8); PG8_WAIT_L(0); PG8_BAR; PG8_MMA(0, 0, At, B0); PG8_MMA(0, 1, At, B1); PG8_BAR; PG8_SCHED;
            PG8_LDA(At, 1, 1); PG8_STAGE(PG8_SB(1, 0), b3, voffB); PG8_STAGE(PG8_SB(1, 1), b3 + hstepB, voffB); PG8_STAGE(PG8_SA(1, 0), a3, voffA);
            PG8_WAIT_V(8); PG8_WAIT_L(0); PG8_BAR; PG8_MMA(1, 0, At, B0); PG8_MMA(1, 1, At, B1); PG8_BAR; PG8_SCHED;
            } else {
            PG8_LDB(B0, 0, 0); PG8_SCHED; PG8_LDA(At, 0, 0); PG8_STAGE(PG8_SA(1, 1), a1 + hstepA, voffA);
            PG8_WAIT_L(8); PG8_BAR; PG8_WAIT_L(0); PG8_MMA(0, 0, At, B0); PG8_BAR; PG8_SCHED;
            PG8_LDB(B1, 0, 1); PG8_STAGE(PG8_SB(0, 0), b2, voffB);
            PG8_BAR; PG8_WAIT_L(0); PG8_MMA(0, 1, At, B1); PG8_BAR;
            PG8_LDA(At, 0, 1); PG8_STAGE(PG8_SA(0, 0), a2, voffA);
            PG8_BAR; PG8_WAIT_L(0); PG8_MMA(1, 0, At, B0); PG8_BAR; PG8_SCHED;
            PG8_STAGE(PG8_SB(0, 1), b2 + hstepB, voffB);
            PG8_WAIT_V(6); PG8_BAR; PG8_MMA(1, 1, At, B1); PG8_BAR;
            PG8_LDB(B0, 1, 0); PG8_SCHED; PG8_LDA(At, 1, 0); PG8_STAGE(PG8_SA(0, 1), a2 + hstepA, voffA);
            PG8_WAIT_L(8); PG8_BAR; PG8_WAIT_L(0); PG8_MMA(0, 0, At, B0); PG8_BAR; PG8_SCHED;
            PG8_LDB(B1, 1, 1); PG8_STAGE(PG8_SB(1, 0), b3, voffB);
            PG8_BAR; PG8_WAIT_L(0); PG8_MMA(0, 1, At, B1); PG8_BAR;
            PG8_LDA(At, 1, 1); PG8_STAGE(PG8_SA(1, 0), a3, voffA);
            PG8_BAR; PG8_WAIT_L(0); PG8_MMA(1, 0, At, B0); PG8_BAR; PG8_SCHED;
            PG8_STAGE(PG8_SB(1, 1), b3 + hstepB, voffB);
            PG8_WAIT_V(6); PG8_BAR; PG8_MMA(1, 1, At, B1); PG8_BAR;
            }
        }
        if constexpr (KHook::ACTIVE) HK.finish(acc, cur, wr);
        if constexpr (ALIGN_EPI) { if (wr == 0) PG8_BAR; }
        if constexpr (!Epi::AFTER_DRAIN) { int wr_ = wr, wc_ = wc; asm volatile("" : "+s"(wr_), "+s"(wc_)); const int l_ = olane(); const int fr_ = l_ & 15, fq_ = l_ >> 4; E(acc, cur, wr_, wc_, fr_, fq_); S.done(cur); }
        if (!has_next) break;
#pragma unroll
        for (int a = 0; a < 2; ++a)
#pragma unroll
            for (int b = 0; b < 2; ++b)
#pragma unroll
                for (int m = 0; m < 4; ++m)
#pragma unroll
                    for (int n = 0; n < 2; ++n) acc[a][b][m][n] = (f32x4){0.f, 0.f, 0.f, 0.f};
        cur = nxt; cA = nA; cB = nB; ++ui;
        if constexpr (ALIGN_EPI) { if (wr == 1) PG8_BAR; }
    }
    PG8_WAIT_V(0);
    if constexpr (!ALIGN_EPI) { if (wr == 0) PG8_BAR; }
    PG8_BAR;
    if constexpr (Epi::AFTER_DRAIN) { E.fused(acc, cur, wr, wc, fr, fq, lds, wid, lane); S.done(cur); }
#undef PG8_SA
#undef PG8_SB
#undef PG8_STAGE
#undef PG8_LDA
#undef PG8_LDB
#undef PG8_MMA
#undef PG8_WAIT_V
#undef PG8_WAIT_L
#undef PG8_BAR
#undef PG8_SCHED
}
}
#define GAS __attribute__((address_space(1)))
#define LAS __attribute__((address_space(3)))
typedef unsigned short bf16;
typedef unsigned v4u __attribute__((ext_vector_type(4)));
typedef float f32x4 __attribute__((ext_vector_type(4)));
typedef short bf16x8 __attribute__((ext_vector_type(8)));
typedef GAS unsigned gu32;
typedef GAS unsigned long long gu64;
#define RLX_AGENT __ATOMIC_RELAXED, __HIP_MEMORY_SCOPE_AGENT
#define LDS_WAIT() asm volatile("s_waitcnt lgkmcnt(0)" ::: "memory")
#define VM_WAIT() asm volatile("s_waitcnt vmcnt(0)" ::: "memory")
__device__ __forceinline__ unsigned long long rt() { return __builtin_amdgcn_s_memrealtime(); }
__device__ __forceinline__ unsigned f2bf(float f) { unsigned u = __builtin_bit_cast(unsigned, f); return (u + 0x7fffu + ((u >> 16) & 1u)) >> 16; }
__device__ __forceinline__ unsigned pk2(float lo, float hi) { return f2bf(lo) | (f2bf(hi) << 16); }

#define XB_TMO      128
#define XB_XCNT(j)  (256  + 64 * (j))
#define XB_XSUB(j)  (1280 + 64 * (j))
#define XB_XGEN(j)  (2304 + 64 * (j))
#define XB_TOP      3328
#define XB_TOPGEN   3392
#define XCD_BAR_WORDS 3456
#define XB_SPIN_CAP (1u << 18)

__device__ __forceinline__ unsigned xb_ld(unsigned* p)              { return __hip_atomic_load(p, __ATOMIC_RELAXED, __HIP_MEMORY_SCOPE_AGENT); }
__device__ __forceinline__ unsigned xb_add(unsigned* p, unsigned v) { return __hip_atomic_fetch_add(p, v, __ATOMIC_RELAXED, __HIP_MEMORY_SCOPE_AGENT); }
__device__ __forceinline__ unsigned xb_xcc_id() { return (unsigned)__builtin_amdgcn_s_getreg((3 << 11) | 20) & 0xFu; }
#define XB_SPIN(cond, bar) do { unsigned _sp = 0; while (cond) { __builtin_amdgcn_s_sleep(1); \
    if ((++_sp & 255u) == 0u) { if (xb_ld(&(bar)[XB_TMO])) break; if (_sp > XB_SPIN_CAP) { atomicAdd(&(bar)[XB_TMO], 1u); break; } } } } while (0)

struct XcdBarrier {
    unsigned* bar; unsigned x;
    volatile LAS unsigned* st;
};

__device__ __forceinline__ XcdBarrier xcd_barrier_post(unsigned* bar, volatile LAS unsigned* st, const int tid) {
    XcdBarrier b; b.bar = bar; b.x = xb_xcc_id(); b.st = st;
    if (tid == 0) (void)xb_add(&bar[XB_XCNT(b.x)], 1u);
    return b;
}
__device__ __forceinline__ void xcd_barrier_complete(unsigned* bar, unsigned x, unsigned& nloc, unsigned& nx) {
    const unsigned G = gridDim.x * gridDim.y * gridDim.z;
    unsigned sum, cnt, mine, sp = 0u;
    for (;;) {
        sum = 0u; cnt = 0u; mine = 0u;
#pragma unroll
        for (unsigned j = 0; j < 16; ++j) { const unsigned c = xb_ld(&bar[XB_XCNT(j)]); sum += c; cnt += (c > 0u) ? 1u : 0u; mine = (j == x) ? c : mine; }
        if (sum == G) break;
        __builtin_amdgcn_s_sleep(1);
        if ((++sp & 255u) == 0u) { if (xb_ld(&bar[XB_TMO])) break; if (sp > XB_SPIN_CAP) { atomicAdd(&bar[XB_TMO], 1u); break; } }
    }
    nloc = mine > 0u ? mine : 1u; nx = cnt > 0u ? cnt : 1u;
}

__device__ __forceinline__ void xcd_barrier(const XcdBarrier& b, const int tid) {
    asm volatile("s_waitcnt vmcnt(0)" ::: "memory");
    __syncthreads();
    if (tid == 0) {
        unsigned* bar = b.bar; asm volatile("" : "+s"(bar));
        __builtin_amdgcn_s_waitcnt(0);
        unsigned nloc = b.st[0], nx = b.st[1];
        if (nloc == 0u) { xcd_barrier_complete(bar, b.x, nloc, nx); b.st[0] = nloc; b.st[1] = nx; }
        const unsigned old = xb_add(&bar[XB_XSUB(b.x)], 1u);
        const unsigned gen = old / nloc;
        if (old + 1u == (gen + 1u) * nloc) {
            __builtin_amdgcn_fence(__ATOMIC_RELEASE, "agent");
            asm volatile("s_waitcnt vmcnt(0)" ::: "memory");
            const unsigned og = xb_add(&bar[XB_TOP], 1u);
            const unsigned tg = og / nx;
            if (og + 1u == (tg + 1u) * nx) xb_add(&bar[XB_TOPGEN], 1u);
            else XB_SPIN(xb_ld(&bar[XB_TOPGEN]) == tg, bar);
            __builtin_amdgcn_fence(__ATOMIC_ACQUIRE, "agent");
            xb_add(&bar[XB_XGEN(b.x)], 1u);
            asm volatile("s_waitcnt vmcnt(0)" ::: "memory");
        } else {
            XB_SPIN(xb_ld(&bar[XB_XGEN(b.x)]) == gen, bar);
            __builtin_amdgcn_fence(__ATOMIC_ACQUIRE, "agent");
            asm volatile("s_waitcnt vmcnt(0)" ::: "memory");
        }
    }
    __syncthreads();
}

namespace att {
typedef __hip_bfloat16 hbf16;
typedef short bf16x8 __attribute__((ext_vector_type(8)));
typedef short s16x4 __attribute__((ext_vector_type(4)));
typedef float f32x16 __attribute__((ext_vector_type(16)));
typedef float f32x4 __attribute__((ext_vector_type(4)));
typedef unsigned u32x4 __attribute__((ext_vector_type(4)));
typedef unsigned long long u64;
constexpr int QBLK = 32, KVBLK = 64;
constexpr int SHM_V = KVBLK * 128 * 2;
constexpr float THR2 = 11.0f;
#define ATT_SBAR() __builtin_amdgcn_sched_barrier(0)
__device__ __forceinline__ int v_st(int k, int c) { const int kk = (k & ~0xC) | ((k & 4) << 1) | ((k & 8) >> 1); return ((kk >> 3) * 4 + (c >> 5)) * 512 + ((kk & 7) * 32 + (c & 31)) * 2; }
__device__ __forceinline__ int v_rd_base(int lane) { return ((lane & 3) << 3) | (((lane >> 2) & 3) << 6) | (((lane >> 4) & 1) << 5) | (((lane >> 5) & 1) << 8); }
constexpr int v_rd_off(int d0, int ks, int half) { return d0 * 512 + ks * 4096 + half * 2048; }
__device__ __forceinline__ int crow(int r, int hi) { return (r & 3) + 8 * (r >> 2) + 4 * hi; }
__device__ __forceinline__ unsigned cvtpk(float lo, float hi) { unsigned r; asm volatile("v_cvt_pk_bf16_f32 %0, %1, %2" : "=v"(r) : "v"(lo), "v"(hi)); return r; }

struct UnitArgs {
    const unsigned short* Q; int ldq;
    const unsigned short* K; int ldk;
    const unsigned short* V; int ldv;
    unsigned short* O; int ldo;
    int qlo;
    int NT;
    const float* kbias;
    const u64* bm;
    int tid;
    const float* gq; const float* gk;
};

__device__ __forceinline__ void mask_causal(f32x16& p0, f32x16& p1, int dq) {
    const float NEG = -__builtin_inff();
#pragma unroll
    for (int r = 0; r < 16; ++r) { const int c = (r & 3) + 8 * (r >> 2); if (dq - c < 0) p0[r] = NEG; if (dq - c - 32 < 0) p1[r] = NEG; }
}
__device__ __forceinline__ void mask_bits(f32x16& p0, f32x16& p1, u64 w, int hi) {
    const float NEG = -__builtin_inff(); const unsigned lo = (unsigned)w >> (4 * hi), hh = (unsigned)(w >> 32) >> (4 * hi);
#pragma unroll
    for (int r = 0; r < 16; ++r) { const int c = (r & 3) + 8 * (r >> 2);
        const unsigned m0 = (unsigned)__builtin_amdgcn_sbfe((int)lo, c, 1), m1 = (unsigned)__builtin_amdgcn_sbfe((int)hh, c, 1);
        p0[r] = __uint_as_float((__float_as_uint(p0[r]) & m0) | (__float_as_uint(NEG) & ~m0)); p1[r] = __uint_as_float((__float_as_uint(p1[r]) & m1) | (__float_as_uint(NEG) & ~m1)); }
}
__device__ __forceinline__ void partialSM(f32x16& p0, f32x16& p1, float& m_reg, float& mn, float& alpha, const bool fixedref) {
    if (fixedref) { mn = 0.f; alpha = 1.f; }
    else {
        float pmax = p0[0];
#pragma unroll
        for (int r = 1; r < 16; ++r) pmax = fmaxf(pmax, p0[r]);
#pragma unroll
        for (int r = 0; r < 16; ++r) pmax = fmaxf(pmax, p1[r]);
        { auto rr = __builtin_amdgcn_permlane32_swap(__float_as_uint(pmax), __float_as_uint(pmax), false, false); pmax = fmaxf(__uint_as_float(rr[0]), __uint_as_float(rr[1])); }
        if (__builtin_expect(__all((pmax - m_reg) <= THR2), 1)) { mn = m_reg; alpha = 1.f; }
        else { mn = fmaxf(m_reg, pmax); alpha = __builtin_amdgcn_exp2f(m_reg - mn); m_reg = mn; }
    }
    if (!fixedref) {
#pragma unroll
        for (int r = 0; r < 16; ++r) p0[r] = p0[r] - mn;
#pragma unroll
        for (int r = 0; r < 16; ++r) p1[r] = p1[r] - mn;
    }
#pragma unroll
    for (int r = 0; r < 16; ++r) p0[r] = __builtin_amdgcn_exp2f(p0[r]);
}
__device__ __forceinline__ void finishSM(f32x16& p0, f32x16& p1, float alpha, float& l_reg, bf16x8& pa0, bf16x8& pa1, bf16x8& pa2, bf16x8& pa3) {
#pragma unroll
    for (int r = 0; r < 16; ++r) p1[r] = __builtin_amdgcn_exp2f(p1[r]);
    float ps = 0;
#pragma unroll
    for (int r = 0; r < 16; ++r) ps += p0[r];
#pragma unroll
    for (int r = 0; r < 16; ++r) ps += p1[r];
    { auto rr = __builtin_amdgcn_permlane32_swap(__float_as_uint(ps), __float_as_uint(ps), false, false); ps = __uint_as_float(rr[0]) + __uint_as_float(rr[1]); }
    l_reg = l_reg * alpha + ps;
#define ATT_PK4(P, B_, OUT) do { unsigned a0 = cvtpk(P[B_+0], P[B_+1]), a1 = cvtpk(P[B_+2], P[B_+3]);                          \
        unsigned b0 = cvtpk(P[B_+4], P[B_+5]), b1 = cvtpk(P[B_+6], P[B_+7]);                                             \
        auto r0 = __builtin_amdgcn_permlane32_swap(a0, b0, false, false); auto r1 = __builtin_amdgcn_permlane32_swap(a1, b1, false, false); \
        u32x4 w = {r0[0], r1[0], r0[1], r1[1]}; OUT = *reinterpret_cast<bf16x8*>(&w); } while (0)
    ATT_PK4(p0, 0, pa0); ATT_PK4(p0, 8, pa1); ATT_PK4(p1, 0, pa2); ATT_PK4(p1, 8, pa3);
#undef ATT_PK4
}
template <int VB>
__device__ __forceinline__ void pv_tile(f32x16* o, int vb0, bf16x8 pa0, bf16x8 pa1, bf16x8 pa2, bf16x8 pa3) {
#define ATT_TRRD(dst, off) asm volatile("ds_read_b64_tr_b16 %0, %1 offset:%2" : "=&v"(dst) : "v"(vb0), "i"(off) : "memory")
#define ATT_PV_D0(d0) do { s16x4 l0, l1, l2, l3, h0, h1, h2, h3; constexpr int b_ = VB * SHM_V + v_rd_off(d0, 0, 0); \
        ATT_TRRD(l0, b_); ATT_TRRD(h0, b_ + 2048); ATT_TRRD(l1, b_ + 4096); ATT_TRRD(h1, b_ + 6144); ATT_TRRD(l2, b_ + 8192); ATT_TRRD(h2, b_ + 10240); ATT_TRRD(l3, b_ + 12288); ATT_TRRD(h3, b_ + 14336); \
        asm volatile("s_waitcnt lgkmcnt(0)" ::: "memory"); ATT_SBAR();   \
        o[d0] = __builtin_amdgcn_mfma_f32_32x32x16_bf16(pa0, (bf16x8){l0[0], l0[1], l0[2], l0[3], h0[0], h0[1], h0[2], h0[3]}, o[d0], 0, 0, 0);   \
        o[d0] = __builtin_amdgcn_mfma_f32_32x32x16_bf16(pa1, (bf16x8){l1[0], l1[1], l1[2], l1[3], h1[0], h1[1], h1[2], h1[3]}, o[d0], 0, 0, 0);   \
        o[d0] = __builtin_amdgcn_mfma_f32_32x32x16_bf16(pa2, (bf16x8){l2[0], l2[1], l2[2], l2[3], h2[0], h2[1], h2[2], h2[3]}, o[d0], 0, 0, 0);   \
        o[d0] = __builtin_amdgcn_mfma_f32_32x32x16_bf16(pa3, (bf16x8){l3[0], l3[1], l3[2], l3[3], h3[0], h3[1], h3[2], h3[3]}, o[d0], 0, 0, 0); } while (0)
    ATT_PV_D0(0); ATT_PV_D0(1); ATT_PV_D0(2); ATT_PV_D0(3);
#undef ATT_PV_D0
#undef ATT_TRRD
}

template <int DQK, int MODE>
__device__ __forceinline__ void attn_unit(const UnitArgs& a, char* lds) {
    constexpr int SHM_K = KVBLK * DQK * 2, RS = DQK * 2, ND = DQK / 16, NKC = DQK / 64;
    int tid = a.tid; asm volatile("" : "+v"(tid)); const int wid = __builtin_amdgcn_readfirstlane(tid >> 6), lane = tid & 63, r32 = lane & 31, hi = lane >> 5;
    char* V_lds = lds; char* K_lds = lds + 2 * SHM_V;
    float* ws = (float*)(lds + 2 * SHM_V + 2 * SHM_K) + wid * 64; float* li_l = ws; float* al_l = ws + 32;
    float* kbl = (float*)(lds + 2 * SHM_V + 2 * SHM_K + 2048);
    const int NT = a.NT;
    const int qlo = a.qlo, qm = qlo + r32 - 4 * hi;
    const int srow = tid >> 3, c8 = tid & 7;
    const int kws = srow * RS + ((c8 * 16) ^ ((srow & 7) << 4));
    const int vst0 = v_st(srow, c8 * 8);
    const unsigned short* kg = a.K + (size_t)srow * a.ldk + c8 * 8;
    const unsigned short* vg = a.V + (size_t)srow * a.ldv + c8 * 8;
    const u64* bmrow = (MODE == 2) ? a.bm + (size_t)r32 * 64 : nullptr;
    bf16x8 st_k[NKC], st_v[2]; float st_b = 0.f; u64 mw_ld = 0, mw_cur = 0;
#define ATT_VMW() asm volatile("s_waitcnt vmcnt(0)" ::: "memory")
#define ATT_SLOAD(t) do { const size_t ko_ = (size_t)(t) * KVBLK * a.ldk, vo_ = (size_t)(t) * KVBLK * a.ldv; \
        _Pragma("unroll") for (int i_ = 0; i_ < NKC; ++i_) st_k[i_] = *(const bf16x8*)(kg + ko_ + i_ * 64); \
        _Pragma("unroll") for (int i_ = 0; i_ < 2; ++i_) st_v[i_] = *(const bf16x8*)(vg + vo_ + i_ * 64); \
        if (MODE == 1) { if (tid < 64) st_b = a.kbias[(t) * KVBLK + tid]; } \
        if (MODE == 2) { mw_ld = bmrow[(t)]; } } while (0)
#define ATT_SWRITE(bf) do { \
        _Pragma("unroll") for (int i_ = 0; i_ < NKC; ++i_) *(bf16x8*)(K_lds + (bf) * SHM_K + kws + i_ * 128) = st_k[i_]; \
        _Pragma("unroll") for (int i_ = 0; i_ < 2; ++i_) *(bf16x8*)(V_lds + (bf) * SHM_V + vst0 + i_ * 1024) = st_v[i_]; \
        if (MODE == 1) { if (tid < 64) kbl[(bf) * 64 + tid] = st_b; } } while (0)
    const int vb0 = (int)(uintptr_t)V_lds + v_rd_base(lane);
    float m_reg = -1e30f, l_reg = 0; f32x16 o[4] = {};
    bool fixedref;
    { float gqm = 0.f, gkm = 0.f;
#pragma unroll
      for (int i = 0; i < DQK / 64; ++i) { gqm = fmaxf(gqm, fabsf(a.gq[lane + 64 * i])); gkm = fmaxf(gkm, fabsf(a.gk[lane + 64 * i])); }
      gqm = wmax_f(gqm); gkm = wmax_f(gkm);
      const float bound = (float)DQK * (DQK == 128 ? QSCALE128 : QSCALE192) * 1.01f * gqm * gkm;
      fixedref = bound <= 40.0f;
      if (fixedref) m_reg = ((MODE == 1) ? a.kbias[qlo + r32] : 0.f) + bound - THR2; }
    const float cinit = fixedref ? -m_reg : 0.f;
#define ATT_RESC(al) do { if (__any((al) < 1.f)) { if (hi == 0) al_l[r32] = (al); asm volatile("s_waitcnt lgkmcnt(0)" ::: "memory");              \
                     _Pragma("unroll") for (int d_ = 0; d_ < 4; ++d_) _Pragma("unroll") for (int r = 0; r < 16; ++r) o[d_][r] *= al_l[crow(r, hi)]; } } while (0)
#define ATT_MASKT(P0_, P1_, t) do { const int kb_ = (t) * KVBLK; \
        if (MODE == 2) { mask_bits(P0_, P1_, mw_cur, hi); } \
        else { if (kb_ + KVBLK - 1 > qlo) mask_causal(P0_, P1_, qm - kb_); } } while (0)
#define ATT_QKT(KB, P0_, P1_) do { \
        if (MODE == 1) { const float* kb__ = kbl + (KB) * 64 + 4 * hi; \
            _Pragma("unroll") for (int j_ = 0; j_ < 4; ++j_) { const f32x4 b0_ = *(const f32x4*)(kb__ + 8 * j_), b1_ = *(const f32x4*)(kb__ + 32 + 8 * j_); \
                _Pragma("unroll") for (int e_ = 0; e_ < 4; ++e_) { P0_[4 * j_ + e_] = b0_[e_] + cinit; P1_[4 * j_ + e_] = b1_[e_] + cinit; } } } \
        else { _Pragma("unroll") for (int r_ = 0; r_ < 16; ++r_) { P0_[r_] = cinit; P1_[r_] = cinit; } } \
        const char* kbp_[4]; \
        _Pragma("unroll") for (int dd_ = 0; dd_ < 4; ++dd_) kbp_[dd_] = K_lds + (KB) * SHM_K + r32 * RS + (((dd_ * 16 + hi * 8) * 2) ^ ((r32 & 7) << 4)); \
        _Pragma("unroll") for (int d0_ = 0; d0_ < ND; ++d0_) { const char* a_ = kbp_[d0_ & 3] + (d0_ >> 2) * 128; \
            const bf16x8 b0_ = *reinterpret_cast<const bf16x8*>(a_); const bf16x8 b1_ = *reinterpret_cast<const bf16x8*>(a_ + 32 * RS); \
            P0_ = __builtin_amdgcn_mfma_f32_32x32x16_bf16(b0_, qr[d0_], P0_, 0, 0, 0); \
            P1_ = __builtin_amdgcn_mfma_f32_32x32x16_bf16(b1_, qr[d0_], P1_, 0, 0, 0); } } while (0)
    const int grp = wid >> 2;
    int t0 = 0;
    if (MODE == 1 && fixedref) { const int q0u = qlo - 32 * wid; const float bq0 = a.kbias[q0u];
        const float kbl_ = (lane < NT) ? a.kbias[64 * lane + 63] : __builtin_inff();
        const u64 okm = __ballot(kbl_ - bq0 >= -(150.0f + THR2 + 4.0f));
        t0 = (int)__ffsll((long long)okm) - 1; t0 = __builtin_amdgcn_readfirstlane(t0 < 0 ? 0 : t0) & ~1; }
    ATT_SLOAD(t0);
    bf16x8 qr[ND];
#pragma unroll
    for (int d0 = 0; d0 < ND; ++d0) qr[d0] = *(const bf16x8*)(a.Q + (size_t)r32 * a.ldq + d0 * 16 + hi * 8);
    ATT_VMW(); ATT_SWRITE(0); mw_cur = mw_ld;
    if (NT > t0 + 1) ATT_SLOAD(t0 + 1);
    __syncthreads();
    if (grp == 1) __syncthreads();
    f32x16 p0, p1; float mn, al; bf16x8 pa0, pa1, pa2, pa3;
#define ATT_STAGE_NEXT(t) do { if ((t) + 1 < NT) { ATT_VMW(); if (((t) + 1) & 1) { ATT_SWRITE(1); } else { ATT_SWRITE(0); } mw_cur = mw_ld; if ((t) + 2 < NT) { ATT_SLOAD((t) + 2); } } } while (0)
#define ATT_STEP(t, BUF) do { \
        ATT_SBAR(); ATT_QKT(BUF, p0, p1); \
        ATT_MASKT(p0, p1, (t)); partialSM(p0, p1, m_reg, mn, al, fixedref); \
        if (grp == 1) ATT_STAGE_NEXT(t); \
        __syncthreads(); \
        if (grp == 0) ATT_STAGE_NEXT(t); \
        ATT_RESC(al); \
        finishSM(p0, p1, al, l_reg, pa0, pa1, pa2, pa3); ATT_SBAR(); \
        pv_tile<BUF>(o, vb0, pa0, pa1, pa2, pa3); \
        __syncthreads(); } while (0)
    for (int t = t0; t < NT; t += 2) {
        ATT_STEP(t, 0);
        if (t + 1 < NT) ATT_STEP(t + 1, 1);
    }
    if (grp == 0) __syncthreads();
#undef ATT_STEP
#undef ATT_STAGE_NEXT
    if (hi == 0) li_l[r32] = l_reg; asm volatile("s_waitcnt lgkmcnt(0)" ::: "memory");
    float rli[16];
#pragma unroll
    for (int r = 0; r < 16; ++r) rli[r] = __builtin_amdgcn_rcpf(li_l[crow(r, hi)]);
#pragma unroll
    for (int r = 0; r < 16; ++r) { const int orow = crow(r, hi);
#pragma unroll
        for (int d0 = 0; d0 < 4; ++d0) { const float v = o[d0][r] * rli[r]; const float vn = xor_f<1>(v);
            if ((r32 & 1) == 0) *(unsigned*)(a.O + (size_t)orow * a.ldo + d0 * 32 + r32) = cvtpk(v, vn); } }
    __syncthreads();
#undef ATT_VMW
#undef ATT_SLOAD
#undef ATT_SWRITE
#undef ATT_RESC
#undef ATT_MASKT
#undef ATT_QKT
}
#undef ATT_SBAR
}

namespace tk {
typedef short bf16x8 __attribute__((ext_vector_type(8)));
typedef float f32x16 __attribute__((ext_vector_type(16)));
typedef float f32x4 __attribute__((ext_vector_type(4)));
typedef unsigned u32x4 __attribute__((ext_vector_type(4)));
typedef unsigned long long u64;
constexpr int TOPK = 256;
__device__ __forceinline__ float wave_min(float v) { return wmin_f(v); }
__device__ __forceinline__ float wave_max(float v) { return wmax_f(v); }
__device__ __forceinline__ int rdlane_i(int v, int src_uniform) { return __builtin_amdgcn_readlane(v, __builtin_amdgcn_readfirstlane(src_uniform)); }

__device__ __forceinline__ void topk_unit(const unsigned short* EP, const float* misc32, u64* BM, int b, int g, char* lds, char* lds_hist, char* lds_cand, const int tid_in) {
    int tid = tid_in; asm volatile("" : "+v"(tid)); const int wid = __builtin_amdgcn_readfirstlane(tid >> 6), lane = tid & 63, r32 = lane & 31, hi = lane >> 5;
    float* S = (float*)lds;
    const int q0 = g * 8; const size_t tok0 = (size_t)b * SEQ;
    {
        typedef float f32x4a __attribute__((ext_vector_type(4)));
        const int j16 = lane & 15, kg = lane >> 4;
        bf16x8 af[4][2];
        const int nkb = (q0 + 8 + 31) >> 5;
        const unsigned short* kbase = EP + tok0 * N_E_IN + 1280 + kg * 8 + (size_t)j16 * N_E_IN;
        bf16x8 bA[4], bB[4];
#define TK_LOADB(dst, kb_) do { _Pragma("unroll") for (int f_ = 0; f_ < 4; ++f_) dst[f_] = *(const bf16x8*)(kbase + ((size_t)(kb_) * 32 + (f_ >> 1) * 16) * N_E_IN + (f_ & 1) * 32); } while (0)
        if (wid < nkb) TK_LOADB(bA, wid);
#pragma unroll
        for (int rt = 0; rt < 4; ++rt)
#pragma unroll
            for (int ks = 0; ks < 2; ++ks) af[rt][ks] = *(const bf16x8*)(EP + (tok0 + q0 + 2 * (j16 >> 2) + (rt >> 1)) * N_E_IN + 768 + (4 * (rt & 1) + (j16 & 3)) * 64 + ks * 32 + kg * 8);
        f32x4 wv[2][2];
#pragma unroll
        for (int qq = 0; qq < 2; ++qq) { const float* wp = misc32 + (tok0 + q0 + 2 * kg + qq) * 16; wv[qq][0] = *(const f32x4*)wp; wv[qq][1] = *(const f32x4*)(wp + 4); }
#if defined(TKS_CHECK)
#define TK_HEADSUM(s, w_, lo_, hi_) float s = w_[0][0] * __int_as_float(max(__float_as_int(lo_[0]), 0)), s2_ = w_[1][0] * __int_as_float(max(__float_as_int(hi_[0]), 0)); \
            _Pragma("unroll") for (int e = 1; e < 4; ++e) { s = __builtin_fmaf(w_[0][e], __int_as_float(max(__float_as_int(lo_[e]), 0)), s); s2_ = __builtin_fmaf(w_[1][e], __int_as_float(max(__float_as_int(hi_[e]), 0)), s2_); } s += s2_
#else
#define TK_HEADSUM(s, w_, lo_, hi_) float s = 0.f; \
            _Pragma("unroll") for (int e = 0; e < 4; ++e) s += w_[0][e] * __int_as_float(max(__float_as_int(lo_[e]), 0)); \
            _Pragma("unroll") for (int e = 0; e < 4; ++e) s += w_[1][e] * __int_as_float(max(__float_as_int(hi_[e]), 0))
#endif
#define TK_SCORE(bf, kb_) do { f32x4a ac_[2][4]; \
            _Pragma("unroll") for (int kgp = 0; kgp < 2; ++kgp) _Pragma("unroll") for (int rt = 0; rt < 4; ++rt) ac_[kgp][rt] = (f32x4a){0.f, 0.f, 0.f, 0.f}; \
            _Pragma("unroll") for (int ks = 0; ks < 2; ++ks) _Pragma("unroll") for (int rt = 0; rt < 4; ++rt) _Pragma("unroll") for (int kgp = 0; kgp < 2; ++kgp) \
                ac_[kgp][rt] = __builtin_amdgcn_mfma_f32_16x16x32_bf16(af[rt][ks], bf[2 * kgp + ks], ac_[kgp][rt], 0, 0, 0); \
            _Pragma("unroll") for (int kgp = 0; kgp < 2; ++kgp) _Pragma("unroll") for (int qq = 0; qq < 2; ++qq) { TK_HEADSUM(s, wv[qq], ac_[kgp][2 * qq], ac_[kgp][2 * qq + 1]); \
                S[(2 * kg + qq) * 4096 + (kb_) * 32 + kgp * 16 + j16] = s; } } while (0)
#define TK_SCORE2(bf0, kb0_, bf1, kb1_) do { const int kbs_[2] = {(kb0_), (kb1_)}; f32x4a ac_[2][2][4]; \
            _Pragma("unroll") for (int blk = 0; blk < 2; ++blk) _Pragma("unroll") for (int kgp = 0; kgp < 2; ++kgp) _Pragma("unroll") for (int rt = 0; rt < 4; ++rt) ac_[blk][kgp][rt] = (f32x4a){0.f, 0.f, 0.f, 0.f}; \
            _Pragma("unroll") for (int ks = 0; ks < 2; ++ks) _Pragma("unroll") for (int rt = 0; rt < 4; ++rt) _Pragma("unroll") for (int kgp = 0; kgp < 2; ++kgp) { \
                ac_[0][kgp][rt] = __builtin_amdgcn_mfma_f32_16x16x32_bf16(af[rt][ks], bf0[2 * kgp + ks], ac_[0][kgp][rt], 0, 0, 0); ac_[1][kgp][rt] = __builtin_amdgcn_mfma_f32_16x16x32_bf16(af[rt][ks], bf1[2 * kgp + ks], ac_[1][kgp][rt], 0, 0, 0); } \
            _Pragma("unroll") for (int blk = 0; blk < 2; ++blk) _Pragma("unroll") for (int kgp = 0; kgp < 2; ++kgp) _Pragma("unroll") for (int qq = 0; qq < 2; ++qq) { TK_HEADSUM(s, wv[qq], ac_[blk][kgp][2 * qq], ac_[blk][kgp][2 * qq + 1]); \
                S[(2 * kg + qq) * 4096 + kbs_[blk] * 32 + kgp * 16 + j16] = s; } } while (0)
        if (wid + 8 < nkb) TK_LOADB(bB, wid + 8);
        bf16x8 bC[4], bD[4];
        for (int kb = wid; kb < nkb; kb += 32) {
            if (kb + 16 < nkb) { TK_LOADB(bC, kb + 16); if (kb + 24 < nkb) TK_LOADB(bD, kb + 24); }
            if (kb + 8 < nkb) TK_SCORE2(bA, kb, bB, kb + 8); else TK_SCORE(bA, kb);
            if (kb + 16 < nkb) {
                if (kb + 32 < nkb) { TK_LOADB(bA, kb + 32); if (kb + 40 < nkb) TK_LOADB(bB, kb + 40); }
                if (kb + 24 < nkb) TK_SCORE2(bC, kb + 16, bD, kb + 24); else TK_SCORE(bC, kb + 16);
            }
        }
#undef TK_SCORE2
#undef TK_HEADSUM
#undef TK_LOADB
#undef TK_SCORE
    }
    __syncthreads();
    const int qpos = q0 + wid; const int n = qpos + 1; const int ni = (n + 63) >> 6;
    const float NEG = -__builtin_inff(), PINF = __builtin_inff();
    float sc[64]; float mn0 = PINF, mx0 = NEG;
#define TK_NI(var) int var = ni; asm volatile("" : "+s"(var))
    { TK_NI(nic);
#pragma unroll
      for (int c8 = 0; c8 < 8; ++c8) { if (c8 * 8 < nic) {
#pragma unroll
          for (int e = 0; e < 8; ++e) { const int i = c8 * 8 + e; const int key = 64 * i + lane; const float v = S[wid * 4096 + key]; const bool adm = key <= qpos; sc[i] = adm ? v : NEG; mx0 = fmaxf(mx0, sc[i]); mn0 = fminf(mn0, adm ? v : PINF); } }
        else {
#pragma unroll
          for (int e = 0; e < 8; ++e) sc[c8 * 8 + e] = NEG; } } }
    u64 myword = 0ull;
#ifndef TK_REP_SEL
#define TK_REP_SEL 1
#endif
    for (int rsel_ = 0; rsel_ < TK_REP_SEL; ++rsel_) {
    if (n <= TOPK) {
#pragma unroll
        for (int i = 0; i < 4; ++i) { const u64 w = __ballot(64 * i + lane <= qpos); if (lane == i) myword = w; }
    } else {
        unsigned* hist = (unsigned*)lds_hist + wid * 320; float* cand = (float*)lds_cand + wid * 64;
        float lo = wave_min(mn0), hv = wave_max(mx0);
        int need = TOPK; float T_ = lo; int n_eq = 0; bool done = false, all_eq = false;
        for (int level = 0; level < 48 && !done; ++level) {
            if (!(lo < hv)) { T_ = lo; n_eq = need; done = true; break; }
            const float scale = 255.5f / (hv - lo);
            { unsigned z_ = 0u; asm volatile("" : "+v"(z_)); *(u32x4*)(hist + 4 * lane) = (u32x4){z_, z_, z_, z_}; }
            asm volatile("s_waitcnt lgkmcnt(0)" ::: "memory");
            { TK_NI(nic);
#pragma unroll
              for (int c8 = 0; c8 < 8; ++c8) if (c8 * 8 < nic) {
#pragma unroll
                for (int e = 0; e < 8; ++e) { const float s = sc[c8 * 8 + e]; const float d = s - lo; const bool inr = (s <= hv) && (d >= 0.0f); int bin = (int)(d * scale); bin = bin > 255 ? 255 : bin;
                    bin = inr ? bin : 256 + lane;
                    __hip_atomic_fetch_add(hist + bin, 1u, __ATOMIC_RELAXED, __HIP_MEMORY_SCOPE_WORKGROUP); } } }
            asm volatile("s_waitcnt lgkmcnt(0)" ::: "memory");
            const u32x4 hq = *(const u32x4*)(hist + 4 * lane);
            const int tl = (int)(hq[0] + hq[1] + hq[2] + hq[3]);
            int suf = tl;
#pragma unroll
            for (int o = 1; o < 64; o <<= 1) { const int v = down_i(suf, o); if (lane + o < 64) suf += v; }
            const int above = suf - tl;
            const bool mine = (above < need) && (need <= suf);
            int bsel = 0, cab = 0, cin = 0;
            if (mine) { int c = above;
                if (need <= c + (int)hq[3]) { bsel = 3; cab = c; cin = (int)hq[3]; }
                else { c += (int)hq[3];
                    if (need <= c + (int)hq[2]) { bsel = 2; cab = c; cin = (int)hq[2]; }
                    else { c += (int)hq[2];
                        if (need <= c + (int)hq[1]) { bsel = 1; cab = c; cin = (int)hq[1]; }
                        else { c += (int)hq[1]; bsel = 0; cab = c; cin = (int)hq[0]; } } }
                bsel += 4 * lane; }
            const u64 mm = __ballot(mine); const int src = (int)__ffsll((long long)mm) - 1;
            const int bstar = rdlane_i(bsel, src), cabove = rdlane_i(cab, src), cnt_in = rdlane_i(cin, src);
            need -= cabove;
            if (cnt_in <= 64) {
                int base = 0;
                { TK_NI(nic);
#pragma unroll
                  for (int c8 = 0; c8 < 8; ++c8) if (c8 * 8 < nic) {
#pragma unroll
                    for (int e = 0; e < 8; ++e) { const float s = sc[c8 * 8 + e]; const float d = s - lo; int bin = (int)(d * scale); bin = bin > 255 ? 255 : bin;
                        const bool pr = (s <= hv) && (d >= 0.0f) && (bin == bstar); const u64 bl = __ballot(pr);
                        if (bl) { if (pr) cand[base + __popcll(bl & ((1ull << lane) - 1ull))] = s; base += __popcll(bl); } } } }
                asm volatile("s_waitcnt lgkmcnt(0)" ::: "memory");
                const float v = (lane < cnt_in) ? cand[lane] : NEG;
                int gt = 0, ge = 0;
                for (int j = 0; j < cnt_in; ++j) { const float vj = __int_as_float(__builtin_amdgcn_readlane(__float_as_int(v), j)); gt += (vj > v) ? 1 : 0; ge += (vj >= v) ? 1 : 0; }
                const bool ok = (lane < cnt_in) && (gt < need) && (need <= ge);
                const u64 okm = __ballot(ok); const int s2 = (int)__ffsll((long long)okm) - 1;
                T_ = __int_as_float(rdlane_i(__float_as_int(v), s2)); const int gtT = rdlane_i(gt, s2), geT = rdlane_i(ge, s2); n_eq = need - gtT; all_eq = (n_eq == geT - gtT); done = true;
            } else {
                float mn = PINF, mx = NEG;
#pragma unroll
                for (int i = 0; i < 64; ++i) { const float s = sc[i]; const float d = s - lo; int bin = (int)(d * scale); bin = bin > 255 ? 255 : bin;
                    const bool pr = (s <= hv) && (d >= 0.0f) && bin == bstar; mn = fminf(mn, pr ? s : PINF); mx = fmaxf(mx, pr ? s : NEG); }
                lo = wave_min(mn); hv = wave_max(mx);
            }
        }
        if (all_eq) {
            { TK_NI(nic);
#pragma unroll
              for (int c8 = 0; c8 < 8; ++c8) if (c8 * 8 < nic) {
#pragma unroll
                for (int e = 0; e < 8; ++e) { const int i = c8 * 8 + e; const u64 w = __ballot(sc[i] >= T_); if (lane == i) myword = w; } } }
        } else {
            int eqrun = 0;
#pragma unroll
            for (int i = 0; i < 64; ++i) { const float s = sc[i]; const bool eq = (s == T_); const u64 be = __ballot(eq);
                const int rk = eqrun + __popcll(be & ((1ull << lane) - 1ull));
                const bool sel = (s > T_) || (eq && rk < n_eq);
                const u64 w = __ballot(sel); eqrun += __popcll(be);
                if (lane == i) myword = w; }
        }
    }
    }
    BM[(tok0 + qpos) * 64 + lane] = myword;
    __syncthreads();
}

__device__ __forceinline__ void cumsum_unit(const float* misc32, float* cumb, int b, int h, char* lds, const int tid_in) {
    int tid = tid_in; asm volatile("" : "+v"(tid)); const int wid = tid >> 6, lane = tid & 63;
    float* wsum = (float*)lds;
    float v[8]; float run = 0.f;
#pragma unroll
    for (int j = 0; j < 8; ++j) { run += misc32[((size_t)b * SEQ + tid * 8 + j) * 16 + 8 + h]; v[j] = run; }
    float inc = run;
#pragma unroll
    for (int o = 1; o < 64; o <<= 1) { const float t = up_f(inc, o); if (lane >= o) inc += t; }
    if (lane == 63) wsum[wid] = inc;
    __syncthreads();
    float off = inc - run;
    for (int w = 0; w < wid; ++w) off += wsum[w];
#pragma unroll
    for (int j = 0; j < 8; ++j) cumb[(size_t)h * MTOK + (size_t)b * SEQ + tid * 8 + j] = -LOG2E * (off + v[j]);
    __syncthreads();
}
}

namespace tkr {
typedef short bf16x8 __attribute__((ext_vector_type(8)));
typedef float f32x4 __attribute__((ext_vector_type(4)));
typedef unsigned u32x4 __attribute__((ext_vector_type(4)));
typedef unsigned long long u64;
constexpr int TOPK = 256;
using tk::rdlane_i; using tk::wave_min; using tk::wave_max;

__device__ __forceinline__ u64 select64(const float (&sc)[64], const float mn0, const float mx0, const int qpos, char* lds_hist, char* lds_cand, const int wsel, const int lane) {
    const int n = qpos + 1; const int ni = (n + 63) >> 6;
    const float NEG = -__builtin_inff(), PINF = __builtin_inff();
#define TK_NI(var) int var = ni; asm volatile("" : "+s"(var))
    u64 myword = 0ull;
    if (n <= TOPK) {
#pragma unroll
        for (int i = 0; i < 4; ++i) { const u64 w = __ballot(64 * i + lane <= qpos); if (lane == i) myword = w; }
    } else {
        unsigned* hist = (unsigned*)lds_hist + wsel * 320; float* cand = (float*)lds_cand + wsel * 64;
        float lo = wave_min(mn0), hv = wave_max(mx0);
        int need = TOPK; float T_ = lo; int n_eq = 0; bool done = false, all_eq = false;
        for (int level = 0; level < 48 && !done; ++level) {
            if (!(lo < hv)) { T_ = lo; n_eq = need; done = true; break; }
            const float scale = 255.5f / (hv - lo);
            unsigned pkb[32];
            { unsigned z_ = 0u; asm volatile("" : "+v"(z_)); *(u32x4*)(hist + 4 * lane) = (u32x4){z_, z_, z_, z_}; }
            asm volatile("s_waitcnt lgkmcnt(0)" ::: "memory");
            { TK_NI(nic);
#pragma unroll
              for (int c8 = 0; c8 < 8; ++c8) if (c8 * 8 < nic) {
#pragma unroll
                for (int e = 0; e < 8; ++e) { const float s = sc[c8 * 8 + e]; const float d = s - lo; const bool inr = (s <= hv) && (d >= 0.0f); int bin = (int)(d * scale); bin = bin > 255 ? 255 : bin;
                    bin = inr ? bin : 256 + lane;
                    const unsigned bc_ = (unsigned)bin;
                    if (e & 1) pkb[c8 * 4 + (e >> 1)] |= bc_ << 16; else pkb[c8 * 4 + (e >> 1)] = bc_;
                    __hip_atomic_fetch_add(hist + bin, 1u, __ATOMIC_RELAXED, __HIP_MEMORY_SCOPE_WORKGROUP); } } }
            asm volatile("s_waitcnt lgkmcnt(0)" ::: "memory");
            const u32x4 hq = *(const u32x4*)(hist + 4 * lane);
            const int tl = (int)(hq[0] + hq[1] + hq[2] + hq[3]);
            int suf = tl;
#pragma unroll
            for (int o = 1; o < 64; o <<= 1) { const int v = down_i(suf, o); if (lane + o < 64) suf += v; }
            const int above = suf - tl;
            const bool mine = (above < need) && (need <= suf);
            int bsel = 0, cab = 0, cin = 0;
            if (mine) { int c = above;
                if (need <= c + (int)hq[3]) { bsel = 3; cab = c; cin = (int)hq[3]; }
                else { c += (int)hq[3];
                    if (need <= c + (int)hq[2]) { bsel = 2; cab = c; cin = (int)hq[2]; }
                    else { c += (int)hq[2];
                        if (need <= c + (int)hq[1]) { bsel = 1; cab = c; cin = (int)hq[1]; }
                        else { c += (int)hq[1]; bsel = 0; cab = c; cin = (int)hq[0]; } } }
                bsel += 4 * lane; }
            const u64 mm = __ballot(mine); const int src = (int)__ffsll((long long)mm) - 1;
            const int bstar = rdlane_i(bsel, src), cabove = rdlane_i(cab, src), cnt_in = rdlane_i(cin, src);
            need -= cabove;
            if (cnt_in <= 64) {
                int base = 0;
                { TK_NI(nic);
#pragma unroll
                  for (int c8 = 0; c8 < 8; ++c8) if (c8 * 8 < nic) {
#pragma unroll
                    for (int e = 0; e < 8; ++e) { const float s = sc[c8 * 8 + e];
                        const bool pr = ((pkb[c8 * 4 + (e >> 1)] >> (16 * (e & 1))) & 0xffffu) == (unsigned)bstar; const u64 bl = __ballot(pr);
                        if (bl) { if (pr) cand[base + __popcll(bl & ((1ull << lane) - 1ull))] = s; base += __popcll(bl); } } } }
                asm volatile("s_waitcnt lgkmcnt(0)" ::: "memory");
                const float v = (lane < cnt_in) ? cand[lane] : NEG;
                int gt = 0, ge = 0;
                for (int j = 0; j < cnt_in; ++j) { const float vj = __int_as_float(__builtin_amdgcn_readlane(__float_as_int(v), j)); gt += (vj > v) ? 1 : 0; ge += (vj >= v) ? 1 : 0; }
                const bool ok = (lane < cnt_in) && (gt < need) && (need <= ge);
                const u64 okm = __ballot(ok); const int s2 = (int)__ffsll((long long)okm) - 1;
                T_ = __int_as_float(rdlane_i(__float_as_int(v), s2)); const int gtT = rdlane_i(gt, s2), geT = rdlane_i(ge, s2); n_eq = need - gtT; all_eq = (n_eq == geT - gtT); done = true;
            } else {
                float mn = PINF, mx = NEG;
                { TK_NI(nic);
#pragma unroll
                  for (int c8 = 0; c8 < 8; ++c8) if (c8 * 8 < nic) {
#pragma unroll
                    for (int e = 0; e < 8; ++e) { const float s = sc[c8 * 8 + e];
                        const bool pr = ((pkb[c8 * 4 + (e >> 1)] >> (16 * (e & 1))) & 0xffffu) == (unsigned)bstar; mn = fminf(mn, pr ? s : PINF); mx = fmaxf(mx, pr ? s : NEG); } } }
                lo = wave_min(mn); hv = wave_max(mx);
            }
        }
        if (all_eq) {
            { TK_NI(nic);
#pragma unroll
              for (int c8 = 0; c8 < 8; ++c8) if (c8 * 8 < nic) {
#pragma unroll
                for (int e = 0; e < 8; ++e) { const int i = c8 * 8 + e; const u64 w = __ballot(sc[i] >= T_); if (lane == i) myword = w; } } }
        } else {
            int eqrun = 0;
#pragma unroll
            for (int i = 0; i < 64; ++i) { const float s = sc[i]; const bool eq = (s == T_); const u64 be = __ballot(eq);
                const int rk = eqrun + __popcll(be & ((1ull << lane) - 1ull));
                const bool sel = (s > T_) || (eq && rk < n_eq);
                const u64 w = __ballot(sel); eqrun += __popcll(be);
                if (lane == i) myword = w; }
        }
    }

#undef TK_NI
    (void)PINF;
    return myword;
}

__device__ __forceinline__ void regsel_unit(const unsigned short* EP, const float* misc32, u64* BM, int b, int g16, char* lds, char* lds_hist, char* lds_cand, const int tid_in) {
    int tid = tid_in; asm volatile("" : "+v"(tid)); const int wid = __builtin_amdgcn_readfirstlane(tid >> 6), lane = tid & 63, hi = lane >> 5, j16 = lane & 15, kg = lane >> 4;
    const bool godd = (kg & 1) != 0;
    const int q0 = g16 * 16; const size_t tok0 = (size_t)b * SEQ; const int qpos = q0 + 2 * wid + hi;
    char* kst = lds;
    bf16x8 af[2];
#pragma unroll
    for (int ks = 0; ks < 2; ++ks) af[ks] = *(const bf16x8*)(EP + (tok0 + q0 + 2 * wid + (j16 >> 3)) * N_E_IN + 768 + (j16 & 7) * 64 + ks * 32 + kg * 8);
    const f32x4 wq = *(const f32x4*)(misc32 + (tok0 + qpos) * 16 + (godd ? 4 : 0));
    const int nkb = (q0 + 16 + 31) >> 5, nch = (nkb + 3) >> 2;
    typedef __attribute__((address_space(3))) unsigned lds_u32; typedef __attribute__((address_space(3))) char lds_char;
    const unsigned short* gsrc = EP + (tok0 + 8 * wid + (lane >> 3)) * N_E_IN + 1280 + (((lane & 7) ^ ((lane >> 3) & 7)) << 3);
#define TKR_ISSUE(c_) do { const char* gp_ = (const char*)(gsrc + (size_t)(c_) * 128 * N_E_IN); lds_char* d_ = (lds_char*)(kst + ((c_) & 7) * 16384 + wid * 1024); \
        __builtin_amdgcn_global_load_lds((const unsigned*)gp_, (lds_u32*)d_, 16, 0, 0); __builtin_amdgcn_global_load_lds((const unsigned*)(gp_ + (size_t)64 * N_E_IN * 2), (lds_u32*)(d_ + 8192), 16, 0, 0); } while (0)
    const int frow = j16 * 128, fsw = j16 & 7;
    const int klim = qpos - (lane & 31);
    const float NEGI = -__builtin_inff(); const float NANV = __builtin_nanf("");
    float blk[128];
#define TKR_HALF(c_, h_) do { \
        f32x4 a0_[2], a1_[2]; \
        _Pragma("unroll") for (int b2 = 0; b2 < 2; ++b2) { const int bl = 2 * (h_) + b2; a0_[b2] = (f32x4){0.f, 0.f, 0.f, 0.f}; a1_[b2] = (f32x4){0.f, 0.f, 0.f, 0.f}; \
            _Pragma("unroll") for (int ks = 0; ks < 2; ++ks) { const int off_ = bl * 4096 + (((ks * 4 + kg) ^ fsw) << 4); \
                const bf16x8 b0_ = *(const bf16x8*)(kc_ + off_), b1_ = *(const bf16x8*)(kc_ + 16 * 128 + off_); \
                a0_[b2] = __builtin_amdgcn_mfma_f32_16x16x32_bf16(af[ks], b0_, a0_[b2], 0, 0, 0); a1_[b2] = __builtin_amdgcn_mfma_f32_16x16x32_bf16(af[ks], b1_, a1_[b2], 0, 0, 0); } } \
        _Pragma("unroll") for (int b2 = 0; b2 < 2; ++b2) { \
            float p0 = wq[0] * __int_as_float(max(__float_as_int(a0_[b2][0]), 0)), p1 = wq[0] * __int_as_float(max(__float_as_int(a1_[b2][0]), 0)); \
            _Pragma("unroll") for (int e = 1; e < 4; ++e) { p0 = __builtin_fmaf(wq[e], __int_as_float(max(__float_as_int(a0_[b2][e]), 0)), p0); p1 = __builtin_fmaf(wq[e], __int_as_float(max(__float_as_int(a1_[b2][e]), 0)), p1); } \
              \
            const auto sw_ = __builtin_amdgcn_permlane16_swap(__float_as_uint(p0), __float_as_uint(p1), false, false); const float s_ = __uint_as_float(sw_[0]) + __uint_as_float(sw_[1]); blk[4 * (c_) + 2 * (h_) + b2] = ((4 * (c_) + 2 * (h_) + b2) * 32 <= klim) ? s_ : NANV; } } while (0)
#define TKR_CHUNK(c_) do { const char* kc_ = kst + ((c_) & 7) * 16384 + frow; TKR_HALF(c_, 0); __builtin_amdgcn_sched_barrier(0); TKR_HALF(c_, 1); } while (0)
    asm volatile("" ::: "memory");
    __builtin_amdgcn_s_barrier();
    asm volatile("" ::: "memory");
#pragma unroll
    for (int c = 0; c < 6; ++c) if (c < nch) TKR_ISSUE(c);
#define TKR_STEP(c_) do { if ((c_) < nch) { const int r_ = nch - 1 - (c_); \
            if (r_ >= 5) asm volatile("s_waitcnt vmcnt(10)" ::: "memory"); else if (r_ == 4) asm volatile("s_waitcnt vmcnt(8)" ::: "memory"); else if (r_ == 3) asm volatile("s_waitcnt vmcnt(6)" ::: "memory"); \
            else if (r_ == 2) asm volatile("s_waitcnt vmcnt(4)" ::: "memory"); else if (r_ == 1) asm volatile("s_waitcnt vmcnt(2)" ::: "memory"); else asm volatile("s_waitcnt vmcnt(0)" ::: "memory"); \
            __builtin_amdgcn_s_barrier(); asm volatile("" ::: "memory"); \
            if ((c_) + 6 < nch) TKR_ISSUE((c_) + 6); \
            TKR_CHUNK(c_); } \
        else { _Pragma("unroll") for (int bl = 0; bl < 4; ++bl) blk[4 * (c_) + bl] = NANV; } } while (0)
#pragma unroll
    for (int c = 0; c < 32; ++c) TKR_STEP(c);
#undef TKR_STEP
#undef TKR_CHUNK
#undef TKR_HALF
#undef TKR_ISSUE
#pragma unroll
    for (int i = 0; i < 64; ++i) { auto rr = __builtin_amdgcn_permlane32_swap(__float_as_uint(blk[2 * i]), __float_as_uint(blk[2 * i + 1]), false, false); blk[2 * i] = __uint_as_float(rr[0]); blk[2 * i + 1] = __uint_as_float(rr[1]); }
#pragma unroll
    for (int qq = 0; qq < 2; ++qq) {
        const int qp = q0 + 2 * wid + qq;
        float sc[64]; float mn0 = __builtin_inff(), mx0 = NEGI;
#pragma unroll
        for (int i = 0; i < 64; ++i) { const float v = blk[2 * i + qq]; sc[i] = v; mx0 = fmaxf(mx0, v); mn0 = fminf(mn0, v); }
        const u64 word = select64(sc, mn0, mx0, qp, lds_hist, lds_cand, wid, lane);
        BM[(tok0 + qp) * 64 + lane] = word;
    }
}
}

namespace ssd {
typedef short bf16x8 __attribute__((ext_vector_type(8)));
typedef float f32x16 __attribute__((ext_vector_type(16)));
typedef float f32x4 __attribute__((ext_vector_type(4)));
typedef unsigned u32x4 __attribute__((ext_vector_type(4)));
typedef unsigned u32x2 __attribute__((ext_vector_type(2)));
constexpr int LD = 136;
constexpr int O_CS = 0, O_BS = 34816, O_BWT = 69632, O_XT = 104448, O_SB = 121856;
constexpr int ZLD = 72;
__device__ __forceinline__ unsigned short f2bf16(float f) { unsigned u = __float_as_uint(f); return (unsigned short)((u + 0x7fffu + ((u >> 16) & 1u)) >> 16); }
__device__ __forceinline__ float bf2f(unsigned short h) { return __uint_as_float(((unsigned)h) << 16); }
typedef float f32x2_t __attribute__((ext_vector_type(2))); typedef __bf16 bf16x2_t __attribute__((ext_vector_type(2)));
__device__ __forceinline__ unsigned pk_v(float lo, float hi) { const f32x2_t v = {lo, hi}; const bf16x2_t b = __builtin_convertvector(v, bf16x2_t); return __builtin_bit_cast(unsigned, b); }
__device__ __forceinline__ unsigned pk(float lo, float hi) { unsigned r; asm volatile("v_cvt_pk_bf16_f32 %0, %1, %2" : "=v"(r) : "v"(lo), "v"(hi)); return r; }
template <int NK>
__device__ __forceinline__ f32x16 mma(const unsigned short* Ab, const unsigned short* Bb, f32x16 acc, int hi) {
    bf16x8 a[NK], b[NK];
#pragma unroll
    for (int d0 = 0; d0 < NK; ++d0) { a[d0] = *(const bf16x8*)(Ab + d0 * 16 + hi * 8); b[d0] = *(const bf16x8*)(Bb + d0 * 16 + hi * 8); }
#pragma unroll
    for (int d0 = 0; d0 < NK; ++d0) acc = __builtin_amdgcn_mfma_f32_32x32x16_bf16(a[d0], b[d0], acc, 0, 0, 0);
    return acc;
}
__device__ __forceinline__ float siluf(float v) { return v * __builtin_amdgcn_rcpf(1.0f + __expf(-v)); }

__device__ __forceinline__ void conv_halo_save(const unsigned short* XBC, unsigned short* HALO, int unit, const int tid) {
    const int b = unit >> 5, c = unit & 31, cg = tid & 255, rh = tid >> 8; const long tb = (long)b * SEQ + c * 128;
#pragma unroll
    for (int k = 0; k < 3; ++k) { const long l = tb + rh * 64 - 3 + k; u32x4 v = (u32x4){0u, 0u, 0u, 0u};
        if (!(c == 0 && rh == 0)) v = *(const u32x4*)(XBC + (size_t)l * 2048 + cg * 8);
        *(u32x4*)(HALO + ((size_t)(unit * 2 + rh) * 3 + k) * 2048 + cg * 8) = v; }
}
__device__ __forceinline__ void conv_unit(unsigned short* XBC, const unsigned short* HALO, const float* conv_w, const float* conv_b, int unit, const int tid) {
    const int b = unit >> 5, c = unit & 31, cg = tid & 255, rh = tid >> 8; const size_t tb = (size_t)b * SEQ + (size_t)c * 128 + rh * 64; const int col = cg * 8;
    float cw[4][8], cb[8], r0[8], r1[8], r2[8];
#pragma unroll
    for (int j = 0; j < 4; ++j) { const f32x4 w0 = *(const f32x4*)(conv_w + j * 2048 + col), w1 = *(const f32x4*)(conv_w + j * 2048 + col + 4);
#pragma unroll
        for (int e = 0; e < 4; ++e) { cw[j][e] = w0[e]; cw[j][4 + e] = w1[e]; } }
    { const f32x4 b0 = *(const f32x4*)(conv_b + col), b1 = *(const f32x4*)(conv_b + col + 4);
#pragma unroll
      for (int e = 0; e < 4; ++e) { cb[e] = b0[e]; cb[4 + e] = b1[e]; } }
#define CV_UNPK(dst, raw) do { _Pragma("unroll") for (int e = 0; e < 4; ++e) { dst[2 * e] = __uint_as_float(raw[e] << 16); dst[2 * e + 1] = __uint_as_float(raw[e] & 0xffff0000u); } } while (0)
    { const unsigned short* hp = HALO + ((size_t)(unit * 2 + rh) * 3) * 2048 + col;
      const u32x4 h0 = *(const u32x4*)hp, h1 = *(const u32x4*)(hp + 2048), h2 = *(const u32x4*)(hp + 4096); CV_UNPK(r0, h0); CV_UNPK(r1, h1); CV_UNPK(r2, h2); }
    unsigned short* base = XBC + tb * 2048 + col;
    for (int i0 = 0; i0 < 64; i0 += 8) {
        u32x4 raw[8];
#pragma unroll
        for (int i = 0; i < 8; ++i) raw[i] = *(const u32x4*)(base + (size_t)(i0 + i) * 2048);
#pragma unroll
        for (int i = 0; i < 8; ++i) { float cur[8], val[8]; CV_UNPK(cur, raw[i]);
#pragma unroll
            for (int e = 0; e < 8; ++e) { const float v = cb[e] + cw[0][e] * r0[e] + cw[1][e] * r1[e] + cw[2][e] * r2[e] + cw[3][e] * cur[e];
                val[e] = v * __builtin_amdgcn_rcpf(1.0f + __expf(-v)); r0[e] = r1[e]; r1[e] = r2[e]; r2[e] = cur[e]; }
            u32x4 w; w.x = pk(val[0], val[1]); w.y = pk(val[2], val[3]); w.z = pk(val[4], val[5]); w.w = pk(val[6], val[7]);
            *(u32x4*)(base + (size_t)(i0 + i) * 2048) = w; }
    }
#undef CV_UNPK
}

__device__ __forceinline__ void ssd_unit(const unsigned short* XBC, unsigned short* AO, unsigned short* Yo, int ldy, const float* dt32, float* ssy,
                                         float a_log_h, float d_skip_h, int b, int h, char* lds, char* lds_small, const int tid_in) {
    int tid = tid_in; asm volatile("" : "+v"(tid)); const int wid = __builtin_amdgcn_readfirstlane(tid >> 6), lane = tid & 63, r32 = lane & 31, hi = lane >> 5;
    unsigned short* Cs = (unsigned short*)(lds + O_CS); unsigned short* Bs = (unsigned short*)(lds + O_BS); unsigned short* BwT = (unsigned short*)(lds + O_BWT);
    unsigned short* xT = (unsigned short*)(lds + O_XT); unsigned short* Sb = (unsigned short*)(lds + O_SB);
    unsigned short* Ms = Bs; unsigned short* Ys = Bs; unsigned short* Zs = Cs;
    float* cumL = (float*)lds_small; float* dtL = cumL + 128; float* wL = cumL + 256;
    const int g = h >> 2; const float Ah = -__expf(a_log_h);
    for (int i = tid; i < 64 * LD / 2; i += 512) ((unsigned*)Sb)[i] = 0u;
    f32x16 accS = {};
    const int li2 = wid & 3, pi = wid >> 2;
    const unsigned short* gB = XBC + 1024 + g * 128 + (tid & 15) * 8; const unsigned short* gC = XBC + 1536 + g * 128 + (tid & 15) * 8; const unsigned short* gX = XBC + h * 64 + (wid >> 2) * 32 + 8 * hi + (size_t)((wid & 3) * 32 + r32) * 2048;
    u32x4 tB[4], tC[4], tX[2], zreg[2]; float dtn = 0.f, dtn1 = 0.f;
#define SSD_FETCH(cc) do { const size_t tb_ = (size_t)b * SEQ + (size_t)(cc) * 128; \
        _Pragma("unroll") for (int i = 0; i < 4; ++i) { const size_t row = tb_ + (tid >> 4) + 32 * i; tB[i] = *(const u32x4*)(gB + row * 2048); tC[i] = *(const u32x4*)(gC + row * 2048); } \
        _Pragma("unroll") for (int i = 0; i < 2; ++i) { const size_t row = tb_ + (tid >> 3) + 64 * i; tX[i] = *(const u32x4*)(gX + tb_ * 2048 + 16 * i); \
            zreg[i] = *(const u32x4*)(AO + row * K_O_OUT + 512 + h * 64 + (tid & 7) * 8); } \
        if (wid == 0) { dtn = dt32[(tb_ + 2 * lane) * 16 + h]; dtn1 = dt32[(tb_ + 2 * lane + 1) * 16 + h]; } } while (0)
    bf16x8 idf[2];
#pragma unroll
    for (int s = 0; s < 2; ++s)
#pragma unroll
        for (int e = 0; e < 8; ++e) idf[s][e] = (16 * s + 8 * hi + e == r32) ? (short)0x3F80 : (short)0;
    SSD_FETCH(0);
    __syncthreads();
    for (int c = 0; c < SEQ / 128; ++c) {
        const size_t tb = (size_t)b * SEQ + (size_t)c * 128;
#ifndef SSD_RP1
#define SSD_RP1 1
#define SSD_RP2 1
#define SSD_RP3 1
#define SSD_RP5 1
#endif
        if (wid == 0) { const float d0 = dtn, d1 = dtn1; const float a0 = d0 * Ah, a1 = d1 * Ah; float inc = a0 + a1;
#pragma unroll
            for (int o = 1; o < 64; o <<= 1) { const float t = up_f(inc, o); if (lane >= o) inc += t; }
            const float c1 = inc, c0 = inc - a1; const float ce = __int_as_float(__builtin_amdgcn_readlane(__float_as_int(inc), 63));
            typedef float f32x2_ __attribute__((ext_vector_type(2)));
            *(f32x2_*)(dtL + 2 * lane) = (f32x2_){d0, d1}; *(f32x2_*)(cumL + 2 * lane) = (f32x2_){c0, c1};
            *(f32x2_*)(wL + 2 * lane) = (f32x2_){d0 * __expf(ce - c0), d1 * __expf(ce - c1)}; }
        __syncthreads();
        const float cend = cumL[127];
        for (int rp2 = 0; rp2 < SSD_RP2; ++rp2) {
#pragma unroll
        for (int i = 0; i < 4; ++i) { const int row = (tid >> 4) + 32 * i, c0 = (tid & 15) * 8; *(u32x4*)(Cs + row * LD + c0) = tC[i]; *(u32x4*)(Bs + row * LD + c0) = tB[i]; }
        }
        const bf16x8 xf0 = __builtin_bit_cast(bf16x8, tX[0]), xf1 = __builtin_bit_cast(bf16x8, tX[1]);
        u32x4 zcur[2] = {zreg[0], zreg[1]};
        if (c + 1 < SEQ / 128) SSD_FETCH(c + 1);
        __syncthreads();
        { const int lt = wid >> 1;
#pragma unroll
          for (int q2 = 0; q2 < 2; ++q2) { const int nt = 2 * (wid & 1) + q2; const unsigned short* tp = Bs + (lt * 32 + r32) * LD + nt * 32 + 8 * hi;
              f32x16 t = {}; t = __builtin_amdgcn_mfma_f32_32x32x16_bf16(*(const bf16x8*)tp, idf[0], t, 0, 0, 0); t = __builtin_amdgcn_mfma_f32_32x32x16_bf16(*(const bf16x8*)(tp + 16), idf[1], t, 0, 0, 0);
#pragma unroll
              for (int j = 0; j < 4; ++j) { const int l0 = lt * 32 + 8 * j + 4 * hi; const f32x4 w4 = *(const f32x4*)(wL + l0); float v[4];
#pragma unroll
                  for (int e = 0; e < 4; ++e) v[e] = t[4 * j + e] * w4[e];
                  u32x2 w; w.x = pk(v[0], v[1]); w.y = pk(v[2], v[3]); *(u32x2*)(BwT + (nt * 32 + r32) * LD + l0) = w; } }
          const int lx = wid & 3, pt = wid >> 2;
          f32x16 t = {}; t = __builtin_amdgcn_mfma_f32_32x32x16_bf16(xf0, idf[0], t, 0, 0, 0); t = __builtin_amdgcn_mfma_f32_32x32x16_bf16(xf1, idf[1], t, 0, 0, 0);
#pragma unroll
          for (int j = 0; j < 4; ++j) { u32x2 w; w.x = pk_v(t[4 * j], t[4 * j + 1]); w.y = pk_v(t[4 * j + 2], t[4 * j + 3]); *(u32x2*)(xT + (pt * 32 + r32) * LD + lx * 32 + 8 * j + 4 * hi) = w; } }
        unsigned mreg[2][8]; f32x16 accY = {};
        for (int rp3 = 0; rp3 < SSD_RP3; ++rp3) { accY = f32x16{};
        { const int li = wid >> 1; const int l = li * 32 + r32; const float cl = cumL[l];
#pragma unroll
          for (int q = 0; q < 2; ++q) { const int si = 2 * (wid & 1) + q;
              if (si <= li) { f32x16 acc = {}; acc = mma<8>(Bs + (si * 32 + r32) * LD, Cs + l * LD, acc, hi);
#pragma unroll
                  for (int j = 0; j < 4; ++j) { const int s0 = si * 32 + 8 * j + 4 * hi; const f32x4 cs4 = *(const f32x4*)(cumL + s0), dt4 = *(const f32x4*)(dtL + s0); float mv[4];
#pragma unroll
                      for (int e = 0; e < 4; ++e) { mv[e] = (s0 + e <= l) ? acc[4 * j + e] * __expf(cl - cs4[e]) * dt4[e] : 0.f; if (s0 + e == l) mv[e] += d_skip_h; }
                      mreg[q][2 * j] = pk(mv[0], mv[1]); mreg[q][2 * j + 1] = pk(mv[2], mv[3]); } }
              else {
#pragma unroll
                  for (int j = 0; j < 8; ++j) mreg[q][j] = 0u; } } }
        { const int l = li2 * 32 + r32; accY = mma<8>(Sb + (pi * 32 + r32) * LD, Cs + l * LD, accY, hi); const float el = __expf(cumL[l]);
#pragma unroll
          for (int r = 0; r < 16; ++r) accY[r] *= el; }
        }
        __syncthreads();
        { const int li = wid >> 1; const int l = li * 32 + r32;
#pragma unroll
          for (int q = 0; q < 2; ++q) { const int si = 2 * (wid & 1) + q;
#pragma unroll
              for (int j = 0; j < 4; ++j) { u32x2 w; w.x = mreg[q][2 * j]; w.y = mreg[q][2 * j + 1]; *(u32x2*)(Ms + l * LD + si * 32 + 8 * j + 4 * hi) = w; } } }
#pragma unroll
        for (int i = 0; i < 2; ++i) { const int row = (tid >> 3) + 64 * i, ch = tid & 7; *(u32x4*)(Zs + row * ZLD + ch * 8) = zcur[i]; }
        __syncthreads();
        unsigned yreg[8]; float ssq = 0.f;
        { const int l = li2 * 32 + r32;
          accY = mma<8>(xT + (pi * 32 + r32) * LD, Ms + l * LD, accY, hi);
          const float dec = __expf(cend);
#pragma unroll
          for (int r = 0; r < 16; ++r) accS[r] *= dec;
          accS = mma<8>(BwT + (li2 * 32 + r32) * LD, xT + (pi * 32 + r32) * LD, accS, hi);
#pragma unroll
          for (int j = 0; j < 4; ++j) { const int p0 = pi * 32 + 8 * j + 4 * hi; const u32x2 zz = *(const u32x2*)(Zs + l * ZLD + p0); float yg[4];
#pragma unroll
              for (int e = 0; e < 4; ++e) { const float y = accY[4 * j + e];
                  const float zv = (e & 1) ? __uint_as_float(zz[e >> 1] & 0xffff0000u) : __uint_as_float(zz[e >> 1] << 16);
                  yg[e] = y * siluf(zv); ssq += yg[e] * yg[e]; }
              yreg[2 * j] = pk(yg[0], yg[1]); yreg[2 * j + 1] = pk(yg[2], yg[3]); }
          ssq += xor_f<32>(ssq);
          if (hi == 0) ssy[(tb + l) * 32 + h * 2 + pi] = ssq; }
        __syncthreads();
        { const int l = li2 * 32 + r32;
#pragma unroll
          for (int j = 0; j < 4; ++j) { u32x2 w; w.x = yreg[2 * j]; w.y = yreg[2 * j + 1]; *(u32x2*)(Ys + l * ZLD + pi * 32 + 8 * j + 4 * hi) = w; }
          const int p = pi * 32 + r32;
#pragma unroll
          for (int j = 0; j < 4; ++j) { u32x2 w; w.x = pk(accS[4 * j], accS[4 * j + 1]); w.y = pk(accS[4 * j + 2], accS[4 * j + 3]); *(u32x2*)(Sb + p * LD + li2 * 32 + 8 * j + 4 * hi) = w; } }
        __syncthreads();
#pragma unroll
        for (int i = 0; i < 2; ++i) { const int idx = tid + 512 * i, row = idx >> 3, ch = idx & 7; *(u32x4*)(Yo + (tb + row) * ldy + h * 64 + ch * 8) = *(const u32x4*)(Ys + row * ZLD + ch * 8); }
    }
    __syncthreads();
#undef SSD_FETCH
}
}

constexpr int NWAVES = 8;
#ifndef EN_MASK
#define EN_MASK 0xFFFF
#endif
#ifndef REP_MASK
#define REP_MASK 0
#endif
#define REPS(b) ((((REP_MASK) >> (b)) & 1) + 1)
#define EN(b) (((EN_MASK) >> (b)) & 1)
struct Args {
    const float* in[28]; float* out; unsigned char* ws; int ph_lo, ph_hi;
};
struct Frame {
    LAS unsigned char* lds; volatile LAS unsigned* MISC; gu32* ctl; int tid, lane, wave, G;
};
typedef pg8::bf16_t bf16_t;

enum { MAP_ID = 0, MAP_EVEN_IN = 1, MAP_ODD_IN = 2, MAP_UQ = 3 };
__device__ __forceinline__ int colmap(int map, int n) {
    if (map == MAP_EVEN_IN) { if (n < 1352) return n; if (n < 1356) return 2888 + (n - 1352); if (n < 1536) return -1; return 1352 + (n - 1536); }
    if (map == MAP_ODD_IN) { if (n < 640) return n; if (n < 704) { const int jj = n - 640; return 640 + ((jj & 1) ? 32 : 0) + (jj >> 1); } if (n < 720) return 3776 + (n - 704); if (n < 768) return -1; return 704 + (n - 768); }
    if (map == MAP_UQ) { const int h = n >> 8, j = n & 255; if (j < 128) return 192 * h + j; if (j < 192) { const int jj = j - 128; return 192 * h + 128 + ((jj & 1) ? 32 : 0) + (jj >> 1); } return -1; }
    return n;
}
struct WJob { const float* W; bf16* dst; const float* gain; int K, Nsrc, Ndst, map, gk0; };
__device__ __forceinline__ void wconv_item(const WJob& J, LAS float* scr, int item, int lane) {
    const int nblk = J.Ndst / 32, kb = item / nblk, nb = item % nblk, k0 = 64 * kb, n0 = 32 * nb;
    const int sc = colmap(J.map, n0 + (lane & 31));
    float wv_[32];
#pragma unroll
    for (int i = 0; i < 32; ++i) { const int kk = 2 * i + (lane >> 5); wv_[i] = (sc >= 0) ? J.W[(size_t)(k0 + kk) * J.Nsrc + sc] : 0.f; }
#pragma unroll
    for (int i = 0; i < 32; ++i) { const int kk = 2 * i + (lane >> 5); float v = wv_[i];
        if (J.gain && (k0 + kk) >= J.gk0) v *= J.gain[k0 + kk - J.gk0];
        scr[kk * 33 + (lane & 31)] = v; }
    LDS_WAIT(); asm volatile("" ::: "memory");
    const int c = lane & 7;
#pragma unroll
    for (int j = 0; j < 4; ++j) { const int n = (lane >> 3) + 8 * j; const LAS float* s = scr + (8 * c) * 33 + n;
        v4u o; o.x = pk2(s[0 * 33], s[1 * 33]); o.y = pk2(s[2 * 33], s[3 * 33]); o.z = pk2(s[4 * 33], s[5 * 33]); o.w = pk2(s[6 * 33], s[7 * 33]);
        *(GAS v4u*)(J.dst + (size_t)(n0 + n) * J.K + k0 + 8 * c) = o; }
    LDS_WAIT(); asm volatile("" ::: "memory");
}
__device__ __forceinline__ float wave_sum(float v) { return wsum_f(v); }

__global__ void __launch_bounds__(NWAVES * 64, 2) trunk_fwd(Args args) {
    extern __shared__ __attribute__((aligned(16))) unsigned char lds[];
    {
        LAS unsigned char* L0 = (LAS unsigned char*)lds; const int t0 = threadIdx.x;
        for (int u = t0; u < (LDS_BYTES - LDS_MISC) / 4; u += NWAVES * 64) ((LAS unsigned*)(L0 + LDS_MISC))[u] = 0u;
        __syncthreads();
        volatile LAS unsigned* pt0 = (volatile LAS unsigned*)(L0 + LDS_MISC + 128);
        if (t0 < 30) { const unsigned long long p = (t0 < 28) ? (unsigned long long)args.in[t0] : (t0 == 28 ? (unsigned long long)args.out : (unsigned long long)args.ws);
            pt0[2 * t0] = (unsigned)p; pt0[2 * t0 + 1] = (unsigned)(p >> 32); }
        __syncthreads();
    }
    const int wave_s = __builtin_amdgcn_readfirstlane((int)(threadIdx.x >> 6));
#define PTR(k) ((const float*)(const GAS float*)(((unsigned long long)(unsigned)__builtin_amdgcn_readfirstlane((int)ptab[2 * (k) + 1]) << 32) | (unsigned long long)(unsigned)__builtin_amdgcn_readfirstlane((int)ptab[2 * (k)])))
    XcdBarrier bar = xcd_barrier_post((unsigned*)((gu32*)(args.ws + WS_CTL) + CW_BAR), (volatile LAS unsigned*)((LAS unsigned char*)lds + LDS_MISC) + 8, otid(wave_s));
    const int lo = args.ph_lo, hi = args.ph_hi;
#define IN(k) (lo <= (k) && (k) < hi)
#if defined(TPROF)
#define TSTAMP(i) do { if (blockIdx.x == 0 && threadIdx.x == 0) ((volatile LAS unsigned*)((LAS unsigned char*)lds + LDS_MISC + 384))[(i)] = (unsigned)__builtin_amdgcn_s_memrealtime(); } while (0)
#else
#define TSTAMP(i) do { } while (0)
#endif
#define SEAM2(k, kn) do { if (IN(k) && IN(kn)) xcd_barrier(bar, otid(wave_s)); TSTAMP((k) + 1); } while (0)
#define SEAM(k) SEAM2(k, (k) + 1)
    TSTAMP(0);
#define ENV_NOLAYER() \
        LAS unsigned char* L_ = (LAS unsigned char*)lds; asm volatile("" : "+s"(L_)); \
        int bid = blockIdx.x; asm volatile("" : "+s"(bid)); int GG = gridDim.x; asm volatile("" : "+s"(GG)); \
        const int tid = otid(wave_s); \
        volatile LAS unsigned* ptab = (volatile LAS unsigned*)(L_ + LDS_MISC + 128); \
        unsigned char* ws = (unsigned char*)PTR(29); float* out = (float*)PTR(28);
#define ENV() \
        LAS unsigned char* L_ = (LAS unsigned char*)lds; asm volatile("" : "+s"(L_)); \
        int bid = blockIdx.x; asm volatile("" : "+s"(bid)); int GG = gridDim.x; asm volatile("" : "+s"(GG)); \
        const int tid = otid(wave_s); const int lane = tid & 63; const int wave = __builtin_amdgcn_readfirstlane(tid >> 6); (void)lane; (void)wave; (void)bid; (void)GG; \
        char* glds = (char*)L_; PG8_LAS float* stat = (PG8_LAS float*)(L_ + LDS_STAT); volatile LAS unsigned* MISCp = (volatile LAS unsigned*)(L_ + LDS_MISC); \
        volatile LAS unsigned* ptab = (volatile LAS unsigned*)(L_ + LDS_MISC + 128); (void)glds; (void)stat; (void)MISCp; \
        unsigned char* ws = (unsigned char*)PTR(29); float* out = (float*)PTR(28); gu32* ctl = (gu32*)(ws + WS_CTL); (void)out; (void)ctl; \
        float* ssp = (float*)(ws + WS_SSP); float* cumb = (float*)(ws + WS_CUMB); float* misc32 = (float*)(ws + WS_MISC32); float* gss = (float*)(ws + WS_GSS); \
        float* ssy = (float*)(ws + WS_SSY); float* rope = (float*)(ws + WS_ROPE); unsigned long long* BM = (unsigned long long*)(ws + WS_BM); \
        bf16* XB = (bf16*)(ws + WS_XB); bf16* QB = (bf16*)out; \
        bf16* EP = (bf16*)(ws + WS_R + R_EP); bf16* AOE = (bf16*)(ws + WS_R + R_AOE); \
        bf16* C1 = (bf16*)(ws + WS_R + R_C1); bf16* AO = (bf16*)(ws + WS_R + R_AO); bf16* XBC = (bf16*)(ws + WS_R + R_XBC); bf16* KK = (bf16*)(ws + WS_R + R_KK); bf16* VV = (bf16*)(ws + WS_R + R_VV); \
        bf16* HB = (bf16*)(ws + WS_R + R_H); unsigned char* wsw = ws + WS_W; \
        const bf16* W1t = (const bf16*)(wsw + ((layer & 1) ? WO_1 : WE_1)); const bf16* W2t = (const bf16*)(wsw + ((layer & 1) ? WO_2 : WE_2)); \
        (void)ssp; (void)cumb; (void)misc32; (void)gss; (void)ssy; (void)rope; (void)BM; (void)XB; (void)QB; (void)EP; (void)AOE; (void)C1; (void)AO; (void)XBC; (void)KK; (void)VV; (void)HB; (void)W1t; (void)W2t;

    {
        constexpr int layer = 0;
        const int li = layer >> 1; const int gp0 = layer * 8;
        if ((layer & 1) == 0) {
            for (int rep = 0; rep < REPS(0); ++rep) { if (rep) xcd_barrier(bar, otid(wave_s));
            if (EN(0) && IN(gp0 + 0)) { ENV();
                LAS float* scr = (LAS float*)(L_ + wave * 16384);
                const int gw = bid * NWAVES + wave, NGW = GG * NWAVES;
                int it = gw;
#define WJOB(Wp, dstp, gainp, K_, Nsrc_, Ndst_, map_, gk0_) do { const WJob J_{Wp, dstp, gainp, K_, Nsrc_, Ndst_, map_, gk0_}; const int nit_ = ((K_) / 64) * ((Ndst_) / 32); \
                    for (; it < nit_; it += NGW) wconv_item(J_, scr, it, lane); it -= nit_; } while (0)
                WJOB(PTR(3) + (size_t)li * 1024 * 2892, (bf16*)(wsw + WE_IN), PTR(2) + li * 1024, 1024, 2892, 3072, MAP_EVEN_IN, 0);
                WJOB(PTR(9) + (size_t)li * 1024 * 1024, (bf16*)(wsw + WE_OUT), (const float*)nullptr, 1024, 1024, 1024, MAP_ID, 0);
                WJOB(PTR(26) + (size_t)(2 * li) * 1024 * 4096, (bf16*)(wsw + WE_1), PTR(25) + (2 * li) * 1024, 1024, 4096, 4096, MAP_ID, 0);
                WJOB(PTR(27) + (size_t)(2 * li) * 4096 * 1024, (bf16*)(wsw + WE_2), (const float*)nullptr, 4096, 1024, 1024, MAP_ID, 0);
                WJOB(PTR(11) + (size_t)li * 1024 * 3792, (bf16*)(wsw + WO_IN), PTR(10) + li * 1024, 1024, 3792, 3840, MAP_ODD_IN, 0);
                WJOB(PTR(14) + (size_t)li * 384 * 768, (bf16*)(wsw + WO_UQ), PTR(12) + li * 384, 384, 768, 1024, MAP_UQ, 0);
                WJOB(PTR(15) + (size_t)li * 256 * 1024, (bf16*)(wsw + WO_UKV), PTR(13) + li * 256, 256, 1024, 1024, MAP_ID, 0);
                WJOB(PTR(24) + (size_t)li * 1536 * 1024, (bf16*)(wsw + WO_OUT), PTR(23) + li * 1024, 1536, 1024, 1024, MAP_ID, 512);
                WJOB(PTR(26) + (size_t)(2 * li + 1) * 1024 * 4096, (bf16*)(wsw + WO_1), PTR(25) + (2 * li + 1) * 1024, 1024, 4096, 4096, MAP_ID, 0);
                WJOB(PTR(27) + (size_t)(2 * li + 1) * 4096 * 1024, (bf16*)(wsw + WO_2), (const float*)nullptr, 4096, 1024, 1024, MAP_ID, 0);
#undef WJOB
                if (layer == 0) { const float* x_in = PTR(0); const int* positions = (const int*)PTR(1);
                    for (int m0 = gw; m0 < MTOK; m0 += 2 * NGW) {
                        const int m1 = m0 + NGW; const bool two = m1 < MTOK;
                        const GAS f32x4* xa = (const GAS f32x4*)(x_in + (size_t)m0 * DM) + lane; const GAS f32x4* xb2 = (const GAS f32x4*)(x_in + (size_t)(two ? m1 : m0) * DM) + lane; f32x4 va[4], vb[4]; float sa = 0.f, sb = 0.f;
#pragma unroll
                        for (int j = 0; j < 4; ++j) { va[j] = xa[64 * j]; vb[j] = xb2[64 * j]; }
#pragma unroll
                        for (int j = 0; j < 4; ++j) { sa += (va[j].x * va[j].x + va[j].y * va[j].y) + (va[j].z * va[j].z + va[j].w * va[j].w); sb += (vb[j].x * vb[j].x + vb[j].y * vb[j].y) + (vb[j].z * vb[j].z + vb[j].w * vb[j].w); }
                        sa = wave_sum(sa); sb = wave_sum(sb);
                        GAS unsigned long long* oa = (GAS unsigned long long*)(XB + (size_t)m0 * DM) + lane;
#pragma unroll
                        for (int j = 0; j < 4; ++j) oa[64 * j] = (unsigned long long)pk2(va[j].x, va[j].y) | ((unsigned long long)pk2(va[j].z, va[j].w) << 32);
                        if (lane < 4) ssp[(size_t)lane * MTOK + m0] = (lane == 0) ? sa : 0.f;
                        if (two) { GAS unsigned long long* ob = (GAS unsigned long long*)(XB + (size_t)m1 * DM) + lane;
#pragma unroll
                            for (int j = 0; j < 4; ++j) ob[64 * j] = (unsigned long long)pk2(vb[j].x, vb[j].y) | ((unsigned long long)pk2(vb[j].z, vb[j].w) << 32);
                            if (lane < 4) ssp[(size_t)lane * MTOK + m1] = (lane == 0) ? sb : 0.f; }
                    }
                    for (int idx = bid * 512 + tid; idx < MTOK * 32; idx += GG * 512) { const int tok = idx >> 5, i = idx & 31;
                        const float inv = powf(10000.0f, -(float)i / 32.0f); const float ang = (float)positions[tok] * inv; const float sn = sinf(ang), cs = cosf(ang);
                        rope[(size_t)idx * 2] = cs; rope[(size_t)idx * 2 + 1] = sn; }
                }
            }
            }
            SEAM(gp0 + 0);
            for (int rep = 0; rep < REPS(1); ++rep) { if (rep) xcd_barrier(bar, otid(wave_s));
            if (EN(1) && IN(gp0 + 1)) { ENV();
                pg8::Gemm g{XB, (const bf16*)(wsw + WE_IN), MTOK, N_E_IN, DM, DM}; pg8::StaticOrder S; S.init(MTOK, N_E_IN, GG, bid);
                pg8::EpiEvenIn E{EP, ssp, misc32, PTR(5) + li * 128, PTR(6) + li * 128, PTR(7) + li * 128, PTR(8) + li * 128, PTR(4) + li * 4, stat};
                pg8::gemm_phase<pg8::EpiEvenIn, pg8::StaticOrder, true, true>(L_, g, S, E, tid);
            }
            }
            SEAM(gp0 + 1);
            for (int rep = 0; rep < REPS(2); ++rep) { if (rep) xcd_barrier(bar, otid(wave_s));
            if (EN(2) && IN(gp0 + 2)) { ENV();
                if (bid < 32) tk::cumsum_unit(misc32, cumb, bid >> 2, bid & 3, glds, tid);
#if defined(TKS_CHECK)
                for (int v = bid; v < 4096; v += GG) tk::topk_unit(EP, misc32, BM, v & 7, 511 - (v >> 3), glds, glds + LDS_STAT, glds + LDS_FAC, tid);
                __syncthreads();
#define TKR_DST ((unsigned long long*)out)
#else
#define TKR_DST BM
#endif
                for (int v = bid; v < 2048; v += GG) { const int st = v >> 8, x = (v >> 3) & 31;
                    tkr::regsel_unit(EP, misc32, TKR_DST, v & 7, 255 - (32 * st + ((st & 1) ? 31 - x : x)), glds, glds + LDS_STAT, glds + LDS_FAC, tid); }
#undef TKR_DST
            }
            }
#if defined(TKS_CHECK)
            if (IN(gp0 + 2)) { xcd_barrier(bar, otid(wave_s)); { ENV();
                unsigned bad = 0u; const unsigned long long* B2 = (const unsigned long long*)out;
                for (size_t i = (size_t)bid * 512 + tid; i < (size_t)MTOK * 64; i += (size_t)GG * 512) bad += (BM[i] != B2[i]) ? 1u : 0u;
                if (bad) __hip_atomic_fetch_add(ctl + 2048, bad, RLX_AGENT); } }
#endif
            SEAM(gp0 + 2);
            for (int rep = 0; rep < REPS(3); ++rep) { if (rep) xcd_barrier(bar, otid(wave_s));
            if (IN(gp0 + 3)) { ENV();
                gu32* qh = ctl + CW_QUEUE + 64 * (layer * 4 + 1 + 2 * rep);
                for (;;) {
                    if (tid == 0) MISCp[4] = __hip_atomic_fetch_add(qh, 1u, RLX_AGENT);
                    __syncthreads();
                    const int u = (int)MISCp[4];
                    if (u >= 1024) break;
                    const int i = u >> 1; att::UnitArgs a;
                    if ((u & 1) == 0) { if (EN(3) && !(rep == 1 && ((REP_MASK >> 18) & 1))) {
                        const int qb = 15 - (i >> 5), bh = i & 31, b = bh >> 2, h = bh & 3; const size_t r0 = (size_t)b * SEQ + qb * 256 + 32 * wave;
                        a.Q = EP + r0 * N_E_IN + 1536 + 128 * h; a.ldq = N_E_IN; a.K = EP + (size_t)b * SEQ * N_E_IN + 2048 + 128 * h; a.ldk = N_E_IN; a.V = EP + (size_t)b * SEQ * N_E_IN + 2560 + 128 * h; a.ldv = N_E_IN;
                        a.O = AOE + r0 * DM + 512 + 128 * h; a.ldo = DM; a.qlo = qb * 256 + 32 * wave; a.NT = 4 * (qb + 1); a.kbias = cumb + (size_t)h * MTOK + (size_t)b * SEQ; a.bm = nullptr; a.tid = tid; a.gq = PTR(7) + li * 128; a.gk = PTR(8) + li * 128;
                        att::attn_unit<128, 1>(a, glds); }
                    } else if (EN(4) && !(rep == 1 && ((REP_MASK >> 19) & 1))) {
                        const int j = 63 - (i >> 3), b = i & 7, head = wave >> 1, sub = wave & 1; const size_t r0 = (size_t)b * SEQ + j * 64 + 32 * sub;
                        a.Q = EP + r0 * N_E_IN + 128 * head; a.ldq = N_E_IN; a.K = EP + (size_t)b * SEQ * N_E_IN + 512; a.ldk = N_E_IN; a.V = EP + (size_t)b * SEQ * N_E_IN + 640; a.ldv = N_E_IN;
                        a.O = AOE + r0 * DM + 128 * head; a.ldo = DM; a.qlo = j * 64 + 32 * sub; a.NT = j + 1; a.kbias = nullptr; a.bm = BM + r0 * 64; a.tid = tid; a.gq = PTR(5) + li * 128; a.gk = PTR(6) + li * 128;
                        att::attn_unit<128, 2>(a, glds);
                    }
                }
            }
            }
            SEAM(gp0 + 3);
            if (EN(5) && IN(gp0 + 4)) { ENV();
                pg8::Gemm g{AOE, (const bf16*)(wsw + WE_OUT), MTOK, DM, DM, DM}; pg8::StaticOrder S; S.init(MTOK, DM, GG, bid);
                pg8::EpiResid E{XB, ssp, stat, (float*)nullptr};
                pg8::gemm_phase<pg8::EpiResid, pg8::StaticOrder, true, true>(L_, g, S, E, tid);
            }
            SEAM2(gp0 + 4, gp0 + 6);
        } else {
            for (int rep = 0; rep < REPS(6); ++rep) { if (rep) xcd_barrier(bar, otid(wave_s));
            if (EN(6) && IN(gp0 + 0)) { ENV();
                pg8::Gemm g{XB, (const bf16*)(wsw + WO_IN), MTOK, N_O_IN, DM, DM}; pg8::StaticOrder S; S.init(MTOK, N_O_IN, GG, bid);
                pg8::EpiOddIn E{C1, AO, XBC, ssp, gss, misc32, PTR(20) + li * 16, stat};
                pg8::gemm_phase<pg8::EpiOddIn, pg8::StaticOrder, true, true>(L_, g, S, E, tid);
            }
            }
            SEAM(gp0 + 0);
            for (int rep = 0; rep < REPS(7); ++rep) { if (rep) xcd_barrier(bar, otid(wave_s));
            if (EN(7) && IN(gp0 + 1)) { ENV();
                if (rep == 0) for (int u = bid; u < 256; u += GG) ssd::conv_halo_save(XBC, (bf16*)(ws + WS_BM), u, tid);
                if (EN(12)) { pg8::Gemm g{C1, (const bf16*)(wsw + WO_UQ), MTOK, 1024, 384, 768}; pg8::StaticOrder S; S.init(MTOK, 1024, GG, bid);
                  pg8::EpiUq E{QB, gss, PTR(16) + li * 192, rope, stat};
                  pg8::gemm_phase<pg8::EpiUq, pg8::StaticOrder, true, true>(L_, g, S, E, tid); }
                if (EN(13)) { pg8::Gemm g{C1 + 384, (const bf16*)(wsw + WO_UKV), MTOK, 1024, 256, 768}; pg8::StaticOrder S; S.init(MTOK, 1024, GG, bid);
                  pg8::EpiUkv E{KK, VV, C1, gss, PTR(17) + li * 192, rope, stat};
                  pg8::gemm_phase<pg8::EpiUkv, pg8::StaticOrder, true, true>(L_, g, S, E, tid); }
            }
            }
            SEAM(gp0 + 1);
            if (IN(gp0 + 2)) { ENV();
                for (int u = bid; u < 256; u += GG) ssd::conv_unit(XBC, (const bf16*)(ws + WS_BM), PTR(18) + (size_t)li * 4 * 2048, PTR(19) + li * 2048, u, tid);
            }
            SEAM(gp0 + 2);
            for (int rep = 0; rep < REPS(9); ++rep) { if (rep) xcd_barrier(bar, otid(wave_s));
            if (IN(gp0 + 3)) { ENV();
                gu32* qh = ctl + CW_QUEUE + 64 * (layer * 4 + 0 + 2 * rep);
                for (;;) {
                    if (tid == 0) MISCp[4] = __hip_atomic_fetch_add(qh, 1u, RLX_AGENT);
                    __syncthreads();
                    const int u = (int)MISCp[4];
                    if (u >= 128 + 512) break;
                    if (u < 128) { if (EN(8) && rep == 0) { const int b = u >> 4, h = u & 15;
                        ssd::ssd_unit(XBC, AO, AO + 512, K_O_OUT, misc32, ssy, PTR(21)[li * 16 + h], PTR(22)[li * 16 + h], b, h, glds, glds + LDS_STAT, tid); }
                    } else if (EN(9)) { const int i = u - 128; const int qb = 15 - (i >> 5), bh = i & 31, b = bh >> 2, h = bh & 3; const size_t r0 = (size_t)b * SEQ + qb * 256 + 32 * wave; att::UnitArgs a;
                        a.Q = QB + r0 * 768 + 192 * h; a.ldq = 768; a.K = KK + (size_t)b * SEQ * 768 + 192 * h; a.ldk = 768; a.V = VV + (size_t)b * SEQ * 512 + 128 * h; a.ldv = 512;
                        a.O = AO + r0 * K_O_OUT + 128 * h; a.ldo = K_O_OUT; a.qlo = qb * 256 + 32 * wave; a.NT = 4 * (qb + 1); a.kbias = nullptr; a.bm = nullptr; a.tid = tid; a.gq = PTR(16) + li * 192; a.gk = PTR(17) + li * 192;
                        att::attn_unit<192, 0>(a, glds);
                    }
                }
            }
            }
#if defined(PROBE_SSD)
            if (IN(gp0 + 3)) { xcd_barrier(bar, otid(wave_s)); { ENV();
                for (int u = bid; u < 128; u += GG) { const int b = u >> 4, h = u & 15;
                    ssd::ssd_unit(XBC, AO, (bf16*)out + (size_t)24 * 1024 * 1024, 1024, misc32, (float*)(ws + WS_BM), PTR(21)[li * 16 + h], PTR(22)[li * 16 + h], b, h, glds, glds + LDS_STAT, tid); } } }
#endif
            SEAM2(gp0 + 3, gp0 + 5);
            if (EN(5) && IN(gp0 + 5)) { ENV();
                pg8::Gemm g{AO, (const bf16*)(wsw + WO_OUT), MTOK, DM, K_O_OUT, K_O_OUT}; pg8::StaticOrder S; S.init(MTOK, DM, GG, bid);
                pg8::EpiResid E{XB, ssp, stat, (float*)nullptr};
                const pg8::GroupScaleHook HK{ssy, (PG8_LAS float*)(L_ + LDS_FAC)};
                pg8::gemm_phase<pg8::EpiResid, pg8::StaticOrder, true, true, pg8::GroupScaleHook>(L_, g, S, E, tid, HK);
            }
            SEAM(gp0 + 5);
        }
        for (int rep = 0; rep < REPS(5); ++rep) { if (rep) xcd_barrier(bar, otid(wave_s));
        if (EN(11) && IN(gp0 + 6)) { ENV();
            pg8::Gemm g{XB, W1t, MTOK, DFF, DM, DM}; pg8::StaticOrder S; S.init(MTOK, DFF, GG, bid);
            pg8::EpiMlpUp E{HB, ssp};
            pg8::gemm_phase<pg8::EpiMlpUp, pg8::StaticOrder, true, true>(L_, g, S, E, tid);
        }
        }
        SEAM(gp0 + 6);
        if (EN(5) && IN(gp0 + 7)) { ENV();
            pg8::Gemm g{HB, W2t, MTOK, DM, DFF, DFF}; pg8::StaticOrder S; S.init(MTOK, DM, GG, bid);
            pg8::EpiResid E{XB, ssp, stat, layer == 3 ? out : (float*)nullptr};
            pg8::gemm_phase<pg8::EpiResid, pg8::StaticOrder, true, true>(L_, g, S, E, tid);
        }
        if (layer < 3) SEAM(gp0 + 7);
    }
    {
        constexpr int layer = 1;
        const int li = layer >> 1; const int gp0 = layer * 8;
        if ((layer & 1) == 0) {
            for (int rep = 0; rep < REPS(0); ++rep) { if (rep) xcd_barrier(bar, otid(wave_s));
            if (EN(0) && IN(gp0 + 0)) { ENV();
                LAS float* scr = (LAS float*)(L_ + wave * 16384);
                const int gw = bid * NWAVES + wave, NGW = GG * NWAVES;
                int it = gw;
#define WJOB(Wp, dstp, gainp, K_, Nsrc_, Ndst_, map_, gk0_) do { const WJob J_{Wp, dstp, gainp, K_, Nsrc_, Ndst_, map_, gk0_}; const int nit_ = ((K_) / 64) * ((Ndst_) / 32); \
                    for (; it < nit_; it += NGW) wconv_item(J_, scr, it, lane); it -= nit_; } while (0)
                WJOB(PTR(3) + (size_t)li * 1024 * 2892, (bf16*)(wsw + WE_IN), PTR(2) + li * 1024, 1024, 2892, 3072, MAP_EVEN_IN, 0);
                WJOB(PTR(9) + (size_t)li * 1024 * 1024, (bf16*)(wsw + WE_OUT), (const float*)nullptr, 1024, 1024, 1024, MAP_ID, 0);
                WJOB(PTR(26) + (size_t)(2 * li) * 1024 * 4096, (bf16*)(wsw + WE_1), PTR(25) + (2 * li) * 1024, 1024, 4096, 4096, MAP_ID, 0);
                WJOB(PTR(27) + (size_t)(2 * li) * 4096 * 1024, (bf16*)(wsw + WE_2), (const float*)nullptr, 4096, 1024, 1024, MAP_ID, 0);
                WJOB(PTR(11) + (size_t)li * 1024 * 3792, (bf16*)(wsw + WO_IN), PTR(10) + li * 1024, 1024, 3792, 3840, MAP_ODD_IN, 0);
                WJOB(PTR(14) + (size_t)li * 384 * 768, (bf16*)(wsw + WO_UQ), PTR(12) + li * 384, 384, 768, 1024, MAP_UQ, 0);
                WJOB(PTR(15) + (size_t)li * 256 * 1024, (bf16*)(wsw + WO_UKV), PTR(13) + li * 256, 256, 1024, 1024, MAP_ID, 0);
                WJOB(PTR(24) + (size_t)li * 1536 * 1024, (bf16*)(wsw + WO_OUT), PTR(23) + li * 1024, 1536, 1024, 1024, MAP_ID, 512);
                WJOB(PTR(26) + (size_t)(2 * li + 1) * 1024 * 4096, (bf16*)(wsw + WO_1), PTR(25) + (2 * li + 1) * 1024, 1024, 4096, 4096, MAP_ID, 0);
                WJOB(PTR(27) + (size_t)(2 * li + 1) * 4096 * 1024, (bf16*)(wsw + WO_2), (const float*)nullptr, 4096, 1024, 1024, MAP_ID, 0);
#undef WJOB
                if (layer == 0) { const float* x_in = PTR(0); const int* positions = (const int*)PTR(1);
                    for (int m0 = gw; m0 < MTOK; m0 += 2 * NGW) {
                        const int m1 = m0 + NGW; const bool two = m1 < MTOK;
                        const GAS f32x4* xa = (const GAS f32x4*)(x_in + (size_t)m0 * DM) + lane; const GAS f32x4* xb2 = (const GAS f32x4*)(x_in + (size_t)(two ? m1 : m0) * DM) + lane; f32x4 va[4], vb[4]; float sa = 0.f, sb = 0.f;
#pragma unroll
                        for (int j = 0; j < 4; ++j) { va[j] = xa[64 * j]; vb[j] = xb2[64 * j]; }
#pragma unroll
                        for (int j = 0; j < 4; ++j) { sa += (va[j].x * va[j].x + va[j].y * va[j].y) + (va[j].z * va[j].z + va[j].w * va[j].w); sb += (vb[j].x * vb[j].x + vb[j].y * vb[j].y) + (vb[j].z * vb[j].z + vb[j].w * vb[j].w); }
                        sa = wave_sum(sa); sb = wave_sum(sb);
                        GAS unsigned long long* oa = (GAS unsigned long long*)(XB + (size_t)m0 * DM) + lane;
#pragma unroll
                        for (int j = 0; j < 4; ++j) oa[64 * j] = (unsigned long long)pk2(va[j].x, va[j].y) | ((unsigned long long)pk2(va[j].z, va[j].w) << 32);
                        if (lane < 4) ssp[(size_t)lane * MTOK + m0] = (lane == 0) ? sa : 0.f;
                        if (two) { GAS unsigned long long* ob = (GAS unsigned long long*)(XB + (size_t)m1 * DM) + lane;
#pragma unroll
                            for (int j = 0; j < 4; ++j) ob[64 * j] = (unsigned long long)pk2(vb[j].x, vb[j].y) | ((unsigned long long)pk2(vb[j].z, vb[j].w) << 32);
                            if (lane < 4) ssp[(size_t)lane * MTOK + m1] = (lane == 0) ? sb : 0.f; }
                    }
                    for (int idx = bid * 512 + tid; idx < MTOK * 32; idx += GG * 512) { const int tok = idx >> 5, i = idx & 31;
                        const float inv = powf(10000.0f, -(float)i / 32.0f); const float ang = (float)positions[tok] * inv; const float sn = sinf(ang), cs = cosf(ang);
                        rope[(size_t)idx * 2] = cs; rope[(size_t)idx * 2 + 1] = sn; }
                }
            }
            }
            SEAM(gp0 + 0);
            for (int rep = 0; rep < REPS(1); ++rep) { if (rep) xcd_barrier(bar, otid(wave_s));
            if (EN(1) && IN(gp0 + 1)) { ENV();
                pg8::Gemm g{XB, (const bf16*)(wsw + WE_IN), MTOK, N_E_IN, DM, DM}; pg8::StaticOrder S; S.init(MTOK, N_E_IN, GG, bid);
                pg8::EpiEvenIn E{EP, ssp, misc32, PTR(5) + li * 128, PTR(6) + li * 128, PTR(7) + li * 128, PTR(8) + li * 128, PTR(4) + li * 4, stat};
                pg8::gemm_phase<pg8::EpiEvenIn, pg8::StaticOrder, true, true>(L_, g, S, E, tid);
            }
            }
            SEAM(gp0 + 1);
            for (int rep = 0; rep < REPS(2); ++rep) { if (rep) xcd_barrier(bar, otid(wave_s));
            if (EN(2) && IN(gp0 + 2)) { ENV();
                if (bid < 32) tk::cumsum_unit(misc32, cumb, bid >> 2, bid & 3, glds, tid);
#if defined(TKS_CHECK)
                for (int v = bid; v < 4096; v += GG) tk::topk_unit(EP, misc32, BM, v & 7, 511 - (v >> 3), glds, glds + LDS_STAT, glds + LDS_FAC, tid);
                __syncthreads();
#define TKR_DST ((unsigned long long*)out)
#else
#define TKR_DST BM
#endif
                for (int v = bid; v < 2048; v += GG) { const int st = v >> 8, x = (v >> 3) & 31;
                    tkr::regsel_unit(EP, misc32, TKR_DST, v & 7, 255 - (32 * st + ((st & 1) ? 31 - x : x)), glds, glds + LDS_STAT, glds + LDS_FAC, tid); }
#undef TKR_DST
            }
            }
#if defined(TKS_CHECK)
            if (IN(gp0 + 2)) { xcd_barrier(bar, otid(wave_s)); { ENV();
                unsigned bad = 0u; const unsigned long long* B2 = (const unsigned long long*)out;
                for (size_t i = (size_t)bid * 512 + tid; i < (size_t)MTOK * 64; i += (size_t)GG * 512) bad += (BM[i] != B2[i]) ? 1u : 0u;
                if (bad) __hip_atomic_fetch_add(ctl + 2048, bad, RLX_AGENT); } }
#endif
            SEAM(gp0 + 2);
            for (int rep = 0; rep < REPS(3); ++rep) { if (rep) xcd_barrier(bar, otid(wave_s));
            if (IN(gp0 + 3)) { ENV();
                gu32* qh = ctl + CW_QUEUE + 64 * (layer * 4 + 1 + 2 * rep);
                for (;;) {
                    if (tid == 0) MISCp[4] = __hip_atomic_fetch_add(qh, 1u, RLX_AGENT);
                    __syncthreads();
                    const int u = (int)MISCp[4];
                    if (u >= 1024) break;
                    const int i = u >> 1; att::UnitArgs a;
                    if ((u & 1) == 0) { if (EN(3) && !(rep == 1 && ((REP_MASK >> 18) & 1))) {
                        const int qb = 15 - (i >> 5), bh = i & 31, b = bh >> 2, h = bh & 3; const size_t r0 = (size_t)b * SEQ + qb * 256 + 32 * wave;
                        a.Q = EP + r0 * N_E_IN + 1536 + 128 * h; a.ldq = N_E_IN; a.K = EP + (size_t)b * SEQ * N_E_IN + 2048 + 128 * h; a.ldk = N_E_IN; a.V = EP + (size_t)b * SEQ * N_E_IN + 2560 + 128 * h; a.ldv = N_E_IN;
                        a.O = AOE + r0 * DM + 512 + 128 * h; a.ldo = DM; a.qlo = qb * 256 + 32 * wave; a.NT = 4 * (qb + 1); a.kbias = cumb + (size_t)h * MTOK + (size_t)b * SEQ; a.bm = nullptr; a.tid = tid; a.gq = PTR(7) + li * 128; a.gk = PTR(8) + li * 128;
                        att::attn_unit<128, 1>(a, glds); }
                    } else if (EN(4) && !(rep == 1 && ((REP_MASK >> 19) & 1))) {
                        const int j = 63 - (i >> 3), b = i & 7, head = wave >> 1, sub = wave & 1; const size_t r0 = (size_t)b * SEQ + j * 64 + 32 * sub;
                        a.Q = EP + r0 * N_E_IN + 128 * head; a.ldq = N_E_IN; a.K = EP + (size_t)b * SEQ * N_E_IN + 512; a.ldk = N_E_IN; a.V = EP + (size_t)b * SEQ * N_E_IN + 640; a.ldv = N_E_IN;
                        a.O = AOE + r0 * DM + 128 * head; a.ldo = DM; a.qlo = j * 64 + 32 * sub; a.NT = j + 1; a.kbias = nullptr; a.bm = BM + r0 * 64; a.tid = tid; a.gq = PTR(5) + li * 128; a.gk = PTR(6) + li * 128;
                        att::attn_unit<128, 2>(a, glds);
                    }
                }
            }
            }
            SEAM(gp0 + 3);
            if (EN(5) && IN(gp0 + 4)) { ENV();
                pg8::Gemm g{AOE, (const bf16*)(wsw + WE_OUT), MTOK, DM, DM, DM}; pg8::StaticOrder S; S.init(MTOK, DM, GG, bid);
                pg8::EpiResid E{XB, ssp, stat, (float*)nullptr};
                pg8::gemm_phase<pg8::EpiResid, pg8::StaticOrder, true, true>(L_, g, S, E, tid);
            }
            SEAM2(gp0 + 4, gp0 + 6);
        } else {
            for (int rep = 0; rep < REPS(6); ++rep) { if (rep) xcd_barrier(bar, otid(wave_s));
            if (EN(6) && IN(gp0 + 0)) { ENV();
                pg8::Gemm g{XB, (const bf16*)(wsw + WO_IN), MTOK, N_O_IN, DM, DM}; pg8::StaticOrder S; S.init(MTOK, N_O_IN, GG, bid);
                pg8::EpiOddIn E{C1, AO, XBC, ssp, gss, misc32, PTR(20) + li * 16, stat};
                pg8::gemm_phase<pg8::EpiOddIn, pg8::StaticOrder, true, true>(L_, g, S, E, tid);
            }
            }
            SEAM(gp0 + 0);
            for (int rep = 0; rep < REPS(7); ++rep) { if (rep) xcd_barrier(bar, otid(wave_s));
            if (EN(7) && IN(gp0 + 1)) { ENV();
                if (rep == 0) for (int u = bid; u < 256; u += GG) ssd::conv_halo_save(XBC, (bf16*)(ws + WS_BM), u, tid);
                if (EN(12)) { pg8::Gemm g{C1, (const bf16*)(wsw + WO_UQ), MTOK, 1024, 384, 768}; pg8::StaticOrder S; S.init(MTOK, 1024, GG, bid);
                  pg8::EpiUq E{QB, gss, PTR(16) + li * 192, rope, stat};
                  pg8::gemm_phase<pg8::EpiUq, pg8::StaticOrder, true, true>(L_, g, S, E, tid); }
                if (EN(13)) { pg8::Gemm g{C1 + 384, (const bf16*)(wsw + WO_UKV), MTOK, 1024, 256, 768}; pg8::StaticOrder S; S.init(MTOK, 1024, GG, bid);
                  pg8::EpiUkv E{KK, VV, C1, gss, PTR(17) + li * 192, rope, stat};
                  pg8::gemm_phase<pg8::EpiUkv, pg8::StaticOrder, true, true>(L_, g, S, E, tid); }
            }
            }
            SEAM(gp0 + 1);
            if (IN(gp0 + 2)) { ENV();
                for (int u = bid; u < 256; u += GG) ssd::conv_unit(XBC, (const bf16*)(ws + WS_BM), PTR(18) + (size_t)li * 4 * 2048, PTR(19) + li * 2048, u, tid);
            }
            SEAM(gp0 + 2);
            for (int rep = 0; rep < REPS(9); ++rep) { if (rep) xcd_barrier(bar, otid(wave_s));
            if (IN(gp0 + 3)) { ENV();
                gu32* qh = ctl + CW_QUEUE + 64 * (layer * 4 + 0 + 2 * rep);
                for (;;) {
                    if (tid == 0) MISCp[4] = __hip_atomic_fetch_add(qh, 1u, RLX_AGENT);
                    __syncthreads();
                    const int u = (int)MISCp[4];
                    if (u >= 128 + 512) break;
                    if (u < 128) { if (EN(8) && rep == 0) { const int b = u >> 4, h = u & 15;
                        ssd::ssd_unit(XBC, AO, AO + 512, K_O_OUT, misc32, ssy, PTR(21)[li * 16 + h], PTR(22)[li * 16 + h], b, h, glds, glds + LDS_STAT, tid); }
                    } else if (EN(9)) { const int i = u - 128; const int qb = 15 - (i >> 5), bh = i & 31, b = bh >> 2, h = bh & 3; const size_t r0 = (size_t)b * SEQ + qb * 256 + 32 * wave; att::UnitArgs a;
                        a.Q = QB + r0 * 768 + 192 * h; a.ldq = 768; a.K = KK + (size_t)b * SEQ * 768 + 192 * h; a.ldk = 768; a.V = VV + (size_t)b * SEQ * 512 + 128 * h; a.ldv = 512;
                        a.O = AO + r0 * K_O_OUT + 128 * h; a.ldo = K_O_OUT; a.qlo = qb * 256 + 32 * wave; a.NT = 4 * (qb + 1); a.kbias = nullptr; a.bm = nullptr; a.tid = tid; a.gq = PTR(16) + li * 192; a.gk = PTR(17) + li * 192;
                        att::attn_unit<192, 0>(a, glds);
                    }
                }
            }
            }
#if defined(PROBE_SSD)
            if (IN(gp0 + 3)) { xcd_barrier(bar, otid(wave_s)); { ENV();
                for (int u = bid; u < 128; u += GG) { const int b = u >> 4, h = u & 15;
                    ssd::ssd_unit(XBC, AO, (bf16*)out + (size_t)24 * 1024 * 1024, 1024, misc32, (float*)(ws + WS_BM), PTR(21)[li * 16 + h], PTR(22)[li * 16 + h], b, h, glds, glds + LDS_STAT, tid); } } }
#endif
            SEAM2(gp0 + 3, gp0 + 5);
            if (EN(5) && IN(gp0 + 5)) { ENV();
                pg8::Gemm g{AO, (const bf16*)(wsw + WO_OUT), MTOK, DM, K_O_OUT, K_O_OUT}; pg8::StaticOrder S; S.init(MTOK, DM, GG, bid);
                pg8::EpiResid E{XB, ssp, stat, (float*)nullptr};
                const pg8::GroupScaleHook HK{ssy, (PG8_LAS float*)(L_ + LDS_FAC)};
                pg8::gemm_phase<pg8::EpiResid, pg8::StaticOrder, true, true, pg8::GroupScaleHook>(L_, g, S, E, tid, HK);
            }
            SEAM(gp0 + 5);
        }
        for (int rep = 0; rep < REPS(5); ++rep) { if (rep) xcd_barrier(bar, otid(wave_s));
        if (EN(11) && IN(gp0 + 6)) { ENV();
            pg8::Gemm g{XB, W1t, MTOK, DFF, DM, DM}; pg8::StaticOrder S; S.init(MTOK, DFF, GG, bid);
            pg8::EpiMlpUp E{HB, ssp};
            pg8::gemm_phase<pg8::EpiMlpUp, pg8::StaticOrder, true, true>(L_, g, S, E, tid);
        }
        }
        SEAM(gp0 + 6);
        if (EN(5) && IN(gp0 + 7)) { ENV();
            pg8::Gemm g{HB, W2t, MTOK, DM, DFF, DFF}; pg8::StaticOrder S; S.init(MTOK, DM, GG, bid);
            pg8::EpiResid E{XB, ssp, stat, layer == 3 ? out : (float*)nullptr};
            pg8::gemm_phase<pg8::EpiResid, pg8::StaticOrder, true, true>(L_, g, S, E, tid);
        }
        if (layer < 3) SEAM(gp0 + 7);
    }
    {
        constexpr int layer = 2;
        const int li = layer >> 1; const int gp0 = layer * 8;
        if ((layer & 1) == 0) {
            for (int rep = 0; rep < REPS(0); ++rep) { if (rep) xcd_barrier(bar, otid(wave_s));
            if (EN(0) && IN(gp0 + 0)) { ENV();
                LAS float* scr = (LAS float*)(L_ + wave * 16384);
                const int gw = bid * NWAVES + wave, NGW = GG * NWAVES;
                int it = gw;
#define WJOB(Wp, dstp, gainp, K_, Nsrc_, Ndst_, map_, gk0_) do { const WJob J_{Wp, dstp, gainp, K_, Nsrc_, Ndst_, map_, gk0_}; const int nit_ = ((K_) / 64) * ((Ndst_) / 32); \
                    for (; it < nit_; it += NGW) wconv_item(J_, scr, it, lane); it -= nit_; } while (0)
                WJOB(PTR(3) + (size_t)li * 1024 * 2892, (bf16*)(wsw + WE_IN), PTR(2) + li * 1024, 1024, 2892, 3072, MAP_EVEN_IN, 0);
                WJOB(PTR(9) + (size_t)li * 1024 * 1024, (bf16*)(wsw + WE_OUT), (const float*)nullptr, 1024, 1024, 1024, MAP_ID, 0);
                WJOB(PTR(26) + (size_t)(2 * li) * 1024 * 4096, (bf16*)(wsw + WE_1), PTR(25) + (2 * li) * 1024, 1024, 4096, 4096, MAP_ID, 0);
                WJOB(PTR(27) + (size_t)(2 * li) * 4096 * 1024, (bf16*)(wsw + WE_2), (const float*)nullptr, 4096, 1024, 1024, MAP_ID, 0);
                WJOB(PTR(11) + (size_t)li * 1024 * 3792, (bf16*)(wsw + WO_IN), PTR(10) + li * 1024, 1024, 3792, 3840, MAP_ODD_IN, 0);
                WJOB(PTR(14) + (size_t)li * 384 * 768, (bf16*)(wsw + WO_UQ), PTR(12) + li * 384, 384, 768, 1024, MAP_UQ, 0);
                WJOB(PTR(15) + (size_t)li * 256 * 1024, (bf16*)(wsw + WO_UKV), PTR(13) + li * 256, 256, 1024, 1024, MAP_ID, 0);
                WJOB(PTR(24) + (size_t)li * 1536 * 1024, (bf16*)(wsw + WO_OUT), PTR(23) + li * 1024, 1536, 1024, 1024, MAP_ID, 512);
                WJOB(PTR(26) + (size_t)(2 * li + 1) * 1024 * 4096, (bf16*)(wsw + WO_1), PTR(25) + (2 * li + 1) * 1024, 1024, 4096, 4096, MAP_ID, 0);
                WJOB(PTR(27) + (size_t)(2 * li + 1) * 4096 * 1024, (bf16*)(wsw + WO_2), (const float*)nullptr, 4096, 1024, 1024, MAP_ID, 0);
#undef WJOB
                if (layer == 0) { const float* x_in = PTR(0); const int* positions = (const int*)PTR(1);
                    for (int m0 = gw; m0 < MTOK; m0 += 2 * NGW) {
                        const int m1 = m0 + NGW; const bool two = m1 < MTOK;
                        const GAS f32x4* xa = (const GAS f32x4*)(x_in + (size_t)m0 * DM) + lane; const GAS f32x4* xb2 = (const GAS f32x4*)(x_in + (size_t)(two ? m1 : m0) * DM) + lane; f32x4 va[4], vb[4]; float sa = 0.f, sb = 0.f;
#pragma unroll
                        for (int j = 0; j < 4; ++j) { va[j] = xa[64 * j]; vb[j] = xb2[64 * j]; }
#pragma unroll
                        for (int j = 0; j < 4; ++j) { sa += (va[j].x * va[j].x + va[j].y * va[j].y) + (va[j].z * va[j].z + va[j].w * va[j].w); sb += (vb[j].x * vb[j].x + vb[j].y * vb[j].y) + (vb[j].z * vb[j].z + vb[j].w * vb[j].w); }
                        sa = wave_sum(sa); sb = wave_sum(sb);
                        GAS unsigned long long* oa = (GAS unsigned long long*)(XB + (size_t)m0 * DM) + lane;
#pragma unroll
                        for (int j = 0; j < 4; ++j) oa[64 * j] = (unsigned long long)pk2(va[j].x, va[j].y) | ((unsigned long long)pk2(va[j].z, va[j].w) << 32);
                        if (lane < 4) ssp[(size_t)lane * MTOK + m0] = (lane == 0) ? sa : 0.f;
                        if (two) { GAS unsigned long long* ob = (GAS unsigned long long*)(XB + (size_t)m1 * DM) + lane;
#pragma unroll
                            for (int j = 0; j < 4; ++j) ob[64 * j] = (unsigned long long)pk2(vb[j].x, vb[j].y) | ((unsigned long long)pk2(vb[j].z, vb[j].w) << 32);
                            if (lane < 4) ssp[(size_t)lane * MTOK + m1] = (lane == 0) ? sb : 0.f; }
                    }
                    for (int idx = bid * 512 + tid; idx < MTOK * 32; idx += GG * 512) { const int tok = idx >> 5, i = idx & 31;
                        const float inv = powf(10000.0f, -(float)i / 32.0f); const float ang = (float)positions[tok] * inv; const float sn = sinf(ang), cs = cosf(ang);
                        rope[(size_t)idx * 2] = cs; rope[(size_t)idx * 2 + 1] = sn; }
                }
            }
            }
            SEAM(gp0 + 0);
            for (int rep = 0; rep < REPS(1); ++rep) { if (rep) xcd_barrier(bar, otid(wave_s));
            if (EN(1) && IN(gp0 + 1)) { ENV();
                pg8::Gemm g{XB, (const bf16*)(wsw + WE_IN), MTOK, N_E_IN, DM, DM}; pg8::StaticOrder S; S.init(MTOK, N_E_IN, GG, bid);
                pg8::EpiEvenIn E{EP, ssp, misc32, PTR(5) + li * 128, PTR(6) + li * 128, PTR(7) + li * 128, PTR(8) + li * 128, PTR(4) + li * 4, stat};
                pg8::gemm_phase<pg8::EpiEvenIn, pg8::StaticOrder, true, true>(L_, g, S, E, tid);
            }
            }
            SEAM(gp0 + 1);
            for (int rep = 0; rep < REPS(2); ++rep) { if (rep) xcd_barrier(bar, otid(wave_s));
            if (EN(2) && IN(gp0 + 2)) { ENV();
                if (bid < 32) tk::cumsum_unit(misc32, cumb, bid >> 2, bid & 3, glds, tid);
#if defined(TKS_CHECK)
                for (int v = bid; v < 4096; v += GG) tk::topk_unit(EP, misc32, BM, v & 7, 511 - (v >> 3), glds, glds + LDS_STAT, glds + LDS_FAC, tid);
                __syncthreads();
#define TKR_DST ((unsigned long long*)out)
#else
#define TKR_DST BM
#endif
                for (int v = bid; v < 2048; v += GG) { const int st = v >> 8, x = (v >> 3) & 31;
                    tkr::regsel_unit(EP, misc32, TKR_DST, v & 7, 255 - (32 * st + ((st & 1) ? 31 - x : x)), glds, glds + LDS_STAT, glds + LDS_FAC, tid); }
#undef TKR_DST
            }
            }
#if defined(TKS_CHECK)
            if (IN(gp0 + 2)) { xcd_barrier(bar, otid(wave_s)); { ENV();
                unsigned bad = 0u; const unsigned long long* B2 = (const unsigned long long*)out;
                for (size_t i = (size_t)bid * 512 + tid; i < (size_t)MTOK * 64; i += (size_t)GG * 512) bad += (BM[i] != B2[i]) ? 1u : 0u;
                if (bad) __hip_atomic_fetch_add(ctl + 2048, bad, RLX_AGENT); } }
#endif
            SEAM(gp0 + 2);
            for (int rep = 0; rep < REPS(3); ++rep) { if (rep) xcd_barrier(bar, otid(wave_s));
            if (IN(gp0 + 3)) { ENV();
                gu32* qh = ctl + CW_QUEUE + 64 * (layer * 4 + 1 + 2 * rep);
                for (;;) {
                    if (tid == 0) MISCp[4] = __hip_atomic_fetch_add(qh, 1u, RLX_AGENT);
                    __syncthreads();
                    const int u = (int)MISCp[4];
                    if (u >= 1024) break;
                    const int i = u >> 1; att::UnitArgs a;
                    if ((u & 1) == 0) { if (EN(3) && !(rep == 1 && ((REP_MASK >> 18) & 1))) {
                        const int qb = 15 - (i >> 5), bh = i & 31, b = bh >> 2, h = bh & 3; const size_t r0 = (size_t)b * SEQ + qb * 256 + 32 * wave;
                        a.Q = EP + r0 * N_E_IN + 1536 + 128 * h; a.ldq = N_E_IN; a.K = EP + (size_t)b * SEQ * N_E_IN + 2048 + 128 * h; a.ldk = N_E_IN; a.V = EP + (size_t)b * SEQ * N_E_IN + 2560 + 128 * h; a.ldv = N_E_IN;
                        a.O = AOE + r0 * DM + 512 + 128 * h; a.ldo = DM; a.qlo = qb * 256 + 32 * wave; a.NT = 4 * (qb + 1); a.kbias = cumb + (size_t)h * MTOK + (size_t)b * SEQ; a.bm = nullptr; a.tid = tid; a.gq = PTR(7) + li * 128; a.gk = PTR(8) + li * 128;
                        att::attn_unit<128, 1>(a, glds); }
                    } else if (EN(4) && !(rep == 1 && ((REP_MASK >> 19) & 1))) {
                        const int j = 63 - (i >> 3), b = i & 7, head = wave >> 1, sub = wave & 1; const size_t r0 = (size_t)b * SEQ + j * 64 + 32 * sub;
                        a.Q = EP + r0 * N_E_IN + 128 * head; a.ldq = N_E_IN; a.K = EP + (size_t)b * SEQ * N_E_IN + 512; a.ldk = N_E_IN; a.V = EP + (size_t)b * SEQ * N_E_IN + 640; a.ldv = N_E_IN;
                        a.O = AOE + r0 * DM + 128 * head; a.ldo = DM; a.qlo = j * 64 + 32 * sub; a.NT = j + 1; a.kbias = nullptr; a.bm = BM + r0 * 64; a.tid = tid; a.gq = PTR(5) + li * 128; a.gk = PTR(6) + li * 128;
                        att::attn_unit<128, 2>(a, glds);
                    }
                }
            }
            }
            SEAM(gp0 + 3);
            if (EN(5) && IN(gp0 + 4)) { ENV();
                pg8::Gemm g{AOE, (const bf16*)(wsw + WE_OUT), MTOK, DM, DM, DM}; pg8::StaticOrder S; S.init(MTOK, DM, GG, bid);
                pg8::EpiResid E{XB, ssp, stat, (float*)nullptr};
                pg8::gemm_phase<pg8::EpiResid, pg8::StaticOrder, true, true>(L_, g, S, E, tid);
            }
            SEAM2(gp0 + 4, gp0 + 6);
        } else {
            for (int rep = 0; rep < REPS(6); ++rep) { if (rep) xcd_barrier(bar, otid(wave_s));
            if (EN(6) && IN(gp0 + 0)) { ENV();
                pg8::Gemm g{XB, (const bf16*)(wsw + WO_IN), MTOK, N_O_IN, DM, DM}; pg8::StaticOrder S; S.init(MTOK, N_O_IN, GG, bid);
                pg8::EpiOddIn E{C1, AO, XBC, ssp, gss, misc32, PTR(20) + li * 16, stat};
                pg8::gemm_phase<pg8::EpiOddIn, pg8::StaticOrder, true, true>(L_, g, S, E, tid);
            }
            }
            SEAM(gp0 + 0);
            for (int rep = 0; rep < REPS(7); ++rep) { if (rep) xcd_barrier(bar, otid(wave_s));
            if (EN(7) && IN(gp0 + 1)) { ENV();
                if (rep == 0) for (int u = bid; u < 256; u += GG) ssd::conv_halo_save(XBC, (bf16*)(ws + WS_BM), u, tid);
                if (EN(12)) { pg8::Gemm g{C1, (const bf16*)(wsw + WO_UQ), MTOK, 1024, 384, 768}; pg8::StaticOrder S; S.init(MTOK, 1024, GG, bid);
                  pg8::EpiUq E{QB, gss, PTR(16) + li * 192, rope, stat};
                  pg8::gemm_phase<pg8::EpiUq, pg8::StaticOrder, true, true>(L_, g, S, E, tid); }
                if (EN(13)) { pg8::Gemm g{C1 + 384, (const bf16*)(wsw + WO_UKV), MTOK, 1024, 256, 768}; pg8::StaticOrder S; S.init(MTOK, 1024, GG, bid);
                  pg8::EpiUkv E{KK, VV, C1, gss, PTR(17) + li * 192, rope, stat};
                  pg8::gemm_phase<pg8::EpiUkv, pg8::StaticOrder, true, true>(L_, g, S, E, tid); }
            }
            }
            SEAM(gp0 + 1);
            if (IN(gp0 + 2)) { ENV();
                for (int u = bid; u < 256; u += GG) ssd::conv_unit(XBC, (const bf16*)(ws + WS_BM), PTR(18) + (size_t)li * 4 * 2048, PTR(19) + li * 2048, u, tid);
            }
            SEAM(gp0 + 2);
            for (int rep = 0; rep < REPS(9); ++rep) { if (rep) xcd_barrier(bar, otid(wave_s));
            if (IN(gp0 + 3)) { ENV();
                gu32* qh = ctl + CW_QUEUE + 64 * (layer * 4 + 0 + 2 * rep);
                for (;;) {
                    if (tid == 0) MISCp[4] = __hip_atomic_fetch_add(qh, 1u, RLX_AGENT);
                    __syncthreads();
                    const int u = (int)MISCp[4];
                    if (u >= 128 + 512) break;
                    if (u < 128) { if (EN(8) && rep == 0) { const int b = u >> 4, h = u & 15;
                        ssd::ssd_unit(XBC, AO, AO + 512, K_O_OUT, misc32, ssy, PTR(21)[li * 16 + h], PTR(22)[li * 16 + h], b, h, glds, glds + LDS_STAT, tid); }
                    } else if (EN(9)) { const int i = u - 128; const int qb = 15 - (i >> 5), bh = i & 31, b = bh >> 2, h = bh & 3; const size_t r0 = (size_t)b * SEQ + qb * 256 + 32 * wave; att::UnitArgs a;
                        a.Q = QB + r0 * 768 + 192 * h; a.ldq = 768; a.K = KK + (size_t)b * SEQ * 768 + 192 * h; a.ldk = 768; a.V = VV + (size_t)b * SEQ * 512 + 128 * h; a.ldv = 512;
                        a.O = AO + r0 * K_O_OUT + 128 * h; a.ldo = K_O_OUT; a.qlo = qb * 256 + 32 * wave; a.NT = 4 * (qb + 1); a.kbias = nullptr; a.bm = nullptr; a.tid = tid; a.gq = PTR(16) + li * 192; a.gk = PTR(17) + li * 192;
                        att::attn_unit<192, 0>(a, glds);
                    }
                }
            }
            }
#if defined(PROBE_SSD)
            if (IN(gp0 + 3)) { xcd_barrier(bar, otid(wave_s)); { ENV();
                for (int u = bid; u < 128; u += GG) { const int b = u >> 4, h = u & 15;
                    ssd::ssd_unit(XBC, AO, (bf16*)out + (size_t)24 * 1024 * 1024, 1024, misc32, (float*)(ws + WS_BM), PTR(21)[li * 16 + h], PTR(22)[li * 16 + h], b, h, glds, glds + LDS_STAT, tid); } } }
#endif
            SEAM2(gp0 + 3, gp0 + 5);
            if (EN(5) && IN(gp0 + 5)) { ENV();
                pg8::Gemm g{AO, (const bf16*)(wsw + WO_OUT), MTOK, DM, K_O_OUT, K_O_OUT}; pg8::StaticOrder S; S.init(MTOK, DM, GG, bid);
                pg8::EpiResid E{XB, ssp, stat, (float*)nullptr};
                const pg8::GroupScaleHook HK{ssy, (PG8_LAS float*)(L_ + LDS_FAC)};
                pg8::gemm_phase<pg8::EpiResid, pg8::StaticOrder, true, true, pg8::GroupScaleHook>(L_, g, S, E, tid, HK);
            }
            SEAM(gp0 + 5);
        }
        for (int rep = 0; rep < REPS(5); ++rep) { if (rep) xcd_barrier(bar, otid(wave_s));
        if (EN(11) && IN(gp0 + 6)) { ENV();
            pg8::Gemm g{XB, W1t, MTOK, DFF, DM, DM}; pg8::StaticOrder S; S.init(MTOK, DFF, GG, bid);
            pg8::EpiMlpUp E{HB, ssp};
            pg8::gemm_phase<pg8::EpiMlpUp, pg8::StaticOrder, true, true>(L_, g, S, E, tid);
        }
        }
        SEAM(gp0 + 6);
        if (EN(5) && IN(gp0 + 7)) { ENV();
            pg8::Gemm g{HB, W2t, MTOK, DM, DFF, DFF}; pg8::StaticOrder S; S.init(MTOK, DM, GG, bid);
            pg8::EpiResid E{XB, ssp, stat, layer == 3 ? out : (float*)nullptr};
            pg8::gemm_phase<pg8::EpiResid, pg8::StaticOrder, true, true>(L_, g, S, E, tid);
        }
        if (layer < 3) SEAM(gp0 + 7);
    }
    {
        constexpr int layer = 3;
        const int li = layer >> 1; const int gp0 = layer * 8;
        if ((layer & 1) == 0) {
            for (int rep = 0; rep < REPS(0); ++rep) { if (rep) xcd_barrier(bar, otid(wave_s));
            if (EN(0) && IN(gp0 + 0)) { ENV();
                LAS float* scr = (LAS float*)(L_ + wave * 16384);
                const int gw = bid * NWAVES + wave, NGW = GG * NWAVES;
                int it = gw;
#define WJOB(Wp, dstp, gainp, K_, Nsrc_, Ndst_, map_, gk0_) do { const WJob J_{Wp, dstp, gainp, K_, Nsrc_, Ndst_, map_, gk0_}; const int nit_ = ((K_) / 64) * ((Ndst_) / 32); \
                    for (; it < nit_; it += NGW) wconv_item(J_, scr, it, lane); it -= nit_; } while (0)
                WJOB(PTR(3) + (size_t)li * 1024 * 2892, (bf16*)(wsw + WE_IN), PTR(2) + li * 1024, 1024, 2892, 3072, MAP_EVEN_IN, 0);
                WJOB(PTR(9) + (size_t)li * 1024 * 1024, (bf16*)(wsw + WE_OUT), (const float*)nullptr, 1024, 1024, 1024, MAP_ID, 0);
                WJOB(PTR(26) + (size_t)(2 * li) * 1024 * 4096, (bf16*)(wsw + WE_1), PTR(25) + (2 * li) * 1024, 1024, 4096, 4096, MAP_ID, 0);
                WJOB(PTR(27) + (size_t)(2 * li) * 4096 * 1024, (bf16*)(wsw + WE_2), (const float*)nullptr, 4096, 1024, 1024, MAP_ID, 0);
                WJOB(PTR(11) + (size_t)li * 1024 * 3792, (bf16*)(wsw + WO_IN), PTR(10) + li * 1024, 1024, 3792, 3840, MAP_ODD_IN, 0);
                WJOB(PTR(14) + (size_t)li * 384 * 768, (bf16*)(wsw + WO_UQ), PTR(12) + li * 384, 384, 768, 1024, MAP_UQ, 0);
                WJOB(PTR(15) + (size_t)li * 256 * 1024, (bf16*)(wsw + WO_UKV), PTR(13) + li * 256, 256, 1024, 1024, MAP_ID, 0);
                WJOB(PTR(24) + (size_t)li * 1536 * 1024, (bf16*)(wsw + WO_OUT), PTR(23) + li * 1024, 1536, 1024, 1024, MAP_ID, 512);
                WJOB(PTR(26) + (size_t)(2 * li + 1) * 1024 * 4096, (bf16*)(wsw + WO_1), PTR(25) + (2 * li + 1) * 1024, 1024, 4096, 4096, MAP_ID, 0);
                WJOB(PTR(27) + (size_t)(2 * li + 1) * 4096 * 1024, (bf16*)(wsw + WO_2), (const float*)nullptr, 4096, 1024, 1024, MAP_ID, 0);
#undef WJOB
                if (layer == 0) { const float* x_in = PTR(0); const int* positions = (const int*)PTR(1);
                    for (int m0 = gw; m0 < MTOK; m0 += 2 * NGW) {
                        const int m1 = m0 + NGW; const bool two = m1 < MTOK;
                        const GAS f32x4* xa = (const GAS f32x4*)(x_in + (size_t)m0 * DM) + lane; const GAS f32x4* xb2 = (const GAS f32x4*)(x_in + (size_t)(two ? m1 : m0) * DM) + lane; f32x4 va[4], vb[4]; float sa = 0.f, sb = 0.f;
#pragma unroll
                        for (int j = 0; j < 4; ++j) { va[j] = xa[64 * j]; vb[j] = xb2[64 * j]; }
#pragma unroll
                        for (int j = 0; j < 4; ++j) { sa += (va[j].x * va[j].x + va[j].y * va[j].y) + (va[j].z * va[j].z + va[j].w * va[j].w); sb += (vb[j].x * vb[j].x + vb[j].y * vb[j].y) + (vb[j].z * vb[j].z + vb[j].w * vb[j].w); }
                        sa = wave_sum(sa); sb = wave_sum(sb);
                        GAS unsigned long long* oa = (GAS unsigned long long*)(XB + (size_t)m0 * DM) + lane;
#pragma unroll
                        for (int j = 0; j < 4; ++j) oa[64 * j] = (unsigned long long)pk2(va[j].x, va[j].y) | ((unsigned long long)pk2(va[j].z, va[j].w) << 32);
                        if (lane < 4) ssp[(size_t)lane * MTOK + m0] = (lane == 0) ? sa : 0.f;
                        if (two) { GAS unsigned long long* ob = (GAS unsigned long long*)(XB + (size_t)m1 * DM) + lane;
#pragma unroll
                            for (int j = 0; j < 4; ++j) ob[64 * j] = (unsigned long long)pk2(vb[j].x, vb[j].y) | ((unsigned long long)pk2(vb[j].z, vb[j].w) << 32);
                            if (lane < 4) ssp[(size_t)lane * MTOK + m1] = (lane == 0) ? sb : 0.f; }
                    }
                    for (int idx = bid * 512 + tid; idx < MTOK * 32; idx += GG * 512) { const int tok = idx >> 5, i = idx & 31;
                        const float inv = powf(10000.0f, -(float)i / 32.0f); const float ang = (float)positions[tok] * inv; const float sn = sinf(ang), cs = cosf(ang);
                        rope[(size_t)idx * 2] = cs; rope[(size_t)idx * 2 + 1] = sn; }
                }
            }
            }
            SEAM(gp0 + 0);
            for (int rep = 0; rep < REPS(1); ++rep) { if (rep) xcd_barrier(bar, otid(wave_s));
            if (EN(1) && IN(gp0 + 1)) { ENV();
                pg8::Gemm g{XB, (const bf16*)(wsw + WE_IN), MTOK, N_E_IN, DM, DM}; pg8::StaticOrder S; S.init(MTOK, N_E_IN, GG, bid);
                pg8::EpiEvenIn E{EP, ssp, misc32, PTR(5) + li * 128, PTR(6) + li * 128, PTR(7) + li * 128, PTR(8) + li * 128, PTR(4) + li * 4, stat};
                pg8::gemm_phase<pg8::EpiEvenIn, pg8::StaticOrder, true, true>(L_, g, S, E, tid);
            }
            }
            SEAM(gp0 + 1);
            for (int rep = 0; rep < REPS(2); ++rep) { if (rep) xcd_barrier(bar, otid(wave_s));
            if (EN(2) && IN(gp0 + 2)) { ENV();
                if (bid < 32) tk::cumsum_unit(misc32, cumb, bid >> 2, bid & 3, glds, tid);
#if defined(TKS_CHECK)
                for (int v = bid; v < 4096; v += GG) tk::topk_unit(EP, misc32, BM, v & 7, 511 - (v >> 3), glds, glds + LDS_STAT, glds + LDS_FAC, tid);
                __syncthreads();
#define TKR_DST ((unsigned long long*)out)
#else
#define TKR_DST BM
#endif
                for (int v = bid; v < 2048; v += GG) { const int st = v >> 8, x = (v >> 3) & 31;
                    tkr::regsel_unit(EP, misc32, TKR_DST, v & 7, 255 - (32 * st + ((st & 1) ? 31 - x : x)), glds, glds + LDS_STAT, glds + LDS_FAC, tid); }
#undef TKR_DST
            }
            }
#if defined(TKS_CHECK)
            if (IN(gp0 + 2)) { xcd_barrier(bar, otid(wave_s)); { ENV();
                unsigned bad = 0u; const unsigned long long* B2 = (const unsigned long long*)out;
                for (size_t i = (size_t)bid * 512 + tid; i < (size_t)MTOK * 64; i += (size_t)GG * 512) bad += (BM[i] != B2[i]) ? 1u : 0u;
                if (bad) __hip_atomic_fetch_add(ctl + 2048, bad, RLX_AGENT); } }
#endif
            SEAM(gp0 + 2);
            for (int rep = 0; rep < REPS(3); ++rep) { if (rep) xcd_barrier(bar, otid(wave_s));
            if (IN(gp0 + 3)) { ENV();
                gu32* qh = ctl + CW_QUEUE + 64 * (layer * 4 + 1 + 2 * rep);
                for (;;) {
                    if (tid == 0) MISCp[4] = __hip_atomic_fetch_add(qh, 1u, RLX_AGENT);
                    __syncthreads();
                    const int u = (int)MISCp[4];
                    if (u >= 1024) break;
                    const int i = u >> 1; att::UnitArgs a;
                    if ((u & 1) == 0) { if (EN(3) && !(rep == 1 && ((REP_MASK >> 18) & 1))) {
                        const int qb = 15 - (i >> 5), bh = i & 31, b = bh >> 2, h = bh & 3; const size_t r0 = (size_t)b * SEQ + qb * 256 + 32 * wave;
                        a.Q = EP + r0 * N_E_IN + 1536 + 128 * h; a.ldq = N_E_IN; a.K = EP + (size_t)b * SEQ * N_E_IN + 2048 + 128 * h; a.ldk = N_E_IN; a.V = EP + (size_t)b * SEQ * N_E_IN + 2560 + 128 * h; a.ldv = N_E_IN;
                        a.O = AOE + r0 * DM + 512 + 128 * h; a.ldo = DM; a.qlo = qb * 256 + 32 * wave; a.NT = 4 * (qb + 1); a.kbias = cumb + (size_t)h * MTOK + (size_t)b * SEQ; a.bm = nullptr; a.tid = tid; a.gq = PTR(7) + li * 128; a.gk = PTR(8) + li * 128;
                        att::attn_unit<128, 1>(a, glds); }
                    } else if (EN(4) && !(rep == 1 && ((REP_MASK >> 19) & 1))) {
                        const int j = 63 - (i >> 3), b = i & 7, head = wave >> 1, sub = wave & 1; const size_t r0 = (size_t)b * SEQ + j * 64 + 32 * sub;
                        a.Q = EP + r0 * N_E_IN + 128 * head; a.ldq = N_E_IN; a.K = EP + (size_t)b * SEQ * N_E_IN + 512; a.ldk = N_E_IN; a.V = EP + (size_t)b * SEQ * N_E_IN + 640; a.ldv = N_E_IN;
                        a.O = AOE + r0 * DM + 128 * head; a.ldo = DM; a.qlo = j * 64 + 32 * sub; a.NT = j + 1; a.kbias = nullptr; a.bm = BM + r0 * 64; a.tid = tid; a.gq = PTR(5) + li * 128; a.gk = PTR(6) + li * 128;
                        att::attn_unit<128, 2>(a, glds);
                    }
                }
            }
            }
            SEAM(gp0 + 3);
            if (EN(5) && IN(gp0 + 4)) { ENV();
                pg8::Gemm g{AOE, (const bf16*)(wsw + WE_OUT), MTOK, DM, DM, DM}; pg8::StaticOrder S; S.init(MTOK, DM, GG, bid);
                pg8::EpiResid E{XB, ssp, stat, (float*)nullptr};
                pg8::gemm_phase<pg8::EpiResid, pg8::StaticOrder, true, true>(L_, g, S, E, tid);
            }
            SEAM2(gp0 + 4, gp0 + 6);
        } else {
            for (int rep = 0; rep < REPS(6); ++rep) { if (rep) xcd_barrier(bar, otid(wave_s));
            if (EN(6) && IN(gp0 + 0)) { ENV();
                pg8::Gemm g{XB, (const bf16*)(wsw + WO_IN), MTOK, N_O_IN, DM, DM}; pg8::StaticOrder S; S.init(MTOK, N_O_IN, GG, bid);
                pg8::EpiOddIn E{C1, AO, XBC, ssp, gss, misc32, PTR(20) + li * 16, stat};
                pg8::gemm_phase<pg8::EpiOddIn, pg8::StaticOrder, true, true>(L_, g, S, E, tid);
            }
            }
            SEAM(gp0 + 0);
            for (int rep = 0; rep < REPS(7); ++rep) { if (rep) xcd_barrier(bar, otid(wave_s));
            if (EN(7) && IN(gp0 + 1)) { ENV();
                if (rep == 0) for (int u = bid; u < 256; u += GG) ssd::conv_halo_save(XBC, (bf16*)(ws + WS_BM), u, tid);
                if (EN(12)) { pg8::Gemm g{C1, (const bf16*)(wsw + WO_UQ), MTOK, 1024, 384, 768}; pg8::StaticOrder S; S.init(MTOK, 1024, GG, bid);
                  pg8::EpiUq E{QB, gss, PTR(16) + li * 192, rope, stat};
                  pg8::gemm_phase<pg8::EpiUq, pg8::StaticOrder, true, true>(L_, g, S, E, tid); }
                if (EN(13)) { pg8::Gemm g{C1 + 384, (const bf16*)(wsw + WO_UKV), MTOK, 1024, 256, 768}; pg8::StaticOrder S; S.init(MTOK, 1024, GG, bid);
                  pg8::EpiUkv E{KK, VV, C1, gss, PTR(17) + li * 192, rope, stat};
                  pg8::gemm_phase<pg8::EpiUkv, pg8::StaticOrder, true, true>(L_, g, S, E, tid); }
            }
            }
            SEAM(gp0 + 1);
            if (IN(gp0 + 2)) { ENV();
                for (int u = bid; u < 256; u += GG) ssd::conv_unit(XBC, (const bf16*)(ws + WS_BM), PTR(18) + (size_t)li * 4 * 2048, PTR(19) + li * 2048, u, tid);
            }
            SEAM(gp0 + 2);
            for (int rep = 0; rep < REPS(9); ++rep) { if (rep) xcd_barrier(bar, otid(wave_s));
            if (IN(gp0 + 3)) { ENV();
                gu32* qh = ctl + CW_QUEUE + 64 * (layer * 4 + 0 + 2 * rep);
                for (;;) {
                    if (tid == 0) MISCp[4] = __hip_atomic_fetch_add(qh, 1u, RLX_AGENT);
                    __syncthreads();
                    const int u = (int)MISCp[4];
                    if (u >= 128 + 512) break;
                    if (u < 128) { if (EN(8) && rep == 0) { const int b = u >> 4, h = u & 15;
                        ssd::ssd_unit(XBC, AO, AO + 512, K_O_OUT, misc32, ssy, PTR(21)[li * 16 + h], PTR(22)[li * 16 + h], b, h, glds, glds + LDS_STAT, tid); }
                    } else if (EN(9)) { const int i = u - 128; const int qb = 15 - (i >> 5), bh = i & 31, b = bh >> 2, h = bh & 3; const size_t r0 = (size_t)b * SEQ + qb * 256 + 32 * wave; att::UnitArgs a;
                        a.Q = QB + r0 * 768 + 192 * h; a.ldq = 768; a.K = KK + (size_t)b * SEQ * 768 + 192 * h; a.ldk = 768; a.V = VV + (size_t)b * SEQ * 512 + 128 * h; a.ldv = 512;
                        a.O = AO + r0 * K_O_OUT + 128 * h; a.ldo = K_O_OUT; a.qlo = qb * 256 + 32 * wave; a.NT = 4 * (qb + 1); a.kbias = nullptr; a.bm = nullptr; a.tid = tid; a.gq = PTR(16) + li * 192; a.gk = PTR(17) + li * 192;
                        att::attn_unit<192, 0>(a, glds);
                    }
                }
            }
            }
#if defined(PROBE_SSD)
            if (IN(gp0 + 3)) { xcd_barrier(bar, otid(wave_s)); { ENV();
                for (int u = bid; u < 128; u += GG) { const int b = u >> 4, h = u & 15;
                    ssd::ssd_unit(XBC, AO, (bf16*)out + (size_t)24 * 1024 * 1024, 1024, misc32, (float*)(ws + WS_BM), PTR(21)[li * 16 + h], PTR(22)[li * 16 + h], b, h, glds, glds + LDS_STAT, tid); } } }
#endif
            SEAM2(gp0 + 3, gp0 + 5);
            if (EN(5) && IN(gp0 + 5)) { ENV();
                pg8::Gemm g{AO, (const bf16*)(wsw + WO_OUT), MTOK, DM, K_O_OUT, K_O_OUT}; pg8::StaticOrder S; S.init(MTOK, DM, GG, bid);
                pg8::EpiResid E{XB, ssp, stat, (float*)nullptr};
                const pg8::GroupScaleHook HK{ssy, (PG8_LAS float*)(L_ + LDS_FAC)};
                pg8::gemm_phase<pg8::EpiResid, pg8::StaticOrder, true, true, pg8::GroupScaleHook>(L_, g, S, E, tid, HK);
            }
            SEAM(gp0 + 5);
        }
        for (int rep = 0; rep < REPS(5); ++rep) { if (rep) xcd_barrier(bar, otid(wave_s));
        if (EN(11) && IN(gp0 + 6)) { ENV();
            pg8::Gemm g{XB, W1t, MTOK, DFF, DM, DM}; pg8::StaticOrder S; S.init(MTOK, DFF, GG, bid);
            pg8::EpiMlpUp E{HB, ssp};
            pg8::gemm_phase<pg8::EpiMlpUp, pg8::StaticOrder, true, true>(L_, g, S, E, tid);
        }
        }
        SEAM(gp0 + 6);
        if (EN(5) && IN(gp0 + 7)) { ENV();
            pg8::Gemm g{HB, W2t, MTOK, DM, DFF, DFF}; pg8::StaticOrder S; S.init(MTOK, DM, GG, bid);
            pg8::EpiResid E{XB, ssp, stat, layer == 3 ? out : (float*)nullptr};
            pg8::gemm_phase<pg8::EpiResid, pg8::StaticOrder, true, true>(L_, g, S, E, tid);
        }
        if (layer < 3) SEAM(gp0 + 7);
    }
#if defined(TKS_CHECK)
    { ENV_NOLAYER();
      xcd_barrier(bar, otid(wave_s));
      if (bid == 0 && tid == 0) { const unsigned nb = __hip_atomic_load((gu32*)(ws + WS_CTL) + 2048, RLX_AGENT); if (nb) ((float*)PTR(28))[0] = 100.0f * (1.0f + log2f(1.0f + (float)nb)); } }
#endif
#if defined(TPROF)
    { ENV_NOLAYER();
      xcd_barrier(bar, otid(wave_s)); TSTAMP(31);
      __syncthreads();
      if (bid == 0) { volatile LAS unsigned* ts = (volatile LAS unsigned*)(L_ + LDS_MISC + 384);
          const float v1 = (float)(ts[TPROF_A1] - ts[TPROF_A0]) * 0.25f;
          const float v2 = (TPROF_B1 > 0) ? (float)(ts[TPROF_B1] - ts[TPROF_B0]) * (1.0f / 64.0f) : 1000.0f;
          if (tid == 0) out[0] = v1;
          for (int i = 1 + tid; i <= 1048576; i += 512) out[i] = v2; } }
#endif
#if defined(DBG_STOP)
    { ENV_NOLAYER();
      xcd_barrier(bar, otid(wave_s));
      const size_t n = (size_t)MTOK * DM;
      for (size_t i = (size_t)bid * 512 + tid; i < n; i += (size_t)GG * 512) {
          float v;
#if DBG_KIND == 0
          v = __uint_as_float(((unsigned)((const bf16*)(ws + (size_t)DBG_OFF))[i]) << 16);
#elif DBG_KIND == 1
          v = ((const float*)(ws + (size_t)DBG_OFF))[i];
#elif DBG_KIND == 2
          v = out[i];
#else
          v = (float)(((const unsigned*)(ws + (size_t)DBG_OFF))[i] & 0xffffu);
#endif
          if (!(fabsf(v) < 1e30f)) v = 30000.0f;
          out[i] = v; } }
#endif
#undef IN
#undef SEAM
#undef PTR
#undef ENV
}

#ifndef MK_SPLIT
#define MK_SPLIT 0
#endif
extern "C" void kernel_launch(void* const* d_in, const int* in_sizes, int n_in, void* d_out, int out_size, void* d_ws, size_t ws_size, hipStream_t stream) {
    static int grid = 0;
    if (grid == 0) {
        if (n_in != 28 || out_size != MTOK * DM || ws_size < WS_END) { fprintf(stderr, "kernel_launch: unexpected problem shape (n_in %d, out %d, ws %zu)\n", n_in, out_size, ws_size); grid = -1; return; }
        int dev = 0, cus = 0, per_cu = 0;
        if (hipGetDevice(&dev) != hipSuccess || hipDeviceGetAttribute(&cus, hipDeviceAttributeMultiprocessorCount, dev) != hipSuccess) { grid = -1; return; }
        if (hipFuncSetAttribute((const void*)trunk_fwd, hipFuncAttributeMaxDynamicSharedMemorySize, LDS_BYTES) != hipSuccess) { fprintf(stderr, "kernel_launch: hipFuncSetAttribute failed\n"); grid = -1; return; }
        if (hipOccupancyMaxActiveBlocksPerMultiprocessor(&per_cu, (const void*)trunk_fwd, NWAVES * 64, LDS_BYTES) != hipSuccess || per_cu < 1) { fprintf(stderr, "kernel_launch: occupancy query says %d\n", per_cu); }
        (void)hipGetLastError();
        grid = cus;
    }
    if (grid < 0) return;
    (void)hipMemsetAsync((char*)d_ws + WS_CTL, 0, CTL_ZERO_BYTES, stream);
    Args a{};
    for (int i = 0; i < 28; ++i) a.in[i] = (const float*)d_in[i];
    a.out = (float*)d_out; a.ws = (unsigned char*)d_ws;
#if MK_SPLIT
    for (int p = 0; p < 32; ++p) { a.ph_lo = p; a.ph_hi = p + 1; hipLaunchKernelGGL(trunk_fwd, dim3(grid), dim3(NWAVES * 64), LDS_BYTES, stream, a); }
#else
#if defined(DBG_STOP)
    a.ph_lo = 0; a.ph_hi = DBG_STOP;
#else
    a.ph_lo = 0; a.ph_hi = 32;
#endif
    hipLaunchKernelGGL(trunk_fwd, dim3(grid), dim3(NWAVES * 64), LDS_BYTES, stream, a);
#endif
}
```

```cpp
#include <hip/hip_runtime.h>
#include <hip/hip_bf16.h>
#include <cstdio>
#include <cstdint>
#include <cmath>

constexpr int BATCH = 8, SEQ = 4096, DM = 1024, MTOK = BATCH * SEQ, DFF = 4096;
constexpr int N_E_IN = 3072, N_O_IN = 3840;
constexpr int K_O_OUT = 1536;
constexpr float EPS = 1e-6f;
constexpr float LOG2E = 1.4426950408889634f;
constexpr float QSCALE128 = 0.08838834764831845f * LOG2E;
constexpr float QSCALE192 = 0.07216878364870323f * LOG2E;

constexpr size_t MiB = 1u << 20;
constexpr size_t WS_CTL = 0, CTL_ZERO_BYTES = 1 * MiB;
constexpr size_t WS_SSP = 1 * MiB;
constexpr size_t WS_CUMB = WS_SSP + 512 * 1024;
constexpr size_t WS_MISC32 = 2 * MiB;
constexpr size_t WS_GSS = 4 * MiB;
constexpr size_t WS_SSY = 5 * MiB;
constexpr size_t WS_ROPE = 9 * MiB;
constexpr size_t WS_BM = 17 * MiB;
constexpr size_t WS_W = 33 * MiB;
constexpr size_t WS_XB = 85 * MiB;
constexpr size_t WS_R = 149 * MiB;
constexpr size_t WS_END = 501 * MiB;
constexpr size_t WE_IN = 0, WE_OUT = 6 * MiB, WE_1 = 8 * MiB, WE_2 = 16 * MiB;
constexpr size_t WO_IN = 24 * MiB, WO_UQ = 24 * MiB + 7680 * 1024, WO_UKV = WO_UQ + 768 * 1024, WO_OUT = WO_UKV + 512 * 1024, WO_1 = 36 * MiB, WO_2 = 44 * MiB;
static_assert(WO_OUT + 3 * MiB <= WO_1, "weights map");
constexpr size_t R_EP = 0, R_AOE = 192 * MiB;
constexpr size_t R_C1 = 0, R_AO = 48 * MiB, R_XBC = 144 * MiB, R_KK = 272 * MiB, R_VV = 320 * MiB;
constexpr size_t R_H = 0;
constexpr int CW_TMO = 0;
constexpr int CW_BAR = 4096;
constexpr int CW_QUEUE = 16384;

constexpr int RING_BYTES = 131072;
constexpr int LDS_STAT = 139264;
constexpr int LDS_CAND = 147456;
constexpr int LDS_FAC = 149504;
constexpr int LDS_MISC = 155136;
constexpr int LDS_BYTES = 155648;


__device__ __forceinline__ int olane() { int l; asm volatile("v_mbcnt_lo_u32_b32 %0, -1, 0\n\tv_mbcnt_hi_u32_b32 %0, -1, %0" : "=v"(l)); return l; }
__device__ __forceinline__ int otid(int wave_s) { return (wave_s << 6) | olane(); }
template <int M> __device__ __forceinline__ float xor_f(float v) {
    if constexpr (M == 32) { auto rr = __builtin_amdgcn_permlane32_swap(__float_as_uint(v), __float_as_uint(v), false, false); return __uint_as_float(rr[0] == __float_as_uint(v) ? rr[1] : rr[0]); }
    else return __int_as_float(__builtin_amdgcn_ds_swizzle(__float_as_int(v), (M << 10) | 0x1f));
}
__device__ __forceinline__ float up_f(float v, int o) { const int l = olane(); const int s = (l - o) < 0 ? l : (l - o); return __int_as_float(__builtin_amdgcn_ds_bpermute(s << 2, __float_as_int(v))); }
__device__ __forceinline__ int down_i(int v, int o) { const int l = olane(); const int s = (l + o) > 63 ? l : (l + o); return __builtin_amdgcn_ds_bpermute(s << 2, v); }
__device__ __forceinline__ float wsum_f(float v) { v += xor_f<1>(v); v += xor_f<2>(v); v += xor_f<4>(v); v += xor_f<8>(v); v += xor_f<16>(v); v += xor_f<32>(v); return v; }
__device__ __forceinline__ float wmin_f(float v) { v = fminf(v, xor_f<1>(v)); v = fminf(v, xor_f<2>(v)); v = fminf(v, xor_f<4>(v)); v = fminf(v, xor_f<8>(v)); v = fminf(v, xor_f<16>(v)); v = fminf(v, xor_f<32>(v)); return v; }
__device__ __forceinline__ float wmax_f(float v) { v = fmaxf(v, xor_f<1>(v)); v = fmaxf(v, xor_f<2>(v)); v = fmaxf(v, xor_f<4>(v)); v = fmaxf(v, xor_f<8>(v)); v = fmaxf(v, xor_f<16>(v)); v = fmaxf(v, xor_f<32>(v)); return v; }
namespace pg8 {
#define PG8_LAS __attribute__((address_space(3)))
typedef unsigned short bf16_t;
typedef short bf16x8 __attribute__((ext_vector_type(8)));
typedef float f32x4 __attribute__((ext_vector_type(4)));
typedef unsigned u32x4 __attribute__((ext_vector_type(4)));
constexpr int BM = 256, BK = 64, HALF = 128, HTB = HALF * BK * 2  , STAGE_BYTES = 8 * HTB, NXCD = 8, WGM = 8;

__host__ __device__ __forceinline__ int lds_byte(int r, int c) { const int st = (r >> 4) * 2 + (c >> 5), rr = r & 15, cc = c & 31, ob = rr * 64 + cc * 2; return st * 1024 + (ob ^ (((ob >> 9) & 1) << 5)); }
__host__ __device__ __forceinline__ void stage_rc(int b, int& R, int& C) { const int st = b / 1024, sb = b % 1024, swz = sb ^ (((sb >> 9) & 1) << 5); R = (st >> 1) * 16 + swz / 64; C = (st & 1) * 32 + (swz % 64) / 2; }
__host__ __device__ __forceinline__ int perm32(int rho) { const int n = rho >> 4, i = rho & 15; return 8 * (i >> 2) + 4 * n + (i & 3); }

struct Unit { int pm, pn; };
struct Gemm { const bf16_t* A; const bf16_t* Bt; int M, N, K, lda; };

struct StaticOrder {
    int nM, nN, nwg, G, c;
    __host__ __device__ void init(int M, int N, int G_, int c_) { nM = M / BM; nN = N / BM; nwg = nM * nN; G = G_; c = c_; }
    __host__ __device__ bool next(int i, Unit& u) const {
        const long L = (long)i * G + c; if (L >= nwg) return false;
        int wgid = (int)L; { const int q = nwg / NXCD, r = nwg % NXCD, xcd = wgid % NXCD, off = wgid / NXCD; wgid = (xcd < r ? xcd * (q + 1) : r * (q + 1) + (xcd - r) * q) + off; }
        const int nig = WGM * nN, gid = wgid / nig, fm = gid * WGM, gsz = (nM - fm) < WGM ? (nM - fm) : WGM;
        u.pm = fm + ((wgid % nig) % gsz); u.pn = (wgid % nig) / gsz; return true;
    }
    __device__ __forceinline__ void a_ready(const Unit&) const {}
    __device__ __forceinline__ void done(const Unit&) const {}
};


__device__ __forceinline__ unsigned cvt_pk_bf16(float lo, float hi) { unsigned r; asm volatile("v_cvt_pk_bf16_f32 %0, %1, %2" : "=v"(r) : "v"(lo), "v"(hi)); return r; }
typedef unsigned u32x2 __attribute__((ext_vector_type(2)));
#define EPI_BAR() do { asm volatile("s_waitcnt lgkmcnt(0)" ::: "memory"); __builtin_amdgcn_s_barrier(); asm volatile("" ::: "memory"); } while (0)
__device__ __forceinline__ float sq4(const f32x4 x) { return (x[0] * x[0] + x[1] * x[1]) + (x[2] * x[2] + x[3] * x[3]); }
__device__ __forceinline__ float red_fq(float q) { q += xor_f<16>(q); q += xor_f<32>(q); return q; }
__device__ __forceinline__ u32x4 pack8(const f32x4 a, const f32x4 b) { u32x4 w; w.x = cvt_pk_bf16(a[0], a[1]); w.y = cvt_pk_bf16(a[2], a[3]); w.z = cvt_pk_bf16(b[0], b[1]); w.w = cvt_pk_bf16(b[2], b[3]); return w; }
__device__ __forceinline__ float row_rs(const float* ssp, int row) { const float ss = (ssp[row] + ssp[MTOK + row]) + (ssp[2 * MTOK + row] + ssp[3 * MTOK + row]); return rsqrtf(ss * (1.0f / 1024.0f) + EPS); }
__device__ __forceinline__ float log_sigmoidf(float x) { return fminf(x, 0.f) - __logf(1.0f + __expf(-fabsf(x))); }
__device__ __forceinline__ float softplusf(float x) { return fmaxf(x, 0.f) + __logf(1.0f + __expf(-fabsf(x))); }

struct EpiEvenIn {
    static constexpr bool PERM = true, AFTER_DRAIN = false;
    bf16_t* EP; const float* ssp; float* misc32; const float* qn_a; const float* kn_a; const float* qn_b; const float* kn_b; const float* b_f; PG8_LAS float* st;
    __device__ __forceinline__ void operator()(f32x4 (&acc)[2][2][4][2], const Unit& u, int wr, int wc, int fr, int fq) const {
        const int tid_ = ((wr * 4 + wc) << 6) | (fq << 4) | fr;
        const int pn = u.pn;
        const float* g0 = nullptr; const float* g1 = nullptr; float s0 = 1.f, s1 = 1.f;
        if (pn <= 1) { g0 = qn_a; g1 = qn_a; s0 = QSCALE128; s1 = QSCALE128; }
        else if (pn == 2) { g0 = kn_a; }
        else if (pn == 6 || pn == 7) { g0 = qn_b; g1 = qn_b; s0 = QSCALE128; s1 = QSCALE128; }
        else if (pn == 8 || pn == 9) { g0 = kn_b; g1 = kn_b; }
        int rl0 = wr * 64 + fr; asm volatile("" : "+v"(rl0)); const int row0 = u.pm * BM + rl0;
        { const int tid = tid_; if (tid < 256) { st[2048 + tid] = row_rs(ssp, u.pm * BM + tid);
            const float* g = (tid >> 7) ? g1 : g0; st[2304 + tid] = g ? g[tid & 127] * ((tid >> 7) ? s1 : s0) : 1.f; } }
        EPI_BAR();
#pragma unroll
        for (int ai = 0; ai < 2; ++ai)
#pragma unroll
            for (int m = 0; m < 4; ++m) { const int rl = ai * HALF + rl0 + m * 16; const float rs = st[2048 + rl];
#pragma unroll
                for (int bj = 0; bj < 2; ++bj) { acc[ai][bj][m][0] *= rs; acc[ai][bj][m][1] *= rs;
                    if (g0 != nullptr) { const float q = red_fq(sq4(acc[ai][bj][m][0]) + sq4(acc[ai][bj][m][1])); if (fq == 0) st[(rl * 2 + bj) * 4 + wc] = q; } } }
        if (g0 != nullptr) EPI_BAR();
#pragma unroll
        for (int ai = 0; ai < 2; ++ai)
#pragma unroll
            for (int m = 0; m < 4; ++m) { const int rl = ai * HALF + rl0 + m * 16; bf16_t* rowp = EP + (size_t)(u.pm * BM + rl) * N_E_IN + pn * BM + wc * 32 + fq * 8;
#pragma unroll
                for (int bj = 0; bj < 2; ++bj) { float f = 1.f;
                    if ((bj ? g1 : g0) != nullptr) { const f32x4 p = *(const PG8_LAS f32x4*)(st + (rl * 2 + bj) * 4); f = rsqrtf(((p[0] + p[1]) + (p[2] + p[3])) * (1.0f / 128.0f) + EPS); }
                    const PG8_LAS float* gp = st + 2304 + bj * HALF + wc * 32 + fq * 8;
                    const f32x4 v0 = acc[ai][bj][m][0] * *(const PG8_LAS f32x4*)gp * f, v1 = acc[ai][bj][m][1] * *(const PG8_LAS f32x4*)(gp + 4) * f;
                    *(u32x4*)(rowp + bj * HALF) = pack8(v0, v1); }
                asm volatile("" ::: "memory"); }
        if (pn == 5 && wc == 2 && fq < 2) {
#pragma unroll
            for (int ai = 0; ai < 2; ++ai)
#pragma unroll
                for (int m = 0; m < 4; ++m) { float* mp = misc32 + (size_t)(row0 + ai * HALF + m * 16) * 16;
                    if (fq == 0) { *(f32x4*)(mp) = acc[ai][0][m][0]; *(f32x4*)(mp + 4) = acc[ai][0][m][1]; }
                    else { const f32x4 v = acc[ai][0][m][0], bf = *(const f32x4*)b_f; f32x4 lf;
#pragma unroll
                        for (int j = 0; j < 4; ++j) lf[j] = log_sigmoidf(v[j] + bf[j]);
                        *(f32x4*)(mp + 8) = lf; } }
        }
    }
};

struct EpiResid {
    static constexpr bool PERM = true, AFTER_DRAIN = false;
    bf16_t* xb; float* ssp; PG8_LAS float* st; float* fout;
    __device__ __forceinline__ void operator()(f32x4 (&acc)[2][2][4][2], const Unit& u, int wr, int wc, int fr, int fq) const {
        const int tid_ = ((wr * 4 + wc) << 6) | (fq << 4) | fr;
        int rl0 = wr * 64 + fr; asm volatile("" : "+v"(rl0));
#pragma unroll
        for (int ai = 0; ai < 2; ++ai) {
            u32x4 raw[4][2];
#pragma unroll
            for (int m = 0; m < 4; ++m) { const size_t off = (size_t)(u.pm * BM + ai * HALF + rl0 + m * 16) * DM + u.pn * BM + wc * 32 + fq * 8;
                raw[m][0] = *(const u32x4*)(xb + off); raw[m][1] = *(const u32x4*)(xb + off + HALF); }
#pragma unroll
            for (int m = 0; m < 4; ++m) { const int rl = ai * HALF + rl0 + m * 16; const size_t off = (size_t)(u.pm * BM + rl) * DM + u.pn * BM + wc * 32 + fq * 8; float q = 0.f;
#pragma unroll
                for (int bj = 0; bj < 2; ++bj) { const u32x4 rw = raw[m][bj]; f32x4 v0, v1;
                    v0[0] = __uint_as_float(rw[0] << 16); v0[1] = __uint_as_float(rw[0] & 0xffff0000u); v0[2] = __uint_as_float(rw[1] << 16); v0[3] = __uint_as_float(rw[1] & 0xffff0000u);
                    v1[0] = __uint_as_float(rw[2] << 16); v1[1] = __uint_as_float(rw[2] & 0xffff0000u); v1[2] = __uint_as_float(rw[3] << 16); v1[3] = __uint_as_float(rw[3] & 0xffff0000u);
                    v0 += acc[ai][bj][m][0]; v1 += acc[ai][bj][m][1];
                    if (fout) { *(f32x4*)(fout + off + bj * HALF) = v0; *(f32x4*)(fout + off + bj * HALF + 4) = v1; }
                    else { *(u32x4*)(xb + off + bj * HALF) = pack8(v0, v1); q += sq4(v0) + sq4(v1); } }
                if (!fout) { q = red_fq(q); if (fq == 0) st[rl * 4 + wc] = q; } }
            asm volatile("" ::: "memory"); }
        if (fout) return;
        EPI_BAR();
        if (tid_ < 256) { const f32x4 p = *(const PG8_LAS f32x4*)(st + tid_ * 4); ssp[(size_t)u.pn * MTOK + u.pm * BM + tid_] = (p[0] + p[1]) + (p[2] + p[3]); }
    }
};

struct EpiMlpUp {
    static constexpr bool PERM = true, AFTER_DRAIN = false;
    bf16_t* H; const float* ssp;
    __device__ __forceinline__ void operator()(f32x4 (&acc)[2][2][4][2], const Unit& u, int wr, int wc, int fr, int fq) const {
        int row0 = u.pm * BM + wr * 64 + fr; asm volatile("" : "+v"(row0));
        float s4[2][4][4];
#pragma unroll
        for (int ai = 0; ai < 2; ++ai)
#pragma unroll
            for (int m = 0; m < 4; ++m) { const int row = row0 + ai * HALF + m * 16;
#pragma unroll
                for (int p = 0; p < 4; ++p) s4[ai][m][p] = ssp[(size_t)p * MTOK + row]; }
#pragma unroll
        for (int ai = 0; ai < 2; ++ai)
#pragma unroll
            for (int m = 0; m < 4; ++m) { const int row = row0 + ai * HALF + m * 16; const float rs = rsqrtf(((s4[ai][m][0] + s4[ai][m][1]) + (s4[ai][m][2] + s4[ai][m][3])) * (1.0f / 1024.0f) + EPS);
                bf16_t* rowp = H + (size_t)row * DFF + u.pn * BM + wc * 32 + fq * 8;
#pragma unroll
                for (int bj = 0; bj < 2; ++bj) { f32x4 v0 = acc[ai][bj][m][0] * rs, v1 = acc[ai][bj][m][1] * rs;
#pragma unroll
                    for (int j = 0; j < 4; ++j) { const float a = fmaxf(v0[j], 0.f), b = fmaxf(v1[j], 0.f); v0[j] = a * a; v1[j] = b * b; }
                    *(u32x4*)(rowp + bj * HALF) = pack8(v0, v1); } }
    }
};

struct EpiOddIn {
    static constexpr bool PERM = true, AFTER_DRAIN = false;
    bf16_t* C1; bf16_t* AO; bf16_t* XBC; const float* ssp; float* gss; float* dt32; const float* dt_bias; PG8_LAS float* st;
    __device__ __forceinline__ void operator()(f32x4 (&acc)[2][2][4][2], const Unit& u, int wr, int wc, int fr, int fq) const {
        const int tid_ = ((wr * 4 + wc) << 6) | (fq << 4) | fr;
        const int pn = u.pn; int rl0 = wr * 64 + fr; asm volatile("" : "+v"(rl0)); const int row0 = u.pm * BM + rl0;
        bf16_t* dst; int ld;
        if (pn < 3) { dst = C1 + pn * BM; ld = 768; } else if (pn < 7) { dst = AO + 512 + (pn - 3) * BM; ld = K_O_OUT; } else { dst = XBC + (pn - 7) * BM; ld = 2048; }
        { const int tid = tid_; if (tid < 256) st[2048 + tid] = row_rs(ssp, u.pm * BM + tid); }
        EPI_BAR();
#pragma unroll
        for (int ai = 0; ai < 2; ++ai)
#pragma unroll
            for (int m = 0; m < 4; ++m) { const int rl = ai * HALF + rl0 + m * 16; const float rs = st[2048 + rl]; bf16_t* rowp = dst + (size_t)(u.pm * BM + rl) * ld + wc * 32 + fq * 8;
#pragma unroll
                for (int bj = 0; bj < 2; ++bj) { acc[ai][bj][m][0] *= rs; acc[ai][bj][m][1] *= rs; *(u32x4*)(rowp + bj * HALF) = pack8(acc[ai][bj][m][0], acc[ai][bj][m][1]); }
                asm volatile("" ::: "memory"); }
        if (pn < 3) {
#pragma unroll
            for (int ai = 0; ai < 2; ++ai)
#pragma unroll
                for (int m = 0; m < 4; ++m)
#pragma unroll
                    for (int bj = 0; bj < 2; ++bj) { float q = sq4(acc[ai][bj][m][0]) + sq4(acc[ai][bj][m][1]);
                        if (pn == 2 && bj == 1 && wc >= 2) q = 0.f;
                        q = red_fq(q); if (fq == 0) st[((ai * HALF + rl0 + m * 16) * 2 + bj) * 4 + wc] = q; }
            EPI_BAR();
            const int tid = tid_;
            if (tid < 256) {
#pragma unroll
                for (int bj = 0; bj < 2; ++bj) { const f32x4 p = *(const PG8_LAS f32x4*)(st + (tid * 2 + bj) * 4); gss[(size_t)(u.pm * BM + tid) * 8 + 2 * pn + bj] = (p[0] + p[1]) + (p[2] + p[3]); } }
            if (pn == 2 && wc == 2 && fq < 2) {
                const f32x4 b0 = *(const f32x4*)(dt_bias + fq * 8), b1 = *(const f32x4*)(dt_bias + fq * 8 + 4);
#pragma unroll
                for (int ai = 0; ai < 2; ++ai)
#pragma unroll
                    for (int m = 0; m < 4; ++m) { float* mp = dt32 + (size_t)(row0 + ai * HALF + m * 16) * 16 + fq * 8; f32x4 d0, d1;
#pragma unroll
                        for (int j = 0; j < 4; ++j) { d0[j] = softplusf(acc[ai][1][m][0][j] + b0[j]); d1[j] = softplusf(acc[ai][1][m][1][j] + b1[j]); }
                        *(f32x4*)mp = d0; *(f32x4*)(mp + 4) = d1; }
            }
        }
    }
};

struct EpiUq {
    static constexpr bool PERM = true, AFTER_DRAIN = false;
    bf16_t* Q; const float* gss; const float* qn_c; const float* rope; PG8_LAS float* st;
    __device__ __forceinline__ void operator()(f32x4 (&acc)[2][2][4][2], const Unit& u, int wr, int wc, int fr, int fq) const {
        const int tid_ = ((wr * 4 + wc) << 6) | (fq << 4) | fr;
        const int h = u.pn; int rl0 = wr * 64 + fr; asm volatile("" : "+v"(rl0));
        { const int tid = tid_; if (tid < 256) { const float* gp = gss + (size_t)(u.pm * BM + tid) * 8; st[2048 + tid] = rsqrtf(((gp[0] + gp[1]) + gp[2]) * (1.0f / 384.0f) + EPS);
            float gg = 0.f; if (tid < 128) gg = qn_c[tid]; else if (tid < 192) { const int jj = tid - 128; gg = qn_c[128 + ((jj & 1) ? 32 : 0) + (jj >> 1)]; }
            st[2304 + tid] = gg * QSCALE192; } }
        EPI_BAR();
#pragma unroll
        for (int ai = 0; ai < 2; ++ai)
#pragma unroll
            for (int m = 0; m < 4; ++m) { const int rl = ai * HALF + rl0 + m * 16; const float rc = st[2048 + rl]; float q = 0.f;
#pragma unroll
                for (int bj = 0; bj < 2; ++bj) { acc[ai][bj][m][0] *= rc; acc[ai][bj][m][1] *= rc; q += sq4(acc[ai][bj][m][0]) + sq4(acc[ai][bj][m][1]); }
                q = red_fq(q); if (fq == 0) st[rl * 4 + wc] = q; }
        EPI_BAR();
        const int i0 = (wc & 1) * 16 + fq * 4;
        f32x4 cs[2][4][2];
        if (wc < 2) {
#pragma unroll
            for (int ai = 0; ai < 2; ++ai)
#pragma unroll
                for (int m = 0; m < 4; ++m) { const float* rp = rope + ((size_t)(u.pm * BM + ai * HALF + rl0 + m * 16) * 32 + i0) * 2; cs[ai][m][0] = *(const f32x4*)rp; cs[ai][m][1] = *(const f32x4*)(rp + 4); }
        }
#pragma unroll
        for (int ai = 0; ai < 2; ++ai)
#pragma unroll
            for (int m = 0; m < 4; ++m) { const int rl = ai * HALF + rl0 + m * 16; const int row = u.pm * BM + rl;
                const f32x4 p = *(const PG8_LAS f32x4*)(st + rl * 4); const float f = rsqrtf(((p[0] + p[1]) + (p[2] + p[3])) * (1.0f / 192.0f) + EPS);
                bf16_t* rowp = Q + (size_t)row * 768 + h * 192; const PG8_LAS float* gp = st + 2304 + wc * 32 + fq * 8;
                *(u32x4*)(rowp + wc * 32 + fq * 8) = pack8(acc[ai][0][m][0] * *(const PG8_LAS f32x4*)gp * f, acc[ai][0][m][1] * *(const PG8_LAS f32x4*)(gp + 4) * f);
                if (wc < 2) { const f32x4 cs0 = cs[ai][m][0], cs1 = cs[ai][m][1];
                    const f32x4 a = acc[ai][1][m][0] * *(const PG8_LAS f32x4*)(gp + HALF) * f, b = acc[ai][1][m][1] * *(const PG8_LAS f32x4*)(gp + HALF + 4) * f;
                    f32x4 o0, o1;
                    o0[0] = a[0] * cs0[0] - a[1] * cs0[1]; o0[1] = a[1] * cs0[0] + a[0] * cs0[1]; o0[2] = a[2] * cs0[2] - a[3] * cs0[3]; o0[3] = a[3] * cs0[2] + a[2] * cs0[3];
                    o1[0] = b[0] * cs1[0] - b[1] * cs1[1]; o1[1] = b[1] * cs1[0] + b[0] * cs1[1]; o1[2] = b[2] * cs1[2] - b[3] * cs1[3]; o1[3] = b[3] * cs1[2] + b[2] * cs1[3];
                    *(u32x4*)(rowp + 128 + wc * 32 + fq * 8) = pack8(o0, o1); } }
    }
};

struct EpiUkv {
    static constexpr bool PERM = true, AFTER_DRAIN = false;
    bf16_t* KK; bf16_t* VV; const bf16_t* C1; const float* gss; const float* kn_c; const float* rope; PG8_LAS float* st;
    __device__ __forceinline__ void operator()(f32x4 (&acc)[2][2][4][2], const Unit& u, int wr, int wc, int fr, int fq) const {
        const int tid_ = ((wr * 4 + wc) << 6) | (fq << 4) | fr;
        const int h = u.pn; int rl0 = wr * 64 + fr; asm volatile("" : "+v"(rl0)); const int tid = tid_;
        if (tid < 256) { const float* gp = gss + (size_t)(u.pm * BM + tid) * 8; st[2048 + tid] = rsqrtf((gp[3] + gp[4]) * (1.0f / 256.0f) + EPS);
            float gg = 0.f; if (tid < 128) gg = kn_c[tid]; else if (tid < 192) { const int jj = tid - 128; gg = kn_c[128 + ((jj & 1) ? 32 : 0) + (jj >> 1)]; }
            st[2304 + tid] = gg; }
        EPI_BAR();
#pragma unroll
        for (int ai = 0; ai < 2; ++ai)
#pragma unroll
            for (int m = 0; m < 4; ++m) { const int rl = ai * HALF + rl0 + m * 16; const int row = u.pm * BM + rl; const float rc = st[2048 + rl];
#pragma unroll
                for (int bj = 0; bj < 2; ++bj) { acc[ai][bj][m][0] *= rc; acc[ai][bj][m][1] *= rc; }
                *(u32x4*)(VV + (size_t)row * 512 + h * 128 + wc * 32 + fq * 8) = pack8(acc[ai][1][m][0], acc[ai][1][m][1]);
                const float q = red_fq(sq4(acc[ai][0][m][0]) + sq4(acc[ai][0][m][1])); if (fq == 0) st[rl * 4 + wc] = q;
                asm volatile("" ::: "memory"); }
        EPI_BAR();
        if (tid < 256) { const f32x4 p = *(const PG8_LAS f32x4*)(st + tid * 4); const float ss = ((p[0] + p[1]) + (p[2] + p[3])) + gss[(size_t)(u.pm * BM + tid) * 8 + 5];
            st[2048 + tid] = rsqrtf(ss * (1.0f / 192.0f) + EPS); }
        EPI_BAR();
#pragma unroll
        for (int ai = 0; ai < 2; ++ai)
#pragma unroll
            for (int m = 0; m < 4; ++m) { const int rl = ai * HALF + rl0 + m * 16; const float f = st[2048 + rl]; const PG8_LAS float* gp = st + 2304 + wc * 32 + fq * 8;
                *(u32x4*)(KK + (size_t)(u.pm * BM + rl) * 768 + h * 192 + wc * 32 + fq * 8) = pack8(acc[ai][0][m][0] * *(const PG8_LAS f32x4*)gp * f, acc[ai][0][m][1] * *(const PG8_LAS f32x4*)(gp + 4) * f);
                asm volatile("" ::: "memory"); }
        { const int rl = tid >> 1, ib = (tid & 1) * 16; const int row = u.pm * BM + rl; const float f = st[2048 + rl];
          const bf16_t* src = C1 + (size_t)row * 768 + 640 + ib * 2; bf16_t* dstp = KK + (size_t)row * 768 + h * 192 + 128 + ib * 2; const float* rp = rope + ((size_t)row * 32 + ib) * 2;
          const PG8_LAS float* gq = st + 2304 + 128 + ib * 2;
#pragma unroll
          for (int c = 0; c < 4; ++c) { const u32x4 raw = *(const u32x4*)(src + c * 8); const f32x4 g0 = *(const PG8_LAS f32x4*)(gq + c * 8), g1 = *(const PG8_LAS f32x4*)(gq + c * 8 + 4);
              const f32x4 cA = *(const f32x4*)(rp + c * 8), cB = *(const f32x4*)(rp + c * 8 + 4);
              f32x4 xa, xb;
              xa[0] = __uint_as_float(raw[0] << 16) * g0[0] * f; xa[1] = __uint_as_float(raw[0] & 0xffff0000u) * g0[1] * f; xa[2] = __uint_as_float(raw[1] << 16) * g0[2] * f; xa[3] = __uint_as_float(raw[1] & 0xffff0000u) * g0[3] * f;
              xb[0] = __uint_as_float(raw[2] << 16) * g1[0] * f; xb[1] = __uint_as_float(raw[2] & 0xffff0000u) * g1[1] * f; xb[2] = __uint_as_float(raw[3] << 16) * g1[2] * f; xb[3] = __uint_as_float(raw[3] & 0xffff0000u) * g1[3] * f;
              f32x4 o0, o1;
              o0[0] = xa[0] * cA[0] - xa[1] * cA[1]; o0[1] = xa[1] * cA[0] + xa[0] * cA[1]; o0[2] = xa[2] * cA[2] - xa[3] * cA[3]; o0[3] = xa[3] * cA[2] + xa[2] * cA[3];
              o1[0] = xb[0] * cB[0] - xb[1] * cB[1]; o1[1] = xb[1] * cB[0] + xb[0] * cB[1]; o1[2] = xb[2] * cB[2] - xb[3] * cB[3]; o1[3] = xb[3] * cB[2] + xb[2] * cB[3];
              *(u32x4*)(dstp + c * 8) = pack8(o0, o1); } }
    }
};

struct GroupScaleHook {
    static constexpr bool ACTIVE = true;
    const float* ssy; PG8_LAS float* fac;
    __device__ __forceinline__ void step(int t, f32x4 (&acc)[2][2][4][2], const Unit& u, int wid, int wr) const {
        if (t == 0) {
            if (wid < 4) { const int tid = (wid << 6) | olane(); const float* sp = ssy + (size_t)(u.pm * BM + tid) * 32; float r[4];
#pragma unroll
                for (int gq = 0; gq < 4; ++gq) { const f32x4 s0 = *(const f32x4*)(sp + gq * 8), s1 = *(const f32x4*)(sp + gq * 8 + 4);
                    r[gq] = rsqrtf((((s0[0] + s0[1]) + (s0[2] + s0[3])) + ((s1[0] + s1[1]) + (s1[2] + s1[3]))) * (1.0f / 256.0f) + EPS); }
                PG8_LAS float* fp = fac + tid * 5; fp[0] = 1.0f / r[0]; fp[1] = r[0] / r[1]; fp[2] = r[1] / r[2]; fp[3] = r[2] / r[3]; fp[4] = r[3]; }
        } else if (t >= 8 && (t & 3) == 0) { scale(acc, (t - 8) >> 2, wr); }
    }
    __device__ __forceinline__ void finish(f32x4 (&acc)[2][2][4][2], const Unit&, int wr) const { scale(acc, 4, wr); }
    __device__ __forceinline__ void scale(f32x4 (&acc)[2][2][4][2], int k, int wr) const {
        const int rl0 = wr * 64 + (olane() & 15);
#pragma unroll
        for (int ai = 0; ai < 2; ++ai)
#pragma unroll
            for (int m = 0; m < 4; ++m) { const float f = fac[(ai * HALF + rl0 + m * 16) * 5 + k];
#pragma unroll
                for (int bj = 0; bj < 2; ++bj) { acc[ai][bj][m][0] *= f; acc[ai][bj][m][1] *= f; } }
    }
};
struct NoHook { static constexpr bool ACTIVE = false; };
template <class Epi, class Sched, bool ALIGN_EPI = false, bool SP2 = false, class KHook = NoHook>
__device__ __forceinline__ void gemm_phase(PG8_LAS unsigned char* lds, const Gemm g, const Sched& S, const Epi& E, const int tid_in, const KHook HK = KHook()) {
    int tid = tid_in; asm volatile("" : "+v"(tid)); const int wid = __builtin_amdgcn_readfirstlane(tid >> 6), lane = tid & 63, wr = wid >> 2, wc = wid & 3, fr = lane & 15, fq = lane >> 4;
    const int K = g.K, nt = K / BK;
    unsigned voffA[2], voffB[2];
#pragma unroll
    for (int i = 0; i < 2; ++i) { int R, C; stage_rc(tid * 16 + i * 8192, R, C); const int Rb = Epi::PERM ? ((R & ~31) + perm32(R & 31)) : R;
        voffA[i] = (unsigned)(R * g.lda + C) * 2u; voffB[i] = (unsigned)(Rb * K + C) * 2u; }
    const size_t kstep = (size_t)(BK * 2);
    const size_t hstepA = (size_t)HALF * g.lda * 2, hstepB = (size_t)HALF * K * 2;
    const size_t tstepA = 2 * hstepA, tstepB = 2 * hstepB;
    const unsigned ldsw = (unsigned)wid * 1024u;
    const int aoff = lds_byte(wr * 64 + fr, fq * 8), boff = lds_byte(wc * 32 + fr, fq * 8);
#define PG8_SA(b, h) (((b) * 2 + (h)) * HTB)
#define PG8_SB(b, h) ((4 + (b) * 2 + (h)) * HTB)
#define PG8_STAGE(bufoff, gbase, voff) do { _Pragma("unroll") for (int _i = 0; _i < 2; ++_i) \
        __builtin_amdgcn_global_load_lds((const unsigned*)((const char*)(gbase) + (voff)[_i]), (PG8_LAS unsigned*)(lds + (bufoff) + ldsw + _i * 8192), 16, 0, 0); } while (0)
#define PG8_LDA(dst, b, h) do { _Pragma("unroll") for (int m = 0; m < 4; ++m) _Pragma("unroll") for (int k = 0; k < 2; ++k) dst[m][k] = *(const PG8_LAS bf16x8*)(lds + PG8_SA(b, h) + aoff + m * 2048 + k * 1024); } while (0)
#define PG8_LDB(dst, b, h) do { _Pragma("unroll") for (int n = 0; n < 2; ++n) _Pragma("unroll") for (int k = 0; k < 2; ++k) dst[n][k] = *(const PG8_LAS bf16x8*)(lds + PG8_SB(b, h) + boff + n * 2048 + k * 1024); } while (0)
#define PG8_MMA(ai, bj, At, Bt) do { __builtin_amdgcn_s_setprio(1); _Pragma("unroll") for (int m = 0; m < 4; ++m) _Pragma("unroll") for (int n = 0; n < 2; ++n) _Pragma("unroll") for (int k = 0; k < 2; ++k) \
        acc[ai][bj][m][n] = __builtin_amdgcn_mfma_f32_16x16x32_bf16(Bt[n][k], At[m][k], acc[ai][bj][m][n], 0, 0, 0); __builtin_amdgcn_s_setprio(0); } while (0)
#define PG8_WAIT_V(n) asm volatile("s_waitcnt vmcnt(" #n ")" ::: "memory")
#define PG8_WAIT_L(n) asm volatile("s_waitcnt lgkmcnt(" #n ")" ::: "memory")
#define PG8_BAR __builtin_amdgcn_s_barrier()
#define PG8_SCHED __builtin_amdgcn_sched_barrier(0)
    Unit cur, nxt; int ui = 0;
    if (!S.next(0, cur)) return;
    f32x4 acc[2][2][4][2];
#pragma unroll
    for (int a = 0; a < 2; ++a)
#pragma unroll
        for (int b = 0; b < 2; ++b)
#pragma unroll
            for (int m = 0; m < 4; ++m)
#pragma unroll
                for (int n = 0; n < 2; ++n) acc[a][b][m][n] = (f32x4){0.f, 0.f, 0.f, 0.f};
    bf16x8 At[4][2], B0[2][2], B1[2][2];
    const char* cA = (const char*)g.A + (size_t)cur.pm * tstepA; const char* cB = (const char*)g.Bt + (size_t)cur.pn * tstepB;
    S.a_ready(cur);
    if constexpr (SP2) {
        PG8_STAGE(PG8_SB(0, 0), cB, voffB); PG8_STAGE(PG8_SB(0, 1), cB + hstepB, voffB); PG8_STAGE(PG8_SA(0, 0), cA, voffA); PG8_STAGE(PG8_SA(0, 1), cA + hstepA, voffA);
        if (wr == 1) PG8_BAR;
        PG8_WAIT_V(2); PG8_BAR;
        PG8_STAGE(PG8_SB(1, 0), cB + kstep, voffB); PG8_STAGE(PG8_SA(1, 0), cA + kstep, voffA); PG8_STAGE(PG8_SB(1, 1), cB + hstepB + kstep, voffB);
        PG8_WAIT_V(6); PG8_BAR;
    } else {
        PG8_STAGE(PG8_SB(0, 0), cB, voffB); PG8_STAGE(PG8_SA(0, 0), cA, voffA); PG8_STAGE(PG8_SB(0, 1), cB + hstepB, voffB); PG8_STAGE(PG8_SA(0, 1), cA + hstepA, voffA);
        if (wr == 1) PG8_BAR;
        PG8_WAIT_V(4); PG8_BAR;
        PG8_STAGE(PG8_SB(1, 0), cB + kstep, voffB); PG8_STAGE(PG8_SA(1, 0), cA + kstep, voffA); PG8_STAGE(PG8_SB(1, 1), cB + hstepB + kstep, voffB);
        PG8_WAIT_V(6); PG8_BAR;
    }
    for (;;) {
        const bool has_next = S.next(ui + 1, nxt);
        const char* nA = has_next ? (const char*)g.A + (size_t)nxt.pm * tstepA : cA; const char* nB = has_next ? (const char*)g.Bt + (size_t)nxt.pn * tstepB : cB;
        for (int t = 0; t < nt; t += 2) {
            if constexpr (KHook::ACTIVE) HK.step(t, acc, cur, wid, wr);
            const bool last = (t == nt - 2);
            const char* a1 = cA + (size_t)(t + 1) * kstep;
            const char* a2 = last ? nA : cA + (size_t)(t + 2) * kstep; const char* b2 = last ? nB : cB + (size_t)(t + 2) * kstep;
            const char* a3 = a2 + kstep; const char* b3 = b2 + kstep;
            if (last && has_next) S.a_ready(nxt);
            if constexpr (SP2) {
            PG8_LDB(B0, 0, 0); PG8_LDB(B1, 0, 1); PG8_SCHED; PG8_LDA(At, 0, 0); PG8_STAGE(PG8_SA(1, 1), a1 + hstepA, voffA);
            PG8_WAIT_V(8); PG8_WAIT_L(0); PG8_BAR; PG8_MMA(0, 0, At, B0); PG8_MMA(0, 1, At, B1); PG8_BAR; PG8_SCHED;
            PG8_LDA(At, 0, 1); PG8_STAGE(PG8_SB(0, 0), b2, voffB); PG8_STAGE(PG8_SB(0, 1), b2 + hstepB, voffB); PG8_STAGE(PG8_SA(0, 0), a2, voffA);
            PG8_WAIT_V(8); PG8_WAIT_L(0); PG8_BAR; PG8_MMA(1, 0, At, B0); PG8_MMA(1, 1, At, B1); PG8_BAR; PG8_SCHED;
            PG8_LDB(B0, 1, 0); PG8_LDB(B1, 1, 1); PG8_SCHED; PG8_LDA(At, 1, 0); PG8_STAGE(PG8_SA(0, 1), a2 + hstepA, voffA);
            PG8_WAIT_V(8); PG8_WAIT_L(0); PG8_BAR; PG8_MMA(0, 0, At, B0); PG8_MMA(0, 1, At, B1); PG8_BAR; PG8_SCHED;
            PG8_LDA(At, 1, 1); PG8_STAGE(PG8_SB(1, 0), b3, voffB); PG8_STAGE(PG8_SB(1, 1), b3 + hstepB, voffB); PG8_STAGE(PG8_SA(1, 0), a3, voffA);
            PG8_WAIT_V(8); PG8_WAIT_L(0); PG8_BAR; PG8_MMA(1, 0, At, B0); PG8_MMA(1, 1, At, B1); PG8_BAR; PG8_SCHED;
            } else {
            PG8_LDB(B0, 0, 0); PG8_SCHED; PG8_LDA(At, 0, 0); PG8_STAGE(PG8_SA(1, 1), a1 + hstepA, voffA);
            PG8_WAIT_L(8); PG8_BAR; PG8_WAIT_L(0); PG8_MMA(0, 0, At, B0); PG8_BAR; PG8_SCHED;
            PG8_LDB(B1, 0, 1); PG8_STAGE(PG8_SB(0, 0), b2, voffB);
            PG8_BAR; PG8_WAIT_L(0); PG8_MMA(0, 1, At, B1); PG8_BAR;
            PG8_LDA(At, 0, 1); PG8_STAGE(PG8_SA(0, 0), a2, voffA);
            PG8_BAR; PG8_WAIT_L(0); PG8_MMA(1, 0, At, B0); PG8_BAR; PG8_SCHED;
            PG8_STAGE(PG8_SB(0, 1), b2 + hstepB, voffB);
            PG8_WAIT_V(6); PG8_BAR; PG8_MMA(1, 1, At, B1); PG8_BAR;
            PG8_LDB(B0, 1, 0); PG8_SCHED; PG8_LDA(At, 1, 0); PG8_STAGE(PG8_SA(0, 1), a2 + hstepA, voffA);
            PG8_WAIT_L(8); PG8_BAR; PG8_WAIT_L(0); PG8_MMA(0, 0, At, B0); PG8_BAR; PG8_SCHED;
            PG8_LDB(B1, 1, 1); PG8_STAGE(PG8_SB(1, 0), b3, voffB);
            PG8_BAR; PG8_WAIT_L(0); PG8_MMA(0, 1, At, B1); PG8_BAR;
            PG8_LDA(At, 1, 1); PG8_STAGE(PG8_SA(1, 0), a3, voffA);
            PG8_BAR; PG8_WAIT_L(0); PG8_MMA(1, 0, At, B0); PG8_BAR; PG8_SCHED;
            PG8_STAGE(PG8_SB(1, 1), b3 + hstepB, voffB);
            PG8_WAIT_V(6); PG8_BAR; PG8_MMA(1, 1, At, B1); PG8_BAR;
            }
        }
        if constexpr (KHook::ACTIVE) HK.finish(acc, cur, wr);
        if constexpr (ALIGN_EPI) { if (wr == 0) PG8_BAR; }
        if constexpr (!Epi::AFTER_DRAIN) { int wr_ = wr, wc_ = wc; asm volatile("" : "+s"(wr_), "+s"(wc_)); const int l_ = olane(); const int fr_ = l_ & 15, fq_ = l_ >> 4; E(acc, cur, wr_, wc_, fr_, fq_); S.done(cur); }
        if (!has_next) break;
#pragma unroll
        for (int a = 0; a < 2; ++a)
#pragma unroll
            for (int b = 0; b < 2; ++b)
#pragma unroll
                for (int m = 0; m < 4; ++m)
#pragma unroll
                    for (int n = 0; n < 2; ++n) acc[a][b][m][n] = (f32x4){0.f, 0.f, 0.f, 0.f};
        cur = nxt; cA = nA; cB = nB; ++ui;
        if constexpr (ALIGN_EPI) { if (wr == 1) PG8_BAR; }
    }
    PG8_WAIT_V(0);
    if constexpr (!ALIGN_EPI) { if (wr == 0) PG8_BAR; }
    PG8_BAR;
    if constexpr (Epi::AFTER_DRAIN) { E.fused(acc, cur, wr, wc, fr, fq, lds, wid, lane); S.done(cur); }
#undef PG8_SA
#undef PG8_SB
#undef PG8_STAGE
#undef PG8_LDA
#undef PG8_LDB
#undef PG8_MMA
#undef PG8_WAIT_V
#undef PG8_WAIT_L
#undef PG8_BAR
#undef PG8_SCHED
}
}
#define GAS __attribute__((address_space(1)))
#define LAS __attribute__((address_space(3)))
typedef unsigned short bf16;
typedef unsigned v4u __attribute__((ext_vector_type(4)));
typedef float f32x4 __attribute__((ext_vector_type(4)));
typedef short bf16x8 __attribute__((ext_vector_type(8)));
typedef GAS unsigned gu32;
typedef GAS unsigned long long gu64;
#define RLX_AGENT __ATOMIC_RELAXED, __HIP_MEMORY_SCOPE_AGENT
#define LDS_WAIT() asm volatile("s_waitcnt lgkmcnt(0)" ::: "memory")
#define VM_WAIT() asm volatile("s_waitcnt vmcnt(0)" ::: "memory")
__device__ __forceinline__ unsigned long long rt() { return __builtin_amdgcn_s_memrealtime(); }
__device__ __forceinline__ unsigned f2bf(float f) { unsigned u = __builtin_bit_cast(unsigned, f); return (u + 0x7fffu + ((u >> 16) & 1u)) >> 16; }
__device__ __forceinline__ unsigned pk2(float lo, float hi) { return f2bf(lo) | (f2bf(hi) << 16); }

#define XB_TMO      128
#define XB_XCNT(j)  (256  + 64 * (j))
#define XB_XSUB(j)  (1280 + 64 * (j))
#define XB_XGEN(j)  (2304 + 64 * (j))
#define XB_TOP      3328
#define XB_TOPGEN   3392
#define XCD_BAR_WORDS 3456
#define XB_SPIN_CAP (1u << 18)

__device__ __forceinline__ unsigned xb_ld(unsigned* p)              { return __hip_atomic_load(p, __ATOMIC_RELAXED, __HIP_MEMORY_SCOPE_AGENT); }
__device__ __forceinline__ unsigned xb_add(unsigned* p, unsigned v) { return __hip_atomic_fetch_add(p, v, __ATOMIC_RELAXED, __HIP_MEMORY_SCOPE_AGENT); }
__device__ __forceinline__ unsigned xb_xcc_id() { return (unsigned)__builtin_amdgcn_s_getreg((3 << 11) | 20) & 0xFu; }
#define XB_SPIN(cond, bar) do { unsigned _sp = 0; while (cond) { __builtin_amdgcn_s_sleep(1); \
    if ((++_sp & 255u) == 0u) { if (xb_ld(&(bar)[XB_TMO])) break; if (_sp > XB_SPIN_CAP) { atomicAdd(&(bar)[XB_TMO], 1u); break; } } } } while (0)

struct XcdBarrier {
    unsigned* bar; unsigned x;
    volatile LAS unsigned* st;
};

__device__ __forceinline__ XcdBarrier xcd_barrier_post(unsigned* bar, volatile LAS unsigned* st, const int tid) {
    XcdBarrier b; b.bar = bar; b.x = xb_xcc_id(); b.st = st;
    if (tid == 0) (void)xb_add(&bar[XB_XCNT(b.x)], 1u);
    return b;
}
__device__ __forceinline__ void xcd_barrier_complete(unsigned* bar, unsigned x, unsigned& nloc, unsigned& nx) {
    const unsigned G = gridDim.x * gridDim.y * gridDim.z;
    unsigned sum, cnt, mine, sp = 0u;
    for (;;) {
        sum = 0u; cnt = 0u; mine = 0u;
#pragma unroll
        for (unsigned j = 0; j < 16; ++j) { const unsigned c = xb_ld(&bar[XB_XCNT(j)]); sum += c; cnt += (c > 0u) ? 1u : 0u; mine = (j == x) ? c : mine; }
        if (sum == G) break;
        __builtin_amdgcn_s_sleep(1);
        if ((++sp & 255u) == 0u) { if (xb_ld(&bar[XB_TMO])) break; if (sp > XB_SPIN_CAP) { atomicAdd(&bar[XB_TMO], 1u); break; } }
    }
    nloc = mine > 0u ? mine : 1u; nx = cnt > 0u ? cnt : 1u;
}

__device__ __forceinline__ void xcd_barrier(const XcdBarrier& b, const int tid) {
    asm volatile("s_waitcnt vmcnt(0)" ::: "memory");
    __syncthreads();
    if (tid == 0) {
        unsigned* bar = b.bar; asm volatile("" : "+s"(bar));
        __builtin_amdgcn_s_waitcnt(0);
        unsigned nloc = b.st[0], nx = b.st[1];
        if (nloc == 0u) { xcd_barrier_complete(bar, b.x, nloc, nx); b.st[0] = nloc; b.st[1] = nx; }
        const unsigned old = xb_add(&bar[XB_XSUB(b.x)], 1u);
        const unsigned gen = old / nloc;
        if (old + 1u == (gen + 1u) * nloc) {
            __builtin_amdgcn_fence(__ATOMIC_RELEASE, "agent");
            asm volatile("s_waitcnt vmcnt(0)" ::: "memory");
            const unsigned og = xb_add(&bar[XB_TOP], 1u);
            const unsigned tg = og / nx;
            if (og + 1u == (tg + 1u) * nx) xb_add(&bar[XB_TOPGEN], 1u);
            else XB_SPIN(xb_ld(&bar[XB_TOPGEN]) == tg, bar);
            __builtin_amdgcn_fence(__ATOMIC_ACQUIRE, "agent");
            xb_add(&bar[XB_XGEN(b.x)], 1u);
            asm volatile("s_waitcnt vmcnt(0)" ::: "memory");
        } else {
            XB_SPIN(xb_ld(&bar[XB_XGEN(b.x)]) == gen, bar);
            __builtin_amdgcn_fence(__ATOMIC_ACQUIRE, "agent");
            asm volatile("s_waitcnt vmcnt(0)" ::: "memory");
        }
    }
    __syncthreads();
}

namespace att {
typedef __hip_bfloat16 hbf16;
typedef short bf16x8 __attribute__((ext_vector_type(8)));
typedef short s16x4 __attribute__((ext_vector_type(4)));
typedef float f32x16 __attribute__((ext_vector_type(16)));
typedef float f32x4 __attribute__((ext_vector_type(4)));
typedef unsigned u32x4 __attribute__((ext_vector_type(4)));
typedef unsigned long long u64;
constexpr int QBLK = 32, KVBLK = 64;
constexpr int SHM_V = KVBLK * 128 * 2;
constexpr float THR2 = 11.0f;
#define ATT_SBAR() __builtin_amdgcn_sched_barrier(0)
__device__ __forceinline__ int v_st(int k, int c) { const int kk = (k & ~0xC) | ((k & 4) << 1) | ((k & 8) >> 1); return ((kk >> 3) * 4 + (c >> 5)) * 512 + ((kk & 7) * 32 + (c & 31)) * 2; }
__device__ __forceinline__ int v_rd_base(int lane) { return ((lane & 3) << 3) | (((lane >> 2) & 3) << 6) | (((lane >> 4) & 1) << 5) | (((lane >> 5) & 1) << 8); }
constexpr int v_rd_off(int d0, int ks, int half) { return d0 * 512 + ks * 4096 + half * 2048; }
__device__ __forceinline__ int crow(int r, int hi) { return (r & 3) + 8 * (r >> 2) + 4 * hi; }
__device__ __forceinline__ unsigned cvtpk(float lo, float hi) { unsigned r; asm volatile("v_cvt_pk_bf16_f32 %0, %1, %2" : "=v"(r) : "v"(lo), "v"(hi)); return r; }

struct UnitArgs {
    const unsigned short* Q; int ldq;
    const unsigned short* K; int ldk;
    const unsigned short* V; int ldv;
    unsigned short* O; int ldo;
    int qlo;
    int NT;
    const float* kbias;
    const u64* bm;
    int tid;
    const float* gq; const float* gk;
};

__device__ __forceinline__ void mask_causal(f32x16& p0, f32x16& p1, int dq) {
    const float NEG = -__builtin_inff();
#pragma unroll
    for (int r = 0; r < 16; ++r) { const int c = (r & 3) + 8 * (r >> 2); if (dq - c < 0) p0[r] = NEG; if (dq - c - 32 < 0) p1[r] = NEG; }
}
__device__ __forceinline__ void mask_bits(f32x16& p0, f32x16& p1, u64 w, int hi) {
    const float NEG = -__builtin_inff(); const unsigned lo = (unsigned)w >> (4 * hi), hh = (unsigned)(w >> 32) >> (4 * hi);
#pragma unroll
    for (int r = 0; r < 16; ++r) { const int c = (r & 3) + 8 * (r >> 2);
        const unsigned m0 = (unsigned)__builtin_amdgcn_sbfe((int)lo, c, 1), m1 = (unsigned)__builtin_amdgcn_sbfe((int)hh, c, 1);
        p0[r] = __uint_as_float((__float_as_uint(p0[r]) & m0) | (__float_as_uint(NEG) & ~m0)); p1[r] = __uint_as_float((__float_as_uint(p1[r]) & m1) | (__float_as_uint(NEG) & ~m1)); }
}
__device__ __forceinline__ void partialSM(f32x16& p0, f32x16& p1, float& m_reg, float& mn, float& alpha, const bool fixedref) {
    if (fixedref) { mn = 0.f; alpha = 1.f; }
    else {
        float pmax = p0[0];
#pragma unroll
        for (int r = 1; r < 16; ++r) pmax = fmaxf(pmax, p0[r]);
#pragma unroll
        for (int r = 0; r < 16; ++r) pmax = fmaxf(pmax, p1[r]);
        { auto rr = __builtin_amdgcn_permlane32_swap(__float_as_uint(pmax), __float_as_uint(pmax), false, false); pmax = fmaxf(__uint_as_float(rr[0]), __uint_as_float(rr[1])); }
        if (__builtin_expect(__all((pmax - m_reg) <= THR2), 1)) { mn = m_reg; alpha = 1.f; }
        else { mn = fmaxf(m_reg, pmax); alpha = __builtin_amdgcn_exp2f(m_reg - mn); m_reg = mn; }
    }
    if (!fixedref) {
#pragma unroll
        for (int r = 0; r < 16; ++r) p0[r] = p0[r] - mn;
#pragma unroll
        for (int r = 0; r < 16; ++r) p1[r] = p1[r] - mn;
    }
#pragma unroll
    for (int r = 0; r < 16; ++r) p0[r] = __builtin_amdgcn_exp2f(p0[r]);
}
__device__ __forceinline__ void finishSM(f32x16& p0, f32x16& p1, float alpha, float& l_reg, bf16x8& pa0, bf16x8& pa1, bf16x8& pa2, bf16x8& pa3) {
#pragma unroll
    for (int r = 0; r < 16; ++r) p1[r] = __builtin_amdgcn_exp2f(p1[r]);
    float ps = 0;
#pragma unroll
    for (int r = 0; r < 16; ++r) ps += p0[r];
#pragma unroll
    for (int r = 0; r < 16; ++r) ps += p1[r];
    { auto rr = __builtin_amdgcn_permlane32_swap(__float_as_uint(ps), __float_as_uint(ps), false, false); ps = __uint_as_float(rr[0]) + __uint_as_float(rr[1]); }
    l_reg = l_reg * alpha + ps;
#define ATT_PK4(P, B_, OUT) do { unsigned a0 = cvtpk(P[B_+0], P[B_+1]), a1 = cvtpk(P[B_+2], P[B_+3]);                          \
        unsigned b0 = cvtpk(P[B_+4], P[B_+5]), b1 = cvtpk(P[B_+6], P[B_+7]);                                             \
        auto r0 = __builtin_amdgcn_permlane32_swap(a0, b0, false, false); auto r1 = __builtin_amdgcn_permlane32_swap(a1, b1, false, false); \
        u32x4 w = {r0[0], r1[0], r0[1], r1[1]}; OUT = *reinterpret_cast<bf16x8*>(&w); } while (0)
    ATT_PK4(p0, 0, pa0); ATT_PK4(p0, 8, pa1); ATT_PK4(p1, 0, pa2); ATT_PK4(p1, 8, pa3);
#undef ATT_PK4
}
template <int VB>
__device__ __forceinline__ void pv_tile(f32x16* o, int vb0, bf16x8 pa0, bf16x8 pa1, bf16x8 pa2, bf16x8 pa3) {
#define ATT_TRRD(dst, off) asm volatile("ds_read_b64_tr_b16 %0, %1 offset:%2" : "=&v"(dst) : "v"(vb0), "i"(off) : "memory")
#define ATT_PV_D0(d0) do { s16x4 l0, l1, l2, l3, h0, h1, h2, h3; constexpr int b_ = VB * SHM_V + v_rd_off(d0, 0, 0); \
        ATT_TRRD(l0, b_); ATT_TRRD(h0, b_ + 2048); ATT_TRRD(l1, b_ + 4096); ATT_TRRD(h1, b_ + 6144); ATT_TRRD(l2, b_ + 8192); ATT_TRRD(h2, b_ + 10240); ATT_TRRD(l3, b_ + 12288); ATT_TRRD(h3, b_ + 14336); \
        asm volatile("s_waitcnt lgkmcnt(0)" ::: "memory"); ATT_SBAR();   \
        o[d0] = __builtin_amdgcn_mfma_f32_32x32x16_bf16(pa0, (bf16x8){l0[0], l0[1], l0[2], l0[3], h0[0], h0[1], h0[2], h0[3]}, o[d0], 0, 0, 0);   \
        o[d0] = __builtin_amdgcn_mfma_f32_32x32x16_bf16(pa1, (bf16x8){l1[0], l1[1], l1[2], l1[3], h1[0], h1[1], h1[2], h1[3]}, o[d0], 0, 0, 0);   \
        o[d0] = __builtin_amdgcn_mfma_f32_32x32x16_bf16(pa2, (bf16x8){l2[0], l2[1], l2[2], l2[3], h2[0], h2[1], h2[2], h2[3]}, o[d0], 0, 0, 0);   \
        o[d0] = __builtin_amdgcn_mfma_f32_32x32x16_bf16(pa3, (bf16x8){l3[0], l3[1], l3[2], l3[3], h3[0], h3[1], h3[2], h3[3]}, o[d0], 0, 0, 0); } while (0)
    ATT_PV_D0(0); ATT_PV_D0(1); ATT_PV_D0(2); ATT_PV_D0(3);
#undef ATT_PV_D0
#undef ATT_TRRD
}

template <int DQK, int MODE>
__device__ __forceinline__ void attn_unit(const UnitArgs& a, char* lds) {
    constexpr int SHM_K = KVBLK * DQK * 2, RS = DQK * 2, ND = DQK / 16, NKC = DQK / 64;
    int tid = a.tid; asm volatile("" : "+v"(tid)); const int wid = __builtin_amdgcn_readfirstlane(tid >> 6), lane = tid & 63, r32 = lane & 31, hi = lane >> 5;
    char* V_lds = lds; char* K_lds = lds + 2 * SHM_V;
    float* ws = (float*)(lds + 2 * SHM_V + 2 * SHM_K) + wid * 64; float* li_l = ws; float* al_l = ws + 32;
    float* kbl = (float*)(lds + 2 * SHM_V + 2 * SHM_K + 2048);
    const int NT = a.NT;
    const int qlo = a.qlo, qm = qlo + r32 - 4 * hi;
    const int srow = tid >> 3, c8 = tid & 7;
    const int kws = srow * RS + ((c8 * 16) ^ ((srow & 7) << 4));
    const int vst0 = v_st(srow, c8 * 8);
    const unsigned short* kg = a.K + (size_t)srow * a.ldk + c8 * 8;
    const unsigned short* vg = a.V + (size_t)srow * a.ldv + c8 * 8;
    const u64* bmrow = (MODE == 2) ? a.bm + (size_t)r32 * 64 : nullptr;
    bf16x8 st_k[NKC], st_v[2]; float st_b = 0.f; u64 mw_ld = 0, mw_cur = 0;
#define ATT_VMW() asm volatile("s_waitcnt vmcnt(0)" ::: "memory")
#define ATT_SLOAD(t) do { const size_t ko_ = (size_t)(t) * KVBLK * a.ldk, vo_ = (size_t)(t) * KVBLK * a.ldv; \
        _Pragma("unroll") for (int i_ = 0; i_ < NKC; ++i_) st_k[i_] = *(const bf16x8*)(kg + ko_ + i_ * 64); \
        _Pragma("unroll") for (int i_ = 0; i_ < 2; ++i_) st_v[i_] = *(const bf16x8*)(vg + vo_ + i_ * 64); \
        if (MODE == 1) { if (tid < 64) st_b = a.kbias[(t) * KVBLK + tid]; } \
        if (MODE == 2) { mw_ld = bmrow[(t)]; } } while (0)
#define ATT_SWRITE(bf) do { \
        _Pragma("unroll") for (int i_ = 0; i_ < NKC; ++i_) *(bf16x8*)(K_lds + (bf) * SHM_K + kws + i_ * 128) = st_k[i_]; \
        _Pragma("unroll") for (int i_ = 0; i_ < 2; ++i_) *(bf16x8*)(V_lds + (bf) * SHM_V + vst0 + i_ * 1024) = st_v[i_]; \
        if (MODE == 1) { if (tid < 64) kbl[(bf) * 64 + tid] = st_b; } } while (0)
    const int vb0 = (int)(uintptr_t)V_lds + v_rd_base(lane);
    float m_reg = -1e30f, l_reg = 0; f32x16 o[4] = {};
    bool fixedref;
    { float gqm = 0.f, gkm = 0.f;
#pragma unroll
      for (int i = 0; i < DQK / 64; ++i) { gqm = fmaxf(gqm, fabsf(a.gq[lane + 64 * i])); gkm = fmaxf(gkm, fabsf(a.gk[lane + 64 * i])); }
      gqm = wmax_f(gqm); gkm = wmax_f(gkm);
      const float bound = (float)DQK * (DQK == 128 ? QSCALE128 : QSCALE192) * 1.01f * gqm * gkm;
      fixedref = bound <= 40.0f;
      if (fixedref) m_reg = ((MODE == 1) ? a.kbias[qlo + r32] : 0.f) + bound - THR2; }
    const float cinit = fixedref ? -m_reg : 0.f;
#define ATT_RESC(al) do { if (__any((al) < 1.f)) { if (hi == 0) al_l[r32] = (al); asm volatile("s_waitcnt lgkmcnt(0)" ::: "memory");              \
                     _Pragma("unroll") for (int d_ = 0; d_ < 4; ++d_) _Pragma("unroll") for (int r = 0; r < 16; ++r) o[d_][r] *= al_l[crow(r, hi)]; } } while (0)
#define ATT_MASKT(P0_, P1_, t) do { const int kb_ = (t) * KVBLK; \
        if (MODE == 2) { mask_bits(P0_, P1_, mw_cur, hi); } \
        else { if (kb_ + KVBLK - 1 > qlo) mask_causal(P0_, P1_, qm - kb_); } } while (0)
#define ATT_QKT(KB, P0_, P1_) do { \
        if (MODE == 1) { const float* kb__ = kbl + (KB) * 64 + 4 * hi; \
            _Pragma("unroll") for (int j_ = 0; j_ < 4; ++j_) { const f32x4 b0_ = *(const f32x4*)(kb__ + 8 * j_), b1_ = *(const f32x4*)(kb__ + 32 + 8 * j_); \
                _Pragma("unroll") for (int e_ = 0; e_ < 4; ++e_) { P0_[4 * j_ + e_] = b0_[e_] + cinit; P1_[4 * j_ + e_] = b1_[e_] + cinit; } } } \
        else { _Pragma("unroll") for (int r_ = 0; r_ < 16; ++r_) { P0_[r_] = cinit; P1_[r_] = cinit; } } \
        const char* kbp_[4]; \
        _Pragma("unroll") for (int dd_ = 0; dd_ < 4; ++dd_) kbp_[dd_] = K_lds + (KB) * SHM_K + r32 * RS + (((dd_ * 16 + hi * 8) * 2) ^ ((r32 & 7) << 4)); \
        _Pragma("unroll") for (int d0_ = 0; d0_ < ND; ++d0_) { const char* a_ = kbp_[d0_ & 3] + (d0_ >> 2) * 128; \
            const bf16x8 b0_ = *reinterpret_cast<const bf16x8*>(a_); const bf16x8 b1_ = *reinterpret_cast<const bf16x8*>(a_ + 32 * RS); \
            P0_ = __builtin_amdgcn_mfma_f32_32x32x16_bf16(b0_, qr[d0_], P0_, 0, 0, 0); \
            P1_ = __builtin_amdgcn_mfma_f32_32x32x16_bf16(b1_, qr[d0_], P1_, 0, 0, 0); } } while (0)
    const int grp = wid >> 2;
    int t0 = 0;
    if (MODE == 1 && fixedref) { const int q0u = qlo - 32 * wid; const float bq0 = a.kbias[q0u];
        const float kbl_ = (lane < NT) ? a.kbias[64 * lane + 63] : __builtin_inff();
        const u64 okm = __ballot(kbl_ - bq0 >= -(150.0f + THR2 + 4.0f));
        t0 = (int)__ffsll((long long)okm) - 1; t0 = __builtin_amdgcn_readfirstlane(t0 < 0 ? 0 : t0) & ~1; }
    ATT_SLOAD(t0);
    bf16x8 qr[ND];
#pragma unroll
    for (int d0 = 0; d0 < ND; ++d0) qr[d0] = *(const bf16x8*)(a.Q + (size_t)r32 * a.ldq + d0 * 16 + hi * 8);
    ATT_VMW(); ATT_SWRITE(0); mw_cur = mw_ld;
    if (NT > t0 + 1) ATT_SLOAD(t0 + 1);
    __syncthreads();
    if (grp == 1) __syncthreads();
    f32x16 p0, p1; float mn, al; bf16x8 pa0, pa1, pa2, pa3;
#define ATT_STAGE_NEXT(t) do { if ((t) + 1 < NT) { ATT_VMW(); if (((t) + 1) & 1) { ATT_SWRITE(1); } else { ATT_SWRITE(0); } mw_cur = mw_ld; if ((t) + 2 < NT) { ATT_SLOAD((t) + 2); } } } while (0)
#define ATT_STEP(t, BUF) do { \
        ATT_SBAR(); ATT_QKT(BUF, p0, p1); \
        ATT_MASKT(p0, p1, (t)); partialSM(p0, p1, m_reg, mn, al, fixedref); \
        if (grp == 1) ATT_STAGE_NEXT(t); \
        __syncthreads(); \
        if (grp == 0) ATT_STAGE_NEXT(t); \
        ATT_RESC(al); \
        finishSM(p0, p1, al, l_reg, pa0, pa1, pa2, pa3); ATT_SBAR(); \
        pv_tile<BUF>(o, vb0, pa0, pa1, pa2, pa3); \
        __syncthreads(); } while (0)
    for (int t = t0; t < NT; t += 2) {
        ATT_STEP(t, 0);
        if (t + 1 < NT) ATT_STEP(t + 1, 1);
    }
    if (grp == 0) __syncthreads();
#undef ATT_STEP
#undef ATT_STAGE_NEXT
    if (hi == 0) li_l[r32] = l_reg; asm volatile("s_waitcnt lgkmcnt(0)" ::: "memory");
    float rli[16];
#pragma unroll
    for (int r = 0; r < 16; ++r) rli[r] = __builtin_amdgcn_rcpf(li_l[crow(r, hi)]);
#pragma unroll
    for (int r = 0; r < 16; ++r) { const int orow = crow(r, hi);
#pragma unroll
        for (int d0 = 0; d0 < 4; ++d0) { const float v = o[d0][r] * rli[r]; const float vn = xor_f<1>(v);
            if ((r32 & 1) == 0) *(unsigned*)(a.O + (size_t)orow * a.ldo + d0 * 32 + r32) = cvtpk(v, vn); } }
    __syncthreads();
#undef ATT_VMW
#undef ATT_SLOAD
#undef ATT_SWRITE
#undef ATT_RESC
#undef ATT_MASKT
#undef ATT_QKT
}
#undef ATT_SBAR
}

namespace tk {
typedef short bf16x8 __attribute__((ext_vector_type(8)));
typedef float f32x16 __attribute__((ext_vector_type(16)));
typedef float f32x4 __attribute__((ext_vector_type(4)));
typedef unsigned u32x4 __attribute__((ext_vector_type(4)));
typedef unsigned long long u64;
constexpr int TOPK = 256;
__device__ __forceinline__ float wave_min(float v) { return wmin_f(v); }
__device__ __forceinline__ float wave_max(float v) { return wmax_f(v); }
__device__ __forceinline__ int rdlane_i(int v, int src_uniform) { return __builtin_amdgcn_readlane(v, __builtin_amdgcn_readfirstlane(src_uniform)); }

__device__ __forceinline__ void topk_unit(const unsigned short* EP, const float* misc32, u64* BM, int b, int g, char* lds, char* lds_hist, char* lds_cand, const int tid_in) {
    int tid = tid_in; asm volatile("" : "+v"(tid)); const int wid = __builtin_amdgcn_readfirstlane(tid >> 6), lane = tid & 63, r32 = lane & 31, hi = lane >> 5;
    float* S = (float*)lds;
    const int q0 = g * 8; const size_t tok0 = (size_t)b * SEQ;
    {
        typedef float f32x4a __attribute__((ext_vector_type(4)));
        const int j16 = lane & 15, kg = lane >> 4;
        bf16x8 af[4][2];
        const int nkb = (q0 + 8 + 31) >> 5;
        const unsigned short* kbase = EP + tok0 * N_E_IN + 1280 + kg * 8 + (size_t)j16 * N_E_IN;
        bf16x8 bA[4], bB[4];
#define TK_LOADB(dst, kb_) do { _Pragma("unroll") for (int f_ = 0; f_ < 4; ++f_) dst[f_] = *(const bf16x8*)(kbase + ((size_t)(kb_) * 32 + (f_ >> 1) * 16) * N_E_IN + (f_ & 1) * 32); } while (0)
        if (wid < nkb) TK_LOADB(bA, wid);
#pragma unroll
        for (int rt = 0; rt < 4; ++rt)
#pragma unroll
            for (int ks = 0; ks < 2; ++ks) af[rt][ks] = *(const bf16x8*)(EP + (tok0 + q0 + 2 * (j16 >> 2) + (rt >> 1)) * N_E_IN + 768 + (4 * (rt & 1) + (j16 & 3)) * 64 + ks * 32 + kg * 8);
        f32x4 wv[2][2];
#pragma unroll
        for (int qq = 0; qq < 2; ++qq) { const float* wp = misc32 + (tok0 + q0 + 2 * kg + qq) * 16; wv[qq][0] = *(const f32x4*)wp; wv[qq][1] = *(const f32x4*)(wp + 4); }
#if defined(TKS_CHECK)
#define TK_HEADSUM(s, w_, lo_, hi_) float s = w_[0][0] * __int_as_float(max(__float_as_int(lo_[0]), 0)), s2_ = w_[1][0] * __int_as_float(max(__float_as_int(hi_[0]), 0)); \
            _Pragma("unroll") for (int e = 1; e < 4; ++e) { s = __builtin_fmaf(w_[0][e], __int_as_float(max(__float_as_int(lo_[e]), 0)), s); s2_ = __builtin_fmaf(w_[1][e], __int_as_float(max(__float_as_int(hi_[e]), 0)), s2_); } s += s2_
#else
#define TK_HEADSUM(s, w_, lo_, hi_) float s = 0.f; \
            _Pragma("unroll") for (int e = 0; e < 4; ++e) s += w_[0][e] * __int_as_float(max(__float_as_int(lo_[e]), 0)); \
            _Pragma("unroll") for (int e = 0; e < 4; ++e) s += w_[1][e] * __int_as_float(max(__float_as_int(hi_[e]), 0))
#endif
#define TK_SCORE(bf, kb_) do { f32x4a ac_[2][4]; \
            _Pragma("unroll") for (int kgp = 0; kgp < 2; ++kgp) _Pragma("unroll") for (int rt = 0; rt < 4; ++rt) ac_[kgp][rt] = (f32x4a){0.f, 0.f, 0.f, 0.f}; \
            _Pragma("unroll") for (int ks = 0; ks < 2; ++ks) _Pragma("unroll") for (int rt = 0; rt < 4; ++rt) _Pragma("unroll") for (int kgp = 0; kgp < 2; ++kgp) \
                ac_[kgp][rt] = __builtin_amdgcn_mfma_f32_16x16x32_bf16(af[rt][ks], bf[2 * kgp + ks], ac_[kgp][rt], 0, 0, 0); \
            _Pragma("unroll") for (int kgp = 0; kgp < 2; ++kgp) _Pragma("unroll") for (int qq = 0; qq < 2; ++qq) { TK_HEADSUM(s, wv[qq], ac_[kgp][2 * qq], ac_[kgp][2 * qq + 1]); \
                S[(2 * kg + qq) * 4096 + (kb_) * 32 + kgp * 16 + j16] = s; } } while (0)
#define TK_SCORE2(bf0, kb0_, bf1, kb1_) do { const int kbs_[2] = {(kb0_), (kb1_)}; f32x4a ac_[2][2][4]; \
            _Pragma("unroll") for (int blk = 0; blk < 2; ++blk) _Pragma("unroll") for (int kgp = 0; kgp < 2; ++kgp) _Pragma("unroll") for (int rt = 0; rt < 4; ++rt) ac_[blk][kgp][rt] = (f32x4a){0.f, 0.f, 0.f, 0.f}; \
            _Pragma("unroll") for (int ks = 0; ks < 2; ++ks) _Pragma("unroll") for (int rt = 0; rt < 4; ++rt) _Pragma("unroll") for (int kgp = 0; kgp < 2; ++kgp) { \
                ac_[0][kgp][rt] = __builtin_amdgcn_mfma_f32_16x16x32_bf16(af[rt][ks], bf0[2 * kgp + ks], ac_[0][kgp][rt], 0, 0, 0); ac_[1][kgp][rt] = __builtin_amdgcn_mfma_f32_16x16x32_bf16(af[rt][ks], bf1[2 * kgp + ks], ac_[1][kgp][rt], 0, 0, 0); } \
            _Pragma("unroll") for (int blk = 0; blk < 2; ++blk) _Pragma("unroll") for (int kgp = 0; kgp < 2; ++kgp) _Pragma("unroll") for (int qq = 0; qq < 2; ++qq) { TK_HEADSUM(s, wv[qq], ac_[blk][kgp][2 * qq], ac_[blk][kgp][2 * qq + 1]); \
                S[(2 * kg + qq) * 4096 + kbs_[blk] * 32 + kgp * 16 + j16] = s; } } while (0)
        if (wid + 8 < nkb) TK_LOADB(bB, wid + 8);
        bf16x8 bC[4], bD[4];
        for (int kb = wid; kb < nkb; kb += 32) {
            if (kb + 16 < nkb) { TK_LOADB(bC, kb + 16); if (kb + 24 < nkb) TK_LOADB(bD, kb + 24); }
            if (kb + 8 < nkb) TK_SCORE2(bA, kb, bB, kb + 8); else TK_SCORE(bA, kb);
            if (kb + 16 < nkb) {
                if (kb + 32 < nkb) { TK_LOADB(bA, kb + 32); if (kb + 40 < nkb) TK_LOADB(bB, kb + 40); }
                if (kb + 24 < nkb) TK_SCORE2(bC, kb + 16, bD, kb + 24); else TK_SCORE(bC, kb + 16);
            }
        }
#undef TK_SCORE2
#undef TK_HEADSUM
#undef TK_LOADB
#undef TK_SCORE
    }
    __syncthreads();
    const int qpos = q0 + wid; const int n = qpos + 1; const int ni = (n + 63) >> 6;
    const float NEG = -__builtin_inff(), PINF = __builtin_inff();
    float sc[64]; float mn0 = PINF, mx0 = NEG;
#define TK_NI(var) int var = ni; asm volatile("" : "+s"(var))
    { TK_NI(nic);
#pragma unroll
      for (int c8 = 0; c8 < 8; ++c8) { if (c8 * 8 < nic) {
#pragma unroll
          for (int e = 0; e < 8; ++e) { const int i = c8 * 8 + e; const int key = 64 * i + lane; const float v = S[wid * 4096 + key]; const bool adm = key <= qpos; sc[i] = adm ? v : NEG; mx0 = fmaxf(mx0, sc[i]); mn0 = fminf(mn0, adm ? v : PINF); } }
        else {
#pragma unroll
          for (int e = 0; e < 8; ++e) sc[c8 * 8 + e] = NEG; } } }
    u64 myword = 0ull;
#ifndef TK_REP_SEL
#define TK_REP_SEL 1
#endif
    for (int rsel_ = 0; rsel_ < TK_REP_SEL; ++rsel_) {
    if (n <= TOPK) {
#pragma unroll
        for (int i = 0; i < 4; ++i) { const u64 w = __ballot(64 * i + lane <= qpos); if (lane == i) myword = w; }
    } else {
        unsigned* hist = (unsigned*)lds_hist + wid * 320; float* cand = (float*)lds_cand + wid * 64;
        float lo = wave_min(mn0), hv = wave_max(mx0);
        int need = TOPK; float T_ = lo; int n_eq = 0; bool done = false, all_eq = false;
        for (int level = 0; level < 48 && !done; ++level) {
            if (!(lo < hv)) { T_ = lo; n_eq = need; done = true; break; }
            const float scale = 255.5f / (hv - lo);
            { unsigned z_ = 0u; asm volatile("" : "+v"(z_)); *(u32x4*)(hist + 4 * lane) = (u32x4){z_, z_, z_, z_}; }
            asm volatile("s_waitcnt lgkmcnt(0)" ::: "memory");
            { TK_NI(nic);
#pragma unroll
              for (int c8 = 0; c8 < 8; ++c8) if (c8 * 8 < nic) {
#pragma unroll
                for (int e = 0; e < 8; ++e) { const float s = sc[c8 * 8 + e]; const float d = s - lo; const bool inr = (s <= hv) && (d >= 0.0f); int bin = (int)(d * scale); bin = bin > 255 ? 255 : bin;
                    bin = inr ? bin : 256 + lane;
                    __hip_atomic_fetch_add(hist + bin, 1u, __ATOMIC_RELAXED, __HIP_MEMORY_SCOPE_WORKGROUP); } } }
            asm volatile("s_waitcnt lgkmcnt(0)" ::: "memory");
            const u32x4 hq = *(const u32x4*)(hist + 4 * lane);
            const int tl = (int)(hq[0] + hq[1] + hq[2] + hq[3]);
            int suf = tl;
#pragma unroll
            for (int o = 1; o < 64; o <<= 1) { const int v = down_i(suf, o); if (lane + o < 64) suf += v; }
            const int above = suf - tl;
            const bool mine = (above < need) && (need <= suf);
            int bsel = 0, cab = 0, cin = 0;
            if (mine) { int c = above;
                if (need <= c + (int)hq[3]) { bsel = 3; cab = c; cin = (int)hq[3]; }
                else { c += (int)hq[3];
                    if (need <= c + (int)hq[2]) { bsel = 2; cab = c; cin = (int)hq[2]; }
                    else { c += (int)hq[2];
                        if (need <= c + (int)hq[1]) { bsel = 1; cab = c; cin = (int)hq[1]; }
                        else { c += (int)hq[1]; bsel = 0; cab = c; cin = (int)hq[0]; } } }
                bsel += 4 * lane; }
            const u64 mm = __ballot(mine); const int src = (int)__ffsll((long long)mm) - 1;
            const int bstar = rdlane_i(bsel, src), cabove = rdlane_i(cab, src), cnt_in = rdlane_i(cin, src);
            need -= cabove;
            if (cnt_in <= 64) {
                int base = 0;
                { TK_NI(nic);
#pragma unroll
                  for (int c8 = 0; c8 < 8; ++c8) if (c8 * 8 < nic) {
#pragma unroll
                    for (int e = 0; e < 8; ++e) { const float s = sc[c8 * 8 + e]; const float d = s - lo; int bin = (int)(d * scale); bin = bin > 255 ? 255 : bin;
                        const bool pr = (s <= hv) && (d >= 0.0f) && (bin == bstar); const u64 bl = __ballot(pr);
                        if (bl) { if (pr) cand[base + __popcll(bl & ((1ull << lane) - 1ull))] = s; base += __popcll(bl); } } } }
                asm volatile("s_waitcnt lgkmcnt(0)" ::: "memory");
                const float v = (lane < cnt_in) ? cand[lane] : NEG;
                int gt = 0, ge = 0;
                for (int j = 0; j < cnt_in; ++j) { const float vj = __int_as_float(__builtin_amdgcn_readlane(__float_as_int(v), j)); gt += (vj > v) ? 1 : 0; ge += (vj >= v) ? 1 : 0; }
                const bool ok = (lane < cnt_in) && (gt < need) && (need <= ge);
                const u64 okm = __ballot(ok); const int s2 = (int)__ffsll((long long)okm) - 1;
                T_ = __int_as_float(rdlane_i(__float_as_int(v), s2)); const int gtT = rdlane_i(gt, s2), geT = rdlane_i(ge, s2); n_eq = need - gtT; all_eq = (n_eq == geT - gtT); done = true;
            } else {
                float mn = PINF, mx = NEG;
#pragma unroll
                for (int i = 0; i < 64; ++i) { const float s = sc[i]; const float d = s - lo; int bin = (int)(d * scale); bin = bin > 255 ? 255 : bin;
                    const bool pr = (s <= hv) && (d >= 0.0f) && bin == bstar; mn = fminf(mn, pr ? s : PINF); mx = fmaxf(mx, pr ? s : NEG); }
                lo = wave_min(mn); hv = wave_max(mx);
            }
        }
        if (all_eq) {
            { TK_NI(nic);
#pragma unroll
              for (int c8 = 0; c8 < 8; ++c8) if (c8 * 8 < nic) {
#pragma unroll
                for (int e = 0; e < 8; ++e) { const int i = c8 * 8 + e; const u64 w = __ballot(sc[i] >= T_); if (lane == i) myword = w; } } }
        } else {
            int eqrun = 0;
#pragma unroll
            for (int i = 0; i < 64; ++i) { const float s = sc[i]; const bool eq = (s == T_); const u64 be = __ballot(eq);
                const int rk = eqrun + __popcll(be & ((1ull << lane) - 1ull));
                const bool sel = (s > T_) || (eq && rk < n_eq);
                const u64 w = __ballot(sel); eqrun += __popcll(be);
                if (lane == i) myword = w; }
        }
    }
    }
    BM[(tok0 + qpos) * 64 + lane] = myword;
    __syncthreads();
}

__device__ __forceinline__ void cumsum_unit(const float* misc32, float* cumb, int b, int h, char* lds, const int tid_in) {
    int tid = tid_in; asm volatile("" : "+v"(tid)); const int wid = tid >> 6, lane = tid & 63;
    float* wsum = (float*)lds;
    float v[8]; float run = 0.f;
#pragma unroll
    for (int j = 0; j < 8; ++j) { run += misc32[((size_t)b * SEQ + tid * 8 + j) * 16 + 8 + h]; v[j] = run; }
    float inc = run;
#pragma unroll
    for (int o = 1; o < 64; o <<= 1) { const float t = up_f(inc, o); if (lane >= o) inc += t; }
    if (lane == 63) wsum[wid] = inc;
    __syncthreads();
    float off = inc - run;
    for (int w = 0; w < wid; ++w) off += wsum[w];
#pragma unroll
    for (int j = 0; j < 8; ++j) cumb[(size_t)h * MTOK + (size_t)b * SEQ + tid * 8 + j] = -LOG2E * (off + v[j]);
    __syncthreads();
}
}

namespace tkr {
typedef short bf16x8 __attribute__((ext_vector_type(8)));
typedef float f32x4 __attribute__((ext_vector_type(4)));
typedef unsigned u32x4 __attribute__((ext_vector_type(4)));
typedef unsigned long long u64;
constexpr int TOPK = 256;
using tk::rdlane_i; using tk::wave_min; using tk::wave_max;

__device__ __forceinline__ u64 select64(const float (&sc)[64], const float mn0, const float mx0, const int qpos, char* lds_hist, char* lds_cand, const int wsel, const int lane) {
    const int n = qpos + 1; const int ni = (n + 63) >> 6;
    const float NEG = -__builtin_inff(), PINF = __builtin_inff();
#define TK_NI(var) int var = ni; asm volatile("" : "+s"(var))
    u64 myword = 0ull;
    if (n <= TOPK) {
#pragma unroll
        for (int i = 0; i < 4; ++i) { const u64 w = __ballot(64 * i + lane <= qpos); if (lane == i) myword = w; }
    } else {
        unsigned* hist = (unsigned*)lds_hist + wsel * 320; float* cand = (float*)lds_cand + wsel * 64;
        float lo = wave_min(mn0), hv = wave_max(mx0);
        int need = TOPK; float T_ = lo; int n_eq = 0; bool done = false, all_eq = false;
        for (int level = 0; level < 48 && !done; ++level) {
            if (!(lo < hv)) { T_ = lo; n_eq = need; done = true; break; }
            const float scale = 255.5f / fmaxf(hv - lo, 1e-30f);
            unsigned pkb[32];
            { unsigned z_ = 0u; asm volatile("" : "+v"(z_)); *(u32x4*)(hist + 4 * lane) = (u32x4){z_, z_, z_, z_}; }
            asm volatile("s_waitcnt lgkmcnt(0)" ::: "memory");
            { TK_NI(nic);
#pragma unroll
              for (int c8 = 0; c8 < 8; ++c8) if (c8 * 8 < nic) {
#pragma unroll
                for (int e = 0; e < 8; ++e) { const float s = sc[c8 * 8 + e]; const float d = s - lo; const bool inr = (s <= hv) && (d >= 0.0f); int bin = (int)(d * scale);
                    bin = inr ? bin : 256 + lane;
                    const unsigned bc_ = (unsigned)bin;
                    if (e & 1) pkb[c8 * 4 + (e >> 1)] |= bc_ << 16; else pkb[c8 * 4 + (e >> 1)] = bc_;
                    __hip_atomic_fetch_add(hist + bin, 1u, __ATOMIC_RELAXED, __HIP_MEMORY_SCOPE_WORKGROUP); } } }
            asm volatile("s_waitcnt lgkmcnt(0)" ::: "memory");
            const u32x4 hq = *(const u32x4*)(hist + 4 * lane);
            const int tl = (int)(hq[0] + hq[1] + hq[2] + hq[3]);
            int suf = tl;
#pragma unroll
            for (int o = 1; o < 64; o <<= 1) { const int v = down_i(suf, o); if (lane + o < 64) suf += v; }
            const int above = suf - tl;
            const bool mine = (above < need) && (need <= suf);
            int bsel = 0, cab = 0, cin = 0;
            if (mine) { int c = above;
                if (need <= c + (int)hq[3]) { bsel = 3; cab = c; cin = (int)hq[3]; }
                else { c += (int)hq[3];
                    if (need <= c + (int)hq[2]) { bsel = 2; cab = c; cin = (int)hq[2]; }
                    else { c += (int)hq[2];
                        if (need <= c + (int)hq[1]) { bsel = 1; cab = c; cin = (int)hq[1]; }
                        else { c += (int)hq[1]; bsel = 0; cab = c; cin = (int)hq[0]; } } }
                bsel += 4 * lane; }
            const u64 mm = __ballot(mine); const int src = (int)__ffsll((long long)mm) - 1;
            const int bstar = rdlane_i(bsel, src), cabove = rdlane_i(cab, src), cnt_in = rdlane_i(cin, src);
            need -= cabove;
            if (cnt_in <= 64) {
                int base = 0;
                { TK_NI(nic);
#pragma unroll
                  for (int c8 = 0; c8 < 8; ++c8) if (c8 * 8 < nic) {
#pragma unroll
                    for (int e = 0; e < 8; ++e) { const float s = sc[c8 * 8 + e];
                        const bool pr = ((pkb[c8 * 4 + (e >> 1)] >> (16 * (e & 1))) & 0xffffu) == (unsigned)bstar; const u64 bl = __ballot(pr);
                        if (bl) { if (pr) cand[base + __popcll(bl & ((1ull << lane) - 1ull))] = s; base += __popcll(bl); } } } }
                asm volatile("s_waitcnt lgkmcnt(0)" ::: "memory");
                const float v = (lane < cnt_in) ? cand[lane] : NEG;
                int gt = 0, ge = 0;
                for (int j = 0; j < cnt_in; ++j) { const float vj = __int_as_float(__builtin_amdgcn_readlane(__float_as_int(v), j)); gt += (vj > v) ? 1 : 0; ge += (vj >= v) ? 1 : 0; }
                const bool ok = (lane < cnt_in) && (gt < need) && (need <= ge);
                const u64 okm = __ballot(ok); const int s2 = (int)__ffsll((long long)okm) - 1;
                T_ = __int_as_float(rdlane_i(__float_as_int(v), s2)); const int gtT = rdlane_i(gt, s2), geT = rdlane_i(ge, s2); n_eq = need - gtT; all_eq = (n_eq == geT - gtT); done = true;
            } else {
                float mn = PINF, mx = NEG;
                { TK_NI(nic);
#pragma unroll
                  for (int c8 = 0; c8 < 8; ++c8) if (c8 * 8 < nic) {
#pragma unroll
                    for (int e = 0; e < 8; ++e) { const float s = sc[c8 * 8 + e];
                        const bool pr = ((pkb[c8 * 4 + (e >> 1)] >> (16 * (e & 1))) & 0xffffu) == (unsigned)bstar; mn = fminf(mn, pr ? s : PINF); mx = fmaxf(mx, pr ? s : NEG); } } }
                lo = wave_min(mn); hv = wave_max(mx);
            }
        }
        if (all_eq) {
            { TK_NI(nic);
#pragma unroll
              for (int c8 = 0; c8 < 8; ++c8) if (c8 * 8 < nic) {
#pragma unroll
                for (int e = 0; e < 8; ++e) { const int i = c8 * 8 + e; const u64 w = __ballot(sc[i] >= T_); if (lane == i) myword = w; } } }
        } else {
            int eqrun = 0;
#pragma unroll
            for (int i = 0; i < 64; ++i) { const float s = sc[i]; const bool eq = (s == T_); const u64 be = __ballot(eq);
                const int rk = eqrun + __popcll(be & ((1ull << lane) - 1ull));
                const bool sel = (s > T_) || (eq && rk < n_eq);
                const u64 w = __ballot(sel); eqrun += __popcll(be);
                if (lane == i) myword = w; }
        }
    }

#undef TK_NI
    (void)PINF;
    return myword;
}

__device__ __forceinline__ void regsel_unit(const unsigned short* EP, const float* misc32, u64* BM, int b, int g16, char* lds, char* lds_hist, char* lds_cand, const int tid_in) {
    int tid = tid_in; asm volatile("" : "+v"(tid)); const int wid = __builtin_amdgcn_readfirstlane(tid >> 6), lane = tid & 63, hi = lane >> 5, j16 = lane & 15, kg = lane >> 4;
    const bool godd = (kg & 1) != 0;
    const int q0 = g16 * 16; const size_t tok0 = (size_t)b * SEQ; const int qpos = q0 + 2 * wid + hi;
    char* kst = lds;
    bf16x8 af[2];
#pragma unroll
    for (int ks = 0; ks < 2; ++ks) af[ks] = *(const bf16x8*)(EP + (tok0 + q0 + 2 * wid + (j16 >> 3)) * N_E_IN + 768 + (j16 & 7) * 64 + ks * 32 + kg * 8);
    const f32x4 wq = *(const f32x4*)(misc32 + (tok0 + qpos) * 16 + (godd ? 4 : 0));
    const int nkb = (q0 + 16 + 31) >> 5, nch = (nkb + 3) >> 2;
    typedef __attribute__((address_space(3))) unsigned lds_u32; typedef __attribute__((address_space(3))) char lds_char;
    const unsigned short* gsrc = EP + (tok0 + 8 * wid + (lane >> 3)) * N_E_IN + 1280 + (((lane & 7) ^ ((lane >> 3) & 7)) << 3);
#define TKR_ISSUE(c_) do { const char* gp_ = (const char*)(gsrc + (size_t)(c_) * 128 * N_E_IN); lds_char* d_ = (lds_char*)(kst + ((c_) & 7) * 16384 + wid * 1024); \
        __builtin_amdgcn_global_load_lds((const unsigned*)gp_, (lds_u32*)d_, 16, 0, 0); __builtin_amdgcn_global_load_lds((const unsigned*)(gp_ + (size_t)64 * N_E_IN * 2), (lds_u32*)(d_ + 8192), 16, 0, 0); } while (0)
    const int frow = j16 * 128, fsw = j16 & 7;
    const int klim = qpos - (lane & 31);
    const float NEGI = -__builtin_inff(); const float NANV = __builtin_nanf("");
    float blk[128];
#define TKR_HALF(c_, h_) do { \
        f32x4 a0_[2], a1_[2]; \
        _Pragma("unroll") for (int b2 = 0; b2 < 2; ++b2) { const int bl = 2 * (h_) + b2; a0_[b2] = (f32x4){0.f, 0.f, 0.f, 0.f}; a1_[b2] = (f32x4){0.f, 0.f, 0.f, 0.f}; \
            _Pragma("unroll") for (int ks = 0; ks < 2; ++ks) { const int off_ = bl * 4096 + (((ks * 4 + kg) ^ fsw) << 4); \
                const bf16x8 b0_ = *(const bf16x8*)(kc_ + off_), b1_ = *(const bf16x8*)(kc_ + 16 * 128 + off_); \
                a0_[b2] = __builtin_amdgcn_mfma_f32_16x16x32_bf16(af[ks], b0_, a0_[b2], 0, 0, 0); a1_[b2] = __builtin_amdgcn_mfma_f32_16x16x32_bf16(af[ks], b1_, a1_[b2], 0, 0, 0); } } \
        _Pragma("unroll") for (int b2 = 0; b2 < 2; ++b2) { \
            float p0 = wq[0] * __int_as_float(max(__float_as_int(a0_[b2][0]), 0)), p1 = wq[0] * __int_as_float(max(__float_as_int(a1_[b2][0]), 0)); \
            _Pragma("unroll") for (int e = 1; e < 4; ++e) { p0 = __builtin_fmaf(wq[e], __int_as_float(max(__float_as_int(a0_[b2][e]), 0)), p0); p1 = __builtin_fmaf(wq[e], __int_as_float(max(__float_as_int(a1_[b2][e]), 0)), p1); } \
              \
            const auto sw_ = __builtin_amdgcn_permlane16_swap(__float_as_uint(p0), __float_as_uint(p1), false, false); const float s_ = __uint_as_float(sw_[0]) + __uint_as_float(sw_[1]); blk[4 * (c_) + 2 * (h_) + b2] = ((4 * (c_) + 2 * (h_) + b2) * 32 <= klim) ? s_ : NANV; } } while (0)
#define TKR_CHUNK(c_) do { const char* kc_ = kst + ((c_) & 7) * 16384 + frow; TKR_HALF(c_, 0); __builtin_amdgcn_sched_barrier(0); TKR_HALF(c_, 1); } while (0)
    asm volatile("" ::: "memory");
    __builtin_amdgcn_s_barrier();
    asm volatile("" ::: "memory");
#pragma unroll
    for (int c = 0; c < 6; ++c) if (c < nch) TKR_ISSUE(c);
#define TKR_STEP(c_) do { if ((c_) < nch) { const int r_ = nch - 1 - (c_); \
            if (r_ >= 5) asm volatile("s_waitcnt vmcnt(10)" ::: "memory"); else if (r_ == 4) asm volatile("s_waitcnt vmcnt(8)" ::: "memory"); else if (r_ == 3) asm volatile("s_waitcnt vmcnt(6)" ::: "memory"); \
            else if (r_ == 2) asm volatile("s_waitcnt vmcnt(4)" ::: "memory"); else if (r_ == 1) asm volatile("s_waitcnt vmcnt(2)" ::: "memory"); else asm volatile("s_waitcnt vmcnt(0)" ::: "memory"); \
            __builtin_amdgcn_s_barrier(); asm volatile("" ::: "memory"); \
            if ((c_) + 6 < nch) TKR_ISSUE((c_) + 6); \
            TKR_CHUNK(c_); } \
        else { _Pragma("unroll") for (int bl = 0; bl < 4; ++bl) blk[4 * (c_) + bl] = NANV; } } while (0)
#pragma unroll
    for (int c = 0; c < 32; ++c) TKR_STEP(c);
#undef TKR_STEP
#undef TKR_CHUNK
#undef TKR_HALF
#undef TKR_ISSUE
#pragma unroll
    for (int i = 0; i < 64; ++i) { auto rr = __builtin_amdgcn_permlane32_swap(__float_as_uint(blk[2 * i]), __float_as_uint(blk[2 * i + 1]), false, false); blk[2 * i] = __uint_as_float(rr[0]); blk[2 * i + 1] = __uint_as_float(rr[1]); }
#pragma unroll
    for (int qq = 0; qq < 2; ++qq) {
        const int qp = q0 + 2 * wid + qq;
        float sc[64]; float mn0 = __builtin_inff(), mx0 = NEGI;
#pragma unroll
        for (int i = 0; i < 64; ++i) { const float v = blk[2 * i + qq]; sc[i] = v; mx0 = fmaxf(mx0, v); mn0 = fminf(mn0, v); }
        const u64 word = select64(sc, mn0, mx0, qp, lds_hist, lds_cand, wid, lane);
        BM[(tok0 + qp) * 64 + lane] = word;
    }
}
}

namespace ssd {
typedef short bf16x8 __attribute__((ext_vector_type(8)));
typedef float f32x16 __attribute__((ext_vector_type(16)));
typedef float f32x4 __attribute__((ext_vector_type(4)));
typedef unsigned u32x4 __attribute__((ext_vector_type(4)));
typedef unsigned u32x2 __attribute__((ext_vector_type(2)));
constexpr int LD = 136;
constexpr int O_CS = 0, O_BS = 34816, O_BWT = 69632, O_XT = 104448, O_SB = 121856;
constexpr int ZLD = 72;
__device__ __forceinline__ unsigned short f2bf16(float f) { unsigned u = __float_as_uint(f); return (unsigned short)((u + 0x7fffu + ((u >> 16) & 1u)) >> 16); }
__device__ __forceinline__ float bf2f(unsigned short h) { return __uint_as_float(((unsigned)h) << 16); }
typedef float f32x2_t __attribute__((ext_vector_type(2))); typedef __bf16 bf16x2_t __attribute__((ext_vector_type(2)));
__device__ __forceinline__ unsigned pk_v(float lo, float hi) { const f32x2_t v = {lo, hi}; const bf16x2_t b = __builtin_convertvector(v, bf16x2_t); return __builtin_bit_cast(unsigned, b); }
__device__ __forceinline__ unsigned pk(float lo, float hi) { unsigned r; asm volatile("v_cvt_pk_bf16_f32 %0, %1, %2" : "=v"(r) : "v"(lo), "v"(hi)); return r; }
template <int NK>
__device__ __forceinline__ f32x16 mma(const unsigned short* Ab, const unsigned short* Bb, f32x16 acc, int hi) {
    bf16x8 a[NK], b[NK];
#pragma unroll
    for (int d0 = 0; d0 < NK; ++d0) { a[d0] = *(const bf16x8*)(Ab + d0 * 16 + hi * 8); b[d0] = *(const bf16x8*)(Bb + d0 * 16 + hi * 8); }
#pragma unroll
    for (int d0 = 0; d0 < NK; ++d0) acc = __builtin_amdgcn_mfma_f32_32x32x16_bf16(a[d0], b[d0], acc, 0, 0, 0);
    return acc;
}
__device__ __forceinline__ float siluf(float v) { return v * __builtin_amdgcn_rcpf(1.0f + __expf(-v)); }

__device__ __forceinline__ void conv_halo_save(const unsigned short* XBC, unsigned short* HALO, int unit, const int tid) {
    const int b = unit >> 5, c = unit & 31, cg = tid & 255, rh = tid >> 8; const long tb = (long)b * SEQ + c * 128;
#pragma unroll
    for (int k = 0; k < 3; ++k) { const long l = tb + rh * 64 - 3 + k; u32x4 v = (u32x4){0u, 0u, 0u, 0u};
        if (!(c == 0 && rh == 0)) v = *(const u32x4*)(XBC + (size_t)l * 2048 + cg * 8);
        *(u32x4*)(HALO + ((size_t)(unit * 2 + rh) * 3 + k) * 2048 + cg * 8) = v; }
}
__device__ __forceinline__ void conv_unit(unsigned short* XBC, const unsigned short* HALO, const float* conv_w, const float* conv_b, int unit, const int tid) {
    const int b = unit >> 5, c = unit & 31, cg = tid & 255, rh = tid >> 8; const size_t tb = (size_t)b * SEQ + (size_t)c * 128 + rh * 64; const int col = cg * 8;
    float cw[4][8], cb[8], r0[8], r1[8], r2[8];
#pragma unroll
    for (int j = 0; j < 4; ++j) { const f32x4 w0 = *(const f32x4*)(conv_w + j * 2048 + col), w1 = *(const f32x4*)(conv_w + j * 2048 + col + 4);
#pragma unroll
        for (int e = 0; e < 4; ++e) { cw[j][e] = w0[e]; cw[j][4 + e] = w1[e]; } }
    { const f32x4 b0 = *(const f32x4*)(conv_b + col), b1 = *(const f32x4*)(conv_b + col + 4);
#pragma unroll
      for (int e = 0; e < 4; ++e) { cb[e] = b0[e]; cb[4 + e] = b1[e]; } }
#define CV_UNPK(dst, raw) do { _Pragma("unroll") for (int e = 0; e < 4; ++e) { dst[2 * e] = __uint_as_float(raw[e] << 16); dst[2 * e + 1] = __uint_as_float(raw[e] & 0xffff0000u); } } while (0)
    { const unsigned short* hp = HALO + ((size_t)(unit * 2 + rh) * 3) * 2048 + col;
      const u32x4 h0 = *(const u32x4*)hp, h1 = *(const u32x4*)(hp + 2048), h2 = *(const u32x4*)(hp + 4096); CV_UNPK(r0, h0); CV_UNPK(r1, h1); CV_UNPK(r2, h2); }
    unsigned short* base = XBC + tb * 2048 + col;
    for (int i0 = 0; i0 < 64; i0 += 8) {
        u32x4 raw[8];
#pragma unroll
        for (int i = 0; i < 8; ++i) raw[i] = *(const u32x4*)(base + (size_t)(i0 + i) * 2048);
#pragma unroll
        for (int i = 0; i < 8; ++i) { float cur[8], val[8]; CV_UNPK(cur, raw[i]);
#pragma unroll
            for (int e = 0; e < 8; ++e) { const float v = cb[e] + cw[0][e] * r0[e] + cw[1][e] * r1[e] + cw[2][e] * r2[e] + cw[3][e] * cur[e];
                val[e] = v * __builtin_amdgcn_rcpf(1.0f + __expf(-v)); r0[e] = r1[e]; r1[e] = r2[e]; r2[e] = cur[e]; }
            u32x4 w; w.x = pk(val[0], val[1]); w.y = pk(val[2], val[3]); w.z = pk(val[4], val[5]); w.w = pk(val[6], val[7]);
            *(u32x4*)(base + (size_t)(i0 + i) * 2048) = w; }
    }
#undef CV_UNPK
}

__device__ __forceinline__ void ssd_unit(const unsigned short* XBC, unsigned short* AO, unsigned short* Yo, int ldy, const float* dt32, float* ssy,
                                         float a_log_h, float d_skip_h, int b, int h, char* lds, char* lds_small, const int tid_in) {
    int tid = tid_in; asm volatile("" : "+v"(tid)); const int wid = __builtin_amdgcn_readfirstlane(tid >> 6), lane = tid & 63, r32 = lane & 31, hi = lane >> 5;
    unsigned short* Cs = (unsigned short*)(lds + O_CS); unsigned short* Bs = (unsigned short*)(lds + O_BS); unsigned short* BwT = (unsigned short*)(lds + O_BWT);
    unsigned short* xT = (unsigned short*)(lds + O_XT); unsigned short* Sb = (unsigned short*)(lds + O_SB);
    unsigned short* Ms = Bs; unsigned short* Ys = Bs; unsigned short* Zs = Cs;
    float* cumL = (float*)lds_small; float* dtL = cumL + 128; float* wL = cumL + 256;
    const int g = h >> 2; const float Ah = -__expf(a_log_h);
    for (int i = tid; i < 64 * LD / 2; i += 512) ((unsigned*)Sb)[i] = 0u;
    f32x16 accS = {};
    const int li2 = wid & 3, pi = wid >> 2;
    const unsigned short* gB = XBC + 1024 + g * 128 + (tid & 15) * 8; const unsigned short* gC = XBC + 1536 + g * 128 + (tid & 15) * 8; const unsigned short* gX = XBC + h * 64 + (wid >> 2) * 32 + 8 * hi + (size_t)((wid & 3) * 32 + r32) * 2048;
    u32x4 tB[4], tC[4], tX[2], zreg[2]; float dtn = 0.f, dtn1 = 0.f;
#define SSD_FETCH(cc) do { const size_t tb_ = (size_t)b * SEQ + (size_t)(cc) * 128; \
        _Pragma("unroll") for (int i = 0; i < 4; ++i) { const size_t row = tb_ + (tid >> 4) + 32 * i; tB[i] = *(const u32x4*)(gB + row * 2048); tC[i] = *(const u32x4*)(gC + row * 2048); } \
        _Pragma("unroll") for (int i = 0; i < 2; ++i) { const size_t row = tb_ + (tid >> 3) + 64 * i; tX[i] = *(const u32x4*)(gX + tb_ * 2048 + 16 * i); \
            zreg[i] = *(const u32x4*)(AO + row * K_O_OUT + 512 + h * 64 + (tid & 7) * 8); } \
        if (wid == 0) { dtn = dt32[(tb_ + 2 * lane) * 16 + h]; dtn1 = dt32[(tb_ + 2 * lane + 1) * 16 + h]; } } while (0)
    bf16x8 idf[2];
#pragma unroll
    for (int s = 0; s < 2; ++s)
#pragma unroll
        for (int e = 0; e < 8; ++e) idf[s][e] = (16 * s + 8 * hi + e == r32) ? (short)0x3F80 : (short)0;
    SSD_FETCH(0);
    __syncthreads();
    for (int c = 0; c < SEQ / 128; ++c) {
        const size_t tb = (size_t)b * SEQ + (size_t)c * 128;
#ifndef SSD_RP1
#define SSD_RP1 1
#define SSD_RP2 1
#define SSD_RP3 1
#define SSD_RP5 1
#endif
        if (wid == 0) { const float d0 = dtn, d1 = dtn1; const float a0 = d0 * Ah, a1 = d1 * Ah; float inc = a0 + a1;
#pragma unroll
            for (int o = 1; o < 64; o <<= 1) { const float t = up_f(inc, o); if (lane >= o) inc += t; }
            const float c1 = inc, c0 = inc - a1; const float ce = __int_as_float(__builtin_amdgcn_readlane(__float_as_int(inc), 63));
            typedef float f32x2_ __attribute__((ext_vector_type(2)));
            *(f32x2_*)(dtL + 2 * lane) = (f32x2_){d0, d1}; *(f32x2_*)(cumL + 2 * lane) = (f32x2_){c0, c1};
            *(f32x2_*)(wL + 2 * lane) = (f32x2_){d0 * __expf(ce - c0), d1 * __expf(ce - c1)}; }
        __syncthreads();
        const float cend = cumL[127];
        for (int rp2 = 0; rp2 < SSD_RP2; ++rp2) {
#pragma unroll
        for (int i = 0; i < 4; ++i) { const int row = (tid >> 4) + 32 * i, c0 = (tid & 15) * 8; *(u32x4*)(Cs + row * LD + c0) = tC[i]; *(u32x4*)(Bs + row * LD + c0) = tB[i]; }
        }
        const bf16x8 xf0 = __builtin_bit_cast(bf16x8, tX[0]), xf1 = __builtin_bit_cast(bf16x8, tX[1]);
        u32x4 zcur[2] = {zreg[0], zreg[1]};
        if (c + 1 < SEQ / 128) SSD_FETCH(c + 1);
        __syncthreads();
        { const int lt = wid >> 1;
#pragma unroll
          for (int q2 = 0; q2 < 2; ++q2) { const int nt = 2 * (wid & 1) + q2; const unsigned short* tp = Bs + (lt * 32 + r32) * LD + nt * 32 + 8 * hi;
              f32x16 t = {}; t = __builtin_amdgcn_mfma_f32_32x32x16_bf16(*(const bf16x8*)tp, idf[0], t, 0, 0, 0); t = __builtin_amdgcn_mfma_f32_32x32x16_bf16(*(const bf16x8*)(tp + 16), idf[1], t, 0, 0, 0);
#pragma unroll
              for (int j = 0; j < 4; ++j) { const int l0 = lt * 32 + 8 * j + 4 * hi; const f32x4 w4 = *(const f32x4*)(wL + l0); float v[4];
#pragma unroll
                  for (int e = 0; e < 4; ++e) v[e] = t[4 * j + e] * w4[e];
                  u32x2 w; w.x = pk(v[0], v[1]); w.y = pk(v[2], v[3]); *(u32x2*)(BwT + (nt * 32 + r32) * LD + l0) = w; } }
          const int lx = wid & 3, pt = wid >> 2;
          f32x16 t = {}; t = __builtin_amdgcn_mfma_f32_32x32x16_bf16(xf0, idf[0], t, 0, 0, 0); t = __builtin_amdgcn_mfma_f32_32x32x16_bf16(xf1, idf[1], t, 0, 0, 0);
#pragma unroll
          for (int j = 0; j < 4; ++j) { u32x2 w; w.x = pk_v(t[4 * j], t[4 * j + 1]); w.y = pk_v(t[4 * j + 2], t[4 * j + 3]); *(u32x2*)(xT + (pt * 32 + r32) * LD + lx * 32 + 8 * j + 4 * hi) = w; } }
        unsigned mreg[2][8]; f32x16 accY = {};
        for (int rp3 = 0; rp3 < SSD_RP3; ++rp3) { accY = f32x16{};
        { const int li = wid >> 1; const int l = li * 32 + r32; const float cl = cumL[l];
#pragma unroll
          for (int q = 0; q < 2; ++q) { const int si = 2 * (wid & 1) + q;
              if (si <= li) { f32x16 acc = {}; acc = mma<8>(Bs + (si * 32 + r32) * LD, Cs + l * LD, acc, hi);
#pragma unroll
                  for (int j = 0; j < 4; ++j) { const int s0 = si * 32 + 8 * j + 4 * hi; const f32x4 cs4 = *(const f32x4*)(cumL + s0), dt4 = *(const f32x4*)(dtL + s0); float mv[4];
#pragma unroll
                      for (int e = 0; e < 4; ++e) { mv[e] = (s0 + e <= l) ? acc[4 * j + e] * __expf(cl - cs4[e]) * dt4[e] : 0.f; if (s0 + e == l) mv[e] += d_skip_h; }
                      mreg[q][2 * j] = pk(mv[0], mv[1]); mreg[q][2 * j + 1] = pk(mv[2], mv[3]); } }
              else {
#pragma unroll
                  for (int j = 0; j < 8; ++j) mreg[q][j] = 0u; } } }
        { const int l = li2 * 32 + r32; accY = mma<8>(Sb + (pi * 32 + r32) * LD, Cs + l * LD, accY, hi); const float el = __expf(cumL[l]);
#pragma unroll
          for (int r = 0; r < 16; ++r) accY[r] *= el; }
        }
        __syncthreads();
        { const int li = wid >> 1; const int l = li * 32 + r32;
#pragma unroll
          for (int q = 0; q < 2; ++q) { const int si = 2 * (wid & 1) + q;
#pragma unroll
              for (int j = 0; j < 4; ++j) { u32x2 w; w.x = mreg[q][2 * j]; w.y = mreg[q][2 * j + 1]; *(u32x2*)(Ms + l * LD + si * 32 + 8 * j + 4 * hi) = w; } } }
#pragma unroll
        for (int i = 0; i < 2; ++i) { const int row = (tid >> 3) + 64 * i, ch = tid & 7; *(u32x4*)(Zs + row * ZLD + ch * 8) = zcur[i]; }
        __syncthreads();
        unsigned yreg[8]; float ssq = 0.f;
        { const int l = li2 * 32 + r32;
          accY = mma<8>(xT + (pi * 32 + r32) * LD, Ms + l * LD, accY, hi);
          const float dec = __expf(cend);
#pragma unroll
          for (int r = 0; r < 16; ++r) accS[r] *= dec;
          accS = mma<8>(BwT + (li2 * 32 + r32) * LD, xT + (pi * 32 + r32) * LD, accS, hi);
#pragma unroll
          for (int j = 0; j < 4; ++j) { const int p0 = pi * 32 + 8 * j + 4 * hi; const u32x2 zz = *(const u32x2*)(Zs + l * ZLD + p0); float yg[4];
#pragma unroll
              for (int e = 0; e < 4; ++e) { const float y = accY[4 * j + e];
                  const float zv = (e & 1) ? __uint_as_float(zz[e >> 1] & 0xffff0000u) : __uint_as_float(zz[e >> 1] << 16);
                  yg[e] = y * siluf(zv); ssq += yg[e] * yg[e]; }
              yreg[2 * j] = pk(yg[0], yg[1]); yreg[2 * j + 1] = pk(yg[2], yg[3]); }
          ssq += xor_f<32>(ssq);
          if (hi == 0) ssy[(tb + l) * 32 + h * 2 + pi] = ssq; }
        __syncthreads();
        { const int l = li2 * 32 + r32;
#pragma unroll
          for (int j = 0; j < 4; ++j) { u32x2 w; w.x = yreg[2 * j]; w.y = yreg[2 * j + 1]; *(u32x2*)(Ys + l * ZLD + pi * 32 + 8 * j + 4 * hi) = w; }
          const int p = pi * 32 + r32;
#pragma unroll
          for (int j = 0; j < 4; ++j) { u32x2 w; w.x = pk(accS[4 * j], accS[4 * j + 1]); w.y = pk(accS[4 * j + 2], accS[4 * j + 3]); *(u32x2*)(Sb + p * LD + li2 * 32 + 8 * j + 4 * hi) = w; } }
        __syncthreads();
#pragma unroll
        for (int i = 0; i < 2; ++i) { const int idx = tid + 512 * i, row = idx >> 3, ch = idx & 7; *(u32x4*)(Yo + (tb + row) * ldy + h * 64 + ch * 8) = *(const u32x4*)(Ys + row * ZLD + ch * 8); }
    }
    __syncthreads();
#undef SSD_FETCH
}
}

constexpr int NWAVES = 8;
#ifndef EN_MASK
#define EN_MASK 0xFFFF
#endif
#ifndef REP_MASK
#define REP_MASK 0
#endif
#define REPS(b) ((((REP_MASK) >> (b)) & 1) + 1)
#define EN(b) (((EN_MASK) >> (b)) & 1)
struct Args {
    const float* in[28]; float* out; unsigned char* ws; int ph_lo, ph_hi;
};
struct Frame {
    LAS unsigned char* lds; volatile LAS unsigned* MISC; gu32* ctl; int tid, lane, wave, G;
};
typedef pg8::bf16_t bf16_t;

enum { MAP_ID = 0, MAP_EVEN_IN = 1, MAP_ODD_IN = 2, MAP_UQ = 3 };
__device__ __forceinline__ int colmap(int map, int n) {
    if (map == MAP_EVEN_IN) { if (n < 1352) return n; if (n < 1356) return 2888 + (n - 1352); if (n < 1536) return -1; return 1352 + (n - 1536); }
    if (map == MAP_ODD_IN) { if (n < 640) return n; if (n < 704) { const int jj = n - 640; return 640 + ((jj & 1) ? 32 : 0) + (jj >> 1); } if (n < 720) return 3776 + (n - 704); if (n < 768) return -1; return 704 + (n - 768); }
    if (map == MAP_UQ) { const int h = n >> 8, j = n & 255; if (j < 128) return 192 * h + j; if (j < 192) { const int jj = j - 128; return 192 * h + 128 + ((jj & 1) ? 32 : 0) + (jj >> 1); } return -1; }
    return n;
}
struct WJob { const float* W; bf16* dst; const float* gain; int K, Nsrc, Ndst, map, gk0; };
__device__ __forceinline__ void wconv_item(const WJob& J, LAS float* scr, int item, int lane) {
    const int nblk = J.Ndst / 32, kb = item / nblk, nb = item % nblk, k0 = 64 * kb, n0 = 32 * nb;
    const int sc = colmap(J.map, n0 + (lane & 31));
    float wv_[32];
#pragma unroll
    for (int i = 0; i < 32; ++i) { const int kk = 2 * i + (lane >> 5); wv_[i] = (sc >= 0) ? J.W[(size_t)(k0 + kk) * J.Nsrc + sc] : 0.f; }
#pragma unroll
    for (int i = 0; i < 32; ++i) { const int kk = 2 * i + (lane >> 5); float v = wv_[i];
        if (J.gain && (k0 + kk) >= J.gk0) v *= J.gain[k0 + kk - J.gk0];
        scr[kk * 33 + (lane & 31)] = v; }
    LDS_WAIT(); asm volatile("" ::: "memory");
    const int c = lane & 7;
#pragma unroll
    for (int j = 0; j < 4; ++j) { const int n = (lane >> 3) + 8 * j; const LAS float* s = scr + (8 * c) * 33 + n;
        v4u o; o.x = pk2(s[0 * 33], s[1 * 33]); o.y = pk2(s[2 * 33], s[3 * 33]); o.z = pk2(s[4 * 33], s[5 * 33]); o.w = pk2(s[6 * 33], s[7 * 33]);
        *(GAS v4u*)(J.dst + (size_t)(n0 + n) * J.K + k0 + 8 * c) = o; }
    LDS_WAIT(); asm volatile("" ::: "memory");
}
__device__ __forceinline__ float wave_sum(float v) { return wsum_f(v); }

__global__ void __launch_bounds__(NWAVES * 64, 2) trunk_fwd(Args args) {
    extern __shared__ __attribute__((aligned(16))) unsigned char lds[];
    {
        LAS unsigned char* L0 = (LAS unsigned char*)lds; const int t0 = threadIdx.x;
        for (int u = t0; u < (LDS_BYTES - LDS_MISC) / 4; u += NWAVES * 64) ((LAS unsigned*)(L0 + LDS_MISC))[u] = 0u;
        __syncthreads();
        volatile LAS unsigned* pt0 = (volatile LAS unsigned*)(L0 + LDS_MISC + 128);
        if (t0 < 30) { const unsigned long long p = (t0 < 28) ? (unsigned long long)args.in[t0] : (t0 == 28 ? (unsigned long long)args.out : (unsigned long long)args.ws);
            pt0[2 * t0] = (unsigned)p; pt0[2 * t0 + 1] = (unsigned)(p >> 32); }
        __syncthreads();
    }
    const int wave_s = __builtin_amdgcn_readfirstlane((int)(threadIdx.x >> 6));
#define PTR(k) ((const float*)(const GAS float*)(((unsigned long long)(unsigned)__builtin_amdgcn_readfirstlane((int)ptab[2 * (k) + 1]) << 32) | (unsigned long long)(unsigned)__builtin_amdgcn_readfirstlane((int)ptab[2 * (k)])))
    XcdBarrier bar = xcd_barrier_post((unsigned*)((gu32*)(args.ws + WS_CTL) + CW_BAR), (volatile LAS unsigned*)((LAS unsigned char*)lds + LDS_MISC) + 8, otid(wave_s));
    const int lo = args.ph_lo, hi = args.ph_hi;
#define IN(k) (lo <= (k) && (k) < hi)
#if defined(TPROF)
#define TSTAMP(i) do { if (blockIdx.x == 0 && threadIdx.x == 0) ((volatile LAS unsigned*)((LAS unsigned char*)lds + LDS_MISC + 384))[(i)] = (unsigned)__builtin_amdgcn_s_memrealtime(); } while (0)
#else
#define TSTAMP(i) do { } while (0)
#endif
#define SEAM2(k, kn) do { if (IN(k) && IN(kn)) xcd_barrier(bar, otid(wave_s)); TSTAMP((k) + 1); } while (0)
#define SEAM(k) SEAM2(k, (k) + 1)
    TSTAMP(0);
#define ENV_NOLAYER() \
        LAS unsigned char* L_ = (LAS unsigned char*)lds; asm volatile("" : "+s"(L_)); \
        int bid = blockIdx.x; asm volatile("" : "+s"(bid)); int GG = gridDim.x; asm volatile("" : "+s"(GG)); \
        const int tid = otid(wave_s); \
        volatile LAS unsigned* ptab = (volatile LAS unsigned*)(L_ + LDS_MISC + 128); \
        unsigned char* ws = (unsigned char*)PTR(29); float* out = (float*)PTR(28);
#define ENV() \
        LAS unsigned char* L_ = (LAS unsigned char*)lds; asm volatile("" : "+s"(L_)); \
        int bid = blockIdx.x; asm volatile("" : "+s"(bid)); int GG = gridDim.x; asm volatile("" : "+s"(GG)); \
        const int tid = otid(wave_s); const int lane = tid & 63; const int wave = __builtin_amdgcn_readfirstlane(tid >> 6); (void)lane; (void)wave; (void)bid; (void)GG; \
        char* glds = (char*)L_; PG8_LAS float* stat = (PG8_LAS float*)(L_ + LDS_STAT); volatile LAS unsigned* MISCp = (volatile LAS unsigned*)(L_ + LDS_MISC); \
        volatile LAS unsigned* ptab = (volatile LAS unsigned*)(L_ + LDS_MISC + 128); (void)glds; (void)stat; (void)MISCp; \
        unsigned char* ws = (unsigned char*)PTR(29); float* out = (float*)PTR(28); gu32* ctl = (gu32*)(ws + WS_CTL); (void)out; (void)ctl; \
        float* ssp = (float*)(ws + WS_SSP); float* cumb = (float*)(ws + WS_CUMB); float* misc32 = (float*)(ws + WS_MISC32); float* gss = (float*)(ws + WS_GSS); \
        float* ssy = (float*)(ws + WS_SSY); float* rope = (float*)(ws + WS_ROPE); unsigned long long* BM = (unsigned long long*)(ws + WS_BM); \
        bf16* XB = (bf16*)(ws + WS_XB); bf16* QB = (bf16*)out; \
        bf16* EP = (bf16*)(ws + WS_R + R_EP); bf16* AOE = (bf16*)(ws + WS_R + R_AOE); \
        bf16* C1 = (bf16*)(ws + WS_R + R_C1); bf16* AO = (bf16*)(ws + WS_R + R_AO); bf16* XBC = (bf16*)(ws + WS_R + R_XBC); bf16* KK = (bf16*)(ws + WS_R + R_KK); bf16* VV = (bf16*)(ws + WS_R + R_VV); \
        bf16* HB = (bf16*)(ws + WS_R + R_H); unsigned char* wsw = ws + WS_W; \
        const bf16* W1t = (const bf16*)(wsw + ((layer & 1) ? WO_1 : WE_1)); const bf16* W2t = (const bf16*)(wsw + ((layer & 1) ? WO_2 : WE_2)); \
        (void)ssp; (void)cumb; (void)misc32; (void)gss; (void)ssy; (void)rope; (void)BM; (void)XB; (void)QB; (void)EP; (void)AOE; (void)C1; (void)AO; (void)XBC; (void)KK; (void)VV; (void)HB; (void)W1t; (void)W2t;

    {
        constexpr int layer = 0;
        const int li = layer >> 1; const int gp0 = layer * 8;
        if ((layer & 1) == 0) {
            for (int rep = 0; rep < REPS(0); ++rep) { if (rep) xcd_barrier(bar, otid(wave_s));
            if (EN(0) && IN(gp0 + 0)) { ENV();
                LAS float* scr = (LAS float*)(L_ + wave * 16384);
                const int gw = bid * NWAVES + wave, NGW = GG * NWAVES;
                int it = gw;
#define WJOB(Wp, dstp, gainp, K_, Nsrc_, Ndst_, map_, gk0_) do { const WJob J_{Wp, dstp, gainp, K_, Nsrc_, Ndst_, map_, gk0_}; const int nit_ = ((K_) / 64) * ((Ndst_) / 32); \
                    for (; it < nit_; it += NGW) wconv_item(J_, scr, it, lane); it -= nit_; } while (0)
                WJOB(PTR(3) + (size_t)li * 1024 * 2892, (bf16*)(wsw + WE_IN), PTR(2) + li * 1024, 1024, 2892, 3072, MAP_EVEN_IN, 0);
                WJOB(PTR(9) + (size_t)li * 1024 * 1024, (bf16*)(wsw + WE_OUT), (const float*)nullptr, 1024, 1024, 1024, MAP_ID, 0);
                WJOB(PTR(26) + (size_t)(2 * li) * 1024 * 4096, (bf16*)(wsw + WE_1), PTR(25) + (2 * li) * 1024, 1024, 4096, 4096, MAP_ID, 0);
                WJOB(PTR(27) + (size_t)(2 * li) * 4096 * 1024, (bf16*)(wsw + WE_2), (const float*)nullptr, 4096, 1024, 1024, MAP_ID, 0);
                WJOB(PTR(11) + (size_t)li * 1024 * 3792, (bf16*)(wsw + WO_IN), PTR(10) + li * 1024, 1024, 3792, 3840, MAP_ODD_IN, 0);
                WJOB(PTR(14) + (size_t)li * 384 * 768, (bf16*)(wsw + WO_UQ), PTR(12) + li * 384, 384, 768, 1024, MAP_UQ, 0);
                WJOB(PTR(15) + (size_t)li * 256 * 1024, (bf16*)(wsw + WO_UKV), PTR(13) + li * 256, 256, 1024, 1024, MAP_ID, 0);
                WJOB(PTR(24) + (size_t)li * 1536 * 1024, (bf16*)(wsw + WO_OUT), PTR(23) + li * 1024, 1536, 1024, 1024, MAP_ID, 512);
                WJOB(PTR(26) + (size_t)(2 * li + 1) * 1024 * 4096, (bf16*)(wsw + WO_1), PTR(25) + (2 * li + 1) * 1024, 1024, 4096, 4096, MAP_ID, 0);
                WJOB(PTR(27) + (size_t)(2 * li + 1) * 4096 * 1024, (bf16*)(wsw + WO_2), (const float*)nullptr, 4096, 1024, 1024, MAP_ID, 0);
#undef WJOB
                if (layer == 0) { const float* x_in = PTR(0); const int* positions = (const int*)PTR(1);
                    for (int m0 = gw; m0 < MTOK; m0 += 2 * NGW) {
                        const int m1 = m0 + NGW; const bool two = m1 < MTOK;
                        const GAS f32x4* xa = (const GAS f32x4*)(x_in + (size_t)m0 * DM) + lane; const GAS f32x4* xb2 = (const GAS f32x4*)(x_in + (size_t)(two ? m1 : m0) * DM) + lane; f32x4 va[4], vb[4]; float sa = 0.f, sb = 0.f;
#pragma unroll
                        for (int j = 0; j < 4; ++j) { va[j] = xa[64 * j]; vb[j] = xb2[64 * j]; }
#pragma unroll
                        for (int j = 0; j < 4; ++j) { sa += (va[j].x * va[j].x + va[j].y * va[j].y) + (va[j].z * va[j].z + va[j].w * va[j].w); sb += (vb[j].x * vb[j].x + vb[j].y * vb[j].y) + (vb[j].z * vb[j].z + vb[j].w * vb[j].w); }
                        sa = wave_sum(sa); sb = wave_sum(sb);
                        GAS unsigned long long* oa = (GAS unsigned long long*)(XB + (size_t)m0 * DM) + lane;
#pragma unroll
                        for (int j = 0; j < 4; ++j) oa[64 * j] = (unsigned long long)pk2(va[j].x, va[j].y) | ((unsigned long long)pk2(va[j].z, va[j].w) << 32);
                        if (lane < 4) ssp[(size_t)lane * MTOK + m0] = (lane == 0) ? sa : 0.f;
                        if (two) { GAS unsigned long long* ob = (GAS unsigned long long*)(XB + (size_t)m1 * DM) + lane;
#pragma unroll
                            for (int j = 0; j < 4; ++j) ob[64 * j] = (unsigned long long)pk2(vb[j].x, vb[j].y) | ((unsigned long long)pk2(vb[j].z, vb[j].w) << 32);
                            if (lane < 4) ssp[(size_t)lane * MTOK + m1] = (lane == 0) ? sb : 0.f; }
                    }
                    for (int idx = bid * 512 + tid; idx < MTOK * 32; idx += GG * 512) { const int tok = idx >> 5, i = idx & 31;
                        const float inv = powf(10000.0f, -(float)i / 32.0f); const float ang = (float)positions[tok] * inv; const float sn = sinf(ang), cs = cosf(ang);
                        rope[(size_t)idx * 2] = cs; rope[(size_t)idx * 2 + 1] = sn; }
                }
            }
            }
            SEAM(gp0 + 0);
            for (int rep = 0; rep < REPS(1); ++rep) { if (rep) xcd_barrier(bar, otid(wave_s));
            if (EN(1) && IN(gp0 + 1)) { ENV();
                pg8::Gemm g{XB, (const bf16*)(wsw + WE_IN), MTOK, N_E_IN, DM, DM}; pg8::StaticOrder S; S.init(MTOK, N_E_IN, GG, bid);
                pg8::EpiEvenIn E{EP, ssp, misc32, PTR(5) + li * 128, PTR(6) + li * 128, PTR(7) + li * 128, PTR(8) + li * 128, PTR(4) + li * 4, stat};
                pg8::gemm_phase<pg8::EpiEvenIn, pg8::StaticOrder, true, true>(L_, g, S, E, tid);
            }
            }
            SEAM(gp0 + 1);
            for (int rep = 0; rep < REPS(2); ++rep) { if (rep) xcd_barrier(bar, otid(wave_s));
            if (EN(2) && IN(gp0 + 2)) { ENV();
                if (bid < 32) tk::cumsum_unit(misc32, cumb, bid >> 2, bid & 3, glds, tid);
#if defined(TKS_CHECK)
                for (int v = bid; v < 4096; v += GG) tk::topk_unit(EP, misc32, BM, v & 7, 511 - (v >> 3), glds, glds + LDS_STAT, glds + LDS_FAC, tid);
                __syncthreads();
#define TKR_DST ((unsigned long long*)out)
#else
#define TKR_DST BM
#endif
                for (int v = bid; v < 2048; v += GG) { const int st = v >> 8, x = (v >> 3) & 31;
                    tkr::regsel_unit(EP, misc32, TKR_DST, v & 7, 255 - (32 * st + ((st & 1) ? 31 - x : x)), glds, glds + LDS_STAT, glds + LDS_FAC, tid); }
#undef TKR_DST
            }
            }
#if defined(TKS_CHECK)
            if (IN(gp0 + 2)) { xcd_barrier(bar, otid(wave_s)); { ENV();
                unsigned bad = 0u; const unsigned long long* B2 = (const unsigned long long*)out;
                for (size_t i = (size_t)bid * 512 + tid; i < (size_t)MTOK * 64; i += (size_t)GG * 512) bad += (BM[i] != B2[i]) ? 1u : 0u;
                if (bad) __hip_atomic_fetch_add(ctl + 2048, bad, RLX_AGENT); } }
#endif
            SEAM(gp0 + 2);
            for (int rep = 0; rep < REPS(3); ++rep) { if (rep) xcd_barrier(bar, otid(wave_s));
            if (IN(gp0 + 3)) { ENV();
                gu32* qh = ctl + CW_QUEUE + 64 * (layer * 4 + 1 + 2 * rep);
                for (;;) {
                    if (tid == 0) MISCp[4] = __hip_atomic_fetch_add(qh, 1u, RLX_AGENT);
                    __syncthreads();
                    const int u = (int)MISCp[4];
                    if (u >= 1024) break;
                    const int i = u >> 1; att::UnitArgs a;
                    if ((u & 1) == 0) { if (EN(3) && !(rep == 1 && ((REP_MASK >> 18) & 1))) {
                        const int qb = 15 - (i >> 5), bh = i & 31, b = bh >> 2, h = bh & 3; const size_t r0 = (size_t)b * SEQ + qb * 256 + 32 * wave;
                        a.Q = EP + r0 * N_E_IN + 1536 + 128 * h; a.ldq = N_E_IN; a.K = EP + (size_t)b * SEQ * N_E_IN + 2048 + 128 * h; a.ldk = N_E_IN; a.V = EP + (size_t)b * SEQ * N_E_IN + 2560 + 128 * h; a.ldv = N_E_IN;
                        a.O = AOE + r0 * DM + 512 + 128 * h; a.ldo = DM; a.qlo = qb * 256 + 32 * wave; a.NT = 4 * (qb + 1); a.kbias = cumb + (size_t)h * MTOK + (size_t)b * SEQ; a.bm = nullptr; a.tid = tid; a.gq = PTR(7) + li * 128; a.gk = PTR(8) + li * 128;
                        att::attn_unit<128, 1>(a, glds); }
                    } else if (EN(4) && !(rep == 1 && ((REP_MASK >> 19) & 1))) {
                        const int j = 63 - (i >> 3), b = i & 7, head = wave >> 1, sub = wave & 1; const size_t r0 = (size_t)b * SEQ + j * 64 + 32 * sub;
                        a.Q = EP + r0 * N_E_IN + 128 * head; a.ldq = N_E_IN; a.K = EP + (size_t)b * SEQ * N_E_IN + 512; a.ldk = N_E_IN; a.V = EP + (size_t)b * SEQ * N_E_IN + 640; a.ldv = N_E_IN;
                        a.O = AOE + r0 * DM + 128 * head; a.ldo = DM; a.qlo = j * 64 + 32 * sub; a.NT = j + 1; a.kbias = nullptr; a.bm = BM + r0 * 64; a.tid = tid; a.gq = PTR(5) + li * 128; a.gk = PTR(6) + li * 128;
                        att::attn_unit<128, 2>(a, glds);
                    }
                }
            }
            }
            SEAM(gp0 + 3);
            if (EN(5) && IN(gp0 + 4)) { ENV();
                pg8::Gemm g{AOE, (const bf16*)(wsw + WE_OUT), MTOK, DM, DM, DM}; pg8::StaticOrder S; S.init(MTOK, DM, GG, bid);
                pg8::EpiResid E{XB, ssp, stat, (float*)nullptr};
                pg8::gemm_phase<pg8::EpiResid, pg8::StaticOrder, true, true>(L_, g, S, E, tid);
            }
            SEAM2(gp0 + 4, gp0 + 6);
        } else {
            for (int rep = 0; rep < REPS(6); ++rep) { if (rep) xcd_barrier(bar, otid(wave_s));
            if (EN(6) && IN(gp0 + 0)) { ENV();
                pg8::Gemm g{XB, (const bf16*)(wsw + WO_IN), MTOK, N_O_IN, DM, DM}; pg8::StaticOrder S; S.init(MTOK, N_O_IN, GG, bid);
                pg8::EpiOddIn E{C1, AO, XBC, ssp, gss, misc32, PTR(20) + li * 16, stat};
                pg8::gemm_phase<pg8::EpiOddIn, pg8::StaticOrder, true, true>(L_, g, S, E, tid);
            }
            }
            SEAM(gp0 + 0);
            for (int rep = 0; rep < REPS(7); ++rep) { if (rep) xcd_barrier(bar, otid(wave_s));
            if (EN(7) && IN(gp0 + 1)) { ENV();
                if (rep == 0) for (int u = bid; u < 256; u += GG) ssd::conv_halo_save(XBC, (bf16*)(ws + WS_BM), u, tid);
                if (EN(12)) { pg8::Gemm g{C1, (const bf16*)(wsw + WO_UQ), MTOK, 1024, 384, 768}; pg8::StaticOrder S; S.init(MTOK, 1024, GG, bid);
                  pg8::EpiUq E{QB, gss, PTR(16) + li * 192, rope, stat};
                  pg8::gemm_phase<pg8::EpiUq, pg8::StaticOrder, true, true>(L_, g, S, E, tid); }
                if (EN(13)) { pg8::Gemm g{C1 + 384, (const bf16*)(wsw + WO_UKV), MTOK, 1024, 256, 768}; pg8::StaticOrder S; S.init(MTOK, 1024, GG, bid);
                  pg8::EpiUkv E{KK, VV, C1, gss, PTR(17) + li * 192, rope, stat};
                  pg8::gemm_phase<pg8::EpiUkv, pg8::StaticOrder, true, true>(L_, g, S, E, tid); }
            }
            }
            SEAM(gp0 + 1);
            if (IN(gp0 + 2)) { ENV();
                for (int u = bid; u < 256; u += GG) ssd::conv_unit(XBC, (const bf16*)(ws + WS_BM), PTR(18) + (size_t)li * 4 * 2048, PTR(19) + li * 2048, u, tid);
            }
            SEAM(gp0 + 2);
            for (int rep = 0; rep < REPS(9); ++rep) { if (rep) xcd_barrier(bar, otid(wave_s));
            if (IN(gp0 + 3)) { ENV();
                gu32* qh = ctl + CW_QUEUE + 64 * (layer * 4 + 0 + 2 * rep);
                for (;;) {
                    if (tid == 0) MISCp[4] = __hip_atomic_fetch_add(qh, 1u, RLX_AGENT);
                    __syncthreads();
                    const int u = (int)MISCp[4];
                    if (u >= 128 + 512) break;
                    if (u < 128) { if (EN(8) && rep == 0) { const int b = u >> 4, h = u & 15;
                        ssd::ssd_unit(XBC, AO, AO + 512, K_O_OUT, misc32, ssy, PTR(21)[li * 16 + h], PTR(22)[li * 16 + h], b, h, glds, glds + LDS_STAT, tid); }
                    } else if (EN(9)) { const int i = u - 128; const int qb = 15 - (i >> 5), bh = i & 31, b = bh >> 2, h = bh & 3; const size_t r0 = (size_t)b * SEQ + qb * 256 + 32 * wave; att::UnitArgs a;
                        a.Q = QB + r0 * 768 + 192 * h; a.ldq = 768; a.K = KK + (size_t)b * SEQ * 768 + 192 * h; a.ldk = 768; a.V = VV + (size_t)b * SEQ * 512 + 128 * h; a.ldv = 512;
                        a.O = AO + r0 * K_O_OUT + 128 * h; a.ldo = K_O_OUT; a.qlo = qb * 256 + 32 * wave; a.NT = 4 * (qb + 1); a.kbias = nullptr; a.bm = nullptr; a.tid = tid; a.gq = PTR(16) + li * 192; a.gk = PTR(17) + li * 192;
                        att::attn_unit<192, 0>(a, glds);
                    }
                }
            }
            }
#if defined(PROBE_SSD)
            if (IN(gp0 + 3)) { xcd_barrier(bar, otid(wave_s)); { ENV();
                for (int u = bid; u < 128; u += GG) { const int b = u >> 4, h = u & 15;
                    ssd::ssd_unit(XBC, AO, (bf16*)out + (size_t)24 * 1024 * 1024, 1024, misc32, (float*)(ws + WS_BM), PTR(21)[li * 16 + h], PTR(22)[li * 16 + h], b, h, glds, glds + LDS_STAT, tid); } } }
#endif
            SEAM2(gp0 + 3, gp0 + 5);
            if (EN(5) && IN(gp0 + 5)) { ENV();
                pg8::Gemm g{AO, (const bf16*)(wsw + WO_OUT), MTOK, DM, K_O_OUT, K_O_OUT}; pg8::StaticOrder S; S.init(MTOK, DM, GG, bid);
                pg8::EpiResid E{XB, ssp, stat, (float*)nullptr};
                const pg8::GroupScaleHook HK{ssy, (PG8_LAS float*)(L_ + LDS_FAC)};
                pg8::gemm_phase<pg8::EpiResid, pg8::StaticOrder, true, true, pg8::GroupScaleHook>(L_, g, S, E, tid, HK);
            }
            SEAM(gp0 + 5);
        }
        for (int rep = 0; rep < REPS(5); ++rep) { if (rep) xcd_barrier(bar, otid(wave_s));
        if (EN(11) && IN(gp0 + 6)) { ENV();
            pg8::Gemm g{XB, W1t, MTOK, DFF, DM, DM}; pg8::StaticOrder S; S.init(MTOK, DFF, GG, bid);
            pg8::EpiMlpUp E{HB, ssp};
            pg8::gemm_phase<pg8::EpiMlpUp, pg8::StaticOrder, true, true>(L_, g, S, E, tid);
        }
        }
        SEAM(gp0 + 6);
        if (EN(5) && IN(gp0 + 7)) { ENV();
            pg8::Gemm g{HB, W2t, MTOK, DM, DFF, DFF}; pg8::StaticOrder S; S.init(MTOK, DM, GG, bid);
            pg8::EpiResid E{XB, ssp, stat, layer == 3 ? out : (float*)nullptr};
            pg8::gemm_phase<pg8::EpiResid, pg8::StaticOrder, true, true>(L_, g, S, E, tid);
        }
        if (layer < 3) SEAM(gp0 + 7);
    }
    {
        constexpr int layer = 1;
        const int li = layer >> 1; const int gp0 = layer * 8;
        if ((layer & 1) == 0) {
            for (int rep = 0; rep < REPS(0); ++rep) { if (rep) xcd_barrier(bar, otid(wave_s));
            if (EN(0) && IN(gp0 + 0)) { ENV();
                LAS float* scr = (LAS float*)(L_ + wave * 16384);
                const int gw = bid * NWAVES + wave, NGW = GG * NWAVES;
                int it = gw;
#define WJOB(Wp, dstp, gainp, K_, Nsrc_, Ndst_, map_, gk0_) do { const WJob J_{Wp, dstp, gainp, K_, Nsrc_, Ndst_, map_, gk0_}; const int nit_ = ((K_) / 64) * ((Ndst_) / 32); \
                    for (; it < nit_; it += NGW) wconv_item(J_, scr, it, lane); it -= nit_; } while (0)
                WJOB(PTR(3) + (size_t)li * 1024 * 2892, (bf16*)(wsw + WE_IN), PTR(2) + li * 1024, 1024, 2892, 3072, MAP_EVEN_IN, 0);
                WJOB(PTR(9) + (size_t)li * 1024 * 1024, (bf16*)(wsw + WE_OUT), (const float*)nullptr, 1024, 1024, 1024, MAP_ID, 0);
                WJOB(PTR(26) + (size_t)(2 * li) * 1024 * 4096, (bf16*)(wsw + WE_1), PTR(25) + (2 * li) * 1024, 1024, 4096, 4096, MAP_ID, 0);
                WJOB(PTR(27) + (size_t)(2 * li) * 4096 * 1024, (bf16*)(wsw + WE_2), (const float*)nullptr, 4096, 1024, 1024, MAP_ID, 0);
                WJOB(PTR(11) + (size_t)li * 1024 * 3792, (bf16*)(wsw + WO_IN), PTR(10) + li * 1024, 1024, 3792, 3840, MAP_ODD_IN, 0);
                WJOB(PTR(14) + (size_t)li * 384 * 768, (bf16*)(wsw + WO_UQ), PTR(12) + li * 384, 384, 768, 1024, MAP_UQ, 0);
                WJOB(PTR(15) + (size_t)li * 256 * 1024, (bf16*)(wsw + WO_UKV), PTR(13) + li * 256, 256, 1024, 1024, MAP_ID, 0);
                WJOB(PTR(24) + (size_t)li * 1536 * 1024, (bf16*)(wsw + WO_OUT), PTR(23) + li * 1024, 1536, 1024, 1024, MAP_ID, 512);
                WJOB(PTR(26) + (size_t)(2 * li + 1) * 1024 * 4096, (bf16*)(wsw + WO_1), PTR(25) + (2 * li + 1) * 1024, 1024, 4096, 4096, MAP_ID, 0);
                WJOB(PTR(27) + (size_t)(2 * li + 1) * 4096 * 1024, (bf16*)(wsw + WO_2), (const float*)nullptr, 4096, 1024, 1024, MAP_ID, 0);
#undef WJOB
                if (layer == 0) { const float* x_in = PTR(0); const int* positions = (const int*)PTR(1);
                    for (int m0 = gw; m0 < MTOK; m0 += 2 * NGW) {
                        const int m1 = m0 + NGW; const bool two = m1 < MTOK;
                        const GAS f32x4* xa = (const GAS f32x4*)(x_in + (size_t)m0 * DM) + lane; const GAS f32x4* xb2 = (const GAS f32x4*)(x_in + (size_t)(two ? m1 : m0) * DM) + lane; f32x4 va[4], vb[4]; float sa = 0.f, sb = 0.f;
#pragma unroll
                        for (int j = 0; j < 4; ++j) { va[j] = xa[64 * j]; vb[j] = xb2[64 * j]; }
#pragma unroll
                        for (int j = 0; j < 4; ++j) { sa += (va[j].x * va[j].x + va[j].y * va[j].y) + (va[j].z * va[j].z + va[j].w * va[j].w); sb += (vb[j].x * vb[j].x + vb[j].y * vb[j].y) + (vb[j].z * vb[j].z + vb[j].w * vb[j].w); }
                        sa = wave_sum(sa); sb = wave_sum(sb);
                        GAS unsigned long long* oa = (GAS unsigned long long*)(XB + (size_t)m0 * DM) + lane;
#pragma unroll
                        for (int j = 0; j < 4; ++j) oa[64 * j] = (unsigned long long)pk2(va[j].x, va[j].y) | ((unsigned long long)pk2(va[j].z, va[j].w) << 32);
                        if (lane < 4) ssp[(size_t)lane * MTOK + m0] = (lane == 0) ? sa : 0.f;
                        if (two) { GAS unsigned long long* ob = (GAS unsigned long long*)(XB + (size_t)m1 * DM) + lane;
#pragma unroll
                            for (int j = 0; j < 4; ++j) ob[64 * j] = (unsigned long long)pk2(vb[j].x, vb[j].y) | ((unsigned long long)pk2(vb[j].z, vb[j].w) << 32);
                            if (lane < 4) ssp[(size_t)lane * MTOK + m1] = (lane == 0) ? sb : 0.f; }
                    }
                    for (int idx = bid * 512 + tid; idx < MTOK * 32; idx += GG * 512) { const int tok = idx >> 5, i = idx & 31;
                        const float inv = powf(10000.0f, -(float)i / 32.0f); const float ang = (float)positions[tok] * inv; const float sn = sinf(ang), cs = cosf(ang);
                        rope[(size_t)idx * 2] = cs; rope[(size_t)idx * 2 + 1] = sn; }
                }
            }
            }
            SEAM(gp0 + 0);
            for (int rep = 0; rep < REPS(1); ++rep) { if (rep) xcd_barrier(bar, otid(wave_s));
            if (EN(1) && IN(gp0 + 1)) { ENV();
                pg8::Gemm g{XB, (const bf16*)(wsw + WE_IN), MTOK, N_E_IN, DM, DM}; pg8::StaticOrder S; S.init(MTOK, N_E_IN, GG, bid);
                pg8::EpiEvenIn E{EP, ssp, misc32, PTR(5) + li * 128, PTR(6) + li * 128, PTR(7) + li * 128, PTR(8) + li * 128, PTR(4) + li * 4, stat};
                pg8::gemm_phase<pg8::EpiEvenIn, pg8::StaticOrder, true, true>(L_, g, S, E, tid);
            }
            }
            SEAM(gp0 + 1);
            for (int rep = 0; rep < REPS(2); ++rep) { if (rep) xcd_barrier(bar, otid(wave_s));
            if (EN(2) && IN(gp0 + 2)) { ENV();
                if (bid < 32) tk::cumsum_unit(misc32, cumb, bid >> 2, bid & 3, glds, tid);
#if defined(TKS_CHECK)
                for (int v = bid; v < 4096; v += GG) tk::topk_unit(EP, misc32, BM, v & 7, 511 - (v >> 3), glds, glds + LDS_STAT, glds + LDS_FAC, tid);
                __syncthreads();
#define TKR_DST ((unsigned long long*)out)
#else
#define TKR_DST BM
#endif
                for (int v = bid; v < 2048; v += GG) { const int st = v >> 8, x = (v >> 3) & 31;
                    tkr::regsel_unit(EP, misc32, TKR_DST, v & 7, 255 - (32 * st + ((st & 1) ? 31 - x : x)), glds, glds + LDS_STAT, glds + LDS_FAC, tid); }
#undef TKR_DST
            }
            }
#if defined(TKS_CHECK)
            if (IN(gp0 + 2)) { xcd_barrier(bar, otid(wave_s)); { ENV();
                unsigned bad = 0u; const unsigned long long* B2 = (const unsigned long long*)out;
                for (size_t i = (size_t)bid * 512 + tid; i < (size_t)MTOK * 64; i += (size_t)GG * 512) bad += (BM[i] != B2[i]) ? 1u : 0u;
                if (bad) __hip_atomic_fetch_add(ctl + 2048, bad, RLX_AGENT); } }
#endif
            SEAM(gp0 + 2);
            for (int rep = 0; rep < REPS(3); ++rep) { if (rep) xcd_barrier(bar, otid(wave_s));
            if (IN(gp0 + 3)) { ENV();
                gu32* qh = ctl + CW_QUEUE + 64 * (layer * 4 + 1 + 2 * rep);
                for (;;) {
                    if (tid == 0) MISCp[4] = __hip_atomic_fetch_add(qh, 1u, RLX_AGENT);
                    __syncthreads();
                    const int u = (int)MISCp[4];
                    if (u >= 1024) break;
                    const int i = u >> 1; att::UnitArgs a;
                    if ((u & 1) == 0) { if (EN(3) && !(rep == 1 && ((REP_MASK >> 18) & 1))) {
                        const int qb = 15 - (i >> 5), bh = i & 31, b = bh >> 2, h = bh & 3; const size_t r0 = (size_t)b * SEQ + qb * 256 + 32 * wave;
                        a.Q = EP + r0 * N_E_IN + 1536 + 128 * h; a.ldq = N_E_IN; a.K = EP + (size_t)b * SEQ * N_E_IN + 2048 + 128 * h; a.ldk = N_E_IN; a.V = EP + (size_t)b * SEQ * N_E_IN + 2560 + 128 * h; a.ldv = N_E_IN;
                        a.O = AOE + r0 * DM + 512 + 128 * h; a.ldo = DM; a.qlo = qb * 256 + 32 * wave; a.NT = 4 * (qb + 1); a.kbias = cumb + (size_t)h * MTOK + (size_t)b * SEQ; a.bm = nullptr; a.tid = tid; a.gq = PTR(7) + li * 128; a.gk = PTR(8) + li * 128;
                        att::attn_unit<128, 1>(a, glds); }
                    } else if (EN(4) && !(rep == 1 && ((REP_MASK >> 19) & 1))) {
                        const int j = 63 - (i >> 3), b = i & 7, head = wave >> 1, sub = wave & 1; const size_t r0 = (size_t)b * SEQ + j * 64 + 32 * sub;
                        a.Q = EP + r0 * N_E_IN + 128 * head; a.ldq = N_E_IN; a.K = EP + (size_t)b * SEQ * N_E_IN + 512; a.ldk = N_E_IN; a.V = EP + (size_t)b * SEQ * N_E_IN + 640; a.ldv = N_E_IN;
                        a.O = AOE + r0 * DM + 128 * head; a.ldo = DM; a.qlo = j * 64 + 32 * sub; a.NT = j + 1; a.kbias = nullptr; a.bm = BM + r0 * 64; a.tid = tid; a.gq = PTR(5) + li * 128; a.gk = PTR(6) + li * 128;
                        att::attn_unit<128, 2>(a, glds);
                    }
                }
            }
            }
            SEAM(gp0 + 3);
            if (EN(5) && IN(gp0 + 4)) { ENV();
                pg8::Gemm g{AOE, (const bf16*)(wsw + WE_OUT), MTOK, DM, DM, DM}; pg8::StaticOrder S; S.init(MTOK, DM, GG, bid);
                pg8::EpiResid E{XB, ssp, stat, (float*)nullptr};
                pg8::gemm_phase<pg8::EpiResid, pg8::StaticOrder, true, true>(L_, g, S, E, tid);
            }
            SEAM2(gp0 + 4, gp0 + 6);
        } else {
            for (int rep = 0; rep < REPS(6); ++rep) { if (rep) xcd_barrier(bar, otid(wave_s));
            if (EN(6) && IN(gp0 + 0)) { ENV();
                pg8::Gemm g{XB, (const bf16*)(wsw + WO_IN), MTOK, N_O_IN, DM, DM}; pg8::StaticOrder S; S.init(MTOK, N_O_IN, GG, bid);
                pg8::EpiOddIn E{C1, AO, XBC, ssp, gss, misc32, PTR(20) + li * 16, stat};
                pg8::gemm_phase<pg8::EpiOddIn, pg8::StaticOrder, true, true>(L_, g, S, E, tid);
            }
            }
            SEAM(gp0 + 0);
            for (int rep = 0; rep < REPS(7); ++rep) { if (rep) xcd_barrier(bar, otid(wave_s));
            if (EN(7) && IN(gp0 + 1)) { ENV();
                if (rep == 0) for (int u = bid; u < 256; u += GG) ssd::conv_halo_save(XBC, (bf16*)(ws + WS_BM), u, tid);
                if (EN(12)) { pg8::Gemm g{C1, (const bf16*)(wsw + WO_UQ), MTOK, 1024, 384, 768}; pg8::StaticOrder S; S.init(MTOK, 1024, GG, bid);
                  pg8::EpiUq E{QB, gss, PTR(16) + li * 192, rope, stat};
                  pg8::gemm_phase<pg8::EpiUq, pg8::StaticOrder, true, true>(L_, g, S, E, tid); }
                if (EN(13)) { pg8::Gemm g{C1 + 384, (const bf16*)(wsw + WO_UKV), MTOK, 1024, 256, 768}; pg8::StaticOrder S; S.init(MTOK, 1024, GG, bid);
                  pg8::EpiUkv E{KK, VV, C1, gss, PTR(17) + li * 192, rope, stat};
                  pg8::gemm_phase<pg8::EpiUkv, pg8::StaticOrder, true, true>(L_, g, S, E, tid); }
            }
            }
            SEAM(gp0 + 1);
            if (IN(gp0 + 2)) { ENV();
                for (int u = bid; u < 256; u += GG) ssd::conv_unit(XBC, (const bf16*)(ws + WS_BM), PTR(18) + (size_t)li * 4 * 2048, PTR(19) + li * 2048, u, tid);
            }
            SEAM(gp0 + 2);
            for (int rep = 0; rep < REPS(9); ++rep) { if (rep) xcd_barrier(bar, otid(wave_s));
            if (IN(gp0 + 3)) { ENV();
                gu32* qh = ctl + CW_QUEUE + 64 * (layer * 4 + 0 + 2 * rep);
                for (;;) {
                    if (tid == 0) MISCp[4] = __hip_atomic_fetch_add(qh, 1u, RLX_AGENT);
                    __syncthreads();
                    const int u = (int)MISCp[4];
                    if (u >= 128 + 512) break;
                    if (u < 128) { if (EN(8) && rep == 0) { const int b = u >> 4, h = u & 15;
                        ssd::ssd_unit(XBC, AO, AO + 512, K_O_OUT, misc32, ssy, PTR(21)[li * 16 + h], PTR(22)[li * 16 + h], b, h, glds, glds + LDS_STAT, tid); }
                    } else if (EN(9)) { const int i = u - 128; const int qb = 15 - (i >> 5), bh = i & 31, b = bh >> 2, h = bh & 3; const size_t r0 = (size_t)b * SEQ + qb * 256 + 32 * wave; att::UnitArgs a;
                        a.Q = QB + r0 * 768 + 192 * h; a.ldq = 768; a.K = KK + (size_t)b * SEQ * 768 + 192 * h; a.ldk = 768; a.V = VV + (size_t)b * SEQ * 512 + 128 * h; a.ldv = 512;
                        a.O = AO + r0 * K_O_OUT + 128 * h; a.ldo = K_O_OUT; a.qlo = qb * 256 + 32 * wave; a.NT = 4 * (qb + 1); a.kbias = nullptr; a.bm = nullptr; a.tid = tid; a.gq = PTR(16) + li * 192; a.gk = PTR(17) + li * 192;
                        att::attn_unit<192, 0>(a, glds);
                    }
                }
            }
            }
#if defined(PROBE_SSD)
            if (IN(gp0 + 3)) { xcd_barrier(bar, otid(wave_s)); { ENV();
                for (int u = bid; u < 128; u += GG) { const int b = u >> 4, h = u & 15;
                    ssd::ssd_unit(XBC, AO, (bf16*)out + (size_t)24 * 1024 * 1024, 1024, misc32, (float*)(ws + WS_BM), PTR(21)[li * 16 + h], PTR(22)[li * 16 + h], b, h, glds, glds + LDS_STAT, tid); } } }
#endif
            SEAM2(gp0 + 3, gp0 + 5);
            if (EN(5) && IN(gp0 + 5)) { ENV();
                pg8::Gemm g{AO, (const bf16*)(wsw + WO_OUT), MTOK, DM, K_O_OUT, K_O_OUT}; pg8::StaticOrder S; S.init(MTOK, DM, GG, bid);
                pg8::EpiResid E{XB, ssp, stat, (float*)nullptr};
                const pg8::GroupScaleHook HK{ssy, (PG8_LAS float*)(L_ + LDS_FAC)};
                pg8::gemm_phase<pg8::EpiResid, pg8::StaticOrder, true, true, pg8::GroupScaleHook>(L_, g, S, E, tid, HK);
            }
            SEAM(gp0 + 5);
        }
        for (int rep = 0; rep < REPS(5); ++rep) { if (rep) xcd_barrier(bar, otid(wave_s));
        if (EN(11) && IN(gp0 + 6)) { ENV();
            pg8::Gemm g{XB, W1t, MTOK, DFF, DM, DM}; pg8::StaticOrder S; S.init(MTOK, DFF, GG, bid);
            pg8::EpiMlpUp E{HB, ssp};
            pg8::gemm_phase<pg8::EpiMlpUp, pg8::StaticOrder, true, true>(L_, g, S, E, tid);
        }
        }
        SEAM(gp0 + 6);
        if (EN(5) && IN(gp0 + 7)) { ENV();
            pg8::Gemm g{HB, W2t, MTOK, DM, DFF, DFF}; pg8::StaticOrder S; S.init(MTOK, DM, GG, bid);
            pg8::EpiResid E{XB, ssp, stat, layer == 3 ? out : (float*)nullptr};
            pg8::gemm_phase<pg8::EpiResid, pg8::StaticOrder, true, true>(L_, g, S, E, tid);
        }
        if (layer < 3) SEAM(gp0 + 7);
    }
    {
        constexpr int layer = 2;
        const int li = layer >> 1; const int gp0 = layer * 8;
        if ((layer & 1) == 0) {
            for (int rep = 0; rep < REPS(0); ++rep) { if (rep) xcd_barrier(bar, otid(wave_s));
            if (EN(0) && IN(gp0 + 0)) { ENV();
                LAS float* scr = (LAS float*)(L_ + wave * 16384);
                const int gw = bid * NWAVES + wave, NGW = GG * NWAVES;
                int it = gw;
#define WJOB(Wp, dstp, gainp, K_, Nsrc_, Ndst_, map_, gk0_) do { const WJob J_{Wp, dstp, gainp, K_, Nsrc_, Ndst_, map_, gk0_}; const int nit_ = ((K_) / 64) * ((Ndst_) / 32); \
                    for (; it < nit_; it += NGW) wconv_item(J_, scr, it, lane); it -= nit_; } while (0)
                WJOB(PTR(3) + (size_t)li * 1024 * 2892, (bf16*)(wsw + WE_IN), PTR(2) + li * 1024, 1024, 2892, 3072, MAP_EVEN_IN, 0);
                WJOB(PTR(9) + (size_t)li * 1024 * 1024, (bf16*)(wsw + WE_OUT), (const float*)nullptr, 1024, 1024, 1024, MAP_ID, 0);
                WJOB(PTR(26) + (size_t)(2 * li) * 1024 * 4096, (bf16*)(wsw + WE_1), PTR(25) + (2 * li) * 1024, 1024, 4096, 4096, MAP_ID, 0);
                WJOB(PTR(27) + (size_t)(2 * li) * 4096 * 1024, (bf16*)(wsw + WE_2), (const float*)nullptr, 4096, 1024, 1024, MAP_ID, 0);
                WJOB(PTR(11) + (size_t)li * 1024 * 3792, (bf16*)(wsw + WO_IN), PTR(10) + li * 1024, 1024, 3792, 3840, MAP_ODD_IN, 0);
                WJOB(PTR(14) + (size_t)li * 384 * 768, (bf16*)(wsw + WO_UQ), PTR(12) + li * 384, 384, 768, 1024, MAP_UQ, 0);
                WJOB(PTR(15) + (size_t)li * 256 * 1024, (bf16*)(wsw + WO_UKV), PTR(13) + li * 256, 256, 1024, 1024, MAP_ID, 0);
                WJOB(PTR(24) + (size_t)li * 1536 * 1024, (bf16*)(wsw + WO_OUT), PTR(23) + li * 1024, 1536, 1024, 1024, MAP_ID, 512);
                WJOB(PTR(26) + (size_t)(2 * li + 1) * 1024 * 4096, (bf16*)(wsw + WO_1), PTR(25) + (2 * li + 1) * 1024, 1024, 4096, 4096, MAP_ID, 0);
                WJOB(PTR(27) + (size_t)(2 * li + 1) * 4096 * 1024, (bf16*)(wsw + WO_2), (const float*)nullptr, 4096, 1024, 1024, MAP_ID, 0);
#undef WJOB
                if (layer == 0) { const float* x_in = PTR(0); const int* positions = (const int*)PTR(1);
                    for (int m0 = gw; m0 < MTOK; m0 += 2 * NGW) {
                        const int m1 = m0 + NGW; const bool two = m1 < MTOK;
                        const GAS f32x4* xa = (const GAS f32x4*)(x_in + (size_t)m0 * DM) + lane; const GAS f32x4* xb2 = (const GAS f32x4*)(x_in + (size_t)(two ? m1 : m0) * DM) + lane; f32x4 va[4], vb[4]; float sa = 0.f, sb = 0.f;
#pragma unroll
                        for (int j = 0; j < 4; ++j) { va[j] = xa[64 * j]; vb[j] = xb2[64 * j]; }
#pragma unroll
                        for (int j = 0; j < 4; ++j) { sa += (va[j].x * va[j].x + va[j].y * va[j].y) + (va[j].z * va[j].z + va[j].w * va[j].w); sb += (vb[j].x * vb[j].x + vb[j].y * vb[j].y) + (vb[j].z * vb[j].z + vb[j].w * vb[j].w); }
                        sa = wave_sum(sa); sb = wave_sum(sb);
                        GAS unsigned long long* oa = (GAS unsigned long long*)(XB + (size_t)m0 * DM) + lane;
#pragma unroll
                        for (int j = 0; j < 4; ++j) oa[64 * j] = (unsigned long long)pk2(va[j].x, va[j].y) | ((unsigned long long)pk2(va[j].z, va[j].w) << 32);
                        if (lane < 4) ssp[(size_t)lane * MTOK + m0] = (lane == 0) ? sa : 0.f;
                        if (two) { GAS unsigned long long* ob = (GAS unsigned long long*)(XB + (size_t)m1 * DM) + lane;
#pragma unroll
                            for (int j = 0; j < 4; ++j) ob[64 * j] = (unsigned long long)pk2(vb[j].x, vb[j].y) | ((unsigned long long)pk2(vb[j].z, vb[j].w) << 32);
                            if (lane < 4) ssp[(size_t)lane * MTOK + m1] = (lane == 0) ? sb : 0.f; }
                    }
                    for (int idx = bid * 512 + tid; idx < MTOK * 32; idx += GG * 512) { const int tok = idx >> 5, i = idx & 31;
                        const float inv = powf(10000.0f, -(float)i / 32.0f); const float ang = (float)positions[tok] * inv; const float sn = sinf(ang), cs = cosf(ang);
                        rope[(size_t)idx * 2] = cs; rope[(size_t)idx * 2 + 1] = sn; }
                }
            }
            }
            SEAM(gp0 + 0);
            for (int rep = 0; rep < REPS(1); ++rep) { if (rep) xcd_barrier(bar, otid(wave_s));
            if (EN(1) && IN(gp0 + 1)) { ENV();
                pg8::Gemm g{XB, (const bf16*)(wsw + WE_IN), MTOK, N_E_IN, DM, DM}; pg8::StaticOrder S; S.init(MTOK, N_E_IN, GG, bid);
                pg8::EpiEvenIn E{EP, ssp, misc32, PTR(5) + li * 128, PTR(6) + li * 128, PTR(7) + li * 128, PTR(8) + li * 128, PTR(4) + li * 4, stat};
                pg8::gemm_phase<pg8::EpiEvenIn, pg8::StaticOrder, true, true>(L_, g, S, E, tid);
            }
            }
            SEAM(gp0 + 1);
            for (int rep = 0; rep < REPS(2); ++rep) { if (rep) xcd_barrier(bar, otid(wave_s));
            if (EN(2) && IN(gp0 + 2)) { ENV();
                if (bid < 32) tk::cumsum_unit(misc32, cumb, bid >> 2, bid & 3, glds, tid);
#if defined(TKS_CHECK)
                for (int v = bid; v < 4096; v += GG) tk::topk_unit(EP, misc32, BM, v & 7, 511 - (v >> 3), glds, glds + LDS_STAT, glds + LDS_FAC, tid);
                __syncthreads();
#define TKR_DST ((unsigned long long*)out)
#else
#define TKR_DST BM
#endif
                for (int v = bid; v < 2048; v += GG) { const int st = v >> 8, x = (v >> 3) & 31;
                    tkr::regsel_unit(EP, misc32, TKR_DST, v & 7, 255 - (32 * st + ((st & 1) ? 31 - x : x)), glds, glds + LDS_STAT, glds + LDS_FAC, tid); }
#undef TKR_DST
            }
            }
#if defined(TKS_CHECK)
            if (IN(gp0 + 2)) { xcd_barrier(bar, otid(wave_s)); { ENV();
                unsigned bad = 0u; const unsigned long long* B2 = (const unsigned long long*)out;
                for (size_t i = (size_t)bid * 512 + tid; i < (size_t)MTOK * 64; i += (size_t)GG * 512) bad += (BM[i] != B2[i]) ? 1u : 0u;
                if (bad) __hip_atomic_fetch_add(ctl + 2048, bad, RLX_AGENT); } }
#endif
            SEAM(gp0 + 2);
            for (int rep = 0; rep < REPS(3); ++rep) { if (rep) xcd_barrier(bar, otid(wave_s));
            if (IN(gp0 + 3)) { ENV();
                gu32* qh = ctl + CW_QUEUE + 64 * (layer * 4 + 1 + 2 * rep);
                for (;;) {
                    if (tid == 0) MISCp[4] = __hip_atomic_fetch_add(qh, 1u, RLX_AGENT);
                    __syncthreads();
                    const int u = (int)MISCp[4];
                    if (u >= 1024) break;
                    const int i = u >> 1; att::UnitArgs a;
                    if ((u & 1) == 0) { if (EN(3) && !(rep == 1 && ((REP_MASK >> 18) & 1))) {
                        const int qb = 15 - (i >> 5), bh = i & 31, b = bh >> 2, h = bh & 3; const size_t r0 = (size_t)b * SEQ + qb * 256 + 32 * wave;
                        a.Q = EP + r0 * N_E_IN + 1536 + 128 * h; a.ldq = N_E_IN; a.K = EP + (size_t)b * SEQ * N_E_IN + 2048 + 128 * h; a.ldk = N_E_IN; a.V = EP + (size_t)b * SEQ * N_E_IN + 2560 + 128 * h; a.ldv = N_E_IN;
                        a.O = AOE + r0 * DM + 512 + 128 * h; a.ldo = DM; a.qlo = qb * 256 + 32 * wave; a.NT = 4 * (qb + 1); a.kbias = cumb + (size_t)h * MTOK + (size_t)b * SEQ; a.bm = nullptr; a.tid = tid; a.gq = PTR(7) + li * 128; a.gk = PTR(8) + li * 128;
                        att::attn_unit<128, 1>(a, glds); }
                    } else if (EN(4) && !(rep == 1 && ((REP_MASK >> 19) & 1))) {
                        const int j = 63 - (i >> 3), b = i & 7, head = wave >> 1, sub = wave & 1; const size_t r0 = (size_t)b * SEQ + j * 64 + 32 * sub;
                        a.Q = EP + r0 * N_E_IN + 128 * head; a.ldq = N_E_IN; a.K = EP + (size_t)b * SEQ * N_E_IN + 512; a.ldk = N_E_IN; a.V = EP + (size_t)b * SEQ * N_E_IN + 640; a.ldv = N_E_IN;
                        a.O = AOE + r0 * DM + 128 * head; a.ldo = DM; a.qlo = j * 64 + 32 * sub; a.NT = j + 1; a.kbias = nullptr; a.bm = BM + r0 * 64; a.tid = tid; a.gq = PTR(5) + li * 128; a.gk = PTR(6) + li * 128;
                        att::attn_unit<128, 2>(a, glds);
                    }
                }
            }
            }
            SEAM(gp0 + 3);
            if (EN(5) && IN(gp0 + 4)) { ENV();
                pg8::Gemm g{AOE, (const bf16*)(wsw + WE_OUT), MTOK, DM, DM, DM}; pg8::StaticOrder S; S.init(MTOK, DM, GG, bid);
                pg8::EpiResid E{XB, ssp, stat, (float*)nullptr};
                pg8::gemm_phase<pg8::EpiResid, pg8::StaticOrder, true, true>(L_, g, S, E, tid);
            }
            SEAM2(gp0 + 4, gp0 + 6);
        } else {
            for (int rep = 0; rep < REPS(6); ++rep) { if (rep) xcd_barrier(bar, otid(wave_s));
            if (EN(6) && IN(gp0 + 0)) { ENV();
                pg8::Gemm g{XB, (const bf16*)(wsw + WO_IN), MTOK, N_O_IN, DM, DM}; pg8::StaticOrder S; S.init(MTOK, N_O_IN, GG, bid);
                pg8::EpiOddIn E{C1, AO, XBC, ssp, gss, misc32, PTR(20) + li * 16, stat};
                pg8::gemm_phase<pg8::EpiOddIn, pg8::StaticOrder, true, true>(L_, g, S, E, tid);
            }
            }
            SEAM(gp0 + 0);
            for (int rep = 0; rep < REPS(7); ++rep) { if (rep) xcd_barrier(bar, otid(wave_s));
            if (EN(7) && IN(gp0 + 1)) { ENV();
                if (rep == 0) for (int u = bid; u < 256; u += GG) ssd::conv_halo_save(XBC, (bf16*)(ws + WS_BM), u, tid);
                if (EN(12)) { pg8::Gemm g{C1, (const bf16*)(wsw + WO_UQ), MTOK, 1024, 384, 768}; pg8::StaticOrder S; S.init(MTOK, 1024, GG, bid);
                  pg8::EpiUq E{QB, gss, PTR(16) + li * 192, rope, stat};
                  pg8::gemm_phase<pg8::EpiUq, pg8::StaticOrder, true, true>(L_, g, S, E, tid); }
                if (EN(13)) { pg8::Gemm g{C1 + 384, (const bf16*)(wsw + WO_UKV), MTOK, 1024, 256, 768}; pg8::StaticOrder S; S.init(MTOK, 1024, GG, bid);
                  pg8::EpiUkv E{KK, VV, C1, gss, PTR(17) + li * 192, rope, stat};
                  pg8::gemm_phase<pg8::EpiUkv, pg8::StaticOrder, true, true>(L_, g, S, E, tid); }
            }
            }
            SEAM(gp0 + 1);
            if (IN(gp0 + 2)) { ENV();
                for (int u = bid; u < 256; u += GG) ssd::conv_unit(XBC, (const bf16*)(ws + WS_BM), PTR(18) + (size_t)li * 4 * 2048, PTR(19) + li * 2048, u, tid);
            }
            SEAM(gp0 + 2);
            for (int rep = 0; rep < REPS(9); ++rep) { if (rep) xcd_barrier(bar, otid(wave_s));
            if (IN(gp0 + 3)) { ENV();
                gu32* qh = ctl + CW_QUEUE + 64 * (layer * 4 + 0 + 2 * rep);
                for (;;) {
                    if (tid == 0) MISCp[4] = __hip_atomic_fetch_add(qh, 1u, RLX_AGENT);
                    __syncthreads();
                    const int u = (int)MISCp[4];
                    if (u >= 128 + 512) break;
                    if (u < 128) { if (EN(8) && rep == 0) { const int b = u >> 4, h = u & 15;
                        ssd::ssd_unit(XBC, AO, AO + 512, K_O_OUT, misc32, ssy, PTR(21)[li * 16 + h], PTR(22)[li * 16 + h], b, h, glds, glds + LDS_STAT, tid); }
                    } else if (EN(9)) { const int i = u - 128; const int qb = 15 - (i >> 5), bh = i & 31, b = bh >> 2, h = bh & 3; const size_t r0 = (size_t)b * SEQ + qb * 256 + 32 * wave; att::UnitArgs a;
                        a.Q = QB + r0 * 768 + 192 * h; a.ldq = 768; a.K = KK + (size_t)b * SEQ * 768 + 192 * h; a.ldk = 768; a.V = VV + (size_t)b * SEQ * 512 + 128 * h; a.ldv = 512;
                        a.O = AO + r0 * K_O_OUT + 128 * h; a.ldo = K_O_OUT; a.qlo = qb * 256 + 32 * wave; a.NT = 4 * (qb + 1); a.kbias = nullptr; a.bm = nullptr; a.tid = tid; a.gq = PTR(16) + li * 192; a.gk = PTR(17) + li * 192;
                        att::attn_unit<192, 0>(a, glds);
                    }
                }
            }
            }
#if defined(PROBE_SSD)
            if (IN(gp0 + 3)) { xcd_barrier(bar, otid(wave_s)); { ENV();
                for (int u = bid; u < 128; u += GG) { const int b = u >> 4, h = u & 15;
                    ssd::ssd_unit(XBC, AO, (bf16*)out + (size_t)24 * 1024 * 1024, 1024, misc32, (float*)(ws + WS_BM), PTR(21)[li * 16 + h], PTR(22)[li * 16 + h], b, h, glds, glds + LDS_STAT, tid); } } }
#endif
            SEAM2(gp0 + 3, gp0 + 5);
            if (EN(5) && IN(gp0 + 5)) { ENV();
                pg8::Gemm g{AO, (const bf16*)(wsw + WO_OUT), MTOK, DM, K_O_OUT, K_O_OUT}; pg8::StaticOrder S; S.init(MTOK, DM, GG, bid);
                pg8::EpiResid E{XB, ssp, stat, (float*)nullptr};
                const pg8::GroupScaleHook HK{ssy, (PG8_LAS float*)(L_ + LDS_FAC)};
                pg8::gemm_phase<pg8::EpiResid, pg8::StaticOrder, true, true, pg8::GroupScaleHook>(L_, g, S, E, tid, HK);
            }
            SEAM(gp0 + 5);
        }
        for (int rep = 0; rep < REPS(5); ++rep) { if (rep) xcd_barrier(bar, otid(wave_s));
        if (EN(11) && IN(gp0 + 6)) { ENV();
            pg8::Gemm g{XB, W1t, MTOK, DFF, DM, DM}; pg8::StaticOrder S; S.init(MTOK, DFF, GG, bid);
            pg8::EpiMlpUp E{HB, ssp};
            pg8::gemm_phase<pg8::EpiMlpUp, pg8::StaticOrder, true, true>(L_, g, S, E, tid);
        }
        }
        SEAM(gp0 + 6);
        if (EN(5) && IN(gp0 + 7)) { ENV();
            pg8::Gemm g{HB, W2t, MTOK, DM, DFF, DFF}; pg8::StaticOrder S; S.init(MTOK, DM, GG, bid);
            pg8::EpiResid E{XB, ssp, stat, layer == 3 ? out : (float*)nullptr};
            pg8::gemm_phase<pg8::EpiResid, pg8::StaticOrder, true, true>(L_, g, S, E, tid);
        }
        if (layer < 3) SEAM(gp0 + 7);
    }
    {
        constexpr int layer = 3;
        const int li = layer >> 1; const int gp0 = layer * 8;
        if ((layer & 1) == 0) {
            for (int rep = 0; rep < REPS(0); ++rep) { if (rep) xcd_barrier(bar, otid(wave_s));
            if (EN(0) && IN(gp0 + 0)) { ENV();
                LAS float* scr = (LAS float*)(L_ + wave * 16384);
                const int gw = bid * NWAVES + wave, NGW = GG * NWAVES;
                int it = gw;
#define WJOB(Wp, dstp, gainp, K_, Nsrc_, Ndst_, map_, gk0_) do { const WJob J_{Wp, dstp, gainp, K_, Nsrc_, Ndst_, map_, gk0_}; const int nit_ = ((K_) / 64) * ((Ndst_) / 32); \
                    for (; it < nit_; it += NGW) wconv_item(J_, scr, it, lane); it -= nit_; } while (0)
                WJOB(PTR(3) + (size_t)li * 1024 * 2892, (bf16*)(wsw + WE_IN), PTR(2) + li * 1024, 1024, 2892, 3072, MAP_EVEN_IN, 0);
                WJOB(PTR(9) + (size_t)li * 1024 * 1024, (bf16*)(wsw + WE_OUT), (const float*)nullptr, 1024, 1024, 1024, MAP_ID, 0);
                WJOB(PTR(26) + (size_t)(2 * li) * 1024 * 4096, (bf16*)(wsw + WE_1), PTR(25) + (2 * li) * 1024, 1024, 4096, 4096, MAP_ID, 0);
                WJOB(PTR(27) + (size_t)(2 * li) * 4096 * 1024, (bf16*)(wsw + WE_2), (const float*)nullptr, 4096, 1024, 1024, MAP_ID, 0);
                WJOB(PTR(11) + (size_t)li * 1024 * 3792, (bf16*)(wsw + WO_IN), PTR(10) + li * 1024, 1024, 3792, 3840, MAP_ODD_IN, 0);
                WJOB(PTR(14) + (size_t)li * 384 * 768, (bf16*)(wsw + WO_UQ), PTR(12) + li * 384, 384, 768, 1024, MAP_UQ, 0);
                WJOB(PTR(15) + (size_t)li * 256 * 1024, (bf16*)(wsw + WO_UKV), PTR(13) + li * 256, 256, 1024, 1024, MAP_ID, 0);
                WJOB(PTR(24) + (size_t)li * 1536 * 1024, (bf16*)(wsw + WO_OUT), PTR(23) + li * 1024, 1536, 1024, 1024, MAP_ID, 512);
                WJOB(PTR(26) + (size_t)(2 * li + 1) * 1024 * 4096, (bf16*)(wsw + WO_1), PTR(25) + (2 * li + 1) * 1024, 1024, 4096, 4096, MAP_ID, 0);
                WJOB(PTR(27) + (size_t)(2 * li + 1) * 4096 * 1024, (bf16*)(wsw + WO_2), (const float*)nullptr, 4096, 1024, 1024, MAP_ID, 0);
#undef WJOB
                if (layer == 0) { const float* x_in = PTR(0); const int* positions = (const int*)PTR(1);
                    for (int m0 = gw; m0 < MTOK; m0 += 2 * NGW) {
                        const int m1 = m0 + NGW; const bool two = m1 < MTOK;
                        const GAS f32x4* xa = (const GAS f32x4*)(x_in + (size_t)m0 * DM) + lane; const GAS f32x4* xb2 = (const GAS f32x4*)(x_in + (size_t)(two ? m1 : m0) * DM) + lane; f32x4 va[4], vb[4]; float sa = 0.f, sb = 0.f;
#pragma unroll
                        for (int j = 0; j < 4; ++j) { va[j] = xa[64 * j]; vb[j] = xb2[64 * j]; }
#pragma unroll
                        for (int j = 0; j < 4; ++j) { sa += (va[j].x * va[j].x + va[j].y * va[j].y) + (va[j].z * va[j].z + va[j].w * va[j].w); sb += (vb[j].x * vb[j].x + vb[j].y * vb[j].y) + (vb[j].z * vb[j].z + vb[j].w * vb[j].w); }
                        sa = wave_sum(sa); sb = wave_sum(sb);
                        GAS unsigned long long* oa = (GAS unsigned long long*)(XB + (size_t)m0 * DM) + lane;
#pragma unroll
                        for (int j = 0; j < 4; ++j) oa[64 * j] = (unsigned long long)pk2(va[j].x, va[j].y) | ((unsigned long long)pk2(va[j].z, va[j].w) << 32);
                        if (lane < 4) ssp[(size_t)lane * MTOK + m0] = (lane == 0) ? sa : 0.f;
                        if (two) { GAS unsigned long long* ob = (GAS unsigned long long*)(XB + (size_t)m1 * DM) + lane;
#pragma unroll
                            for (int j = 0; j < 4; ++j) ob[64 * j] = (unsigned long long)pk2(vb[j].x, vb[j].y) | ((unsigned long long)pk2(vb[j].z, vb[j].w) << 32);
                            if (lane < 4) ssp[(size_t)lane * MTOK + m1] = (lane == 0) ? sb : 0.f; }
                    }
                    for (int idx = bid * 512 + tid; idx < MTOK * 32; idx += GG * 512) { const int tok = idx >> 5, i = idx & 31;
                        const float inv = powf(10000.0f, -(float)i / 32.0f); const float ang = (float)positions[tok] * inv; const float sn = sinf(ang), cs = cosf(ang);
                        rope[(size_t)idx * 2] = cs; rope[(size_t)idx * 2 + 1] = sn; }
                }
            }
            }
            SEAM(gp0 + 0);
            for (int rep = 0; rep < REPS(1); ++rep) { if (rep) xcd_barrier(bar, otid(wave_s));
            if (EN(1) && IN(gp0 + 1)) { ENV();
                pg8::Gemm g{XB, (const bf16*)(wsw + WE_IN), MTOK, N_E_IN, DM, DM}; pg8::StaticOrder S; S.init(MTOK, N_E_IN, GG, bid);
                pg8::EpiEvenIn E{EP, ssp, misc32, PTR(5) + li * 128, PTR(6) + li * 128, PTR(7) + li * 128, PTR(8) + li * 128, PTR(4) + li * 4, stat};
                pg8::gemm_phase<pg8::EpiEvenIn, pg8::StaticOrder, true, true>(L_, g, S, E, tid);
            }
            }
            SEAM(gp0 + 1);
            for (int rep = 0; rep < REPS(2); ++rep) { if (rep) xcd_barrier(bar, otid(wave_s));
            if (EN(2) && IN(gp0 + 2)) { ENV();
                if (bid < 32) tk::cumsum_unit(misc32, cumb, bid >> 2, bid & 3, glds, tid);
#if defined(TKS_CHECK)
                for (int v = bid; v < 4096; v += GG) tk::topk_unit(EP, misc32, BM, v & 7, 511 - (v >> 3), glds, glds + LDS_STAT, glds + LDS_FAC, tid);
                __syncthreads();
#define TKR_DST ((unsigned long long*)out)
#else
#define TKR_DST BM
#endif
                for (int v = bid; v < 2048; v += GG) { const int st = v >> 8, x = (v >> 3) & 31;
                    tkr::regsel_unit(EP, misc32, TKR_DST, v & 7, 255 - (32 * st + ((st & 1) ? 31 - x : x)), glds, glds + LDS_STAT, glds + LDS_FAC, tid); }
#undef TKR_DST
            }
            }
#if defined(TKS_CHECK)
            if (IN(gp0 + 2)) { xcd_barrier(bar, otid(wave_s)); { ENV();
                unsigned bad = 0u; const unsigned long long* B2 = (const unsigned long long*)out;
                for (size_t i = (size_t)bid * 512 + tid; i < (size_t)MTOK * 64; i += (size_t)GG * 512) bad += (BM[i] != B2[i]) ? 1u : 0u;
                if (bad) __hip_atomic_fetch_add(ctl + 2048, bad, RLX_AGENT); } }
#endif
            SEAM(gp0 + 2);
            for (int rep = 0; rep < REPS(3); ++rep) { if (rep) xcd_barrier(bar, otid(wave_s));
            if (IN(gp0 + 3)) { ENV();
                gu32* qh = ctl + CW_QUEUE + 64 * (layer * 4 + 1 + 2 * rep);
                for (;;) {
                    if (tid == 0) MISCp[4] = __hip_atomic_fetch_add(qh, 1u, RLX_AGENT);
                    __syncthreads();
                    const int u = (int)MISCp[4];
                    if (u >= 1024) break;
                    const int i = u >> 1; att::UnitArgs a;
                    if ((u & 1) == 0) { if (EN(3) && !(rep == 1 && ((REP_MASK >> 18) & 1))) {
                        const int qb = 15 - (i >> 5), bh = i & 31, b = bh >> 2, h = bh & 3; const size_t r0 = (size_t)b * SEQ + qb * 256 + 32 * wave;
                        a.Q = EP + r0 * N_E_IN + 1536 + 128 * h; a.ldq = N_E_IN; a.K = EP + (size_t)b * SEQ * N_E_IN + 2048 + 128 * h; a.ldk = N_E_IN; a.V = EP + (size_t)b * SEQ * N_E_IN + 2560 + 128 * h; a.ldv = N_E_IN;
                        a.O = AOE + r0 * DM + 512 + 128 * h; a.ldo = DM; a.qlo = qb * 256 + 32 * wave; a.NT = 4 * (qb + 1); a.kbias = cumb + (size_t)h * MTOK + (size_t)b * SEQ; a.bm = nullptr; a.tid = tid; a.gq = PTR(7) + li * 128; a.gk = PTR(8) + li * 128;
                        att::attn_unit<128, 1>(a, glds); }
                    } else if (EN(4) && !(rep == 1 && ((REP_MASK >> 19) & 1))) {
                        const int j = 63 - (i >> 3), b = i & 7, head = wave >> 1, sub = wave & 1; const size_t r0 = (size_t)b * SEQ + j * 64 + 32 * sub;
                        a.Q = EP + r0 * N_E_IN + 128 * head; a.ldq = N_E_IN; a.K = EP + (size_t)b * SEQ * N_E_IN + 512; a.ldk = N_E_IN; a.V = EP + (size_t)b * SEQ * N_E_IN + 640; a.ldv = N_E_IN;
                        a.O = AOE + r0 * DM + 128 * head; a.ldo = DM; a.qlo = j * 64 + 32 * sub; a.NT = j + 1; a.kbias = nullptr; a.bm = BM + r0 * 64; a.tid = tid; a.gq = PTR(5) + li * 128; a.gk = PTR(6) + li * 128;
                        att::attn_unit<128, 2>(a, glds);
                    }
                }
            }
            }
            SEAM(gp0 + 3);
            if (EN(5) && IN(gp0 + 4)) { ENV();
                pg8::Gemm g{AOE, (const bf16*)(wsw + WE_OUT), MTOK, DM, DM, DM}; pg8::StaticOrder S; S.init(MTOK, DM, GG, bid);
                pg8::EpiResid E{XB, ssp, stat, (float*)nullptr};
                pg8::gemm_phase<pg8::EpiResid, pg8::StaticOrder, true, true>(L_, g, S, E, tid);
            }
            SEAM2(gp0 + 4, gp0 + 6);
        } else {
            for (int rep = 0; rep < REPS(6); ++rep) { if (rep) xcd_barrier(bar, otid(wave_s));
            if (EN(6) && IN(gp0 + 0)) { ENV();
                pg8::Gemm g{XB, (const bf16*)(wsw + WO_IN), MTOK, N_O_IN, DM, DM}; pg8::StaticOrder S; S.init(MTOK, N_O_IN, GG, bid);
                pg8::EpiOddIn E{C1, AO, XBC, ssp, gss, misc32, PTR(20) + li * 16, stat};
                pg8::gemm_phase<pg8::EpiOddIn, pg8::StaticOrder, true, true>(L_, g, S, E, tid);
            }
            }
            SEAM(gp0 + 0);
            for (int rep = 0; rep < REPS(7); ++rep) { if (rep) xcd_barrier(bar, otid(wave_s));
            if (EN(7) && IN(gp0 + 1)) { ENV();
                if (rep == 0) for (int u = bid; u < 256; u += GG) ssd::conv_halo_save(XBC, (bf16*)(ws + WS_BM), u, tid);
                if (EN(12)) { pg8::Gemm g{C1, (const bf16*)(wsw + WO_UQ), MTOK, 1024, 384, 768}; pg8::StaticOrder S; S.init(MTOK, 1024, GG, bid);
                  pg8::EpiUq E{QB, gss, PTR(16) + li * 192, rope, stat};
                  pg8::gemm_phase<pg8::EpiUq, pg8::StaticOrder, true, true>(L_, g, S, E, tid); }
                if (EN(13)) { pg8::Gemm g{C1 + 384, (const bf16*)(wsw + WO_UKV), MTOK, 1024, 256, 768}; pg8::StaticOrder S; S.init(MTOK, 1024, GG, bid);
                  pg8::EpiUkv E{KK, VV, C1, gss, PTR(17) + li * 192, rope, stat};
                  pg8::gemm_phase<pg8::EpiUkv, pg8::StaticOrder, true, true>(L_, g, S, E, tid); }
            }
            }
            SEAM(gp0 + 1);
            if (IN(gp0 + 2)) { ENV();
                for (int u = bid; u < 256; u += GG) ssd::conv_unit(XBC, (const bf16*)(ws + WS_BM), PTR(18) + (size_t)li * 4 * 2048, PTR(19) + li * 2048, u, tid);
            }
            SEAM(gp0 + 2);
            for (int rep = 0; rep < REPS(9); ++rep) { if (rep) xcd_barrier(bar, otid(wave_s));
            if (IN(gp0 + 3)) { ENV();
                gu32* qh = ctl + CW_QUEUE + 64 * (layer * 4 + 0 + 2 * rep);
                for (;;) {
                    if (tid == 0) MISCp[4] = __hip_atomic_fetch_add(qh, 1u, RLX_AGENT);
                    __syncthreads();
                    const int u = (int)MISCp[4];
                    if (u >= 128 + 512) break;
                    if (u < 128) { if (EN(8) && rep == 0) { const int b = u >> 4, h = u & 15;
                        ssd::ssd_unit(XBC, AO, AO + 512, K_O_OUT, misc32, ssy, PTR(21)[li * 16 + h], PTR(22)[li * 16 + h], b, h, glds, glds + LDS_STAT, tid); }
                    } else if (EN(9)) { const int i = u - 128; const int qb = 15 - (i >> 5), bh = i & 31, b = bh >> 2, h = bh & 3; const size_t r0 = (size_t)b * SEQ + qb * 256 + 32 * wave; att::UnitArgs a;
                        a.Q = QB + r0 * 768 + 192 * h; a.ldq = 768; a.K = KK + (size_t)b * SEQ * 768 + 192 * h; a.ldk = 768; a.V = VV + (size_t)b * SEQ * 512 + 128 * h; a.ldv = 512;
                        a.O = AO + r0 * K_O_OUT + 128 * h; a.ldo = K_O_OUT; a.qlo = qb * 256 + 32 * wave; a.NT = 4 * (qb + 1); a.kbias = nullptr; a.bm = nullptr; a.tid = tid; a.gq = PTR(16) + li * 192; a.gk = PTR(17) + li * 192;
                        att::attn_unit<192, 0>(a, glds);
                    }
                }
            }
            }
#if defined(PROBE_SSD)
            if (IN(gp0 + 3)) { xcd_barrier(bar, otid(wave_s)); { ENV();
                for (int u = bid; u < 128; u += GG) { const int b = u >> 4, h = u & 15;
                    ssd::ssd_unit(XBC, AO, (bf16*)out + (size_t)24 * 1024 * 1024, 1024, misc32, (float*)(ws + WS_BM), PTR(21)[li * 16 + h], PTR(22)[li * 16 + h], b, h, glds, glds + LDS_STAT, tid); } } }
#endif
            SEAM2(gp0 + 3, gp0 + 5);
            if (EN(5) && IN(gp0 + 5)) { ENV();
                pg8::Gemm g{AO, (const bf16*)(wsw + WO_OUT), MTOK, DM, K_O_OUT, K_O_OUT}; pg8::StaticOrder S; S.init(MTOK, DM, GG, bid);
                pg8::EpiResid E{XB, ssp, stat, (float*)nullptr};
                const pg8::GroupScaleHook HK{ssy, (PG8_LAS float*)(L_ + LDS_FAC)};
                pg8::gemm_phase<pg8::EpiResid, pg8::StaticOrder, true, true, pg8::GroupScaleHook>(L_, g, S, E, tid, HK);
            }
            SEAM(gp0 + 5);
        }
        for (int rep = 0; rep < REPS(5); ++rep) { if (rep) xcd_barrier(bar, otid(wave_s));
        if (EN(11) && IN(gp0 + 6)) { ENV();
            pg8::Gemm g{XB, W1t, MTOK, DFF, DM, DM}; pg8::StaticOrder S; S.init(MTOK, DFF, GG, bid);
            pg8::EpiMlpUp E{HB, ssp};
            pg8::gemm_phase<pg8::EpiMlpUp, pg8::StaticOrder, true, true>(L_, g, S, E, tid);
        }
        }
        SEAM(gp0 + 6);
        if (EN(5) && IN(gp0 + 7)) { ENV();
            pg8::Gemm g{HB, W2t, MTOK, DM, DFF, DFF}; pg8::StaticOrder S; S.init(MTOK, DM, GG, bid);
            pg8::EpiResid E{XB, ssp, stat, layer == 3 ? out : (float*)nullptr};
            pg8::gemm_phase<pg8::EpiResid, pg8::StaticOrder, true, true>(L_, g, S, E, tid);
        }
        if (layer < 3) SEAM(gp0 + 7);
    }
#if defined(TKS_CHECK)
    { ENV_NOLAYER();
      xcd_barrier(bar, otid(wave_s));
      if (bid == 0 && tid == 0) { const unsigned nb = __hip_atomic_load((gu32*)(ws + WS_CTL) + 2048, RLX_AGENT); if (nb) ((float*)PTR(28))[0] = 100.0f * (1.0f + log2f(1.0f + (float)nb)); } }
#endif
#if defined(TPROF)
    { ENV_NOLAYER();
      xcd_barrier(bar, otid(wave_s)); TSTAMP(31);
      __syncthreads();
      if (bid == 0) { volatile LAS unsigned* ts = (volatile LAS unsigned*)(L_ + LDS_MISC + 384);
          const float v1 = (float)(ts[TPROF_A1] - ts[TPROF_A0]) * 0.25f;
          const float v2 = (TPROF_B1 > 0) ? (float)(ts[TPROF_B1] - ts[TPROF_B0]) * (1.0f / 64.0f) : 1000.0f;
          if (tid == 0) out[0] = v1;
          for (int i = 1 + tid; i <= 1048576; i += 512) out[i] = v2; } }
#endif
#if defined(DBG_STOP)
    { ENV_NOLAYER();
      xcd_barrier(bar, otid(wave_s));
      const size_t n = (size_t)MTOK * DM;
      for (size_t i = (size_t)bid * 512 + tid; i < n; i += (size_t)GG * 512) {
          float v;
#if DBG_KIND == 0
          v = __uint_as_float(((unsigned)((const bf16*)(ws + (size_t)DBG_OFF))[i]) << 16);
#elif DBG_KIND == 1
          v = ((const float*)(ws + (size_t)DBG_OFF))[i];
#elif DBG_KIND == 2
          v = out[i];
#else
          v = (float)(((const unsigned*)(ws + (size_t)DBG_OFF))[i] & 0xffffu);
#endif
          if (!(fabsf(v) < 1e30f)) v = 30000.0f;
          out[i] = v; } }
#endif
#undef IN
#undef SEAM
#undef PTR
#undef ENV
}

#ifndef MK_SPLIT
#define MK_SPLIT 0
#endif
extern "C" void kernel_launch(void* const* d_in, const int* in_sizes, int n_in, void* d_out, int out_size, void* d_ws, size_t ws_size, hipStream_t stream) {
    static int grid = 0;
    if (grid == 0) {
        if (n_in != 28 || out_size != MTOK * DM || ws_size < WS_END) { fprintf(stderr, "kernel_launch: unexpected problem shape (n_in %d, out %d, ws %zu)\n", n_in, out_size, ws_size); grid = -1; return; }
        int dev = 0, cus = 0, per_cu = 0;
        if (hipGetDevice(&dev) != hipSuccess || hipDeviceGetAttribute(&cus, hipDeviceAttributeMultiprocessorCount, dev) != hipSuccess) { grid = -1; return; }
        if (hipFuncSetAttribute((const void*)trunk_fwd, hipFuncAttributeMaxDynamicSharedMemorySize, LDS_BYTES) != hipSuccess) { fprintf(stderr, "kernel_launch: hipFuncSetAttribute failed\n"); grid = -1; return; }
        if (hipOccupancyMaxActiveBlocksPerMultiprocessor(&per_cu, (const void*)trunk_fwd, NWAVES * 64, LDS_BYTES) != hipSuccess || per_cu < 1) { fprintf(stderr, "kernel_launch: occupancy query says %d\n", per_cu); }
        (void)hipGetLastError();
        grid = cus;
    }
    if (grid < 0) return;
    (void)hipMemsetAsync((char*)d_ws + WS_CTL, 0, CTL_ZERO_BYTES, stream);
    Args a{};
    for (int i = 0; i < 28; ++i) a.in[i] = (const float*)d_in[i];
    a.out = (float*)d_out; a.ws = (unsigned char*)d_ws;
#if MK_SPLIT
    for (int p = 0; p < 32; ++p) { a.ph_lo = p; a.ph_hi = p + 1; hipLaunchKernelGGL(trunk_fwd, dim3(grid), dim3(NWAVES * 64), LDS_BYTES, stream, a); }
#else
#if defined(DBG_STOP)
    a.ph_lo = 0; a.ph_hi = DBG_STOP;
#else
    a.ph_lo = 0; a.ph_hi = 32;
#endif
    hipLaunchKernelGGL(trunk_fwd, dim3(grid), dim3(NWAVES * 64), LDS_BYTES, stream, a);
#endif
}
```
